# Optimizing an MI355X kernel written in HIP

```python
import math
import jax
import jax.numpy as jnp
from jax import lax
import numpy as np

D_MODEL = 1024
BATCH = 8
SEQ = 4096
DEPTH = 2

HEAD_DIM = 64
N_HEADS_DIFF = D_MODEL // (2 * HEAD_DIM)
DIFF_QK_DIM = HEAD_DIM // 2
N_HEADS_DIL = D_MODEL // (2 * HEAD_DIM)
N_ATTN_HEADS = N_HEADS_DIFF + N_HEADS_DIL
DIL_PAIRS = ((128, 1), (512, 4), (2048, 16))
ATTN_BLOCK = 128
SSM_GROUP_WIDTH = 16
SSM_GROUPS = D_MODEL // SSM_GROUP_WIDTH
SSM_STATE = 64
SSM_CHUNK = 128
D_FF = 2816
N_EXPERTS = 8
TOP_K = 2
D_FF_EXPERT = 1408
DN_ALPHA = (2.0 * DEPTH) ** 0.25
DN_BETA = (8.0 * DEPTH) ** -0.25
EPS = 1e-5
F32 = jnp.float32

kernel_name = 'hybrid_diff_dilated_s5_moe_block'


def _layernorm(x, g, b):
    xf = x.astype(F32)
    mu = jnp.mean(xf, axis=-1, keepdims=True)
    var = jnp.mean(jnp.square(xf - mu), axis=-1, keepdims=True)
    y = (xf - mu) * lax.rsqrt(var + EPS)
    return (y * g.astype(F32) + b.astype(F32)).astype(x.dtype)


def _rmsnorm(x, w):
    xf = x.astype(F32)
    y = xf * lax.rsqrt(jnp.mean(jnp.square(xf), axis=-1, keepdims=True) + EPS)
    return (y * w.astype(F32)).astype(x.dtype)


def _ada(c, w, b):
    mod = jax.nn.silu(c) @ w + b
    return jnp.split(mod[:, None, :], 6, axis=-1)


def _swiglu(h, w_gate, w_up, w_down):
    return (jax.nn.silu(h @ w_gate) * (h @ w_up)) @ w_down


def _alibi_slopes():
    i = jnp.arange(N_ATTN_HEADS, dtype=F32) + 1.0
    return jnp.exp2(-8.0 * i / N_ATTN_HEADS)


def _diff_attention(q, k, v, lam, slopes):
    bsz, n_h, s_len, _, dq = q.shape
    nb = s_len // ATTN_BLOCK
    qb = q.reshape(bsz, n_h, nb, ATTN_BLOCK, 2, dq).transpose(2, 0, 1, 3, 4, 5)
    scale = dq ** -0.5
    spos = jnp.arange(s_len)
    lam = lam.astype(F32)

    def block(args):
        i, qi = args
        s = jnp.einsum('bhqmd,bhkmd->bhmqk', qi, k).astype(F32) * scale
        dist = (i * ATTN_BLOCK + jnp.arange(ATTN_BLOCK))[:, None] - spos[None, :]
        bias = -slopes[:, None, None, None] * dist.astype(F32)
        s = jnp.where(dist >= 0, s + bias, -jnp.inf)
        p = jax.nn.softmax(s, axis=-1).astype(v.dtype)
        o = jnp.einsum('bhmqk,bhkd->bhmqd', p, v)
        return o[:, :, 0] - lam.astype(o.dtype) * o[:, :, 1]

    o = lax.map(block, (jnp.arange(nb), qb))
    return o.transpose(1, 2, 0, 3, 4).reshape(bsz, n_h, s_len, -1)


def _dilated_branch(q, k, v, slopes, window, dilation):
    bsz, n_h, s_len, dh = q.shape
    blk = ATTN_BLOCK
    n_back = window // dilation
    sub_len = -(-s_len // dilation)
    sub_len = -(-sub_len // blk) * blk
    s_pad = sub_len * dilation
    nb = sub_len // blk
    pad = ((0, 0), (0, 0), (0, s_pad - s_len), (0, 0))

    def strided(a):
        a = jnp.pad(a, pad).reshape(bsz, n_h, sub_len, dilation, dh).transpose(0, 1, 3, 2, 4)
        return a.reshape(bsz, n_h, dilation, nb, blk, dh)

    def with_prev(a):
        prev = jnp.pad(a, ((0, 0),) * 3 + ((1, 0), (0, 0), (0, 0)))[:, :, :, :-1]
        return jnp.concatenate([prev, a], axis=4)

    qs = strided(q)
    kc = with_prev(strided(k))
    vc = with_prev(strided(v))
    s = jnp.einsum('bhrnqd,bhrnkd->bhrnqk', qs, kc).astype(F32) * (dh ** -0.5)
    qi = np.arange(blk)[:, None]
    kj = np.arange(2 * blk)[None, :]
    dist = qi + blk - kj
    valid = (dist >= 0) & (dist <= n_back)
    mask = valid[None] & ((np.arange(nb)[:, None, None] > 0) | (kj[None] >= blk))
    bias = -slopes[:, None, None, None, None] * jnp.asarray(dist * dilation, F32)
    s = jnp.where(mask, s + bias, -jnp.inf)
    lse = jax.nn.logsumexp(s, axis=-1)
    p = jnp.exp(s - lse[..., None]).astype(v.dtype)
    o = jnp.einsum('bhrnqk,bhrnkd->bhrnqd', p, vc)
    o = o.reshape(bsz, n_h, dilation, sub_len, dh).transpose(0, 1, 3, 2, 4)
    o = o.reshape(bsz, n_h, s_pad, dh)[:, :, :s_len]
    lse = lse.reshape(bsz, n_h, dilation, sub_len).transpose(0, 1, 3, 2)
    lse = lse.reshape(bsz, n_h, s_pad)[:, :, :s_len]
    return o, lse


def _dilated_mixture(q, k, v, slopes):
    outs, lses = [], []
    for window, dilation in DIL_PAIRS:
        o, l = _dilated_branch(q, k, v, slopes, window, dilation)
        outs.append(o)
        lses.append(l)
    wts = jax.nn.softmax(jnp.stack(lses), axis=0).astype(q.dtype)
    return jnp.einsum('gbhs,gbhsd->bhsd', wts, jnp.stack(outs))


def _hybrid_attention(h, layer_idx, w_in, lam_q1, lam_k1, lam_q2, lam_k2, subln_w, w_out):
    bsz, s_len, _ = h.shape
    proj = h @ w_in
    aq, ak, av, bq, bk, bv = jnp.split(proj, 6, axis=-1)
    slopes = _alibi_slopes()
    q = aq.reshape(bsz, s_len, N_HEADS_DIFF, 2, DIFF_QK_DIM).transpose(0, 2, 1, 3, 4)
    k = ak.reshape(bsz, s_len, N_HEADS_DIFF, 2, DIFF_QK_DIM).transpose(0, 2, 1, 3, 4)
    v = av.reshape(bsz, s_len, N_HEADS_DIFF, HEAD_DIM).transpose(0, 2, 1, 3)
    lam_init = 0.8 - 0.6 * math.exp(-0.3 * layer_idx)
    lam = (jnp.exp(jnp.sum(lam_q1.astype(F32) * lam_k1.astype(F32)))
           - jnp.exp(jnp.sum(lam_q2.astype(F32) * lam_k2.astype(F32))) + lam_init)
    oa = _diff_attention(q, k, v, lam, slopes[:N_HEADS_DIFF])
    oa = _rmsnorm(oa, subln_w) * (1.0 - lam_init)
    q = bq.reshape(bsz, s_len, N_HEADS_DIL, HEAD_DIM).transpose(0, 2, 1, 3)
    k = bk.reshape(bsz, s_len, N_HEADS_DIL, HEAD_DIM).transpose(0, 2, 1, 3)
    v = bv.reshape(bsz, s_len, N_HEADS_DIL, HEAD_DIM).transpose(0, 2, 1, 3)
    ob = _dilated_mixture(q, k, v, slopes[N_HEADS_DIFF:])
    o = jnp.concatenate([oa, ob], axis=1).transpose(0, 2, 1, 3).reshape(bsz, s_len, D_MODEL)
    return o @ w_out


def _cplx_combine(e1, e2):
    a1r, a1i, b1r, b1i = e1
    a2r, a2i, b2r, b2i = e2
    return (a2r * a1r - a2i * a1i,
            a2r * a1i + a2i * a1r,
            a2r * b1r - a2i * b1i + b2r,
            a2r * b1i + a2i * b1r + b2i)


def _s5(h, a_re, a_im, log_dt, b_re, b_im, c_re, c_im, d_skip):
    bsz, s_len, _ = h.shape
    u = h.astype(F32)
    ar, ai = a_re.astype(F32), a_im.astype(F32)
    dt = jnp.exp(log_dt.astype(F32))[:, None]
    mag = jnp.exp(dt * ar)
    abr, abi = mag * jnp.cos(dt * ai), mag * jnp.sin(dt * ai)
    den = ar * ar + ai * ai
    nr, ni = abr - 1.0, abi
    zr, zi = (nr * ar + ni * ai) / den, (ni * ar - nr * ai) / den
    br, bi = b_re.astype(F32), b_im.astype(F32)
    bbr = zr[..., None] * br - zi[..., None] * bi
    bbi = zr[..., None] * bi + zi[..., None] * br
    cr, ci = c_re.astype(F32), c_im.astype(F32)
    n_chunks = s_len // SSM_CHUNK
    uc = u.reshape(bsz, n_chunks, SSM_CHUNK, SSM_GROUPS, SSM_GROUP_WIDTH).transpose(1, 2, 0, 3, 4)

    def chunk(carry, uk):
        h0r, h0i = carry
        xr = jnp.einsum('lbgc,gpc->lbgp', uk, bbr)
        xi = jnp.einsum('lbgc,gpc->lbgp', uk, bbi)
        a_r = jnp.broadcast_to(abr, xr.shape)
        a_i = jnp.broadcast_to(abi, xr.shape)
        cum_r, cum_i, hr, hi = lax.associative_scan(_cplx_combine, (a_r, a_i, xr, xi), axis=0)
        hr, hi = hr + cum_r * h0r - cum_i * h0i, hi + cum_r * h0i + cum_i * h0r
        y = jnp.einsum('lbgp,gcp->lbgc', hr, cr) - jnp.einsum('lbgp,gcp->lbgc', hi, ci)
        return (hr[-1], hi[-1]), y

    init = (jnp.zeros((bsz, SSM_GROUPS, SSM_STATE), F32),) * 2
    _, y = lax.scan(chunk, init, uc)
    y = y.transpose(2, 0, 1, 3, 4).reshape(bsz, s_len, D_MODEL)
    return (y + d_skip.astype(F32) * u).astype(h.dtype)


def _moe(h, router_w, router_b, w_gate, w_up, w_down):
    logits = (h @ router_w).astype(F32) + router_b.astype(F32)
    top_v, top_i = lax.top_k(logits, TOP_K)
    gates = jax.nn.softmax(top_v, axis=-1)
    cw = jnp.sum(jax.nn.one_hot(top_i, N_EXPERTS, dtype=F32) * gates[..., None], axis=-2)
    cw = cw.astype(h.dtype)
    y = jnp.zeros_like(h)
    for e in range(N_EXPERTS):
        y = y + cw[..., e:e + 1] * _swiglu(h, w_gate[e], w_up[e], w_down[e])
    return y


def _attention_layer(x, c, layer_idx, ada_w, ada_b, w_in, lam_q1, lam_k1, lam_q2, lam_k2,
                     subln_w, w_out, ln1_g, ln1_b, ffn_w_gate, ffn_w_up, ffn_w_down, ln2_g, ln2_b):
    sh1, sc1, g1, sh2, sc2, g2 = _ada(c, ada_w, ada_b)
    y = _hybrid_attention(x * (1.0 + sc1) + sh1, layer_idx, w_in, lam_q1, lam_k1, lam_q2, lam_k2,
                          subln_w, w_out)
    x = _layernorm(DN_ALPHA * x + (1.0 + g1) * y, ln1_g, ln1_b)
    y = _swiglu(x * (1.0 + sc2) + sh2, ffn_w_gate, ffn_w_up, ffn_w_down)
    return _layernorm(DN_ALPHA * x + (1.0 + g2) * y, ln2_g, ln2_b)


def _ssm_layer(x, c, ada_w, ada_b, a_re, a_im, log_dt, b_re, b_im, c_re, c_im, d_skip, w_glu, b_glu,
               ln1_g, ln1_b, router_w, router_b, exp_w_gate, exp_w_up, exp_w_down, ln2_g, ln2_b):
    sh1, sc1, g1, sh2, sc2, g2 = _ada(c, ada_w, ada_b)
    y = _s5(x * (1.0 + sc1) + sh1, a_re, a_im, log_dt, b_re, b_im, c_re, c_im, d_skip)
    z = jax.nn.gelu(y) @ w_glu + b_glu
    y = z[..., :D_MODEL] * jax.nn.sigmoid(z[..., D_MODEL:])
    x = _layernorm(DN_ALPHA * x + (1.0 + g1) * y, ln1_g, ln1_b)
    y = _moe(x * (1.0 + sc2) + sh2, router_w, router_b, exp_w_gate, exp_w_up, exp_w_down)
    return _layernorm(DN_ALPHA * x + (1.0 + g2) * y, ln2_g, ln2_b)


def setup_inputs(seed: int = 0) -> dict:
    key = jax.random.key(seed)
    ks = iter(jax.random.split(key, 64))
    D = D_MODEL

    def nrm(shape, scale):
        return jax.random.normal(next(ks), shape, F32) * scale

    def gain(n):
        return 1.0 + nrm((n,), 0.01)

    ada_scale = 0.1 * D ** -0.5
    v_cols = jnp.concatenate([jnp.ones((D,), F32), jnp.full((D // 2,), DN_BETA, F32),
                              jnp.ones((D,), F32), jnp.full((D // 2,), DN_BETA, F32)])
    n_idx = jnp.arange(SSM_STATE, dtype=F32)[None, :]
    p = {}
    p['x'] = nrm((BATCH, SEQ, D), 1.0)
    p['c'] = nrm((BATCH, D), 1.0)
    p['l0_ada_w'] = nrm((D, 6 * D), ada_scale)
    p['l0_ada_b'] = nrm((6 * D,), 0.01)
    p['l0_w_in'] = nrm((D, 3 * D), D ** -0.5) * v_cols
    p['l0_lam_q1'] = nrm((DIFF_QK_DIM,), 0.1)
    p['l0_lam_k1'] = nrm((DIFF_QK_DIM,), 0.1)
    p['l0_lam_q2'] = nrm((DIFF_QK_DIM,), 0.1)
    p['l0_lam_k2'] = nrm((DIFF_QK_DIM,), 0.1)
    p['l0_subln_w'] = gain(HEAD_DIM)
    p['l0_w_out'] = nrm((D, D), DN_BETA * D ** -0.5)
    p['l0_ln1_g'] = gain(D)
    p['l0_ln1_b'] = nrm((D,), 0.01)
    p['l0_ffn_w_gate'] = nrm((D, D_FF), D ** -0.5)
    p['l0_ffn_w_up'] = nrm((D, D_FF), D ** -0.5)
    p['l0_ffn_w_down'] = nrm((D_FF, D), DN_BETA * D_FF ** -0.5)
    p['l0_ln2_g'] = gain(D)
    p['l0_ln2_b'] = nrm((D,), 0.01)
    p['l1_ada_w'] = nrm((D, 6 * D), ada_scale)
    p['l1_ada_b'] = nrm((6 * D,), 0.01)
    p['l1_a_re'] = -0.5 + nrm((SSM_GROUPS, SSM_STATE), 0.01)
    p['l1_a_im'] = math.pi * n_idx + nrm((SSM_GROUPS, SSM_STATE), 0.01)
    p['l1_log_dt'] = jax.random.uniform(next(ks), (SSM_GROUPS,), F32, math.log(1e-3), math.log(1e-1))
    p['l1_b_re'] = nrm((SSM_GROUPS, SSM_STATE, SSM_GROUP_WIDTH), (2.0 * SSM_GROUP_WIDTH) ** -0.5)
    p['l1_b_im'] = nrm((SSM_GROUPS, SSM_STATE, SSM_GROUP_WIDTH), (2.0 * SSM_GROUP_WIDTH) ** -0.5)
    p['l1_c_re'] = nrm((SSM_GROUPS, SSM_GROUP_WIDTH, SSM_STATE), (2.0 * SSM_STATE) ** -0.5)
    p['l1_c_im'] = nrm((SSM_GROUPS, SSM_GROUP_WIDTH, SSM_STATE), (2.0 * SSM_STATE) ** -0.5)
    p['l1_d_skip'] = nrm((D,), 0.5)
    p['l1_w_glu'] = nrm((D, 2 * D), DN_BETA * D ** -0.5)
    p['l1_b_glu'] = nrm((2 * D,), 0.01)
    p['l1_ln1_g'] = gain(D)
    p['l1_ln1_b'] = nrm((D,), 0.01)
    p['l1_router_w'] = nrm((D, N_EXPERTS), D ** -0.5)
    p['l1_router_b'] = nrm((N_EXPERTS,), 0.01)
    p['l1_exp_w_gate'] = nrm((N_EXPERTS, D, D_FF_EXPERT), D ** -0.5)
    p['l1_exp_w_up'] = nrm((N_EXPERTS, D, D_FF_EXPERT), D ** -0.5)
    p['l1_exp_w_down'] = nrm((N_EXPERTS, D_FF_EXPERT, D), DN_BETA * D_FF_EXPERT ** -0.5)
    p['l1_ln2_g'] = gain(D)
    p['l1_ln2_b'] = nrm((D,), 0.01)
    return p


def reference(x, c,
              l0_ada_w, l0_ada_b, l0_w_in, l0_lam_q1, l0_lam_k1, l0_lam_q2, l0_lam_k2, l0_subln_w,
              l0_w_out, l0_ln1_g, l0_ln1_b, l0_ffn_w_gate, l0_ffn_w_up, l0_ffn_w_down, l0_ln2_g, l0_ln2_b,
              l1_ada_w, l1_ada_b, l1_a_re, l1_a_im, l1_log_dt, l1_b_re, l1_b_im, l1_c_re, l1_c_im,
              l1_d_skip, l1_w_glu, l1_b_glu, l1_ln1_g, l1_ln1_b, l1_router_w, l1_router_b,
              l1_exp_w_gate, l1_exp_w_up, l1_exp_w_down, l1_ln2_g, l1_ln2_b):
    layer_params = (
        (l0_ada_w, l0_ada_b, l0_w_in, l0_lam_q1, l0_lam_k1, l0_lam_q2, l0_lam_k2, l0_subln_w,
         l0_w_out, l0_ln1_g, l0_ln1_b, l0_ffn_w_gate, l0_ffn_w_up, l0_ffn_w_down, l0_ln2_g, l0_ln2_b),
        (l1_ada_w, l1_ada_b, l1_a_re, l1_a_im, l1_log_dt, l1_b_re, l1_b_im, l1_c_re, l1_c_im,
         l1_d_skip, l1_w_glu, l1_b_glu, l1_ln1_g, l1_ln1_b, l1_router_w, l1_router_b,
         l1_exp_w_gate, l1_exp_w_up, l1_exp_w_down, l1_ln2_g, l1_ln2_b),
    )
    for i in range(DEPTH):
        if i % 2 == 0:
            x = _attention_layer(x, c, i, *layer_params[i])
        else:
            x = _ssm_layer(x, c, *layer_params[i])
    return x
```

```cpp
#include <hip/hip_runtime.h>
#include <cstdio>
#include <cstdint>

#ifndef MK_N_LAUNCHES
#define MK_N_LAUNCHES 1
#endif

namespace pg8 {
#define PG8_LAS __attribute__((address_space(3)))
typedef unsigned short h16_t;
typedef _Float16 f16x8 __attribute__((ext_vector_type(8)));
typedef _Float16 f16x2 __attribute__((ext_vector_type(2)));
typedef float f32x4 __attribute__((ext_vector_type(4)));
typedef unsigned u32x4 __attribute__((ext_vector_type(4)));
constexpr int BM = 256, BK = 64, HALF = 128, HTB = HALF * BK * 2  , STAGE_BYTES = 8 * HTB, NXCD = 8, WGM = 8;

__host__ __device__ __forceinline__ int lds_byte(int r, int c) { const int st = (r >> 4) * 2 + (c >> 5), rr = r & 15, cc = c & 31, ob = rr * 64 + cc * 2; return st * 1024 + (ob ^ (((ob >> 9) & 1) << 5)); }
__host__ __device__ __forceinline__ void stage_rc(int b, int& R, int& C) { const int st = b / 1024, sb = b % 1024, swz = sb ^ (((sb >> 9) & 1) << 5); R = (st >> 1) * 16 + swz / 64; C = (st & 1) * 32 + (swz % 64) / 2; }
__host__ __device__ __forceinline__ int perm32(int rho) { const int n = rho >> 4, i = rho & 15; return 8 * (i >> 2) + 4 * n + (i & 3); }

struct Unit { int pm, pn; };
struct Gemm { const h16_t* A; const h16_t* Bt; int M, N, K; };

struct StaticOrder {
    int nM, nN, nwg, G, c;
    __host__ __device__ void init(int M, int N, int G_, int c_) { nM = M / BM; nN = N / BM; nwg = nM * nN; G = G_; c = c_; }
    __host__ __device__ bool next(int i, Unit& u) const {
        const long L = (long)i * G + c; if (L >= nwg) return false;
        int wgid = (int)L; { const int q = nwg / NXCD, r = nwg % NXCD, xcd = wgid % NXCD, off = wgid / NXCD; wgid = (xcd < r ? xcd * (q + 1) : r * (q + 1) + (xcd - r) * q) + off; }
        const int nig = WGM * nN, gid = wgid / nig, fm = gid * WGM, gsz = (nM - fm) < WGM ? (nM - fm) : WGM;
        u.pm = fm + ((wgid % nig) % gsz); u.pn = (wgid % nig) / gsz; return true;
    }
    __device__ __forceinline__ void a_ready(const Unit&) const {}
    __device__ __forceinline__ void done(const Unit&) const {}
};
struct MoeOrder {
    int tp[9]; int nN, G, c;
    __device__ bool next(int i, Unit& u) const {
        const long L = (long)i * G + c; const int T = tp[8]; if (L >= (long)T * nN) return false;
        const int rt = (int)(L / nN), cn = (int)(L % nN); int e = 0;
#pragma unroll
        for (int k = 1; k < 8; ++k) e += (rt >= tp[k]) ? 1 : 0;
        u.pm = rt; u.pn = e * nN + cn; return true;
    }
    __device__ __forceinline__ void a_ready(const Unit&) const {}
    __device__ __forceinline__ void done(const Unit&) const {}
};

__device__ __forceinline__ unsigned pk2h(float lo, float hi) { f16x2 v = {(_Float16)lo, (_Float16)hi}; return __builtin_bit_cast(unsigned, v); }
__device__ __forceinline__ float fast_sigmoid(float v) { return __builtin_amdgcn_rcpf(1.0f + __builtin_amdgcn_exp2f(-1.4426950408889634f * v)); }

struct EpiF16 {
    static constexpr bool PERM = true, AFTER_DRAIN = false;
    h16_t* O; int ldc; int nmod; float sA; float sB;
    __device__ __forceinline__ void operator()(const f32x4 (&acc)[2][2][4][2], const Unit& u, int wr, int wc, int fr, int fq) const {
        const int row0 = u.pm * BM + wr * 64 + fr; const int pn = u.pn % nmod;
        float sc = 1.f; if (sA != 0.f) { if (pn < 2) sc = sA; else if (pn == 6 || pn == 7) sc = sB; }
        const int col0 = pn * BM + wc * 32 + 8 * fq;
#pragma unroll
        for (int ai = 0; ai < 2; ++ai)
#pragma unroll
            for (int m = 0; m < 4; ++m) { h16_t* rowp = O + (size_t)(row0 + ai * HALF + m * 16) * ldc + col0;
#pragma unroll
                for (int bj = 0; bj < 2; ++bj) { const f32x4 v0 = acc[ai][bj][m][0] * sc, v1 = acc[ai][bj][m][1] * sc;
                    u32x4 w; w.x = pk2h(v0[0], v0[1]); w.y = pk2h(v0[2], v0[3]); w.z = pk2h(v1[0], v1[1]); w.w = pk2h(v1[2], v1[3]);
                    *(u32x4*)(rowp + bj * HALF) = w; } }
    }
};

struct EpiQKV {
    static constexpr bool PERM = true, AFTER_DRAIN = false;
    h16_t* O; h16_t* KA; h16_t* KB1; h16_t* KB4; h16_t* KB16; unsigned* kmax; float sA, sB;
    __device__ __forceinline__ static int pi32(int r) { return (r & 0x13) | ((r & 4) << 1) | ((r & 8) >> 1); }
    __device__ __forceinline__ void operator()(const f32x4 (&acc)[2][2][4][2], const Unit& u, int wr, int wc, int fr, int fq) const {
        const int row0 = u.pm * BM + wr * 64 + fr, pn = u.pn;
        const bool isKA = (pn == 2 || pn == 3), isKB = (pn == 8 || pn == 9);
        if (!isKA && !isKB) {
            const float sc = (pn < 2) ? sA : (pn == 6 || pn == 7) ? sB : 1.0f;
            const int col0 = pn * BM + wc * 32 + 8 * fq;
#pragma unroll
            for (int ai = 0; ai < 2; ++ai)
#pragma unroll
                for (int m = 0; m < 4; ++m) { h16_t* rowp = O + (size_t)(row0 + ai * HALF + m * 16) * 3072 + col0;
#pragma unroll
                    for (int bj = 0; bj < 2; ++bj) { const f32x4 v0 = acc[ai][bj][m][0] * sc, v1 = acc[ai][bj][m][1] * sc;
                        u32x4 w; w.x = pk2h(v0[0], v0[1]); w.y = pk2h(v0[2], v0[3]); w.z = pk2h(v1[0], v1[1]); w.w = pk2h(v1[2], v1[3]);
                        *(u32x4*)(rowp + bj * HALF) = w; } }
            return;
        }
        const int b = u.pm >> 4;
        float mx[2] = {0.f, 0.f};
#pragma unroll
        for (int ai = 0; ai < 2; ++ai)
#pragma unroll
            for (int m = 0; m < 4; ++m) { const int t = (row0 + ai * HALF + m * 16) & 4095;
#pragma unroll
                for (int bj = 0; bj < 2; ++bj) { const f32x4 v0 = acc[ai][bj][m][0], v1 = acc[ai][bj][m][1];
                    u32x4 w; w.x = pk2h(v0[0], v0[1]); w.y = pk2h(v0[2], v0[3]); w.z = pk2h(v1[0], v1[1]); w.w = pk2h(v1[2], v1[3]);
                    const int cs = (pn & 1) * 256 + bj * HALF + wc * 32 + 8 * fq, h = cs >> 6, c8 = (cs & 63) >> 3, bh = b * 8 + h;
                    if (isKA) {
                        const int frag = (c8 >> 2) * 2 + ((c8 >> 1) & 1), hi = c8 & 1;
                        *(u32x4*)(KA + ((size_t)((bh * 128 + (t >> 5)) * 4 + frag) * 64 + hi * 32 + pi32(t & 31)) * 8) = w;
                        float q2 = (v0[0] * v0[0] + v0[1] * v0[1]) + (v0[2] * v0[2] + v0[3] * v0[3]) + (v1[0] * v1[0] + v1[1] * v1[1]) + (v1[2] * v1[2] + v1[3] * v1[3]);
                        q2 += __shfl_xor(q2, 16); q2 += __shfl_xor(q2, 32);
                        mx[bj] = fmaxf(mx[bj], q2);
                    } else {
                        const int sl = c8 >> 1, hi = c8 & 1;
                        { const int uu = t >> 5, r = t & 31; *(u32x4*)(KB1 + ((size_t)((bh * 128 + uu) * 4 + sl) * 64 + hi * 32 + pi32(r)) * 8) = w; }
                        { const int i = t >> 2, uu = (t & 3) * 32 + (i >> 5), r = i & 31; *(u32x4*)(KB4 + ((size_t)((bh * 128 + uu) * 4 + sl) * 64 + hi * 32 + pi32(r)) * 8) = w; }
                        { const int i = t >> 4, uu = (t & 15) * 8 + (i >> 5), r = i & 31; *(u32x4*)(KB16 + ((size_t)((bh * 128 + uu) * 4 + sl) * 64 + hi * 32 + pi32(r)) * 8) = w; }
                    } } }
        if (isKA) {
#pragma unroll
            for (int bj = 0; bj < 2; ++bj) { float v = mx[bj];
                v = fmaxf(v, __shfl_xor(v, 1)); v = fmaxf(v, __shfl_xor(v, 2)); v = fmaxf(v, __shfl_xor(v, 4)); v = fmaxf(v, __shfl_xor(v, 8));
                const int cs = (pn & 1) * 256 + bj * HALF + wc * 32;
                if ((threadIdx.x & 63) == 0) __hip_atomic_fetch_max(kmax + (b * 8 + (cs >> 6)) * 2 + ((cs >> 5) & 1), __float_as_uint(v * 1.002f), __ATOMIC_RELAXED, __HIP_MEMORY_SCOPE_AGENT); }
        }
    }
};

template <int MODE> struct EpiGated {
    static constexpr bool PERM = true, AFTER_DRAIN = false;
    h16_t* O; int ldc; int nmod; const float* bias;
    __device__ __forceinline__ void operator()(const f32x4 (&acc)[2][2][4][2], const Unit& u, int wr, int wc, int fr, int fq) const {
        const int row0 = u.pm * BM + wr * 64 + fr; const int pn = u.pn % nmod;
        const int col0 = pn * HALF + wc * 32 + 8 * fq;
        f32x4 ba[2], bb[2];
#pragma unroll
        for (int n = 0; n < 2; ++n) { if (MODE == 1) { ba[n] = *(const f32x4*)(bias + col0 + 4 * n); bb[n] = *(const f32x4*)(bias + 1024 + col0 + 4 * n); } else { ba[n] = (f32x4){0.f, 0.f, 0.f, 0.f}; bb[n] = ba[n]; } }
#pragma unroll
        for (int ai = 0; ai < 2; ++ai)
#pragma unroll
            for (int m = 0; m < 4; ++m) { h16_t* rowp = O + (size_t)(row0 + ai * HALF + m * 16) * ldc + col0;
                float r[8];
#pragma unroll
                for (int n = 0; n < 2; ++n)
#pragma unroll
                    for (int e = 0; e < 4; ++e) { const float a = acc[ai][0][m][n][e] + ba[n][e], b = acc[ai][1][m][n][e] + bb[n][e];
                        r[4 * n + e] = (MODE == 0) ? (a * fast_sigmoid(a)) * b : a * fast_sigmoid(b); }
                u32x4 w; w.x = pk2h(r[0], r[1]); w.y = pk2h(r[2], r[3]); w.z = pk2h(r[4], r[5]); w.w = pk2h(r[6], r[7]);
                *(u32x4*)rowp = w; }
    }
};

template <class Epi, class Sched, bool ALIGN_EPI = false, bool SP2 = false>
__device__ __forceinline__ void gemm_phase(PG8_LAS unsigned char* lds, const Gemm g, const Sched& S, const Epi& E) {
    const int tid = threadIdx.x, wid = __builtin_amdgcn_readfirstlane(tid >> 6), lane = tid & 63, wr = wid >> 2, wc = wid & 3, fr = lane & 15, fq = lane >> 4;
    const int K = g.K, nt = K / BK;
    unsigned voffA[2], voffB[2];
#pragma unroll
    for (int i = 0; i < 2; ++i) { int R, C; stage_rc(tid * 16 + i * 8192, R, C); const int Rb = Epi::PERM ? ((R & ~31) + perm32(R & 31)) : R;
        voffA[i] = (unsigned)(R * K + C) * 2u; voffB[i] = (unsigned)(Rb * K + C) * 2u; }
    const size_t kstep = (size_t)(BK * 2);
    const size_t hstep = (size_t)HALF * K * 2;
    const size_t tstep = 2 * hstep;
    const unsigned ldsw = (unsigned)wid * 1024u;
    const int aoff = lds_byte(wr * 64 + fr, fq * 8), boff = lds_byte(wc * 32 + fr, fq * 8);
#define PG8_SA(b, h) (((b) * 2 + (h)) * HTB)
#define PG8_SB(b, h) ((4 + (b) * 2 + (h)) * HTB)
#define PG8_STAGE(bufoff, gbase, voff) do { _Pragma("unroll") for (int _i = 0; _i < 2; ++_i) \
        __builtin_amdgcn_global_load_lds((const unsigned*)((const char*)(gbase) + (voff)[_i]), (PG8_LAS unsigned*)(lds + (bufoff) + ldsw + _i * 8192), 16, 0, 0); } while (0)
#define PG8_LDA(dst, b, h) do { _Pragma("unroll") for (int m = 0; m < 4; ++m) _Pragma("unroll") for (int k = 0; k < 2; ++k) dst[m][k] = *(const PG8_LAS f16x8*)(lds + PG8_SA(b, h) + aoff + m * 2048 + k * 1024); } while (0)
#define PG8_LDB(dst, b, h) do { _Pragma("unroll") for (int n = 0; n < 2; ++n) _Pragma("unroll") for (int k = 0; k < 2; ++k) dst[n][k] = *(const PG8_LAS f16x8*)(lds + PG8_SB(b, h) + boff + n * 2048 + k * 1024); } while (0)
#define PG8_MMA(ai, bj, At, Bt) do { __builtin_amdgcn_s_setprio(1); _Pragma("unroll") for (int m = 0; m < 4; ++m) _Pragma("unroll") for (int n = 0; n < 2; ++n) _Pragma("unroll") for (int k = 0; k < 2; ++k) \
        acc[ai][bj][m][n] = __builtin_amdgcn_mfma_f32_16x16x32_f16(Bt[n][k], At[m][k], acc[ai][bj][m][n], 0, 0, 0); __builtin_amdgcn_s_setprio(0); } while (0)
#define PG8_WAIT_V(n) asm volatile("s_waitcnt vmcnt(" #n ")" ::: "memory")
#define PG8_WAIT_L(n) asm volatile("s_waitcnt lgkmcnt(" #n ")" ::: "memory")
#define PG8_BAR __builtin_amdgcn_s_barrier()
#define PG8_SCHED __builtin_amdgcn_sched_barrier(0)
    Unit cur, nxt; int ui = 0;
    if (!S.next(0, cur)) return;
    f32x4 acc[2][2][4][2];
#pragma unroll
    for (int a = 0; a < 2; ++a)
#pragma unroll
        for (int b = 0; b < 2; ++b)
#pragma unroll
            for (int m = 0; m < 4; ++m)
#pragma unroll
                for (int n = 0; n < 2; ++n) acc[a][b][m][n] = (f32x4){0.f, 0.f, 0.f, 0.f};
    f16x8 At[4][2], B0[2][2], B1[2][2];
    const char* cA = (const char*)g.A + (size_t)cur.pm * tstep; const char* cB = (const char*)g.Bt + (size_t)cur.pn * tstep;
    S.a_ready(cur);
    if constexpr (SP2) {
        PG8_STAGE(PG8_SB(0, 0), cB, voffB); PG8_STAGE(PG8_SB(0, 1), cB + hstep, voffB); PG8_STAGE(PG8_SA(0, 0), cA, voffA); PG8_STAGE(PG8_SA(0, 1), cA + hstep, voffA);
        if (wr == 1) PG8_BAR;
        PG8_WAIT_V(2); PG8_BAR;
        PG8_STAGE(PG8_SB(1, 0), cB + kstep, voffB); PG8_STAGE(PG8_SA(1, 0), cA + kstep, voffA); PG8_STAGE(PG8_SB(1, 1), cB + hstep + kstep, voffB);
        PG8_WAIT_V(6); PG8_BAR;
    } else {
        PG8_STAGE(PG8_SB(0, 0), cB, voffB); PG8_STAGE(PG8_SA(0, 0), cA, voffA); PG8_STAGE(PG8_SB(0, 1), cB + hstep, voffB); PG8_STAGE(PG8_SA(0, 1), cA + hstep, voffA);
        if (wr == 1) PG8_BAR;
        PG8_WAIT_V(4); PG8_BAR;
        PG8_STAGE(PG8_SB(1, 0), cB + kstep, voffB); PG8_STAGE(PG8_SA(1, 0), cA + kstep, voffA); PG8_STAGE(PG8_SB(1, 1), cB + hstep + kstep, voffB);
        PG8_WAIT_V(6); PG8_BAR;
    }
    for (;;) {
        const bool has_next = S.next(ui + 1, nxt);
        const char* nA = has_next ? (const char*)g.A + (size_t)nxt.pm * tstep : cA; const char* nB = has_next ? (const char*)g.Bt + (size_t)nxt.pn * tstep : cB;
        for (int t = 0; t < nt; t += 2) {
            const bool last = (t == nt - 2);
            const char* a1 = cA + (size_t)(t + 1) * kstep;
            const char* a2 = last ? nA : cA + (size_t)(t + 2) * kstep; const char* b2 = last ? nB : cB + (size_t)(t + 2) * kstep;
            const char* a3 = a2 + kstep; const char* b3 = b2 + kstep;
            if (last && has_next) S.a_ready(nxt);
            if constexpr (SP2) {
            PG8_LDB(B0, 0, 0); PG8_LDB(B1, 0, 1); PG8_SCHED; PG8_LDA(At, 0, 0); PG8_STAGE(PG8_SA(1, 1), a1 + hstep, voffA);
            PG8_WAIT_V(8); PG8_WAIT_L(0); PG8_BAR; PG8_MMA(0, 0, At, B0); PG8_MMA(0, 1, At, B1); PG8_BAR; PG8_SCHED;
            PG8_LDA(At, 0, 1); PG8_STAGE(PG8_SB(0, 0), b2, voffB); PG8_STAGE(PG8_SB(0, 1), b2 + hstep, voffB); PG8_STAGE(PG8_SA(0, 0), a2, voffA);
            PG8_WAIT_V(8); PG8_WAIT_L(0); PG8_BAR; PG8_MMA(1, 0, At, B0); PG8_MMA(1, 1, At, B1); PG8_BAR; PG8_SCHED;
            PG8_LDB(B0, 1, 0); PG8_LDB(B1, 1, 1); PG8_SCHED; PG8_LDA(At, 1, 0); PG8_STAGE(PG8_SA(0, 1), a2 + hstep, voffA);
            PG8_WAIT_V(8); PG8_WAIT_L(0); PG8_BAR; PG8_MMA(0, 0, At, B0); PG8_MMA(0, 1, At, B1); PG8_BAR; PG8_SCHED;
            PG8_LDA(At, 1, 1); PG8_STAGE(PG8_SB(1, 0), b3, voffB); PG8_STAGE(PG8_SB(1, 1), b3 + hstep, voffB); PG8_STAGE(PG8_SA(1, 0), a3, voffA);
            PG8_WAIT_V(8); PG8_WAIT_L(0); PG8_BAR; PG8_MMA(1, 0, At, B0); PG8_MMA(1, 1, At, B1); PG8_BAR; PG8_SCHED;
            } else {
            PG8_LDB(B0, 0, 0); PG8_SCHED; PG8_LDA(At, 0, 0); PG8_STAGE(PG8_SA(1, 1), a1 + hstep, voffA);
            PG8_WAIT_L(8); PG8_BAR; PG8_WAIT_L(0); PG8_MMA(0, 0, At, B0); PG8_BAR; PG8_SCHED;
            PG8_LDB(B1, 0, 1); PG8_STAGE(PG8_SB(0, 0), b2, voffB);
            PG8_BAR; PG8_WAIT_L(0); PG8_MMA(0, 1, At, B1); PG8_BAR;
            PG8_LDA(At, 0, 1); PG8_STAGE(PG8_SA(0, 0), a2, voffA);
            PG8_BAR; PG8_WAIT_L(0); PG8_MMA(1, 0, At, B0); PG8_BAR; PG8_SCHED;
            PG8_STAGE(PG8_SB(0, 1), b2 + hstep, voffB);
            PG8_WAIT_V(6); PG8_BAR; PG8_MMA(1, 1, At, B1); PG8_BAR;
            PG8_LDB(B0, 1, 0); PG8_SCHED; PG8_LDA(At, 1, 0); PG8_STAGE(PG8_SA(0, 1), a2 + hstep, voffA);
            PG8_WAIT_L(8); PG8_BAR; PG8_WAIT_L(0); PG8_MMA(0, 0, At, B0); PG8_BAR; PG8_SCHED;
            PG8_LDB(B1, 1, 1); PG8_STAGE(PG8_SB(1, 0), b3, voffB);
            PG8_BAR; PG8_WAIT_L(0); PG8_MMA(0, 1, At, B1); PG8_BAR;
            PG8_LDA(At, 1, 1); PG8_STAGE(PG8_SA(1, 0), a3, voffA);
            PG8_BAR; PG8_WAIT_L(0); PG8_MMA(1, 0, At, B0); PG8_BAR; PG8_SCHED;
            PG8_STAGE(PG8_SB(1, 1), b3 + hstep, voffB);
            PG8_WAIT_V(6); PG8_BAR; PG8_MMA(1, 1, At, B1); PG8_BAR;
            }
        }
        if constexpr (ALIGN_EPI) { if (wr == 0) PG8_BAR; }
        if constexpr (!Epi::AFTER_DRAIN) { E(acc, cur, wr, wc, fr, fq); S.done(cur); }
        if (!has_next) break;
#pragma unroll
        for (int a = 0; a < 2; ++a)
#pragma unroll
            for (int b = 0; b < 2; ++b)
#pragma unroll
                for (int m = 0; m < 4; ++m)
#pragma unroll
                    for (int n = 0; n < 2; ++n) acc[a][b][m][n] = (f32x4){0.f, 0.f, 0.f, 0.f};
        cur = nxt; cA = nA; cB = nB; ++ui;
        if constexpr (ALIGN_EPI) { if (wr == 1) PG8_BAR; }
    }
    PG8_WAIT_V(0);
    if constexpr (!ALIGN_EPI) { if (wr == 0) PG8_BAR; }
    PG8_BAR;
    if constexpr (Epi::AFTER_DRAIN) { E.fused(acc, cur, wr, wc, fr, fq, lds, wid, lane); S.done(cur); }
#undef PG8_SA
#undef PG8_SB
#undef PG8_STAGE
#undef PG8_LDA
#undef PG8_LDB
#undef PG8_MMA
#undef PG8_WAIT_V
#undef PG8_WAIT_L
#undef PG8_BAR
#undef PG8_SCHED
}
}

constexpr int NWAVES = 8;
constexpr int BATCH = 8, SEQ = 4096, D = 1024, M = BATCH * SEQ;
constexpr int DFF = 2816, NEXP = 8, DFE = 1408;
constexpr int NPH = 17;
constexpr int N_LAUNCHES = MK_N_LAUNCHES;
static_assert(N_LAUNCHES == 1, "one launch only (PH4 has an inner grid barrier)");
constexpr float LN_EPS = 1e-5f, LOG2E = 1.4426950408889634f, DN_ALPHA = 1.4142135623730951f;
constexpr float QSCALE_A = 0.17677669529663687f * LOG2E;
constexpr float QSCALE_B = 0.125f * LOG2E;

constexpr size_t MiB = 1u << 20;
constexpr size_t WS_CTL = 0, CTL_ZERO_BYTES = 1 * MiB;
constexpr size_t WS_MOD = 1 * MiB;
constexpr size_t WS_SSMA = 1 * MiB + 512 * 1024;
constexpr size_t WS_SSMB = WS_SSMA + 64 * 1024;
constexpr size_t WS_TOKE = 2 * MiB + 512 * 1024;
constexpr size_t WS_TOKG = WS_TOKE + 256 * 1024;
constexpr size_t WS_TOKP = WS_TOKG + 256 * 1024;
constexpr size_t WS_W_IN = 4 * MiB, WS_W_OUT = 10 * MiB, WS_W_F1 = 12 * MiB, WS_W_F2 = 23 * MiB, WS_W_GLU = 28 * MiB + 512 * 1024;
constexpr size_t WS_W_E1 = 32 * MiB + 512 * 1024, WS_W_E2 = 76 * MiB + 512 * 1024;
constexpr size_t WS_A = 100 * MiB, WS_B = 292 * MiB, WS_C = 356 * MiB, WS_VT1 = 424 * MiB, WS_END = 488 * MiB;
constexpr size_t WS_UG = 228 * MiB;
constexpr size_t WS_SSMM = 196 * MiB;
constexpr size_t WS_KA = 356 * MiB, WS_KB1 = 388 * MiB, WS_KB4 = 420 * MiB, WS_KB16 = 452 * MiB;
constexpr int MOE_MAX_TILES = 264;
static_assert(WS_W_E2 + (size_t)NEXP * D * DFE * 2 <= WS_A, "weights fit");
static_assert((size_t)MOE_MAX_TILES * 256 * DFE * 2 <= WS_B - WS_A, "hidden_g fits region A");
static_assert(WS_B + (size_t)MOE_MAX_TILES * 256 * D * 2 <= WS_VT1, "gathered rows fit");
constexpr int CW_TMO = 0, CW_CODE = 1;
constexpr int CW_ECNT = 64;
constexpr int CW_ECUR = 128;
constexpr int CW_UQ = 1024;
constexpr int CW_TQ = 192;
constexpr int CW_PREP = 512;
constexpr int CW_KMAX = 256;
constexpr int CW_BAR = 4096;

constexpr int RING_OFF = 0, RING_BYTES = 131072;
constexpr int LDSCTL_OFF = RING_BYTES + 1024, MISC_OFF = LDSCTL_OFF + 320;
constexpr int LDS_BYTES = 147456;

#define GAS __attribute__((address_space(1)))
#define LAS __attribute__((address_space(3)))
typedef unsigned short h16;
typedef unsigned v4u __attribute__((ext_vector_type(4)));
typedef unsigned v2u __attribute__((ext_vector_type(2)));
typedef float f32x4 __attribute__((ext_vector_type(4)));
typedef GAS unsigned gu32;
#define RLX_AGENT __ATOMIC_RELAXED, __HIP_MEMORY_SCOPE_AGENT
#define LDS_WAIT() asm volatile("s_waitcnt lgkmcnt(0)" ::: "memory")
#define VM_WAIT() asm volatile("s_waitcnt vmcnt(0)" ::: "memory")
using pg8::pk2h;
__device__ __forceinline__ float h2f(unsigned short v) { return (float)__builtin_bit_cast(_Float16, v); }
__device__ __forceinline__ float hlo(unsigned w) { return h2f((unsigned short)(w & 0xffffu)); }
__device__ __forceinline__ float hhi(unsigned w) { return h2f((unsigned short)(w >> 16)); }
#define DPPF_(x, ctrl, rm) __builtin_bit_cast(float, __builtin_amdgcn_update_dpp(0, __builtin_bit_cast(int, (x)), (ctrl), (rm), 0xf, false))
__device__ __forceinline__ float wave_sum(float v) {
    v += DPPF_(v, 0xb1, 0xf);
    v += DPPF_(v, 0x4e, 0xf);
    v += DPPF_(v, 0x124, 0xf);
    v += DPPF_(v, 0x128, 0xf);
    v += DPPF_(v, 0x142, 0xa);
    v += DPPF_(v, 0x143, 0xc);
    return __builtin_bit_cast(float, __builtin_amdgcn_readlane(__builtin_bit_cast(int, v), 63));
}
__device__ __forceinline__ float wave_max(float v) {
#pragma unroll
    for (int o = 1; o < 64; o <<= 1) v = fmaxf(v, __shfl_xor(v, o));
    return v;
}
__device__ __forceinline__ float ex2(float v) { return __builtin_amdgcn_exp2f(v); }
__device__ __forceinline__ float gelu_tanh(float v) {
    const float z = 0.7978845608028654f * (v + 0.044715f * v * v * v);
    const float e = ex2(2.0f * LOG2E * z);
    const float th = 1.0f - 2.0f * __builtin_amdgcn_rcpf(1.0f + e);
    return 0.5f * v * (1.0f + th);
}

#define XB_TMO      128
#define XB_XCNT(j)  (256  + 64 * (j))
#define XB_XSUB(j)  (1280 + 64 * (j))
#define XB_XGEN(j)  (2304 + 64 * (j))
#define XB_TOP      3328
#define XB_TOPGEN   3392
#define XCD_BAR_WORDS 3456
#define XB_SPIN_CAP (1u << 18)

__device__ __forceinline__ unsigned xb_ld(unsigned* p)              { return __hip_atomic_load(p, __ATOMIC_RELAXED, __HIP_MEMORY_SCOPE_AGENT); }
__device__ __forceinline__ unsigned xb_add(unsigned* p, unsigned v) { return __hip_atomic_fetch_add(p, v, __ATOMIC_RELAXED, __HIP_MEMORY_SCOPE_AGENT); }
__device__ __forceinline__ unsigned xb_xcc_id() { return (unsigned)__builtin_amdgcn_s_getreg((3 << 11) | 20) & 0xFu; }
#define XB_SPIN(cond, bar) do { unsigned _sp = 0; while (cond) { __builtin_amdgcn_s_sleep(1); \
    if ((++_sp & 255u) == 0u) { if (xb_ld(&(bar)[XB_TMO])) break; if (_sp > XB_SPIN_CAP) { atomicAdd(&(bar)[XB_TMO], 1u); break; } } } } while (0)

struct XcdBarrier {
    unsigned* bar; unsigned x;
    volatile LAS unsigned* st;
};

__device__ __forceinline__ XcdBarrier xcd_barrier_post(unsigned* bar, volatile LAS unsigned* st) {
    XcdBarrier b; b.bar = bar; b.x = xb_xcc_id(); b.st = st;
    if (threadIdx.x == 0) (void)xb_add(&bar[XB_XCNT(b.x)], 1u);
    return b;
}
__device__ __forceinline__ void xcd_barrier_complete(unsigned* bar, unsigned x, unsigned& nloc, unsigned& nx) {
    const unsigned G = gridDim.x * gridDim.y * gridDim.z;
    unsigned sum, cnt, mine, sp = 0u;
    for (;;) {
        sum = 0u; cnt = 0u; mine = 0u;
#pragma unroll
        for (unsigned j = 0; j < 16; ++j) { const unsigned c = xb_ld(&bar[XB_XCNT(j)]); sum += c; cnt += (c > 0u) ? 1u : 0u; mine = (j == x) ? c : mine; }
        if (sum == G) break;
        __builtin_amdgcn_s_sleep(1);
        if ((++sp & 255u) == 0u) { if (xb_ld(&bar[XB_TMO])) break; if (sp > XB_SPIN_CAP) { atomicAdd(&bar[XB_TMO], 1u); break; } }
    }
    nloc = mine > 0u ? mine : 1u; nx = cnt > 0u ? cnt : 1u;
}

__device__ __forceinline__ void xcd_barrier(const XcdBarrier& b) {
    asm volatile("s_waitcnt vmcnt(0)" ::: "memory");
    __syncthreads();
    if (threadIdx.x == 0) {
        unsigned* bar = b.bar;
        __builtin_amdgcn_s_waitcnt(0);
        unsigned nloc = b.st[0], nx = b.st[1];
        if (nloc == 0u) { xcd_barrier_complete(bar, b.x, nloc, nx); b.st[0] = nloc; b.st[1] = nx; }
        const unsigned old = xb_add(&bar[XB_XSUB(b.x)], 1u);
        const unsigned gen = old / nloc;
        if (old + 1u == (gen + 1u) * nloc) {
            __builtin_amdgcn_fence(__ATOMIC_RELEASE, "agent");
            asm volatile("s_waitcnt vmcnt(0)" ::: "memory");
            const unsigned og = xb_add(&bar[XB_TOP], 1u);
            const unsigned tg = og / nx;
            if (og + 1u == (tg + 1u) * nx) xb_add(&bar[XB_TOPGEN], 1u);
            else XB_SPIN(xb_ld(&bar[XB_TOPGEN]) == tg, bar);
            __builtin_amdgcn_fence(__ATOMIC_ACQUIRE, "agent");
            xb_add(&bar[XB_XGEN(b.x)], 1u);
            asm volatile("s_waitcnt vmcnt(0)" ::: "memory");
        } else {
            XB_SPIN(xb_ld(&bar[XB_XGEN(b.x)]) == gen, bar);
            __builtin_amdgcn_fence(__ATOMIC_ACQUIRE, "agent");
            asm volatile("s_waitcnt vmcnt(0)" ::: "memory");
        }
    }
    __syncthreads();
}

struct Frame {
    LAS unsigned char* lds;
    volatile LAS unsigned* MISC;
    gu32* ctl;
    int tid, lane, wave;
    int vcu, G;
    const float* in[39]; float* out; unsigned char* ws;
};
enum { I_X = 0, I_C, I_ADAW0, I_ADAB0, I_WIN, I_LQ1, I_LK1, I_LQ2, I_LK2, I_SUBLN, I_WOUT, I_LN1G0, I_LN1B0, I_FG, I_FU, I_FD, I_LN2G0, I_LN2B0,
       I_ADAW1, I_ADAB1, I_ARE, I_AIM, I_LOGDT, I_BRE, I_BIM, I_CRE, I_CIM, I_DSKIP, I_WGLU, I_BGLU, I_LN1G1, I_LN1B1, I_RW, I_RB, I_EG, I_EU, I_ED, I_LN2G1, I_LN2B1 };

__device__ __forceinline__ void ph0_mods(Frame& F) {
    LAS float* sc = (LAS float*)(F.lds);
    LAS float* part = (LAS float*)(F.lds + 32768);
    float* mod = (float*)(F.ws + WS_MOD);
    if ((int)blockIdx.x < 192) {
        const float* c = F.in[I_C];
        for (int i = F.tid; i < BATCH * D; i += NWAVES * 64) { const float v = c[i]; sc[i] = v / (1.0f + expf(-v)); }
        __syncthreads();
        for (int it = blockIdx.x; it < 192; it += F.G) {
            const int l = it / 96, j0 = (it % 96) * 64;
            const float* W = F.in[l ? I_ADAW1 : I_ADAW0]; const float* bias = F.in[l ? I_ADAB1 : I_ADAB0];
            float acc[8];
#pragma unroll
            for (int b = 0; b < 8; ++b) acc[b] = 0.f;
            const int k0 = F.wave * 128;
            for (int kk = k0; kk < k0 + 128; kk += 16) { float w[16];
#pragma unroll
                for (int i = 0; i < 16; ++i) w[i] = W[(size_t)(kk + i) * (6 * D) + j0 + F.lane];
#pragma unroll
                for (int i = 0; i < 16; ++i)
#pragma unroll
                    for (int b = 0; b < 8; ++b) acc[b] += sc[b * D + kk + i] * w[i]; }
#pragma unroll
            for (int b = 0; b < 8; ++b) part[(F.wave * 8 + b) * 64 + F.lane] = acc[b];
            __syncthreads();
            float s = 0.f;
#pragma unroll
            for (int w2 = 0; w2 < 8; ++w2) s += part[(w2 * 8 + F.wave) * 64 + F.lane];
            mod[(size_t)(l * 8 + F.wave) * (6 * D) + j0 + F.lane] = s + bias[j0 + F.lane];
            __syncthreads();
        }
    }
    const int gid = blockIdx.x * (NWAVES * 64) + F.tid;
    if (gid < 64 * 64) {
        const int g = gid >> 6;
        const float ar = F.in[I_ARE][gid], ai = F.in[I_AIM][gid], dt = expf(F.in[I_LOGDT][g]);
        const float mag = expf(dt * ar); float sn, cs; sincosf(dt * ai, &sn, &cs);
        const float abr = mag * cs, abi = mag * sn, den = ar * ar + ai * ai, nr = abr - 1.0f, ni = abi;
        const float zr = (nr * ar + ni * ai) / den, zi = (ni * ar - nr * ai) / den;
        float* SA = (float*)(F.ws + WS_SSMA); float* SB = (float*)(F.ws + WS_SSMB);
        SA[gid * 2] = abr; SA[gid * 2 + 1] = abi;
#pragma unroll
        for (int c = 0; c < 16; ++c) { const float br = F.in[I_BRE][gid * 16 + c], bi = F.in[I_BIM][gid * 16 + c];
            SB[(gid * 16 + c) * 2] = zr * br - zi * bi; SB[(gid * 16 + c) * 2 + 1] = zr * bi + zi * br; }
    }
}

struct TItem { const float* src; h16* dst; int ldw, K; };
__device__ __forceinline__ void titem_make(TItem& t, const float* W, int ldw, int K, int N, h16* WT, int rowmap, int item, int lane) {
    const int nblk = N / 32, kb = item / nblk, nb = item % nblk, k0 = 64 * kb, n0 = 32 * nb;
    const int r0 = rowmap == 0 ? n0 : ((n0 >> 7) * 256 + (n0 & 127) + (rowmap == 2 ? 128 : 0));
    t.src = W + (size_t)(k0 + (lane >> 5)) * ldw + n0 + (lane & 31); t.ldw = ldw; t.K = K;
    t.dst = WT + (size_t)(r0 + (lane >> 3)) * K + k0 + 8 * (lane & 7);
}
__device__ __forceinline__ void titem_decode(Frame& F, TItem& t, int it, int lane) {
    constexpr int I_0 = 16 * 96, I_1 = 16 * 32, I_2 = 16 * 88, I_3 = 16 * 88, I_4 = 44 * 32, I_5 = 16 * 32, I_6 = 16 * 32;
    constexpr int I_7 = 16 * 44, I_8 = 16 * 44, I_9 = 22 * 32;
    unsigned char* ws = F.ws; int r = it;
    if (r < I_0) { titem_make(t, F.in[I_WIN], 3 * D, D, 3 * D, (h16*)(ws + WS_W_IN), 0, r, lane); return; } r -= I_0;
    if (r < I_1) { titem_make(t, F.in[I_WOUT], D, D, D, (h16*)(ws + WS_W_OUT), 0, r, lane); return; } r -= I_1;
    if (r < I_2) { titem_make(t, F.in[I_FG], DFF, D, DFF, (h16*)(ws + WS_W_F1), 1, r, lane); return; } r -= I_2;
    if (r < I_3) { titem_make(t, F.in[I_FU], DFF, D, DFF, (h16*)(ws + WS_W_F1), 2, r, lane); return; } r -= I_3;
    if (r < I_4) { titem_make(t, F.in[I_FD], D, DFF, D, (h16*)(ws + WS_W_F2), 0, r, lane); return; } r -= I_4;
    if (r < I_5) { titem_make(t, F.in[I_WGLU], 2 * D, D, D, (h16*)(ws + WS_W_GLU), 1, r, lane); return; } r -= I_5;
    if (r < I_6) { titem_make(t, F.in[I_WGLU] + D, 2 * D, D, D, (h16*)(ws + WS_W_GLU), 2, r, lane); return; } r -= I_6;
    const int e = r / (I_7 + I_8 + I_9); r -= e * (I_7 + I_8 + I_9);
    if (r < I_7) { titem_make(t, F.in[I_EG] + (size_t)e * D * DFE, DFE, D, DFE, (h16*)(ws + WS_W_E1) + (size_t)e * 2 * DFE * D, 1, r, lane); return; } r -= I_7;
    if (r < I_8) { titem_make(t, F.in[I_EU] + (size_t)e * D * DFE, DFE, D, DFE, (h16*)(ws + WS_W_E1) + (size_t)e * 2 * DFE * D, 2, r, lane); return; } r -= I_8;
    titem_make(t, F.in[I_ED] + (size_t)e * DFE * D, D, DFE, D, (h16*)(ws + WS_W_E2) + (size_t)e * D * DFE, 0, r, lane);
}
constexpr int NIT_L0 = 16 * 96 + 16 * 32 + 2 * 16 * 88 + 44 * 32;
constexpr int NIT_ALL = NIT_L0 + 2 * 16 * 32 + NEXP * (2 * 16 * 44 + 22 * 32);
__device__ __forceinline__ void transpose_items(Frame& F, int it0, int it1, LAS float* scr) {
    const int gw = F.vcu * NWAVES + F.wave, NGW = F.G * NWAVES, lane = F.lane;
    const int NITEMS = it1;
    if (it0 + gw < NITEMS) {
        TItem cur; titem_decode(F, cur, it0 + gw, lane);
        float cv[32];
#pragma unroll
        for (int i = 0; i < 32; ++i) cv[i] = cur.src[(size_t)(2 * i) * cur.ldw];
        for (int it = it0 + gw; it < NITEMS; it += NGW) {
            TItem nxt = cur; float nv[32];
            const bool hn = it + NGW < NITEMS;
            if (hn) { titem_decode(F, nxt, it + NGW, lane);
#pragma unroll
                for (int i = 0; i < 32; ++i) nv[i] = nxt.src[(size_t)(2 * i) * nxt.ldw]; }
#pragma unroll
            for (int i = 0; i < 32; ++i) scr[(2 * i + (lane >> 5)) * 33 + (lane & 31)] = cv[i];
            LDS_WAIT(); asm volatile("" ::: "memory");
            const int c = lane & 7;
#pragma unroll
            for (int j = 0; j < 4; ++j) { const int n = (lane >> 3) + 8 * j; const LAS float* sp = scr + (8 * c) * 33 + n;
                v4u o; o.x = pk2h(sp[0 * 33], sp[1 * 33]); o.y = pk2h(sp[2 * 33], sp[3 * 33]); o.z = pk2h(sp[4 * 33], sp[5 * 33]); o.w = pk2h(sp[6 * 33], sp[7 * 33]);
                *(GAS v4u*)(cur.dst + (size_t)(8 * j) * cur.K) = o; }
            LDS_WAIT(); asm volatile("" ::: "memory");
            if (hn) {
#pragma unroll
                for (int i = 0; i < 32; ++i) cv[i] = nv[i];
                cur = nxt; }
        }
    }
}
__device__ __forceinline__ void ph1_prologue(Frame& F) {
    const int gw = F.vcu * NWAVES + F.wave, NGW = F.G * NWAVES, lane = F.lane;
    unsigned char* ws = F.ws;
    transpose_items(F, 0, NIT_ALL, (LAS float*)(F.lds + RING_OFF + F.wave * 16384));
    const float* mod0 = (const float*)(ws + WS_MOD);
    h16* H0 = (h16*)(ws + WS_B);
    {
        const int WPB = F.G, bq = gw / WPB, r0 = gw % WPB; const float* mb = mod0 + (size_t)bq * (6 * D);
        f32x4 sc1[4], shv[4];
#pragma unroll
        for (int j = 0; j < 4; ++j) { const int col = 4 * lane + 256 * j; shv[j] = *(const f32x4*)(mb + col); sc1[j] = 1.0f + *(const f32x4*)(mb + D + col); }
        for (int t0 = r0; t0 < SEQ; t0 += 8 * WPB) {
            f32x4 xr[8][4];
#pragma unroll
            for (int i = 0; i < 8; ++i) { const int t = t0 + i * WPB; if (t < SEQ) {
#pragma unroll
                for (int j = 0; j < 4; ++j) xr[i][j] = *(const f32x4*)(F.in[I_X] + ((size_t)bq * SEQ + t) * D + 4 * lane + 256 * j); } }
#pragma unroll
            for (int i = 0; i < 8; ++i) { const int t = t0 + i * WPB; if (t < SEQ) {
#pragma unroll
                for (int j = 0; j < 4; ++j) { const int col = 4 * lane + 256 * j;
                    const f32x4 h = xr[i][j] * sc1[j] + shv[j]; v2u o; o.x = pk2h(h[0], h[1]); o.y = pk2h(h[2], h[3]);
                    *(v2u*)(H0 + ((size_t)bq * SEQ + t) * D + col) = o; } } }
        }
    }
}

__device__ __forceinline__ f32x4 ld4h(const h16* p) { const v2u w = *(const v2u*)p; return (f32x4){hlo(w.x), hhi(w.x), hlo(w.y), hhi(w.y)}; }
__device__ __forceinline__ void ld8h(const h16* p, float* f) { const v4u w = *(const v4u*)p; f[0] = hlo(w.x); f[1] = hhi(w.x); f[2] = hlo(w.y); f[3] = hhi(w.y); f[4] = hlo(w.z); f[5] = hhi(w.z); f[6] = hlo(w.w); f[7] = hhi(w.w); }
__device__ __forceinline__ float lane_reduce64(float (&v)[64], int lane) {
#pragma unroll
    for (int s = 0; s < 6; ++s) { const int half = 32 >> s; const bool up = (lane & half) != 0;
#pragma unroll
        for (int i = 0; i < half; ++i) { const float lo = v[i], hi = v[i + half]; const float send = up ? lo : hi, keep = up ? hi : lo; v[i] = keep + __shfl_xor(send, half); } }
    return v[0];
}
__device__ __forceinline__ float lam_value(Frame& F) {
    float s1 = 0.f, s2 = 0.f;
#pragma unroll 4
    for (int i = 0; i < 32; ++i) { s1 += F.in[I_LQ1][i] * F.in[I_LK1][i]; s2 += F.in[I_LQ2][i] * F.in[I_LK2][i]; }
    return expf(s1) - expf(s2) + 0.2f;
}
template <bool DIFF, bool DIL> __device__ __forceinline__ void ph4_attn_naive(Frame& F) {
    const h16* QKV = (const h16*)(F.ws + WS_A); h16* O = (h16*)(F.ws + WS_B);
    const int gw = F.vcu * NWAVES + F.wave, NGW = F.G * NWAVES, lane = F.lane;
    const float lam = lam_value(F);
    const float sub_w = F.in[I_SUBLN][lane] * 0.8f;
    if (DIFF) for (int it = gw; it < BATCH * 8 * SEQ; it += NGW) {
        const int bh = it >> 12, r = it & 4095, i = (bh & 1) ? 4095 - r : r, b = bh >> 3, h = bh & 7;
        const size_t rowq = (size_t)(b * SEQ + i) * 3072;
        const float slope2 = exp2f(-0.5f * (float)(h + 1)) * LOG2E;
        float res[2];
#pragma unroll
        for (int mp = 0; mp < 2; ++mp) {
            float q[32];
#pragma unroll
            for (int d8 = 0; d8 < 4; ++d8) ld8h(QKV + rowq + h * 64 + mp * 32 + d8 * 8, q + d8 * 8);
            float acc[64];
#pragma unroll
            for (int d = 0; d < 64; ++d) acc[d] = 0.f;
            float mrun = -INFINITY, l = 0.f;
            for (int j = lane; j <= i; j += 64) {
                const size_t rowk = (size_t)(b * SEQ + j) * 3072;
                float s = 0.f;
#pragma unroll
                for (int d8 = 0; d8 < 4; ++d8) { float kf[8]; ld8h(QKV + rowk + 512 + h * 64 + mp * 32 + d8 * 8, kf);
#pragma unroll
                    for (int e = 0; e < 8; ++e) s += q[d8 * 8 + e] * kf[e]; }
                s -= slope2 * (float)(i - j);
                const float mn = fmaxf(mrun, s), alpha = ex2(mrun - mn), p = ex2(s - mn);
                l = l * alpha + p; mrun = mn;
#pragma unroll
                for (int d8 = 0; d8 < 8; ++d8) { float vf[8]; ld8h(QKV + rowk + 1024 + h * 64 + d8 * 8, vf);
#pragma unroll
                    for (int e = 0; e < 8; ++e) acc[d8 * 8 + e] = acc[d8 * 8 + e] * alpha + p * vf[e]; }
            }
            const float Mx = wave_max(mrun), scl = (mrun == -INFINITY) ? 0.f : ex2(mrun - Mx), L = wave_sum(l * scl);
#pragma unroll
            for (int d = 0; d < 64; ++d) acc[d] *= scl;
            const float mine = lane_reduce64(acc, lane);
            res[mp] = mine / L;
        }
        const float o = res[0] - lam * res[1];
        const float ss = wave_sum(o * o);
        const float y = o * (1.0f / sqrtf(ss * (1.0f / 64.0f) + LN_EPS)) * sub_w;
        O[(size_t)(b * SEQ + i) * D + h * 64 + lane] = (h16)(pk2h(y, 0.f) & 0xffffu);
    }
    if (DIL) for (int it = gw; it < BATCH * 8 * SEQ; it += NGW) {
        const int bh = it >> 12, i = it & 4095, b = bh >> 3, h = bh & 7;
        const size_t rowq = (size_t)(b * SEQ + i) * 3072;
        const float slope2 = exp2f(-0.5f * (float)(h + 9)) * LOG2E;
        float q[64];
#pragma unroll
        for (int d8 = 0; d8 < 8; ++d8) ld8h(QKV + rowq + 1536 + h * 64 + d8 * 8, q + d8 * 8);
        float og[3], lse[3];
#pragma unroll
        for (int g = 0; g < 3; ++g) {
            const int dil = (g == 0) ? 1 : (g == 1) ? 4 : 16;
            float acc[64];
#pragma unroll
            for (int d = 0; d < 64; ++d) acc[d] = 0.f;
            float mrun = -INFINITY, l = 0.f;
            for (int jj = lane; jj <= 128; jj += 64) {
                const int t = i - jj * dil;
                if (t >= 0) {
                    const size_t rowk = (size_t)(b * SEQ + t) * 3072;
                    float s = 0.f;
#pragma unroll
                    for (int d8 = 0; d8 < 8; ++d8) { float kf[8]; ld8h(QKV + rowk + 2048 + h * 64 + d8 * 8, kf);
#pragma unroll
                        for (int e = 0; e < 8; ++e) s += q[d8 * 8 + e] * kf[e]; }
                    s -= slope2 * (float)(jj * dil);
                    const float mn = fmaxf(mrun, s), alpha = ex2(mrun - mn), p = ex2(s - mn);
                    l = l * alpha + p; mrun = mn;
#pragma unroll
                    for (int d8 = 0; d8 < 8; ++d8) { float vf[8]; ld8h(QKV + rowk + 2560 + h * 64 + d8 * 8, vf);
#pragma unroll
                        for (int e = 0; e < 8; ++e) acc[d8 * 8 + e] = acc[d8 * 8 + e] * alpha + p * vf[e]; }
                }
            }
            const float Mx = wave_max(mrun), scl = (mrun == -INFINITY) ? 0.f : ex2(mrun - Mx), L = wave_sum(l * scl);
#pragma unroll
            for (int d = 0; d < 64; ++d) acc[d] *= scl;
            const float mine = lane_reduce64(acc, lane);
            og[g] = mine / L; lse[g] = Mx + log2f(L);
        }
        const float mx = fmaxf(lse[0], fmaxf(lse[1], lse[2]));
        const float w0 = ex2(lse[0] - mx), w1 = ex2(lse[1] - mx), w2 = ex2(lse[2] - mx);
        const float y = (w0 * og[0] + w1 * og[1] + w2 * og[2]) / (w0 + w1 + w2);
        O[(size_t)(b * SEQ + i) * D + 512 + h * 64 + lane] = (h16)(pk2h(y, 0.f) & 0xffffu);
    }
}


typedef _Float16 hf8 __attribute__((ext_vector_type(8)));
typedef float f32x16 __attribute__((ext_vector_type(16)));
__device__ __forceinline__ hf8 ldf8(const h16* p) { return __builtin_bit_cast(hf8, *(const v4u*)p); }
#define MFMA32(a, b, c) __builtin_amdgcn_mfma_f32_32x32x16_f16((a), (b), (c), 0, 0, 0)
typedef short v4i16_t __attribute__((ext_vector_type(4)));
typedef _Float16 hf4 __attribute__((ext_vector_type(4)));
__device__ __forceinline__ void v_stage(LAS unsigned char* vl, const v4u (&vn)[4], int lane) {
#pragma unroll
    for (int i = 0; i < 4; ++i) *(LAS v4u*)(vl + ((lane & 7) >> 2) * 2048 + ((lane >> 3) + 8 * i) * 64 + (lane & 3) * 16) = vn[i];
}
__device__ __forceinline__ hf8 v_frag(const LAS unsigned char* trb, int dt, int s) {
    const v4i16_t lo = __builtin_amdgcn_ds_read_tr16_b64_v4i16((LAS v4i16_t*)(trb + dt * 2048 + (16 * s) * 64));
    const v4i16_t hi = __builtin_amdgcn_ds_read_tr16_b64_v4i16((LAS v4i16_t*)(trb + dt * 2048 + (16 * s + 4) * 64));
    return __builtin_shufflevector(__builtin_bit_cast(hf4, lo), __builtin_bit_cast(hf4, hi), 0, 1, 2, 3, 4, 5, 6, 7);
}
__device__ __forceinline__ float rowmax16(const f32x16& s) {
    float m;
    asm("s_nop 15\n\ts_nop 7\n\t"
                 "v_max3_f32 %0, %1, %2, %3\n\tv_max3_f32 %0, %0, %4, %5\n\tv_max3_f32 %0, %0, %6, %7\n\tv_max3_f32 %0, %0, %8, %9\n\t"
                 "v_max3_f32 %0, %0, %10, %11\n\tv_max3_f32 %0, %0, %12, %13\n\tv_max3_f32 %0, %0, %14, %15\n\tv_max_f32 %0, %0, %16"
                 : "=&v"(m)
                 : "v"(s[0]), "v"(s[1]), "v"(s[2]), "v"(s[3]), "v"(s[4]), "v"(s[5]), "v"(s[6]), "v"(s[7]), "v"(s[8]), "v"(s[9]), "v"(s[10]), "v"(s[11]), "v"(s[12]), "v"(s[13]), "v"(s[14]), "v"(s[15]));
    return m;
}
constexpr float LAZY_THR = 8.0f;
__device__ __forceinline__ float half_max(float v) { auto rr = __builtin_amdgcn_permlane32_swap(__float_as_uint(v), __float_as_uint(v), false, false); return fmaxf(__uint_as_float(rr[0]), __uint_as_float(rr[1])); }
__device__ __forceinline__ float half_sum(float v) { auto rr = __builtin_amdgcn_permlane32_swap(__float_as_uint(v), __float_as_uint(v), false, false); return __uint_as_float(rr[0]) + __uint_as_float(rr[1]); }
constexpr float SKIP_BITS = 30.0f;
__device__ __forceinline__ void ph4_diff_mfma(Frame& F) {
    const h16* QKV = (const h16*)(F.ws + WS_A); const h16* KA = (const h16*)(F.ws + WS_KA); h16* O = (h16*)(F.ws + WS_B);
    int lane_ = F.lane; asm volatile("" : "+v"(lane_));
    const int gw = F.vcu * NWAVES + F.wave, NGW = F.G * NWAVES, lane = lane_, r32 = lane & 31, hi = lane >> 5;
    const float lam = lam_value(F);
    LAS unsigned char* vl = F.lds + RING_OFF + F.wave * 4096;
    const LAS unsigned char* trb = vl + (8 * hi + ((lane & 15) >> 2)) * 64 + (16 * ((lane >> 4) & 1) + 4 * (lane & 3)) * 2;
    for (int k = 0; k < 4; ++k) {
        if (gw >= 2048) break;
        const int ty = gw & 1, qp = (gw >> 1) & 127, b = gw >> 8;
        const int h = (ty == 0) ? ((k == 0) ? 7 : (k == 1) ? 0 : (k == 2) ? 4 : 3) : ((k == 0) ? 6 : (k == 1) ? 1 : (k == 2) ? 5 : 2);
        const int bh = b * 8 + h, qt = (k & 1) ? 127 - qp : qp, i0 = qt * 32;
        const float slope2 = exp2f(-0.5f * (float)(h + 1)) * LOG2E;
        const h16* qrow = QKV + (size_t)(b * SEQ + i0 + r32) * 3072 + h * 64 + 8 * hi;
        hf8 qf[2][2];
#pragma unroll
        for (int mp = 0; mp < 2; ++mp)
#pragma unroll
            for (int sl = 0; sl < 2; ++sl) qf[mp][sl] = ldf8(qrow + mp * 32 + sl * 16);
        float need;
        { float sq[2];
#pragma unroll
            for (int mp = 0; mp < 2; ++mp) { float a = 0.f;
#pragma unroll
                for (int sl = 0; sl < 2; ++sl)
#pragma unroll
                    for (int e = 0; e < 8; ++e) { const float v = (float)qf[mp][sl][e]; a += v * v; }
                a = half_sum(a);
                const float km = __uint_as_float(__hip_atomic_load(F.ctl + CW_KMAX + (b * 8 + h) * 2 + mp, RLX_AGENT));
                sq[mp] = sqrtf(a * km) * 1.001f + 0.01f; }
            need = fmaxf(sq[0], sq[1]) + SKIP_BITS - log2f(1.0f - exp2f(-slope2)); }
        float coff[16];
#pragma unroll
        for (int r = 0; r < 16; ++r) coff[r] = slope2 * (float)(16 * (r >> 3) + 8 * hi + (r & 7));
        f32x16 o[2][2];
#pragma unroll
        for (int mp = 0; mp < 2; ++mp)
#pragma unroll
            for (int dt = 0; dt < 2; ++dt)
#pragma unroll
                for (int r = 0; r < 16; ++r) o[mp][dt][r] = 0.f;
        float mrun[2] = {0.f, 0.f}, lrun[2] = {0.f, 0.f};
        const h16* kbase = KA + ((size_t)(bh * 128) * 4 * 64 + lane) * 8;
        const h16* vbase = QKV + (size_t)(b * SEQ + (lane >> 3)) * 3072 + 1024 + h * 64 + 8 * (lane & 7);
        hf8 kn[2][2]; v4u vn[4];
        { const h16* kb2 = kbase + (size_t)(qt * 4) * 512; const h16* vb2 = vbase + (size_t)(32 * qt) * 3072;
#pragma unroll
            for (int mp = 0; mp < 2; ++mp)
#pragma unroll
                for (int sl = 0; sl < 2; ++sl) kn[mp][sl] = ldf8(kb2 + (mp * 2 + sl) * 512);
#pragma unroll
            for (int i = 0; i < 4; ++i) vn[i] = *(const v4u*)(vb2 + (size_t)(8 * i) * 3072); }
        for (int kt = qt; kt >= 0; --kt) {
            hf8 kf[2][2];
#pragma unroll
            for (int a = 0; a < 2; ++a)
#pragma unroll
                for (int c = 0; c < 2; ++c) kf[a][c] = kn[a][c];
            asm volatile("" ::: "memory");
            v_stage(vl, vn, lane);
            asm volatile("" ::: "memory");
            if (kt > 0) {
                const h16* kb2 = kbase + (size_t)((kt - 1) * 4) * 512; const h16* vb2 = vbase + (size_t)(32 * (kt - 1)) * 3072;
#pragma unroll
                for (int mp = 0; mp < 2; ++mp)
#pragma unroll
                    for (int sl = 0; sl < 2; ++sl) kn[mp][sl] = ldf8(kb2 + (mp * 2 + sl) * 512);
#pragma unroll
                for (int i = 0; i < 4; ++i) vn[i] = *(const v4u*)(vb2 + (size_t)(8 * i) * 3072);
            }
            hf8 vf[2][2];
#pragma unroll
            for (int dt = 0; dt < 2; ++dt)
#pragma unroll
                for (int s2 = 0; s2 < 2; ++s2) vf[dt][s2] = v_frag(trb, dt, s2);
            asm volatile("" ::: "memory");
            const float tb = slope2 * (float)(32 * kt - i0);
            const bool diag = (kt == qt);
            f32x16 sc[2];
#pragma unroll
            for (int mp = 0; mp < 2; ++mp) { const float tbm = tb - mrun[mp];
#pragma unroll
                for (int r = 0; r < 16; ++r) sc[mp][r] = coff[r] + tbm;
                if (diag) {
#pragma unroll
                    for (int r = 0; r < 16; ++r) if (16 * (r >> 3) + 8 * hi + (r & 7) > r32) sc[mp][r] = -INFINITY;
                } }
            sc[0] = MFMA32(kf[0][0], qf[0][0], sc[0]); sc[1] = MFMA32(kf[1][0], qf[1][0], sc[1]);
            sc[0] = MFMA32(kf[0][1], qf[0][1], sc[0]); sc[1] = MFMA32(kf[1][1], qf[1][1], sc[1]);
            hf8 pb[2][2];
#pragma unroll
            for (int mp = 0; mp < 2; ++mp) {
                const float mx = half_max(rowmax16(sc[mp]));
                if (diag || __any(mx > LAZY_THR)) {
                    const float dl = diag ? mx : fmaxf(mx, 0.f), alpha = ex2(-dl); mrun[mp] += dl; lrun[mp] *= alpha;
#pragma unroll
                    for (int r = 0; r < 16; ++r) sc[mp][r] -= dl;
#pragma unroll
                    for (int dt = 0; dt < 2; ++dt)
#pragma unroll
                        for (int r = 0; r < 16; ++r) o[mp][dt][r] *= alpha; }
                float ls = 0.f;
#pragma unroll
                for (int r = 0; r < 16; ++r) { sc[mp][r] = ex2(sc[mp][r]); ls += sc[mp][r]; }
                lrun[mp] += ls;
                v4u p0, p1;
                p0.x = pk2h(sc[mp][0], sc[mp][1]); p0.y = pk2h(sc[mp][2], sc[mp][3]); p0.z = pk2h(sc[mp][4], sc[mp][5]); p0.w = pk2h(sc[mp][6], sc[mp][7]);
                p1.x = pk2h(sc[mp][8], sc[mp][9]); p1.y = pk2h(sc[mp][10], sc[mp][11]); p1.z = pk2h(sc[mp][12], sc[mp][13]); p1.w = pk2h(sc[mp][14], sc[mp][15]);
                pb[mp][0] = __builtin_bit_cast(hf8, p0); pb[mp][1] = __builtin_bit_cast(hf8, p1);
            }
#pragma unroll
            for (int s2 = 0; s2 < 2; ++s2)
#pragma unroll
                for (int mp = 0; mp < 2; ++mp)
#pragma unroll
                    for (int dt = 0; dt < 2; ++dt) o[mp][dt] = MFMA32(vf[dt][s2], pb[mp][s2], o[mp][dt]);
            if (__all(slope2 * (float)(i0 + 1 - 32 * kt) >= need - fminf(mrun[0], mrun[1]))) break;
        }
        const float l0 = half_sum(lrun[0]), l1 = half_sum(lrun[1]);
        const float i0l = 1.0f / l0, i1l = lam / l1;
        float ss = 0.f;
#pragma unroll
        for (int dt = 0; dt < 2; ++dt)
#pragma unroll
            for (int r = 0; r < 16; ++r) { const float v = o[0][dt][r] * i0l - o[1][dt][r] * i1l; o[0][dt][r] = v; ss += v * v; }
        ss = half_sum(ss);
        const float rstd = 0.8f / sqrtf(ss * (1.0f / 64.0f) + LN_EPS);
        h16* orow = O + (size_t)(b * SEQ + i0 + r32) * D + h * 64;
#pragma unroll
        for (int dt = 0; dt < 2; ++dt)
#pragma unroll
            for (int gp = 0; gp < 2; ++gp) { v2u w[2];
#pragma unroll
                for (int e = 0; e < 2; ++e) { const int g = 2 * gp + e, d = 32 * dt + 8 * g + 4 * hi; const f32x4 sw = *(const f32x4*)(F.in[I_SUBLN] + d);
                    w[e].x = pk2h(o[0][dt][4 * g] * rstd * sw[0], o[0][dt][4 * g + 1] * rstd * sw[1]); w[e].y = pk2h(o[0][dt][4 * g + 2] * rstd * sw[2], o[0][dt][4 * g + 3] * rstd * sw[3]); }
                const auto sx = __builtin_amdgcn_permlane32_swap(w[0].x, w[1].x, false, false), sy = __builtin_amdgcn_permlane32_swap(w[0].y, w[1].y, false, false);
                *(v4u*)(orow + 32 * dt + 16 * gp + 8 * hi) = (v4u){sx[0], sy[0], sx[1], sy[1]}; }
    }
}

template <int MODE> __device__ __forceinline__ void dil_pass(Frame& F) {
    constexpr int STR = (MODE == 0) ? 1 : (MODE == 1) ? 4 : 16, NT = (MODE == 0) ? 5 : 4, LO = (MODE == 0) ? 0 : 33, NU = BATCH * 8 * 128;
    const h16* QKV = (const h16*)(F.ws + WS_A); h16* O = (h16*)(F.ws + WS_B);
    const h16* KB = (MODE == 0) ? (const h16*)(F.ws + WS_KB1) : (MODE == 1) ? (const h16*)(F.ws + WS_KB4) : (const h16*)(F.ws + WS_KB16);
    h16* PO1 = (h16*)F.out; h16* PO2 = PO1 + (size_t)BATCH * 8 * SEQ * 64; float* PM1 = (float*)(PO2 + (size_t)BATCH * 8 * SEQ * 64); float* PM2 = PM1 + (size_t)BATCH * 8 * SEQ * 2;
    int lane_ = F.lane; asm volatile("" : "+v"(lane_));
    const int gw = F.vcu * NWAVES + F.wave, NGW = F.G * NWAVES, lane = lane_, r32 = lane & 31, hi = lane >> 5;
    LAS unsigned char* vl = F.lds + RING_OFF + F.wave * 4096;
    const LAS unsigned char* trb = vl + (8 * hi + ((lane & 15) >> 2)) * 64 + (16 * ((lane >> 4) & 1) + 4 * (lane & 3)) * 2;
#define DU_BH(i) ((i) >> 7)
#define DU_RR(i) ((MODE == 0) ? 0 : (MODE == 1) ? (((i) & 127) >> 5) : (((i) & 127) >> 3))
#define DU_QB(i) ((MODE == 0) ? ((i) & 127) : (MODE == 1) ? ((i) & 31) : ((i) & 7))
#define DU_KB0(i) ((MODE == 0) ? DU_QB(i) : DU_QB(i) - 1)
#define DU_NT(i) ((DU_KB0(i) + 1 < NT) ? DU_KB0(i) + 1 : NT)
#define DU_LOADQ(i, q) do { const int bh_ = DU_BH(i), tq_ = STR * (32 * DU_QB(i) + r32) + DU_RR(i); \
        const h16* qr_ = QKV + (size_t)((bh_ >> 3) * SEQ + tq_) * 3072 + 1536 + (bh_ & 7) * 64 + 8 * hi; \
        _Pragma("unroll") for (int sl_ = 0; sl_ < 4; ++sl_) q[sl_] = ldf8(qr_ + sl_ * 16); } while (0)
#define DU_LOADKV(i, kb) do { const int bh_ = DU_BH(i), rr_ = DU_RR(i), ub_ = (MODE == 0) ? 0 : (MODE == 1) ? rr_ * 32 : rr_ * 8; \
        const h16* kp_ = KB + ((size_t)((bh_ * 128 + ub_ + (kb)) * 4) * 64 + lane) * 8; \
        const h16* vp_ = QKV + (size_t)((bh_ >> 3) * SEQ + STR * (32 * (kb) + (lane >> 3)) + rr_) * 3072 + 2560 + (bh_ & 7) * 64 + 8 * (lane & 7); \
        _Pragma("unroll") for (int sl_ = 0; sl_ < 4; ++sl_) kn[sl_] = ldf8(kp_ + sl_ * 512); \
        _Pragma("unroll") for (int i_ = 0; i_ < 4; ++i_) vn[i_] = *(const v4u*)(vp_ + (size_t)(STR * 8 * i_) * 3072); } while (0)
    int idx = gw; if (idx >= NU) return;
    hf8 kn[4]; v4u vn[4];
    if (DU_NT(idx) > 0) DU_LOADKV(idx, DU_KB0(idx));
    for (;;) {
        const int nidx = idx + NGW; const bool hn = nidx < NU;
        const int bh = DU_BH(idx), b = bh >> 3, h = bh & 7, rr = DU_RR(idx), qb = DU_QB(idx), kb0 = DU_KB0(idx), ntile = DU_NT(idx);
        const float sS = exp2f(-0.5f * (float)(h + 9)) * LOG2E * (float)STR;
        const int tq = STR * (32 * qb + r32) + rr;
        hf8 qf[4];
        DU_LOADQ(idx, qf);
        const size_t prw = (size_t)bh * SEQ + tq;
        float pm1 = 0.f, pl1 = 0.f, pm2 = 0.f, pl2 = 0.f;
        float cb[16];
#pragma unroll
        for (int r = 0; r < 16; ++r) { const int ko = 16 * (r >> 3) + 8 * hi + (r & 7), dd = r32 - ko;
            const float lg = (MODE == 0) ? (((dd & 15) == 0) ? 1.5849625007211562f : ((dd & 3) == 0) ? 1.0f : 0.0f) : (MODE == 1) ? (((dd & 3) == 0) ? 1.0f : 0.0f) : 0.0f;
            cb[r] = sS * (float)ko + lg; }
        f32x16 o[2];
#pragma unroll
        for (int dt = 0; dt < 2; ++dt)
#pragma unroll
            for (int r = 0; r < 16; ++r) o[dt][r] = 0.f;
        float mrun = 0.f, lrun = 0.f; bool started = false;
        for (int j = 0; j < ntile; ++j) {
            const int kb = kb0 - j;
            hf8 kf[4];
#pragma unroll
            for (int sl = 0; sl < 4; ++sl) kf[sl] = kn[sl];
            asm volatile("" ::: "memory");
            v_stage(vl, vn, lane);
            asm volatile("" ::: "memory");
            if (j + 1 < ntile) DU_LOADKV(idx, kb - 1);
            else if (hn && DU_NT(nidx) > 0) DU_LOADKV(nidx, DU_KB0(nidx));
            hf8 vf[2][2];
#pragma unroll
            for (int dt = 0; dt < 2; ++dt)
#pragma unroll
                for (int s2 = 0; s2 < 2; ++s2) vf[dt][s2] = v_frag(trb, dt, s2);
            asm volatile("" ::: "memory");
            const float tb = sS * (float)(32 * (kb - qb)) - mrun;
            f32x16 s;
#pragma unroll
            for (int r = 0; r < 16; ++r) s[r] = cb[r] + tb;
            if (j == 0 || j == NT - 1) {
                const int dl0 = 32 * (qb - kb) + r32;
#pragma unroll
                for (int r = 0; r < 16; ++r) { const int dl = dl0 - (16 * (r >> 3) + 8 * hi + (r & 7)); if (dl < LO || dl > 128) s[r] = -INFINITY; }
            }
#pragma unroll
            for (int sl = 0; sl < 4; ++sl) s = MFMA32(kf[sl], qf[sl], s);
            const float mx = half_max(rowmax16(s));
            const bool fresh = !started && mx > -INFINITY;
            if (__any(fresh || mx > LAZY_THR)) {
                const float dl = fresh ? mx : fmaxf(mx, 0.f), alpha = ex2(-dl); mrun += dl; lrun *= alpha; started = started || fresh;
#pragma unroll
                for (int r = 0; r < 16; ++r) s[r] -= dl;
#pragma unroll
                for (int dt = 0; dt < 2; ++dt)
#pragma unroll
                    for (int r = 0; r < 16; ++r) o[dt][r] *= alpha; }
            float ls = 0.f;
#pragma unroll
            for (int r = 0; r < 16; ++r) { s[r] = ex2(s[r]); ls += s[r]; }
            lrun += ls;
            v4u p0, p1;
            p0.x = pk2h(s[0], s[1]); p0.y = pk2h(s[2], s[3]); p0.z = pk2h(s[4], s[5]); p0.w = pk2h(s[6], s[7]);
            p1.x = pk2h(s[8], s[9]); p1.y = pk2h(s[10], s[11]); p1.z = pk2h(s[12], s[13]); p1.w = pk2h(s[14], s[15]);
            const hf8 pb0 = __builtin_bit_cast(hf8, p0), pb1 = __builtin_bit_cast(hf8, p1);
#pragma unroll
            for (int dt = 0; dt < 2; ++dt) { o[dt] = MFMA32(vf[dt][0], pb0, o[dt]); o[dt] = MFMA32(vf[dt][1], pb1, o[dt]); }
        }
        if (ntile == 0 && hn && DU_NT(nidx) > 0) DU_LOADKV(nidx, DU_KB0(nidx));
        const float l = half_sum(lrun), mt = (l > 0.f) ? mrun - sS * (float)r32 : -1.0e30f;
        if (MODE != 2) {
            const float il = (l > 0.f) ? 1.0f / l : 0.f;
            h16* po = ((MODE == 0) ? PO1 : PO2) + prw * 64; float* pm = ((MODE == 0) ? PM1 : PM2) + prw * 2;
#pragma unroll
            for (int dt = 0; dt < 2; ++dt)
#pragma unroll
                for (int gp = 0; gp < 2; ++gp) { v2u w[2];
#pragma unroll
                    for (int e = 0; e < 2; ++e) { const int g = 2 * gp + e; w[e].x = pk2h(o[dt][4 * g] * il, o[dt][4 * g + 1] * il); w[e].y = pk2h(o[dt][4 * g + 2] * il, o[dt][4 * g + 3] * il); }
                    const auto sx = __builtin_amdgcn_permlane32_swap(w[0].x, w[1].x, false, false), sy = __builtin_amdgcn_permlane32_swap(w[0].y, w[1].y, false, false);
                    *(v4u*)(po + 32 * dt + 16 * gp + 8 * hi) = (v4u){sx[0], sy[0], sx[1], sy[1]}; }
            if (hi == 0) { pm[0] = mt; pm[1] = l; }
        } else {
            pm1 = PM1[prw * 2]; pl1 = PM1[prw * 2 + 1]; pm2 = PM2[prw * 2]; pl2 = PM2[prw * 2 + 1];
            const float Mx = fmaxf(pm1, fmaxf(pm2, mt));
            const float w1 = pl1 * ex2(pm1 - Mx), w2 = pl2 * ex2(pm2 - Mx), w3 = ex2(mt - Mx), inv = 1.0f / (w1 + w2 + w3 * l);
            const h16* p1 = PO1 + prw * 64; const h16* p2 = PO2 + prw * 64;
            h16* orow = O + (size_t)(b * SEQ + tq) * D + 512 + h * 64;
#pragma unroll
            for (int dt = 0; dt < 2; ++dt)
#pragma unroll
                for (int gp = 0; gp < 2; ++gp) { v2u w[2];
#pragma unroll
                    for (int e2 = 0; e2 < 2; ++e2) { const int g = 2 * gp + e2, d = 32 * dt + 8 * g + 4 * hi; const f32x4 a = ld4h(p1 + d), c = ld4h(p2 + d);
                        float y[4];
#pragma unroll
                        for (int e = 0; e < 4; ++e) y[e] = (w1 * a[e] + w2 * c[e] + w3 * o[dt][4 * g + e]) * inv;
                        w[e2].x = pk2h(y[0], y[1]); w[e2].y = pk2h(y[2], y[3]); }
                    const auto sx = __builtin_amdgcn_permlane32_swap(w[0].x, w[1].x, false, false), sy = __builtin_amdgcn_permlane32_swap(w[0].y, w[1].y, false, false);
                    *(v4u*)(orow + 32 * dt + 16 * gp + 8 * hi) = (v4u){sx[0], sy[0], sx[1], sy[1]}; }
        }
        if (!hn) break;
        idx = nidx;
    }
#undef DU_BH
#undef DU_RR
#undef DU_QB
#undef DU_KB0
#undef DU_NT
#undef DU_LOADQ
#undef DU_LOADKV
}

struct RowLn { f32x4 n[4]; };
__device__ __forceinline__ void ln_rows(f32x4 (&v)[4], const float* lg, const float* lb, int lane) {
    float s = 0.f;
#pragma unroll
    for (int j = 0; j < 4; ++j) s += (v[j][0] + v[j][1]) + (v[j][2] + v[j][3]);
    const float mean = wave_sum(s) * (1.0f / D); float s2 = 0.f;
#pragma unroll
    for (int j = 0; j < 4; ++j) { v[j] = v[j] - mean; s2 += (v[j][0] * v[j][0] + v[j][1] * v[j][1]) + (v[j][2] * v[j][2] + v[j][3] * v[j][3]); }
    const float rstd = 1.0f / sqrtf(wave_sum(s2) * (1.0f / D) + LN_EPS);
#pragma unroll
    for (int j = 0; j < 4; ++j) { const int col = 4 * lane + 256 * j; v[j] = v[j] * rstd * *(const f32x4*)(lg + col) + *(const f32x4*)(lb + col); }
}
struct RowIn { f32x4 x[4]; v2u hx[4]; v2u y[4]; };
template <bool XF32> __device__ __forceinline__ void row_load(RowIn& r, const float* xin, const h16* hin, const h16* y, int lane) {
#pragma unroll
    for (int j = 0; j < 4; ++j) { const int col = 4 * lane + 256 * j; if (XF32) r.x[j] = *(const f32x4*)(xin + col); else r.hx[j] = *(const v2u*)(hin + col); r.y[j] = *(const v2u*)(y + col); }
}
__device__ __forceinline__ f32x4 cvt4(v2u w) { return (f32x4){hlo(w.x), hhi(w.x), hlo(w.y), hhi(w.y)}; }
struct RowVec { f32x4 rdiv[4], psh[4], gate1[4], lg[4], lb[4], sc1[4], sh[4]; };
template <bool XF32> __device__ __forceinline__ void rowvec_load(RowVec& q, const float* psc, const float* psh, const float* gate, const float* lg, const float* lb, const float* sc, const float* sh, int lane) {
#pragma unroll
    for (int j = 0; j < 4; ++j) { const int col = 4 * lane + 256 * j;
        if (!XF32) { const f32x4 d = 1.0f + *(const f32x4*)(psc + col); q.rdiv[j] = (f32x4){__builtin_amdgcn_rcpf(d[0]), __builtin_amdgcn_rcpf(d[1]), __builtin_amdgcn_rcpf(d[2]), __builtin_amdgcn_rcpf(d[3])}; q.psh[j] = *(const f32x4*)(psh + col); }
        q.gate1[j] = 1.0f + *(const f32x4*)(gate + col); q.lg[j] = *(const f32x4*)(lg + col); q.lb[j] = *(const f32x4*)(lb + col);
        q.sc1[j] = 1.0f + *(const f32x4*)(sc + col); q.sh[j] = *(const f32x4*)(sh + col); }
}
__device__ __forceinline__ void ln_rows_v(f32x4 (&v)[4], const RowVec& q) {
    float s = 0.f;
#pragma unroll
    for (int j = 0; j < 4; ++j) s += (v[j][0] + v[j][1]) + (v[j][2] + v[j][3]);
    const float mean = wave_sum(s) * (1.0f / D); float s2 = 0.f;
#pragma unroll
    for (int j = 0; j < 4; ++j) { v[j] = v[j] - mean; s2 += (v[j][0] * v[j][0] + v[j][1] * v[j][1]) + (v[j][2] * v[j][2] + v[j][3] * v[j][3]); }
    const float rstd = 1.0f / sqrtf(wave_sum(s2) * (1.0f / D) + LN_EPS);
#pragma unroll
    for (int j = 0; j < 4; ++j) v[j] = v[j] * rstd * q.lg[j] + q.lb[j];
}
template <bool XF32> __device__ __forceinline__ void row_block(const RowIn& in, const RowVec& q, h16* ho, f32x4 (&hv)[4], int lane) {
    f32x4 v[4];
#pragma unroll
    for (int j = 0; j < 4; ++j) { f32x4 xv; if (XF32) xv = in.x[j]; else xv = (cvt4(in.hx[j]) - q.psh[j]) * q.rdiv[j];
        v[j] = DN_ALPHA * xv + q.gate1[j] * cvt4(in.y[j]); }
    ln_rows_v(v, q);
#pragma unroll
    for (int j = 0; j < 4; ++j) { const int col = 4 * lane + 256 * j;
        hv[j] = v[j] * q.sc1[j] + q.sh[j];
        v2u o; o.x = pk2h(hv[j][0], hv[j][1]); o.y = pk2h(hv[j][2], hv[j][3]); *(v2u*)(ho + col) = o; }
}
template <bool XF32> __device__ __forceinline__ void ph_rows(Frame& F, const float* xin, const h16* HIN, const float* psc, const float* psh, const h16* Y, const float* modl_gate  ,
                                        const float* lg, const float* lb, const float* mod_sc, const float* mod_sh, h16* HO) {
    const int gw = F.vcu * NWAVES + F.wave, WPB = F.G;
    const int b = gw / WPB, r0 = gw % WPB; const size_t bo = (size_t)b * (6 * D);
    RowVec q; rowvec_load<XF32>(q, psc + bo, psh + bo, modl_gate + bo, lg, lb, mod_sc + bo, mod_sh + bo, F.lane);
    for (int t0 = r0; t0 < SEQ; t0 += 4 * WPB) {
        RowIn r[4];
#pragma unroll
        for (int i = 0; i < 4; ++i) { const int t = t0 + i * WPB; if (t < SEQ) { const size_t m = (size_t)b * SEQ + t; row_load<XF32>(r[i], xin + m * D, HIN + m * D, Y + m * D, F.lane); } }
#pragma unroll
        for (int i = 0; i < 4; ++i) { const int t = t0 + i * WPB; if (t < SEQ) { const size_t m = (size_t)b * SEQ + t; f32x4 hv[4];
            row_block<XF32>(r[i], q, HO + m * D, hv, F.lane); } }
    }
}

__device__ __forceinline__ void ph10_ssm_naive(Frame& F) {
    const h16* U = (const h16*)(F.ws + WS_B); h16* GY = (h16*)(F.ws + WS_C);
    const float* SA = (const float*)(F.ws + WS_SSMA); const float* SB = (const float*)(F.ws + WS_SSMB);
    const int gw = F.vcu * NWAVES + F.wave, NGW = F.G * NWAVES, lane = F.lane;
    for (int it = gw; it < BATCH * 64; it += NGW) {
        const int b = it >> 6, g = it & 63, gp = g * 64 + lane;
        const float abr = SA[gp * 2], abi = SA[gp * 2 + 1];
        float bbr[16], bbi[16], cr[16], ci[16];
#pragma unroll
        for (int c = 0; c < 16; ++c) { bbr[c] = SB[(gp * 16 + c) * 2]; bbi[c] = SB[(gp * 16 + c) * 2 + 1]; cr[c] = F.in[I_CRE][(g * 16 + c) * 64 + lane]; ci[c] = F.in[I_CIM][(g * 16 + c) * 64 + lane]; }
        const float dsk = F.in[I_DSKIP][g * 16 + (lane & 15)];
        float hr = 0.f, hi = 0.f;
        for (int t = 0; t < SEQ; ++t) {
            const h16* ur = U + (size_t)(b * SEQ + t) * D + g * 16;
            float u[16]; ld8h(ur, u); ld8h(ur + 8, u + 8);
            float xr = 0.f, xi = 0.f;
#pragma unroll
            for (int c = 0; c < 16; ++c) { xr += bbr[c] * u[c]; xi += bbi[c] * u[c]; }
            const float nhr = abr * hr - abi * hi + xr, nhi = abr * hi + abi * hr + xi; hr = nhr; hi = nhi;
            float mine = 0.f;
#pragma unroll
            for (int c = 0; c < 16; ++c) { const float yc = wave_sum(cr[c] * hr - ci[c] * hi); if (lane == c) mine = yc; }
            if (lane < 16) { const float val = mine + dsk * h2f(ur[lane]); GY[(size_t)(b * SEQ + t) * D + g * 16 + lane] = (h16)(pk2h(gelu_tanh(val), 0.f) & 0xffffu); }
        }
    }
}


__device__ __forceinline__ void ssm_prep(Frame& F) {
    typedef float f32x2v __attribute__((ext_vector_type(2)));
    const float* SA = (const float*)(F.ws + WS_SSMA); const float* SB = (const float*)(F.ws + WS_SSMB);
    LAS f32x2v* PW = (LAS f32x2v*)(F.lds + RING_OFF);
    LAS f32x2v* BB = (LAS f32x2v*)(F.lds + RING_OFF + 16384);
    LAS f32x2v* CC = (LAS f32x2v*)(F.lds + RING_OFF + 32768);
    LAS float* KL = (LAS float*)(F.lds + RING_OFF + 49152);
    const int tid = F.tid;
    LAS int* tsk = (LAS int*)(F.lds + RING_OFF + 65536);
    for (;;) {
        if (tid == 0) *tsk = (int)__hip_atomic_fetch_add(F.ctl + CW_PREP, 1u, RLX_AGENT);
        __syncthreads();
        const int task = *tsk;
        __syncthreads();
        if (task >= 256) break;
        const int g = task >> 2, part = task & 3;
        const float idt = 1.0f / expf(F.in[I_LOGDT][g]);
        if (tid < 64) { float pr = 1.0f, pi = 0.0f; const float ar = SA[(g * 64 + tid) * 2], ai = SA[(g * 64 + tid) * 2 + 1];
            for (int k = 0; k <= 16; ++k) { PW[k * 64 + tid] = (f32x2v){pr, pi}; const float nr = pr * ar - pi * ai, ni = pr * ai + pi * ar; pr = nr; pi = ni; } }
        for (int e = tid; e < 1024; e += NWAVES * 64) { BB[e] = (f32x2v){SB[(g * 1024 + e) * 2] * idt, SB[(g * 1024 + e) * 2 + 1] * idt};
            CC[e] = (f32x2v){F.in[I_CRE][g * 1024 + e], F.in[I_CIM][g * 1024 + e]}; }
        __syncthreads();
        h16* base = (h16*)((unsigned char*)F.out + 100 * MiB) + (size_t)g * 131072;
        if (part == 0) {
            for (int q = tid; q < 64 * 64; q += NWAVES * 64) { const int f = q >> 6, l = q & 63, rt = f >> 4, t = f & 15, r32 = l & 31, hi = l >> 5, p = 16 * rt + (r32 & 15), im = r32 >> 4;
                const f32x2v a = PW[(15 - t) * 64 + p]; hf8 v;
#pragma unroll
                for (int j = 0; j < 8; ++j) { const f32x2v bb = BB[p * 16 + 8 * hi + j]; v[j] = (_Float16)(im ? (a.x * bb.y + a.y * bb.x) : (a.x * bb.x - a.y * bb.y)); }
                *(v4u*)(base + (size_t)q * 8) = __builtin_bit_cast(v4u, v); }
        } else if (part == 1) {
            for (int q = tid; q < 64 * 64; q += NWAVES * 64) { const int f = q >> 6, l = q & 63, rtY = f >> 3, q8 = f & 7, rt = q8 >> 1, sIm = q8 & 1, r32 = l & 31, hi = l >> 5;
                const int t = 2 * rtY + (r32 >> 4), c = r32 & 15; hf8 v;
#pragma unroll
                for (int j = 0; j < 8; ++j) { const int p = 16 * rt + (j & 3) + 8 * (j >> 2) + 4 * hi; const f32x2v a = PW[(t + 1) * 64 + p], cc = CC[c * 64 + p];
                    const float zr = cc.x * a.x - cc.y * a.y, zi = cc.x * a.y + cc.y * a.x; v[j] = (_Float16)(sIm ? -zi : zr); }
                *(v4u*)(base + 32768 + (size_t)q * 8) = __builtin_bit_cast(v4u, v); }
        } else {
            { const int L = tid >> 5, c = (tid >> 1) & 15, c20 = (tid & 1) * 8; float acc8[8];
#pragma unroll
                for (int j = 0; j < 8; ++j) acc8[j] = 0.f;
                for (int p = 0; p < 64; ++p) { const f32x2v a = PW[L * 64 + p], cc = CC[c * 64 + p];
                    const float zr = cc.x * a.x - cc.y * a.y, zi = cc.x * a.y + cc.y * a.x;
#pragma unroll
                    for (int j = 0; j < 8; ++j) { const f32x2v bb = BB[p * 16 + c20 + j]; acc8[j] += zr * bb.x - zi * bb.y; } }
#pragma unroll
                for (int j = 0; j < 8; ++j) KL[L * 256 + c * 16 + c20 + j] = acc8[j]; }
            __syncthreads();
            const int q0 = (part - 2) * 4096;
            for (int q = q0 + tid; q < q0 + 4096; q += NWAVES * 64) { const int f = q >> 6, l = q & 63, rtY = f >> 4, s = f & 15, r32 = l & 31, hi = l >> 5;
                const int t = 2 * rtY + (r32 >> 4), c = r32 & 15, L = t - s; hf8 v;
#pragma unroll
                for (int j = 0; j < 8; ++j) v[j] = (_Float16)((L >= 0) ? KL[(L & 15) * 256 + c * 16 + 8 * hi + j] : 0.f);
                *(v4u*)(base + 65536 + (size_t)q * 8) = __builtin_bit_cast(v4u, v); }
        }
        __syncthreads();
    }
}
__device__ __forceinline__ void ph10_ssm_mfma(Frame& F) {
    const h16* U = (const h16*)(F.ws + WS_B); h16* GY = (h16*)(F.ws + WS_C);
    const float* SA = (const float*)(F.ws + WS_SSMA);
    typedef float f32x2v __attribute__((ext_vector_type(2)));
    LAS f32x2v* SL = (LAS f32x2v*)(F.lds + RING_OFF);
    LAS unsigned char* OPL = F.lds + RING_OFF;
    int tid_ = F.tid; asm volatile("" : "+v"(tid_));
    const int tid = tid_, lane = tid & 63, r32 = lane & 31, hi = lane >> 5, wave = F.wave;
    for (int unit = blockIdx.x; unit < BATCH * 64; unit += F.G) {
        const int b = unit >> 6, g = unit & 63;
        const float dt = expf(F.in[I_LOGDT][g]);
        const h16* MW1 = (const h16*)((const unsigned char*)F.out + 100 * MiB) + (size_t)g * 131072; const h16* MG = MW1 + 32768; const h16* MT = MW1 + 65536;
        const int ch = 32 * wave + r32;
        const h16* urow = U + (size_t)(b * SEQ + 16 * ch) * D + g * 16;
        { v4u w1[8];
#pragma unroll
            for (int i = 0; i < 8; ++i) w1[i] = *(const v4u*)(MW1 + (size_t)(i * 512 + tid) * 8);
#pragma unroll
            for (int i = 0; i < 8; ++i) *(LAS v4u*)(OPL + (size_t)(i * 512 + tid) * 16) = w1[i]; }
        __builtin_amdgcn_sched_barrier(0);
        hf8 ub[16];
#pragma unroll
        for (int t = 0; t < 16; ++t) ub[t] = ldf8(urow + (size_t)t * D + 8 * hi);
        __syncthreads();
        f32x16 acc[4];
#pragma unroll
        for (int rt = 0; rt < 4; ++rt)
#pragma unroll
            for (int r = 0; r < 16; ++r) acc[rt][r] = 0.f;
#pragma unroll
        for (int t = 0; t < 16; ++t)
        {
#pragma unroll
            for (int rt = 0; rt < 4; ++rt) acc[rt] = MFMA32(__builtin_bit_cast(hf8, *(const LAS v4u*)(OPL + (rt * 16 + t) * 1024 + lane * 16)), ub[t], acc[rt]);
            if ((t & 3) == 3) __builtin_amdgcn_sched_barrier(0); }
        __syncthreads();
#pragma unroll
        for (int rt = 0; rt < 4; ++rt)
#pragma unroll
            for (int r = 0; r < 8; ++r) { const int p = 16 * rt + (r & 3) + 8 * (r >> 2) + 4 * hi; SL[p * 257 + ch] = (f32x2v){acc[rt][r], acc[rt][r + 8]}; }
        __syncthreads();
        {
            const int p = tid & 63, sg = tid >> 6;
            float pr = SA[(g * 64 + p) * 2], pi = SA[(g * 64 + p) * 2 + 1];
#pragma unroll
            for (int q = 0; q < 4; ++q) { const float nr = pr * pr - pi * pi, ni = 2.0f * pr * pi; pr = nr; pi = ni; }
            const float aLr = pr, aLi = pi;
            float xr = 0.f, xi = 0.f;
            for (int j0 = 0; j0 < 32; j0 += 8) { f32x2v sv[8];
#pragma unroll
                for (int j = 0; j < 8; ++j) sv[j] = SL[p * 257 + 32 * sg + j0 + j];
#pragma unroll
                for (int j = 0; j < 8; ++j) { const float nr = aLr * xr - aLi * xi + sv[j].x, ni = aLr * xi + aLi * xr + sv[j].y; xr = nr; xi = ni; sv[j] = (f32x2v){xr, xi}; }
#pragma unroll
                for (int j = 0; j < 8; ++j) SL[p * 257 + 32 * sg + j0 + j] = sv[j]; }
#pragma unroll
            for (int q = 0; q < 5; ++q) { const float nr = pr * pr - pi * pi, ni = 2.0f * pr * pi; pr = nr; pi = ni; }
            __syncthreads();
            float cr = 0.f, ci = 0.f;
            for (int s2 = 0; s2 < sg; ++s2) { const int c2 = 32 * s2 + 31; const f32x2v ag = SL[p * 257 + c2];
                const float nr = pr * cr - pi * ci + ag.x, ni = pr * ci + pi * cr + ag.y; cr = nr; ci = ni; }
            __syncthreads();
            float prevr = 0.f, previ = 0.f, wr = 1.0f, wi = 0.0f;
            for (int j0 = 0; j0 < 32; j0 += 8) { f32x2v xv[8];
#pragma unroll
                for (int j = 0; j < 8; ++j) xv[j] = SL[p * 257 + 32 * sg + j0 + j];
#pragma unroll
                for (int j = 0; j < 8; ++j) { const f32x2v in = (f32x2v){prevr + wr * cr - wi * ci, previ + wr * ci + wi * cr};
                    prevr = xv[j].x; previ = xv[j].y; xv[j] = in; const float nr = wr * aLr - wi * aLi, ni = wr * aLi + wi * aLr; wr = nr; wi = ni; }
#pragma unroll
                for (int j = 0; j < 8; ++j) SL[p * 257 + 32 * sg + j0 + j] = xv[j]; }
        }
        __syncthreads();
        v4u ifw[8];
#pragma unroll
        for (int rt = 0; rt < 4; ++rt) { float re[8], im[8];
#pragma unroll
            for (int j = 0; j < 8; ++j) { const int p = 16 * rt + (j & 3) + 8 * (j >> 2) + 4 * hi; const f32x2v v = SL[p * 257 + ch]; re[j] = v.x; im[j] = v.y; }
            v4u w0, w1; w0.x = pk2h(re[0], re[1]); w0.y = pk2h(re[2], re[3]); w0.z = pk2h(re[4], re[5]); w0.w = pk2h(re[6], re[7]);
            w1.x = pk2h(im[0], im[1]); w1.y = pk2h(im[2], im[3]); w1.z = pk2h(im[4], im[5]); w1.w = pk2h(im[6], im[7]);
            ifw[2 * rt] = w0; ifw[2 * rt + 1] = w1; }
        LAS v4u* IFL = (LAS v4u*)(OPL + 49152 + wave * 8192);
        const f32x4 dk0 = *(const f32x4*)(F.in[I_DSKIP] + g * 16 + 4 * hi), dk1 = *(const f32x4*)(F.in[I_DSKIP] + g * 16 + 8 + 4 * hi);
        h16* yrow = GY + (size_t)(b * SEQ + 16 * ch) * D + g * 16;
        v4u pg, pt0, pt1;
        pg = *(const v4u*)(MG + (size_t)tid * 8); pt0 = *(const v4u*)(MT + (size_t)tid * 8); pt1 = pt0;
        __syncthreads();
#pragma unroll
        for (int q = 0; q < 8; ++q) IFL[q * 64 + lane] = ifw[q];
        *(LAS v4u*)(OPL + tid * 16) = pg; if (tid < 128) *(LAS v4u*)(OPL + 8192 + tid * 16) = pt0;
        __syncthreads();
#pragma unroll
        for (int rtY = 0; rtY < 8; ++rtY) {
            LAS unsigned char* cur = OPL + (rtY & 1) * 24576;
            if (rtY < 7) { const int nT = (2 * (rtY + 1) + 2) * 64;
                pg = *(const v4u*)(MG + (size_t)((rtY + 1) * 8 * 64 + tid) * 8);
                if (tid < nT) pt0 = *(const v4u*)(MT + (size_t)((rtY + 1) * 16 * 64 + tid) * 8);
                if (tid + 512 < nT) pt1 = *(const v4u*)(MT + (size_t)((rtY + 1) * 16 * 64 + tid + 512) * 8); }
            f32x16 y0, y1;
#pragma unroll
            for (int r = 0; r < 16; ++r) { y0[r] = 0.f; y1[r] = 0.f; }
#pragma unroll
            for (int q = 0; q < 8; ++q) { const hf8 af = __builtin_bit_cast(hf8, *(const LAS v4u*)(cur + q * 1024 + lane * 16)); const hf8 bf = __builtin_bit_cast(hf8, IFL[q * 64 + lane]); if (q & 1) y1 = MFMA32(af, bf, y1); else y0 = MFMA32(af, bf, y0); }
#pragma unroll
            for (int s2 = 0; s2 <= 2 * rtY + 1; ++s2) { const hf8 af = __builtin_bit_cast(hf8, *(const LAS v4u*)(cur + 8192 + s2 * 1024 + lane * 16)); if (s2 & 1) y1 = MFMA32(af, ub[s2], y1); else y0 = MFMA32(af, ub[s2], y0); }
#pragma unroll
            for (int tt = 0; tt < 2; ++tt) { const size_t ro = (size_t)(2 * rtY + tt) * D;
                const v4u uw = __builtin_bit_cast(v4u, ub[2 * rtY + tt]);
                const auto sw0 = __builtin_amdgcn_permlane32_swap(uw.x, uw.z, false, false), sw1 = __builtin_amdgcn_permlane32_swap(uw.y, uw.w, false, false);
                const f32x4 u0 = {hlo(sw0[0]), hhi(sw0[0]), hlo(sw1[0]), hhi(sw1[0])}, u1 = {hlo(sw0[1]), hhi(sw0[1]), hlo(sw1[1]), hhi(sw1[1])};
                float yv[8];
#pragma unroll
                for (int e = 0; e < 8; ++e) yv[e] = (y0[8 * tt + e] + y1[8 * tt + e]) * dt;
                v2u w0, w1;
                w0.x = pk2h(gelu_tanh(yv[0] + dk0[0] * u0[0]), gelu_tanh(yv[1] + dk0[1] * u0[1])); w0.y = pk2h(gelu_tanh(yv[2] + dk0[2] * u0[2]), gelu_tanh(yv[3] + dk0[3] * u0[3]));
                w1.x = pk2h(gelu_tanh(yv[4] + dk1[0] * u1[0]), gelu_tanh(yv[5] + dk1[1] * u1[1])); w1.y = pk2h(gelu_tanh(yv[6] + dk1[2] * u1[2]), gelu_tanh(yv[7] + dk1[3] * u1[3]));
                const auto sx = __builtin_amdgcn_permlane32_swap(w0.x, w1.x, false, false), sy = __builtin_amdgcn_permlane32_swap(w0.y, w1.y, false, false);
                *(v4u*)(yrow + ro + 8 * hi) = (v4u){sx[0], sy[0], sx[1], sy[1]}; }
            if (rtY < 7) { const int nT = (2 * (rtY + 1) + 2) * 64; LAS unsigned char* nxt = OPL + ((rtY + 1) & 1) * 24576;
                *(LAS v4u*)(nxt + tid * 16) = pg;
                if (tid < nT) *(LAS v4u*)(nxt + 8192 + tid * 16) = pt0;
                if (tid + 512 < nT) *(LAS v4u*)(nxt + 8192 + (tid + 512) * 16) = pt1; }
            __syncthreads();
        }
    }
}

__device__ __forceinline__ void ph12_rows_route(Frame& F) {
    const int gw = F.vcu * NWAVES + F.wave, NGW = F.G * NWAVES, lane = F.lane;
    const float* mod1 = (const float*)(F.ws + WS_MOD) + (size_t)BATCH * 6 * D;
    const h16* Y3 = (const h16*)(F.ws + WS_A); h16* H16 = (h16*)(F.ws + WS_VT1);
    int* tok_e = (int*)(F.ws + WS_TOKE); float* tok_g = (float*)(F.ws + WS_TOKG);
    LAS unsigned* lcnt = (LAS unsigned*)(F.lds + 1024);
    if (F.tid < 8) lcnt[F.tid] = 0u;
    __syncthreads();
    LAS f32x4* RWL = (LAS f32x4*)(F.lds + 4096);
    for (int e = F.tid; e < 2048; e += NWAVES * 64) { const int jih = e >> 6, l = e & 63, j = jih >> 3, i = (jih >> 1) & 3, hf = jih & 1;
        RWL[e] = *(const f32x4*)(F.in[I_RW] + (size_t)(4 * l + 256 * j + i) * 8 + 4 * hf); }
    __syncthreads();
    const f32x4 rb0 = *(const f32x4*)(F.in[I_RB]), rb1 = *(const f32x4*)(F.in[I_RB] + 4);
    const h16* UPREV = (const h16*)(F.ws + WS_B);
    const int WPB = F.G, bq = gw / WPB, r0 = gw % WPB; const size_t bo = (size_t)bq * (6 * D);
    RowVec q; rowvec_load<false>(q, mod1 + bo + 1 * D, mod1 + bo, mod1 + bo + 2 * D, F.in[I_LN1G1], F.in[I_LN1B1], mod1 + bo + 4 * D, mod1 + bo + 3 * D, lane);
    for (int t0 = r0; t0 < SEQ; t0 += WPB) {
        { const int m = bq * SEQ + t0;
        RowIn rr1; row_load<false>(rr1, nullptr, UPREV + (size_t)m * D, Y3 + (size_t)m * D, lane);
        f32x4 hv[4];
        row_block<false>(rr1, q, H16 + (size_t)m * D, hv, lane);
        f32x4 a0 = {0.f, 0.f, 0.f, 0.f}, a1 = a0;
#pragma unroll
        for (int j = 0; j < 4; ++j)
#pragma unroll
            for (int i = 0; i < 4; ++i) { a0 += hv[j][i] * RWL[((j * 4 + i) * 2 + 0) * 64 + lane]; a1 += hv[j][i] * RWL[((j * 4 + i) * 2 + 1) * 64 + lane]; }
        float lg[8];
#pragma unroll
        for (int e = 0; e < 4; ++e) { lg[e] = wave_sum(a0[e]) + rb0[e]; lg[4 + e] = wave_sum(a1[e]) + rb1[e]; }
        int e1 = 0; float v1 = lg[0];
#pragma unroll
        for (int e = 1; e < 8; ++e) if (lg[e] > v1) { v1 = lg[e]; e1 = e; }
        int e2 = -1; float v2 = -INFINITY;
#pragma unroll
        for (int e = 0; e < 8; ++e) if (e != e1 && lg[e] > v2) { v2 = lg[e]; e2 = e; }
        const float g1 = 1.0f / (1.0f + expf(v2 - v1)), g2 = 1.0f - g1;
        if (lane == 0) { tok_e[2 * m] = e1; tok_e[2 * m + 1] = e2; tok_g[2 * m] = g1; tok_g[2 * m + 1] = g2;
            __hip_atomic_fetch_add(lcnt + e1, 1u, __ATOMIC_RELAXED, __HIP_MEMORY_SCOPE_WORKGROUP); __hip_atomic_fetch_add(lcnt + e2, 1u, __ATOMIC_RELAXED, __HIP_MEMORY_SCOPE_WORKGROUP); }
        }
    }
    __syncthreads();
    if (F.tid < 8) __hip_atomic_fetch_add(F.ctl + CW_ECNT + F.tid, lcnt[F.tid], RLX_AGENT);
}
__device__ __forceinline__ void moe_prefix(Frame& F, int (&tp)[9]) {
    int acc = 0;
#pragma unroll
    for (int e = 0; e < 8; ++e) { tp[e] = acc; const unsigned c = __hip_atomic_load(F.ctl + CW_ECNT + e, RLX_AGENT); acc += (int)((c + 255u) >> 8); }
    tp[8] = acc;
}
__device__ __forceinline__ void ph13_gather(Frame& F) {
    const int gw = F.vcu * NWAVES + F.wave, NGW = F.G * NWAVES, lane = F.lane;
    int tp[9]; moe_prefix(F, tp);
    const int* tok_e = (const int*)(F.ws + WS_TOKE); int* tok_p = (int*)(F.ws + WS_TOKP);
    const h16* H16 = (const h16*)(F.ws + WS_VT1); h16* HG = (h16*)(F.ws + WS_B);
    for (int base = gw * 16; base < M; base += NGW * 16) {
        const bool own = lane < 16; const int m = base + (lane & 15);
        const int ea = own ? tok_e[2 * m] : -1, eb = own ? tok_e[2 * m + 1] : -1;
        const unsigned long long below = (lane == 0) ? 0ull : (~0ull >> (64 - lane));
        int ra = 0, rb = 0, mycnt = 0;
#pragma unroll
        for (int e = 0; e < 8; ++e) {
            const unsigned long long ma = __ballot(ea == e), mb = __ballot(eb == e);
            const int ca = __popcll(ma), cb = __popcll(mb);
            if (lane == e) mycnt = ca + cb;
            if (ea == e) ra = __popcll(ma & below);
            if (eb == e) rb = ca + __popcll(mb & below);
        }
        unsigned basee = 0u;
        if (lane < 8 && mycnt > 0) basee = __hip_atomic_fetch_add(F.ctl + CW_ECUR + lane, (unsigned)mycnt, RLX_AGENT);
        int tpl = 0;
#pragma unroll
        for (int e = 0; e < 8; ++e) if (lane == e) tpl = tp[e];
        const int segbase = tpl * 256 + (int)basee;
        const int pa = __shfl(segbase, ea & 7) + ra, pb = __shfl(segbase, eb & 7) + rb;
        if (own) { tok_p[2 * m] = pa; tok_p[2 * m + 1] = pb; }
#pragma unroll
        for (int t4 = 0; t4 < 16; t4 += 8) {
            v4u v0[8], v1[8]; int p1[8], p2[8];
#pragma unroll
            for (int i = 0; i < 8; ++i) { const h16* src = H16 + (size_t)(base + t4 + i) * D; v0[i] = *(const v4u*)(src + 8 * lane); v1[i] = *(const v4u*)(src + 512 + 8 * lane);
                p1[i] = __shfl(pa, t4 + i); p2[i] = __shfl(pb, t4 + i); }
#pragma unroll
            for (int i = 0; i < 8; ++i) {
                *(v4u*)(HG + (size_t)p1[i] * D + 8 * lane) = v0[i]; *(v4u*)(HG + (size_t)p1[i] * D + 512 + 8 * lane) = v1[i];
                *(v4u*)(HG + (size_t)p2[i] * D + 8 * lane) = v0[i]; *(v4u*)(HG + (size_t)p2[i] * D + 512 + 8 * lane) = v1[i]; }
        }
    }
}
__device__ __forceinline__ void ph16_final(Frame& F) {
    const int gw = F.vcu * NWAVES + F.wave, NGW = F.G * NWAVES, lane = F.lane;
    const float* mod1 = (const float*)(F.ws + WS_MOD) + (size_t)BATCH * 6 * D;
    const int* tok_p = (const int*)(F.ws + WS_TOKP); const float* tok_g = (const float*)(F.ws + WS_TOKG);
    const h16* YG = (const h16*)(F.ws + WS_B);
    const h16* H16 = (const h16*)(F.ws + WS_VT1);
    struct Row16 { v2u x[4]; v2u a[4], c[4]; float w1, w2; };
    auto load16 = [&](Row16& r, int m) {
        const int p1 = tok_p[2 * m], p2 = tok_p[2 * m + 1]; r.w1 = tok_g[2 * m]; r.w2 = tok_g[2 * m + 1];
#pragma unroll
        for (int j = 0; j < 4; ++j) { const int col = 4 * lane + 256 * j; r.x[j] = *(const v2u*)(H16 + (size_t)m * D + col);
            r.a[j] = *(const v2u*)(YG + (size_t)p1 * D + col); r.c[j] = *(const v2u*)(YG + (size_t)p2 * D + col); } };
    const int WPB = F.G, bq = gw / WPB, r0 = gw % WPB; const size_t bo = (size_t)bq * (6 * D);
    RowVec q; rowvec_load<false>(q, mod1 + bo + 4 * D, mod1 + bo + 3 * D, mod1 + bo + 5 * D, F.in[I_LN2G1], F.in[I_LN2B1], mod1 + bo, mod1 + bo, lane);
    for (int t0 = r0; t0 < SEQ; t0 += 4 * WPB) {
        Row16 rw4[4];
#pragma unroll
        for (int i = 0; i < 4; ++i) { const int t = t0 + i * WPB; if (t < SEQ) load16(rw4[i], bq * SEQ + t); }
#pragma unroll
        for (int i = 0; i < 4; ++i) { const int t = t0 + i * WPB; if (t >= SEQ) continue; const int m = bq * SEQ + t; const Row16& cur = rw4[i];
        f32x4 v[4];
#pragma unroll
        for (int j = 0; j < 4; ++j) {
            const f32x4 ya = {hlo(cur.a[j].x), hhi(cur.a[j].x), hlo(cur.a[j].y), hhi(cur.a[j].y)}, yc = {hlo(cur.c[j].x), hhi(cur.c[j].x), hlo(cur.c[j].y), hhi(cur.c[j].y)};
            const f32x4 x3 = (cvt4(cur.x[j]) - q.psh[j]) * q.rdiv[j];
            v[j] = DN_ALPHA * x3 + q.gate1[j] * (cur.w1 * ya + cur.w2 * yc); }
        ln_rows_v(v, q);
#pragma unroll
        for (int j = 0; j < 4; ++j) *(f32x4*)(F.out + (size_t)m * D + 4 * lane + 256 * j) = v[j];
        }
    }
}

struct Args { const float* in[39]; float* out; unsigned char* ws; int ph_lo, ph_hi; };
__global__ void __launch_bounds__(NWAVES * 64, 2) mk_fwd(Args args) {
    extern __shared__ __attribute__((aligned(16))) unsigned char lds[];
    Frame F;
    F.lds = (LAS unsigned char*)lds;
    F.MISC = (volatile LAS unsigned*)(F.lds + MISC_OFF);
    F.tid = threadIdx.x; F.lane = F.tid & 63; F.wave = __builtin_amdgcn_readfirstlane(F.tid >> 6);
    F.G = gridDim.x; { const int bx = blockIdx.x; F.vcu = (F.G % 8 == 0) ? (bx % 8) * (F.G / 8) + bx / 8 : bx; }
    F.ws = args.ws; F.out = args.out; F.ctl = (gu32*)(args.ws + WS_CTL);
#pragma unroll
    for (int i = 0; i < 39; ++i) F.in[i] = args.in[i];
    for (int u = F.tid; u < (LDS_BYTES - LDSCTL_OFF) / 4; u += NWAVES * 64) ((LAS unsigned*)(F.lds + LDSCTL_OFF))[u] = 0u;
    __syncthreads();
    XcdBarrier bar; bar.bar = (unsigned*)(F.ctl + CW_BAR); bar.x = 0; bar.st = nullptr;
    if (N_LAUNCHES == 1) bar = xcd_barrier_post((unsigned*)(F.ctl + CW_BAR), F.MISC + 8);
    const int lo = args.ph_lo, hi = args.ph_hi;
    unsigned char* ws = args.ws;
    const float* mod0 = (const float*)(ws + WS_MOD); const float* mod1 = mod0 + (size_t)BATCH * 6 * D;
#ifndef PH_MASK
#define PH_MASK 0x1ffff
#endif
#define IN(k) (((PH_MASK >> (k)) & 1) && lo <= (k) && (k) < hi)
#define SEAM(k) do { if (N_LAUNCHES == 1 && IN(k) && IN((k) + 1)) xcd_barrier(bar); } while (0)

    if (IN(0)) { ph0_mods(F); SEAM(0); }
    if (IN(1)) { ph1_prologue(F); SEAM(1); }
    if (IN(2)) {
        pg8::Gemm g{(const h16*)(ws + WS_B), (const h16*)(ws + WS_W_IN), M, 3 * D, D}; pg8::StaticOrder S; S.init(M, 3 * D, F.G, (int)blockIdx.x);
        pg8::EpiQKV E{(h16*)(ws + WS_A), (h16*)(ws + WS_KA), (h16*)(ws + WS_KB1), (h16*)(ws + WS_KB4), (h16*)(ws + WS_KB16), (unsigned*)(F.ctl + CW_KMAX), QSCALE_A, QSCALE_B};
        pg8::gemm_phase<pg8::EpiQKV, pg8::StaticOrder, true, true>(F.lds + RING_OFF, g, S, E);
        SEAM(2);
    }
    if (IN(4)) { ph4_diff_mfma(F); dil_pass<0>(F); dil_pass<1>(F);
        __syncthreads(); ssm_prep(F);
        xcd_barrier(bar); dil_pass<2>(F); SEAM(4); }
    if (IN(5)) {
        pg8::Gemm g{(const h16*)(ws + WS_B), (const h16*)(ws + WS_W_OUT), M, D, D}; pg8::StaticOrder S; S.init(M, D, F.G, (int)blockIdx.x);
        pg8::EpiF16 E{(h16*)(ws + WS_C), D, 4, 0.f, 0.f};
        pg8::gemm_phase<pg8::EpiF16, pg8::StaticOrder, true, true>(F.lds + RING_OFF, g, S, E);
        SEAM(5);
    }
    if (IN(6)) {
        ph_rows<true>(F, F.in[I_X], (const h16*)(ws + WS_B), mod0, mod0, (const h16*)(ws + WS_C), mod0 + 2 * D, F.in[I_LN1G0], F.in[I_LN1B0], mod0 + 4 * D, mod0 + 3 * D, (h16*)(ws + WS_B));
        SEAM(6);
    }
    if (IN(7)) {
        pg8::Gemm g{(const h16*)(ws + WS_B), (const h16*)(ws + WS_W_F1), M, 2 * DFF, D}; pg8::StaticOrder S; S.init(M, 2 * DFF, F.G, (int)blockIdx.x);
        pg8::EpiGated<0> E{(h16*)(ws + WS_A), DFF, 22, nullptr};
        pg8::gemm_phase<pg8::EpiGated<0>, pg8::StaticOrder, true, true>(F.lds + RING_OFF, g, S, E);
        SEAM(7);
    }
    if (IN(8)) {
        pg8::Gemm g{(const h16*)(ws + WS_A), (const h16*)(ws + WS_W_F2), M, D, DFF}; pg8::StaticOrder S; S.init(M, D, F.G, (int)blockIdx.x);
        pg8::EpiF16 E{(h16*)(ws + WS_C), D, 4, 0.f, 0.f};
        pg8::gemm_phase<pg8::EpiF16, pg8::StaticOrder, true, true>(F.lds + RING_OFF, g, S, E);
        SEAM(8);
    }
    if (IN(9)) {
        ph_rows<false>(F, nullptr, (const h16*)(ws + WS_B), mod0 + 4 * D, mod0 + 3 * D, (const h16*)(ws + WS_C), mod0 + 5 * D, F.in[I_LN2G0], F.in[I_LN2B0], mod1 + 1 * D, mod1 + 0 * D, (h16*)(ws + WS_B));
        SEAM(9);
    }
    if (IN(10)) { ph10_ssm_mfma(F); SEAM(10); }
    if (IN(11)) {
        pg8::Gemm g{(const h16*)(ws + WS_C), (const h16*)(ws + WS_W_GLU), M, 2 * D, D}; pg8::StaticOrder S; S.init(M, 2 * D, F.G, (int)blockIdx.x);
        pg8::EpiGated<1> E{(h16*)(ws + WS_A), D, 8, F.in[I_BGLU]};
        pg8::gemm_phase<pg8::EpiGated<1>, pg8::StaticOrder, true, true>(F.lds + RING_OFF, g, S, E);
        SEAM(11);
    }
    if (IN(12)) { ph12_rows_route(F); SEAM(12); }
    if (IN(13)) { ph13_gather(F); SEAM(13); }
    if (IN(14)) {
        pg8::MoeOrder S; moe_prefix(F, S.tp); S.nN = 11; S.G = F.G; S.c = (int)blockIdx.x;
        pg8::Gemm g{(const h16*)(ws + WS_B), (const h16*)(ws + WS_W_E1), 0, 2 * DFE, D};
        pg8::EpiGated<0> E{(h16*)(ws + WS_A), DFE, 11, nullptr};
        pg8::gemm_phase<pg8::EpiGated<0>, pg8::MoeOrder, true, true>(F.lds + RING_OFF, g, S, E);
        SEAM(14);
    }
    if (IN(15)) {
        pg8::MoeOrder S; moe_prefix(F, S.tp); S.nN = 4; S.G = F.G; S.c = (int)blockIdx.x;
        pg8::Gemm g{(const h16*)(ws + WS_A), (const h16*)(ws + WS_W_E2), 0, D, DFE};
        pg8::EpiF16 E{(h16*)(ws + WS_B), D, 4, 0.f, 0.f};
        pg8::gemm_phase<pg8::EpiF16, pg8::MoeOrder, true, true>(F.lds + RING_OFF, g, S, E);
        SEAM(15);
    }
    if (IN(16)) { ph16_final(F); }
#undef IN
#undef SEAM
}

extern "C" void kernel_launch(void* const* d_in, const int* in_sizes, int n_in, void* d_out, int out_size, void* d_ws, size_t ws_size, hipStream_t stream) {
    static int grid = 0;
    if (grid == 0) {
        if (n_in != 39 || in_sizes[0] != M * D || out_size != M * D || ws_size < WS_END) { fprintf(stderr, "kernel_launch: unexpected problem shape (n_in %d, in0 %d, out %d, ws %zu)\n", n_in, n_in > 0 ? in_sizes[0] : -1, out_size, ws_size); grid = -1; return; }
        int dev = 0, cus = 0, per_cu = 0;
        if (hipGetDevice(&dev) != hipSuccess || hipDeviceGetAttribute(&cus, hipDeviceAttributeMultiprocessorCount, dev) != hipSuccess) { grid = -1; return; }
        if (hipFuncSetAttribute((const void*)mk_fwd, hipFuncAttributeMaxDynamicSharedMemorySize, LDS_BYTES) != hipSuccess) { fprintf(stderr, "kernel_launch: hipFuncSetAttribute failed\n"); grid = -1; return; }
        if (hipOccupancyMaxActiveBlocksPerMultiprocessor(&per_cu, (const void*)mk_fwd, NWAVES * 64, LDS_BYTES) != hipSuccess || per_cu < 1) { fprintf(stderr, "kernel_launch: occupancy query says %d\n", per_cu); }
        (void)hipGetLastError();
        grid = cus;
    }
    if (grid < 0) return;
    if (hipMemsetAsync((char*)d_ws + WS_CTL, 0, CTL_ZERO_BYTES, stream) != hipSuccess) return;
    Args a{};
    for (int i = 0; i < 39; ++i) a.in[i] = (const float*)d_in[i];
    a.out = (float*)d_out; a.ws = (unsigned char*)d_ws;
    for (int li = 0; li < N_LAUNCHES; ++li) {
        a.ph_lo = (N_LAUNCHES == 1) ? 0 : li; a.ph_hi = (N_LAUNCHES == 1) ? NPH : li + 1;
        hipLaunchKernelGGL(mk_fwd, dim3(grid), dim3(NWAVES * 64), LDS_BYTES, stream, a);
        if (hipPeekAtLastError() != hipSuccess) { fprintf(stderr, "kernel_launch: launch %d failed\n", li); break; }
    }
}
```

```cpp
#include <hip/hip_runtime.h>
#include <cstdio>
#include <cstdint>

#ifndef MK_N_LAUNCHES
#define MK_N_LAUNCHES 1
#endif

namespace pg8 {
#define PG8_LAS __attribute__((address_space(3)))
typedef unsigned short h16_t;
typedef _Float16 f16x8 __attribute__((ext_vector_type(8)));
typedef _Float16 f16x2 __attribute__((ext_vector_type(2)));
typedef float f32x4 __attribute__((ext_vector_type(4)));
typedef unsigned u32x4 __attribute__((ext_vector_type(4)));
constexpr int BM = 256, BK = 64, HALF = 128, HTB = HALF * BK * 2  , STAGE_BYTES = 8 * HTB, NXCD = 8, WGM = 8;

__host__ __device__ __forceinline__ int lds_byte(int r, int c) { const int st = (r >> 4) * 2 + (c >> 5), rr = r & 15, cc = c & 31, ob = rr * 64 + cc * 2; return st * 1024 + (ob ^ (((ob >> 9) & 1) << 5)); }
__host__ __device__ __forceinline__ void stage_rc(int b, int& R, int& C) { const int st = b / 1024, sb = b % 1024, swz = sb ^ (((sb >> 9) & 1) << 5); R = (st >> 1) * 16 + swz / 64; C = (st & 1) * 32 + (swz % 64) / 2; }
__host__ __device__ __forceinline__ int perm32(int rho) { const int n = rho >> 4, i = rho & 15; return 8 * (i >> 2) + 4 * n + (i & 3); }

struct Unit { int pm, pn; };
struct Gemm { const h16_t* A; const h16_t* Bt; int M, N, K; };

struct StaticOrder {
    int nM, nN, nwg, G, c;
    __host__ __device__ void init(int M, int N, int G_, int c_) { nM = M / BM; nN = N / BM; nwg = nM * nN; G = G_; c = c_; }
    __host__ __device__ bool next(int i, Unit& u) const {
        const long L = (long)i * G + c; if (L >= nwg) return false;
        int wgid = (int)L; { const int q = nwg / NXCD, r = nwg % NXCD, xcd = wgid % NXCD, off = wgid / NXCD; wgid = (xcd < r ? xcd * (q + 1) : r * (q + 1) + (xcd - r) * q) + off; }
        const int nig = WGM * nN, gid = wgid / nig, fm = gid * WGM, gsz = (nM - fm) < WGM ? (nM - fm) : WGM;
        u.pm = fm + ((wgid % nig) % gsz); u.pn = (wgid % nig) / gsz; return true;
    }
    __device__ __forceinline__ void a_ready(const Unit&) const {}
    __device__ __forceinline__ void done(const Unit&) const {}
};
struct MoeOrder {
    int tp[9]; int nN, G, c;
    __device__ bool next(int i, Unit& u) const {
        const long L = (long)i * G + c; const int nM = tp[8], nwg = nM * nN; if (L >= nwg) return false;
        int wgid = (int)L; { const int q = nwg / NXCD, r = nwg % NXCD, xcd = wgid % NXCD, off = wgid / NXCD; wgid = (xcd < r ? xcd * (q + 1) : r * (q + 1) + (xcd - r) * q) + off; }
        const int nig = WGM * nN, gid = wgid / nig, fm = gid * WGM, gsz = (nM - fm) < WGM ? (nM - fm) : WGM;
        const int rt = fm + ((wgid % nig) % gsz), cn = (wgid % nig) / gsz; int e = 0;
#pragma unroll
        for (int k = 1; k < 8; ++k) e += (rt >= tp[k]) ? 1 : 0;
        u.pm = rt; u.pn = e * nN + cn; return true;
    }
    __device__ __forceinline__ void a_ready(const Unit&) const {}
    __device__ __forceinline__ void done(const Unit&) const {}
};

__device__ __forceinline__ unsigned pk2h(float lo, float hi) { f16x2 v = {(_Float16)lo, (_Float16)hi}; return __builtin_bit_cast(unsigned, v); }
__device__ __forceinline__ float fast_sigmoid(float v) { return __builtin_amdgcn_rcpf(1.0f + __builtin_amdgcn_exp2f(-1.4426950408889634f * v)); }

struct EpiF16 {
    static constexpr bool PERM = true, AFTER_DRAIN = false;
    h16_t* O; int ldc; int nmod; float sA; float sB;
    __device__ __forceinline__ void operator()(const f32x4 (&acc)[2][2][4][2], const Unit& u, int wr, int wc, int fr, int fq) const {
        const int row0 = u.pm * BM + wr * 64 + fr; const int pn = u.pn % nmod;
        float sc = 1.f; if (sA != 0.f) { if (pn < 2) sc = sA; else if (pn == 6 || pn == 7) sc = sB; }
        const int col0 = pn * BM + wc * 32 + 8 * fq;
#pragma unroll
        for (int ai = 0; ai < 2; ++ai)
#pragma unroll
            for (int m = 0; m < 4; ++m) { h16_t* rowp = O + (size_t)(row0 + ai * HALF + m * 16) * ldc + col0;
#pragma unroll
                for (int bj = 0; bj < 2; ++bj) { const f32x4 v0 = acc[ai][bj][m][0] * sc, v1 = acc[ai][bj][m][1] * sc;
                    u32x4 w; w.x = pk2h(v0[0], v0[1]); w.y = pk2h(v0[2], v0[3]); w.z = pk2h(v1[0], v1[1]); w.w = pk2h(v1[2], v1[3]);
                    *(u32x4*)(rowp + bj * HALF) = w; } }
    }
};

struct EpiQKV {
    static constexpr bool PERM = true, AFTER_DRAIN = false;
    h16_t* O; h16_t* KA; h16_t* KB1; h16_t* KB4; h16_t* KB16; unsigned* kmax; float sA, sB;
    __device__ __forceinline__ static int pi32(int r) { return (r & 0x13) | ((r & 4) << 1) | ((r & 8) >> 1); }
    __device__ __forceinline__ void operator()(const f32x4 (&acc)[2][2][4][2], const Unit& u, int wr, int wc, int fr, int fq) const {
        const int row0 = u.pm * BM + wr * 64 + fr, pn = u.pn;
        const bool isKA = (pn == 2 || pn == 3), isKB = (pn == 8 || pn == 9);
        if (!isKA && !isKB) {
            const float sc = (pn < 2) ? sA : (pn == 6 || pn == 7) ? sB : 1.0f;
            const int col0 = pn * BM + wc * 32 + 8 * fq;
#pragma unroll
            for (int ai = 0; ai < 2; ++ai)
#pragma unroll
                for (int m = 0; m < 4; ++m) { h16_t* rowp = O + (size_t)(row0 + ai * HALF + m * 16) * 3072 + col0;
#pragma unroll
                    for (int bj = 0; bj < 2; ++bj) { const f32x4 v0 = acc[ai][bj][m][0] * sc, v1 = acc[ai][bj][m][1] * sc;
                        u32x4 w; w.x = pk2h(v0[0], v0[1]); w.y = pk2h(v0[2], v0[3]); w.z = pk2h(v1[0], v1[1]); w.w = pk2h(v1[2], v1[3]);
                        *(u32x4*)(rowp + bj * HALF) = w; } }
            return;
        }
        const int b = u.pm >> 4;
        float mx[2] = {0.f, 0.f};
#pragma unroll
        for (int ai = 0; ai < 2; ++ai)
#pragma unroll
            for (int m = 0; m < 4; ++m) { const int t = (row0 + ai * HALF + m * 16) & 4095;
#pragma unroll
                for (int bj = 0; bj < 2; ++bj) { const f32x4 v0 = acc[ai][bj][m][0], v1 = acc[ai][bj][m][1];
                    u32x4 w; w.x = pk2h(v0[0], v0[1]); w.y = pk2h(v0[2], v0[3]); w.z = pk2h(v1[0], v1[1]); w.w = pk2h(v1[2], v1[3]);
                    const int cs = (pn & 1) * 256 + bj * HALF + wc * 32 + 8 * fq, h = cs >> 6, c8 = (cs & 63) >> 3, bh = b * 8 + h;
                    if (isKA) {
                        const int frag = (c8 >> 2) * 2 + ((c8 >> 1) & 1), hi = c8 & 1;
                        *(u32x4*)(KA + ((size_t)((bh * 128 + (t >> 5)) * 4 + frag) * 64 + hi * 32 + pi32(t & 31)) * 8) = w;
                        float q2 = (v0[0] * v0[0] + v0[1] * v0[1]) + (v0[2] * v0[2] + v0[3] * v0[3]) + (v1[0] * v1[0] + v1[1] * v1[1]) + (v1[2] * v1[2] + v1[3] * v1[3]);
                        q2 += __shfl_xor(q2, 16); q2 += __shfl_xor(q2, 32);
                        mx[bj] = fmaxf(mx[bj], q2);
                    } else {
                        const int sl = c8 >> 1, hi = c8 & 1;
                        { const int uu = t >> 5, r = t & 31; *(u32x4*)(KB1 + ((size_t)((bh * 128 + uu) * 4 + sl) * 64 + hi * 32 + pi32(r)) * 8) = w; }
                        { const int i = t >> 2, uu = (t & 3) * 32 + (i >> 5), r = i & 31; *(u32x4*)(KB4 + ((size_t)((bh * 128 + uu) * 4 + sl) * 64 + hi * 32 + pi32(r)) * 8) = w; }
                        { const int i = t >> 4, uu = (t & 15) * 8 + (i >> 5), r = i & 31; *(u32x4*)(KB16 + ((size_t)((bh * 128 + uu) * 4 + sl) * 64 + hi * 32 + pi32(r)) * 8) = w; }
                    } } }
        if (isKA) {
#pragma unroll
            for (int bj = 0; bj < 2; ++bj) { float v = mx[bj];
                v = fmaxf(v, __shfl_xor(v, 1)); v = fmaxf(v, __shfl_xor(v, 2)); v = fmaxf(v, __shfl_xor(v, 4)); v = fmaxf(v, __shfl_xor(v, 8));
                const int cs = (pn & 1) * 256 + bj * HALF + wc * 32;
                if ((threadIdx.x & 63) == 0) __hip_atomic_fetch_max(kmax + (b * 8 + (cs >> 6)) * 2 + ((cs >> 5) & 1), __float_as_uint(v * 1.002f), __ATOMIC_RELAXED, __HIP_MEMORY_SCOPE_AGENT); }
        }
    }
};

template <int MODE> struct EpiGated {
    static constexpr bool PERM = true, AFTER_DRAIN = false;
    h16_t* O; int ldc; int nmod; const float* bias;
    __device__ __forceinline__ void operator()(const f32x4 (&acc)[2][2][4][2], const Unit& u, int wr, int wc, int fr, int fq) const {
        const int row0 = u.pm * BM + wr * 64 + fr; const int pn = u.pn % nmod;
        const int col0 = pn * HALF + wc * 32 + 8 * fq;
        f32x4 ba[2], bb[2];
#pragma unroll
        for (int n = 0; n < 2; ++n) { if (MODE == 1) { ba[n] = *(const f32x4*)(bias + col0 + 4 * n); bb[n] = *(const f32x4*)(bias + 1024 + col0 + 4 * n); } else { ba[n] = (f32x4){0.f, 0.f, 0.f, 0.f}; bb[n] = ba[n]; } }
#pragma unroll
        for (int ai = 0; ai < 2; ++ai)
#pragma unroll
            for (int m = 0; m < 4; ++m) { h16_t* rowp = O + (size_t)(row0 + ai * HALF + m * 16) * ldc + col0;
                float r[8];
#pragma unroll
                for (int n = 0; n < 2; ++n)
#pragma unroll
                    for (int e = 0; e < 4; ++e) { const float a = acc[ai][0][m][n][e] + ba[n][e], b = acc[ai][1][m][n][e] + bb[n][e];
                        r[4 * n + e] = (MODE == 0) ? (a * fast_sigmoid(a)) * b : a * fast_sigmoid(b); }
                u32x4 w; w.x = pk2h(r[0], r[1]); w.y = pk2h(r[2], r[3]); w.z = pk2h(r[4], r[5]); w.w = pk2h(r[6], r[7]);
                *(u32x4*)rowp = w; }
    }
};

template <class Epi, class Sched, bool ALIGN_EPI = false, bool SP2 = false>
__device__ __forceinline__ void gemm_phase(PG8_LAS unsigned char* lds, const Gemm g, const Sched& S, const Epi& E) {
    const int tid = threadIdx.x, wid = __builtin_amdgcn_readfirstlane(tid >> 6), lane = tid & 63, wr = wid >> 2, wc = wid & 3, fr = lane & 15, fq = lane >> 4;
    const int K = g.K, nt = K / BK;
    unsigned voffA[2], voffB[2];
#pragma unroll
    for (int i = 0; i < 2; ++i) { int R, C; stage_rc(tid * 16 + i * 8192, R, C); const int Rb = Epi::PERM ? ((R & ~31) + perm32(R & 31)) : R;
        voffA[i] = (unsigned)(R * K + C) * 2u; voffB[i] = (unsigned)(Rb * K + C) * 2u; }
    const size_t kstep = (size_t)(BK * 2);
    const size_t hstep = (size_t)HALF * K * 2;
    const size_t tstep = 2 * hstep;
    const unsigned ldsw = (unsigned)wid * 1024u;
    const int aoff = lds_byte(wr * 64 + fr, fq * 8), boff = lds_byte(wc * 32 + fr, fq * 8);
#define PG8_SA(b, h) (((b) * 2 + (h)) * HTB)
#define PG8_SB(b, h) ((4 + (b) * 2 + (h)) * HTB)
#define PG8_STAGE(bufoff, gbase, voff) do { _Pragma("unroll") for (int _i = 0; _i < 2; ++_i) \
        __builtin_amdgcn_global_load_lds((const unsigned*)((const char*)(gbase) + (voff)[_i]), (PG8_LAS unsigned*)(lds + (bufoff) + ldsw + _i * 8192), 16, 0, 0); } while (0)
#define PG8_LDA(dst, b, h) do { _Pragma("unroll") for (int m = 0; m < 4; ++m) _Pragma("unroll") for (int k = 0; k < 2; ++k) dst[m][k] = *(const PG8_LAS f16x8*)(lds + PG8_SA(b, h) + aoff + m * 2048 + k * 1024); } while (0)
#define PG8_LDB(dst, b, h) do { _Pragma("unroll") for (int n = 0; n < 2; ++n) _Pragma("unroll") for (int k = 0; k < 2; ++k) dst[n][k] = *(const PG8_LAS f16x8*)(lds + PG8_SB(b, h) + boff + n * 2048 + k * 1024); } while (0)
#define PG8_MMA(ai, bj, At, Bt) do { __builtin_amdgcn_s_setprio(1); _Pragma("unroll") for (int m = 0; m < 4; ++m) _Pragma("unroll") for (int n = 0; n < 2; ++n) _Pragma("unroll") for (int k = 0; k < 2; ++k) \
        acc[ai][bj][m][n] = __builtin_amdgcn_mfma_f32_16x16x32_f16(Bt[n][k], At[m][k], acc[ai][bj][m][n], 0, 0, 0); __builtin_amdgcn_s_setprio(0); } while (0)
#define PG8_WAIT_V(n) asm volatile("s_waitcnt vmcnt(" #n ")" ::: "memory")
#define PG8_WAIT_L(n) asm volatile("s_waitcnt lgkmcnt(" #n ")" ::: "memory")
#define PG8_BAR __builtin_amdgcn_s_barrier()
#define PG8_SCHED __builtin_amdgcn_sched_barrier(0)
    Unit cur, nxt; int ui = 0;
    if (!S.next(0, cur)) return;
    f32x4 acc[2][2][4][2];
#pragma unroll
    for (int a = 0; a < 2; ++a)
#pragma unroll
        for (int b = 0; b < 2; ++b)
#pragma unroll
            for (int m = 0; m < 4; ++m)
#pragma unroll
                for (int n = 0; n < 2; ++n) acc[a][b][m][n] = (f32x4){0.f, 0.f, 0.f, 0.f};
    f16x8 At[4][2], B0[2][2], B1[2][2];
    const char* cA = (const char*)g.A + (size_t)cur.pm * tstep; const char* cB = (const char*)g.Bt + (size_t)cur.pn * tstep;
    S.a_ready(cur);
    if constexpr (SP2) {
        PG8_STAGE(PG8_SB(0, 0), cB, voffB); PG8_STAGE(PG8_SB(0, 1), cB + hstep, voffB); PG8_STAGE(PG8_SA(0, 0), cA, voffA); PG8_STAGE(PG8_SA(0, 1), cA + hstep, voffA);
        if (wr == 1) PG8_BAR;
        PG8_WAIT_V(2); PG8_BAR;
        PG8_STAGE(PG8_SB(1, 0), cB + kstep, voffB); PG8_STAGE(PG8_SA(1, 0), cA + kstep, voffA); PG8_STAGE(PG8_SB(1, 1), cB + hstep + kstep, voffB);
        PG8_WAIT_V(6); PG8_BAR;
    } else {
        PG8_STAGE(PG8_SB(0, 0), cB, voffB); PG8_STAGE(PG8_SA(0, 0), cA, voffA); PG8_STAGE(PG8_SB(0, 1), cB + hstep, voffB); PG8_STAGE(PG8_SA(0, 1), cA + hstep, voffA);
        if (wr == 1) PG8_BAR;
        PG8_WAIT_V(4); PG8_BAR;
        PG8_STAGE(PG8_SB(1, 0), cB + kstep, voffB); PG8_STAGE(PG8_SA(1, 0), cA + kstep, voffA); PG8_STAGE(PG8_SB(1, 1), cB + hstep + kstep, voffB);
        PG8_WAIT_V(6); PG8_BAR;
    }
    for (;;) {
        const bool has_next = S.next(ui + 1, nxt);
        const char* nA = has_next ? (const char*)g.A + (size_t)nxt.pm * tstep : cA; const char* nB = has_next ? (const char*)g.Bt + (size_t)nxt.pn * tstep : cB;
        for (int t = 0; t < nt; t += 2) {
            const bool last = (t == nt - 2);
            const char* a1 = cA + (size_t)(t + 1) * kstep;
            const char* a2 = last ? nA : cA + (size_t)(t + 2) * kstep; const char* b2 = last ? nB : cB + (size_t)(t + 2) * kstep;
            const char* a3 = a2 + kstep; const char* b3 = b2 + kstep;
            if (last && has_next) S.a_ready(nxt);
            if constexpr (SP2) {
            PG8_LDB(B0, 0, 0); PG8_LDB(B1, 0, 1); PG8_SCHED; PG8_LDA(At, 0, 0); PG8_STAGE(PG8_SA(1, 1), a1 + hstep, voffA);
            PG8_WAIT_V(8); PG8_WAIT_L(0); PG8_BAR; PG8_MMA(0, 0, At, B0); PG8_MMA(0, 1, At, B1); PG8_BAR; PG8_SCHED;
            PG8_LDA(At, 0, 1); PG8_STAGE(PG8_SB(0, 0), b2, voffB); PG8_STAGE(PG8_SB(0, 1), b2 + hstep, voffB); PG8_STAGE(PG8_SA(0, 0), a2, voffA);
            PG8_WAIT_V(8); PG8_WAIT_L(0); PG8_BAR; PG8_MMA(1, 0, At, B0); PG8_MMA(1, 1, At, B1); PG8_BAR; PG8_SCHED;
            PG8_LDB(B0, 1, 0); PG8_LDB(B1, 1, 1); PG8_SCHED; PG8_LDA(At, 1, 0); PG8_STAGE(PG8_SA(0, 1), a2 + hstep, voffA);
            PG8_WAIT_V(8); PG8_WAIT_L(0); PG8_BAR; PG8_MMA(0, 0, At, B0); PG8_MMA(0, 1, At, B1); PG8_BAR; PG8_SCHED;
            PG8_LDA(At, 1, 1); PG8_STAGE(PG8_SB(1, 0), b3, voffB); PG8_STAGE(PG8_SB(1, 1), b3 + hstep, voffB); PG8_STAGE(PG8_SA(1, 0), a3, voffA);
            PG8_WAIT_V(8); PG8_WAIT_L(0); PG8_BAR; PG8_MMA(1, 0, At, B0); PG8_MMA(1, 1, At, B1); PG8_BAR; PG8_SCHED;
            } else {
            PG8_LDB(B0, 0, 0); PG8_SCHED; PG8_LDA(At, 0, 0); PG8_STAGE(PG8_SA(1, 1), a1 + hstep, voffA);
            PG8_WAIT_L(8); PG8_BAR; PG8_WAIT_L(0); PG8_MMA(0, 0, At, B0); PG8_BAR; PG8_SCHED;
            PG8_LDB(B1, 0, 1); PG8_STAGE(PG8_SB(0, 0), b2, voffB);
            PG8_BAR; PG8_WAIT_L(0); PG8_MMA(0, 1, At, B1); PG8_BAR;
            PG8_LDA(At, 0, 1); PG8_STAGE(PG8_SA(0, 0), a2, voffA);
            PG8_BAR; PG8_WAIT_L(0); PG8_MMA(1, 0, At, B0); PG8_BAR; PG8_SCHED;
            PG8_STAGE(PG8_SB(0, 1), b2 + hstep, voffB);
            PG8_WAIT_V(6); PG8_BAR; PG8_MMA(1, 1, At, B1); PG8_BAR;
            PG8_LDB(B0, 1, 0); PG8_SCHED; PG8_LDA(At, 1, 0); PG8_STAGE(PG8_SA(0, 1), a2 + hstep, voffA);
            PG8_WAIT_L(8); PG8_BAR; PG8_WAIT_L(0); PG8_MMA(0, 0, At, B0); PG8_BAR; PG8_SCHED;
            PG8_LDB(B1, 1, 1); PG8_STAGE(PG8_SB(1, 0), b3, voffB);
            PG8_BAR; PG8_WAIT_L(0); PG8_MMA(0, 1, At, B1); PG8_BAR;
            PG8_LDA(At, 1, 1); PG8_STAGE(PG8_SA(1, 0), a3, voffA);
            PG8_BAR; PG8_WAIT_L(0); PG8_MMA(1, 0, At, B0); PG8_BAR; PG8_SCHED;
            PG8_STAGE(PG8_SB(1, 1), b3 + hstep, voffB);
            PG8_WAIT_V(6); PG8_BAR; PG8_MMA(1, 1, At, B1); PG8_BAR;
            }
        }
        if constexpr (ALIGN_EPI) { if (wr == 0) PG8_BAR; }
        if constexpr (!Epi::AFTER_DRAIN) { E(acc, cur, wr, wc, fr, fq); S.done(cur); }
        if (!has_next) break;
#pragma unroll
        for (int a = 0; a < 2; ++a)
#pragma unroll
            for (int b = 0; b < 2; ++b)
#pragma unroll
                for (int m = 0; m < 4; ++m)
#pragma unroll
                    for (int n = 0; n < 2; ++n) acc[a][b][m][n] = (f32x4){0.f, 0.f, 0.f, 0.f};
        cur = nxt; cA = nA; cB = nB; ++ui;
        if constexpr (ALIGN_EPI) { if (wr == 1) PG8_BAR; }
    }
    PG8_WAIT_V(0);
    if constexpr (!ALIGN_EPI) { if (wr == 0) PG8_BAR; }
    PG8_BAR;
    if constexpr (Epi::AFTER_DRAIN) { E.fused(acc, cur, wr, wc, fr, fq, lds, wid, lane); S.done(cur); }
#undef PG8_SA
#undef PG8_SB
#undef PG8_STAGE
#undef PG8_LDA
#undef PG8_LDB
#undef PG8_MMA
#undef PG8_WAIT_V
#undef PG8_WAIT_L
#undef PG8_BAR
#undef PG8_SCHED
}
}

constexpr int NWAVES = 8;
constexpr int BATCH = 8, SEQ = 4096, D = 1024, M = BATCH * SEQ;
constexpr int DFF = 2816, NEXP = 8, DFE = 1408;
constexpr int NPH = 17;
constexpr int N_LAUNCHES = MK_N_LAUNCHES;
static_assert(N_LAUNCHES == 1, "one launch only (PH4 has an inner grid barrier)");
constexpr float LN_EPS = 1e-5f, LOG2E = 1.4426950408889634f, DN_ALPHA = 1.4142135623730951f;
constexpr float QSCALE_A = 0.17677669529663687f * LOG2E;
constexpr float QSCALE_B = 0.125f * LOG2E;

constexpr size_t MiB = 1u << 20;
constexpr size_t WS_CTL = 0, CTL_ZERO_BYTES = 1 * MiB;
constexpr size_t WS_MOD = 1 * MiB;
constexpr size_t WS_SSMA = 1 * MiB + 512 * 1024;
constexpr size_t WS_SSMB = WS_SSMA + 64 * 1024;
constexpr size_t WS_TOKE = 2 * MiB + 512 * 1024;
constexpr size_t WS_TOKG = WS_TOKE + 256 * 1024;
constexpr size_t WS_TOKP = WS_TOKG + 256 * 1024;
constexpr size_t WS_W_IN = 4 * MiB, WS_W_OUT = 10 * MiB, WS_W_F1 = 12 * MiB, WS_W_F2 = 23 * MiB, WS_W_GLU = 28 * MiB + 512 * 1024;
constexpr size_t WS_W_E1 = 32 * MiB + 512 * 1024, WS_W_E2 = 76 * MiB + 512 * 1024;
constexpr size_t WS_A = 100 * MiB, WS_B = 292 * MiB, WS_C = 356 * MiB, WS_VT1 = 424 * MiB, WS_END = 488 * MiB;
constexpr size_t WS_UG = 228 * MiB;
constexpr size_t WS_SSMM = 196 * MiB;
constexpr size_t WS_KA = 356 * MiB, WS_KB1 = 388 * MiB, WS_KB4 = 420 * MiB, WS_KB16 = 452 * MiB;
constexpr int MOE_MAX_TILES = 264;
static_assert(WS_W_E2 + (size_t)NEXP * D * DFE * 2 <= WS_A, "weights fit");
static_assert((size_t)MOE_MAX_TILES * 256 * DFE * 2 <= WS_B - WS_A, "hidden_g fits region A");
static_assert(WS_B + (size_t)MOE_MAX_TILES * 256 * D * 2 <= WS_VT1, "gathered rows fit");
constexpr int CW_TMO = 0, CW_CODE = 1;
constexpr int CW_ECNT = 64;
constexpr int CW_ECUR = 128;
constexpr int CW_UQ = 1024;
constexpr int CW_TQ = 192;
constexpr int CW_PREP = 512;
constexpr int CW_KMAX = 256;
constexpr int CW_BAR = 4096;

constexpr int RING_OFF = 0, RING_BYTES = 131072;
constexpr int LDSCTL_OFF = RING_BYTES + 1024, MISC_OFF = LDSCTL_OFF + 320;
constexpr int LDS_BYTES = 147456;

#define GAS __attribute__((address_space(1)))
#define LAS __attribute__((address_space(3)))
typedef unsigned short h16;
typedef unsigned v4u __attribute__((ext_vector_type(4)));
typedef unsigned v2u __attribute__((ext_vector_type(2)));
typedef float f32x4 __attribute__((ext_vector_type(4)));
typedef GAS unsigned gu32;
#define RLX_AGENT __ATOMIC_RELAXED, __HIP_MEMORY_SCOPE_AGENT
#define LDS_WAIT() asm volatile("s_waitcnt lgkmcnt(0)" ::: "memory")
#define VM_WAIT() asm volatile("s_waitcnt vmcnt(0)" ::: "memory")
using pg8::pk2h;
__device__ __forceinline__ float h2f(unsigned short v) { return (float)__builtin_bit_cast(_Float16, v); }
__device__ __forceinline__ float hlo(unsigned w) { return h2f((unsigned short)(w & 0xffffu)); }
__device__ __forceinline__ float hhi(unsigned w) { return h2f((unsigned short)(w >> 16)); }
#define DPPF_(x, ctrl, rm) __builtin_bit_cast(float, __builtin_amdgcn_update_dpp(0, __builtin_bit_cast(int, (x)), (ctrl), (rm), 0xf, false))
__device__ __forceinline__ float wave_sum(float v) {
    v += DPPF_(v, 0xb1, 0xf);
    v += DPPF_(v, 0x4e, 0xf);
    v += DPPF_(v, 0x124, 0xf);
    v += DPPF_(v, 0x128, 0xf);
    v += DPPF_(v, 0x142, 0xa);
    v += DPPF_(v, 0x143, 0xc);
    return __builtin_bit_cast(float, __builtin_amdgcn_readlane(__builtin_bit_cast(int, v), 63));
}
__device__ __forceinline__ float wave_max(float v) {
#pragma unroll
    for (int o = 1; o < 64; o <<= 1) v = fmaxf(v, __shfl_xor(v, o));
    return v;
}
__device__ __forceinline__ float ex2(float v) { return __builtin_amdgcn_exp2f(v); }
__device__ __forceinline__ float gelu_tanh(float v) {
    const float z = 0.7978845608028654f * (v + 0.044715f * v * v * v);
    const float e = ex2(2.0f * LOG2E * z);
    const float th = 1.0f - 2.0f * __builtin_amdgcn_rcpf(1.0f + e);
    return 0.5f * v * (1.0f + th);
}

#define XB_TMO      128
#define XB_XCNT(j)  (256  + 64 * (j))
#define XB_XSUB(j)  (1280 + 64 * (j))
#define XB_XGEN(j)  (2304 + 64 * (j))
#define XB_TOP      3328
#define XB_TOPGEN   3392
#define XCD_BAR_WORDS 3456
#define XB_SPIN_CAP (1u << 18)

__device__ __forceinline__ unsigned xb_ld(unsigned* p)              { return __hip_atomic_load(p, __ATOMIC_RELAXED, __HIP_MEMORY_SCOPE_AGENT); }
__device__ __forceinline__ unsigned xb_add(unsigned* p, unsigned v) { return __hip_atomic_fetch_add(p, v, __ATOMIC_RELAXED, __HIP_MEMORY_SCOPE_AGENT); }
__device__ __forceinline__ unsigned xb_xcc_id() { return (unsigned)__builtin_amdgcn_s_getreg((3 << 11) | 20) & 0xFu; }
#define XB_SPIN(cond, bar) do { unsigned _sp = 0; while (cond) { __builtin_amdgcn_s_sleep(1); \
    if ((++_sp & 255u) == 0u) { if (xb_ld(&(bar)[XB_TMO])) break; if (_sp > XB_SPIN_CAP) { atomicAdd(&(bar)[XB_TMO], 1u); break; } } } } while (0)

struct XcdBarrier {
    unsigned* bar; unsigned x;
    volatile LAS unsigned* st;
};

__device__ __forceinline__ XcdBarrier xcd_barrier_post(unsigned* bar, volatile LAS unsigned* st) {
    XcdBarrier b; b.bar = bar; b.x = xb_xcc_id(); b.st = st;
    if (threadIdx.x == 0) (void)xb_add(&bar[XB_XCNT(b.x)], 1u);
    return b;
}
__device__ __forceinline__ void xcd_barrier_complete(unsigned* bar, unsigned x, unsigned& nloc, unsigned& nx) {
    const unsigned G = gridDim.x * gridDim.y * gridDim.z;
    unsigned sum, cnt, mine, sp = 0u;
    for (;;) {
        sum = 0u; cnt = 0u; mine = 0u;
#pragma unroll
        for (unsigned j = 0; j < 16; ++j) { const unsigned c = xb_ld(&bar[XB_XCNT(j)]); sum += c; cnt += (c > 0u) ? 1u : 0u; mine = (j == x) ? c : mine; }
        if (sum == G) break;
        __builtin_amdgcn_s_sleep(1);
        if ((++sp & 255u) == 0u) { if (xb_ld(&bar[XB_TMO])) break; if (sp > XB_SPIN_CAP) { atomicAdd(&bar[XB_TMO], 1u); break; } }
    }
    nloc = mine > 0u ? mine : 1u; nx = cnt > 0u ? cnt : 1u;
}

__device__ __forceinline__ void xcd_barrier(const XcdBarrier& b) {
    asm volatile("s_waitcnt vmcnt(0)" ::: "memory");
    __syncthreads();
    if (threadIdx.x == 0) {
        unsigned* bar = b.bar;
        __builtin_amdgcn_s_waitcnt(0);
        unsigned nloc = b.st[0], nx = b.st[1];
        if (nloc == 0u) { xcd_barrier_complete(bar, b.x, nloc, nx); b.st[0] = nloc; b.st[1] = nx; }
        const unsigned old = xb_add(&bar[XB_XSUB(b.x)], 1u);
        const unsigned gen = old / nloc;
        if (old + 1u == (gen + 1u) * nloc) {
            __builtin_amdgcn_fence(__ATOMIC_RELEASE, "agent");
            asm volatile("s_waitcnt vmcnt(0)" ::: "memory");
            const unsigned og = xb_add(&bar[XB_TOP], 1u);
            const unsigned tg = og / nx;
            if (og + 1u == (tg + 1u) * nx) xb_add(&bar[XB_TOPGEN], 1u);
            else XB_SPIN(xb_ld(&bar[XB_TOPGEN]) == tg, bar);
            __builtin_amdgcn_fence(__ATOMIC_ACQUIRE, "agent");
            xb_add(&bar[XB_XGEN(b.x)], 1u);
            asm volatile("s_waitcnt vmcnt(0)" ::: "memory");
        } else {
            XB_SPIN(xb_ld(&bar[XB_XGEN(b.x)]) == gen, bar);
            __builtin_amdgcn_fence(__ATOMIC_ACQUIRE, "agent");
            asm volatile("s_waitcnt vmcnt(0)" ::: "memory");
        }
    }
    __syncthreads();
}

struct Frame {
    LAS unsigned char* lds;
    volatile LAS unsigned* MISC;
    gu32* ctl;
    int tid, lane, wave;
    int vcu, G;
    const float* in[39]; float* out; unsigned char* ws;
};
enum { I_X = 0, I_C, I_ADAW0, I_ADAB0, I_WIN, I_LQ1, I_LK1, I_LQ2, I_LK2, I_SUBLN, I_WOUT, I_LN1G0, I_LN1B0, I_FG, I_FU, I_FD, I_LN2G0, I_LN2B0,
       I_ADAW1, I_ADAB1, I_ARE, I_AIM, I_LOGDT, I_BRE, I_BIM, I_CRE, I_CIM, I_DSKIP, I_WGLU, I_BGLU, I_LN1G1, I_LN1B1, I_RW, I_RB, I_EG, I_EU, I_ED, I_LN2G1, I_LN2B1 };

__device__ __forceinline__ void ph0_mods(Frame& F) {
    LAS float* sc = (LAS float*)(F.lds);
    LAS float* part = (LAS float*)(F.lds + 32768);
    float* mod = (float*)(F.ws + WS_MOD);
    if ((int)blockIdx.x < 192) {
        const float* c = F.in[I_C];
        for (int i = F.tid; i < BATCH * D; i += NWAVES * 64) { const float v = c[i]; sc[i] = v / (1.0f + expf(-v)); }
        __syncthreads();
        for (int it = blockIdx.x; it < 192; it += F.G) {
            const int l = it / 96, j0 = (it % 96) * 64;
            const float* W = F.in[l ? I_ADAW1 : I_ADAW0]; const float* bias = F.in[l ? I_ADAB1 : I_ADAB0];
            float acc[8];
#pragma unroll
            for (int b = 0; b < 8; ++b) acc[b] = 0.f;
            const int k0 = F.wave * 128;
            for (int kk = k0; kk < k0 + 128; kk += 16) { float w[16];
#pragma unroll
                for (int i = 0; i < 16; ++i) w[i] = W[(size_t)(kk + i) * (6 * D) + j0 + F.lane];
#pragma unroll
                for (int i = 0; i < 16; ++i)
#pragma unroll
                    for (int b = 0; b < 8; ++b) acc[b] += sc[b * D + kk + i] * w[i]; }
#pragma unroll
            for (int b = 0; b < 8; ++b) part[(F.wave * 8 + b) * 64 + F.lane] = acc[b];
            __syncthreads();
            float s = 0.f;
#pragma unroll
            for (int w2 = 0; w2 < 8; ++w2) s += part[(w2 * 8 + F.wave) * 64 + F.lane];
            mod[(size_t)(l * 8 + F.wave) * (6 * D) + j0 + F.lane] = s + bias[j0 + F.lane];
            __syncthreads();
        }
    }
    const int gid = blockIdx.x * (NWAVES * 64) + F.tid;
    if (gid < 64 * 64) {
        const int g = gid >> 6;
        const float ar = F.in[I_ARE][gid], ai = F.in[I_AIM][gid], dt = expf(F.in[I_LOGDT][g]);
        const float mag = expf(dt * ar); float sn, cs; sincosf(dt * ai, &sn, &cs);
        const float abr = mag * cs, abi = mag * sn, den = ar * ar + ai * ai, nr = abr - 1.0f, ni = abi;
        const float zr = (nr * ar + ni * ai) / den, zi = (ni * ar - nr * ai) / den;
        float* SA = (float*)(F.ws + WS_SSMA); float* SB = (float*)(F.ws + WS_SSMB);
        SA[gid * 2] = abr; SA[gid * 2 + 1] = abi;
#pragma unroll
        for (int c = 0; c < 16; ++c) { const float br = F.in[I_BRE][gid * 16 + c], bi = F.in[I_BIM][gid * 16 + c];
            SB[(gid * 16 + c) * 2] = zr * br - zi * bi; SB[(gid * 16 + c) * 2 + 1] = zr * bi + zi * br; }
    }
}

struct TItem { const float* src; h16* dst; int ldw, K; };
__device__ __forceinline__ void titem_make(TItem& t, const float* W, int ldw, int K, int N, h16* WT, int rowmap, int item, int lane) {
    const int nblk = N / 32, kb = item / nblk, nb = item % nblk, k0 = 64 * kb, n0 = 32 * nb;
    const int r0 = rowmap == 0 ? n0 : ((n0 >> 7) * 256 + (n0 & 127) + (rowmap == 2 ? 128 : 0));
    t.src = W + (size_t)(k0 + (lane >> 5)) * ldw + n0 + (lane & 31); t.ldw = ldw; t.K = K;
    t.dst = WT + (size_t)(r0 + (lane >> 3)) * K + k0 + 8 * (lane & 7);
}
__device__ __forceinline__ void titem_decode(Frame& F, TItem& t, int it, int lane) {
    constexpr int I_0 = 16 * 96, I_1 = 16 * 32, I_2 = 16 * 88, I_3 = 16 * 88, I_4 = 44 * 32, I_5 = 16 * 32, I_6 = 16 * 32;
    constexpr int I_7 = 16 * 44, I_8 = 16 * 44, I_9 = 22 * 32;
    unsigned char* ws = F.ws; int r = it;
    if (r < I_0) { titem_make(t, F.in[I_WIN], 3 * D, D, 3 * D, (h16*)(ws + WS_W_IN), 0, r, lane); return; } r -= I_0;
    if (r < I_1) { titem_make(t, F.in[I_WOUT], D, D, D, (h16*)(ws + WS_W_OUT), 0, r, lane); return; } r -= I_1;
    if (r < I_2) { titem_make(t, F.in[I_FG], DFF, D, DFF, (h16*)(ws + WS_W_F1), 1, r, lane); return; } r -= I_2;
    if (r < I_3) { titem_make(t, F.in[I_FU], DFF, D, DFF, (h16*)(ws + WS_W_F1), 2, r, lane); return; } r -= I_3;
    if (r < I_4) { titem_make(t, F.in[I_FD], D, DFF, D, (h16*)(ws + WS_W_F2), 0, r, lane); return; } r -= I_4;
    if (r < I_5) { titem_make(t, F.in[I_WGLU], 2 * D, D, D, (h16*)(ws + WS_W_GLU), 1, r, lane); return; } r -= I_5;
    if (r < I_6) { titem_make(t, F.in[I_WGLU] + D, 2 * D, D, D, (h16*)(ws + WS_W_GLU), 2, r, lane); return; } r -= I_6;
    const int e = r / (I_7 + I_8 + I_9); r -= e * (I_7 + I_8 + I_9);
    if (r < I_7) { titem_make(t, F.in[I_EG] + (size_t)e * D * DFE, DFE, D, DFE, (h16*)(ws + WS_W_E1) + (size_t)e * 2 * DFE * D, 1, r, lane); return; } r -= I_7;
    if (r < I_8) { titem_make(t, F.in[I_EU] + (size_t)e * D * DFE, DFE, D, DFE, (h16*)(ws + WS_W_E1) + (size_t)e * 2 * DFE * D, 2, r, lane); return; } r -= I_8;
    titem_make(t, F.in[I_ED] + (size_t)e * DFE * D, D, DFE, D, (h16*)(ws + WS_W_E2) + (size_t)e * D * DFE, 0, r, lane);
}
constexpr int NIT_L0 = 16 * 96 + 16 * 32 + 2 * 16 * 88 + 44 * 32;
constexpr int NIT_ALL = NIT_L0 + 2 * 16 * 32 + NEXP * (2 * 16 * 44 + 22 * 32);
__device__ __forceinline__ void transpose_items(Frame& F, int it0, int it1, LAS float* scr) {
    const int gw = F.vcu * NWAVES + F.wave, NGW = F.G * NWAVES, lane = F.lane;
    const int NITEMS = it1;
    if (it0 + gw < NITEMS) {
        TItem cur; titem_decode(F, cur, it0 + gw, lane);
        float cv[32];
#pragma unroll
        for (int i = 0; i < 32; ++i) cv[i] = cur.src[(size_t)(2 * i) * cur.ldw];
        for (int it = it0 + gw; it < NITEMS; it += NGW) {
            TItem nxt = cur; float nv[32];
            const bool hn = it + NGW < NITEMS;
            if (hn) { titem_decode(F, nxt, it + NGW, lane);
#pragma unroll
                for (int i = 0; i < 32; ++i) nv[i] = nxt.src[(size_t)(2 * i) * nxt.ldw]; }
#pragma unroll
            for (int i = 0; i < 32; ++i) scr[(2 * i + (lane >> 5)) * 33 + (lane & 31)] = cv[i];
            LDS_WAIT(); asm volatile("" ::: "memory");
            const int c = lane & 7;
#pragma unroll
            for (int j = 0; j < 4; ++j) { const int n = (lane >> 3) + 8 * j; const LAS float* sp = scr + (8 * c) * 33 + n;
                v4u o; o.x = pk2h(sp[0 * 33], sp[1 * 33]); o.y = pk2h(sp[2 * 33], sp[3 * 33]); o.z = pk2h(sp[4 * 33], sp[5 * 33]); o.w = pk2h(sp[6 * 33], sp[7 * 33]);
                *(GAS v4u*)(cur.dst + (size_t)(8 * j) * cur.K) = o; }
            LDS_WAIT(); asm volatile("" ::: "memory");
            if (hn) {
#pragma unroll
                for (int i = 0; i < 32; ++i) cv[i] = nv[i];
                cur = nxt; }
        }
    }
}
__device__ __forceinline__ void ph1_prologue(Frame& F) {
    const int gw = F.vcu * NWAVES + F.wave, NGW = F.G * NWAVES, lane = F.lane;
    unsigned char* ws = F.ws;
    transpose_items(F, 0, NIT_ALL, (LAS float*)(F.lds + RING_OFF + F.wave * 16384));
    const float* mod0 = (const float*)(ws + WS_MOD);
    h16* H0 = (h16*)(ws + WS_B);
    {
        const int WPB = F.G, bq = gw / WPB, r0 = gw % WPB; const float* mb = mod0 + (size_t)bq * (6 * D);
        f32x4 sc1[4], shv[4];
#pragma unroll
        for (int j = 0; j < 4; ++j) { const int col = 4 * lane + 256 * j; shv[j] = *(const f32x4*)(mb + col); sc1[j] = 1.0f + *(const f32x4*)(mb + D + col); }
        for (int t0 = r0; t0 < SEQ; t0 += 8 * WPB) {
            f32x4 xr[8][4];
#pragma unroll
            for (int i = 0; i < 8; ++i) { const int t = t0 + i * WPB; if (t < SEQ) {
#pragma unroll
                for (int j = 0; j < 4; ++j) xr[i][j] = *(const f32x4*)(F.in[I_X] + ((size_t)bq * SEQ + t) * D + 4 * lane + 256 * j); } }
#pragma unroll
            for (int i = 0; i < 8; ++i) { const int t = t0 + i * WPB; if (t < SEQ) {
#pragma unroll
                for (int j = 0; j < 4; ++j) { const int col = 4 * lane + 256 * j;
                    const f32x4 h = xr[i][j] * sc1[j] + shv[j]; v2u o; o.x = pk2h(h[0], h[1]); o.y = pk2h(h[2], h[3]);
                    *(v2u*)(H0 + ((size_t)bq * SEQ + t) * D + col) = o; } } }
        }
    }
}

__device__ __forceinline__ f32x4 ld4h(const h16* p) { const v2u w = *(const v2u*)p; return (f32x4){hlo(w.x), hhi(w.x), hlo(w.y), hhi(w.y)}; }
__device__ __forceinline__ void ld8h(const h16* p, float* f) { const v4u w = *(const v4u*)p; f[0] = hlo(w.x); f[1] = hhi(w.x); f[2] = hlo(w.y); f[3] = hhi(w.y); f[4] = hlo(w.z); f[5] = hhi(w.z); f[6] = hlo(w.w); f[7] = hhi(w.w); }
__device__ __forceinline__ float lane_reduce64(float (&v)[64], int lane) {
#pragma unroll
    for (int s = 0; s < 6; ++s) { const int half = 32 >> s; const bool up = (lane & half) != 0;
#pragma unroll
        for (int i = 0; i < half; ++i) { const float lo = v[i], hi = v[i + half]; const float send = up ? lo : hi, keep = up ? hi : lo; v[i] = keep + __shfl_xor(send, half); } }
    return v[0];
}
__device__ __forceinline__ float lam_value(Frame& F) {
    float s1 = 0.f, s2 = 0.f;
#pragma unroll 4
    for (int i = 0; i < 32; ++i) { s1 += F.in[I_LQ1][i] * F.in[I_LK1][i]; s2 += F.in[I_LQ2][i] * F.in[I_LK2][i]; }
    return expf(s1) - expf(s2) + 0.2f;
}
template <bool DIFF, bool DIL> __device__ __forceinline__ void ph4_attn_naive(Frame& F) {
    const h16* QKV = (const h16*)(F.ws + WS_A); h16* O = (h16*)(F.ws + WS_B);
    const int gw = F.vcu * NWAVES + F.wave, NGW = F.G * NWAVES, lane = F.lane;
    const float lam = lam_value(F);
    const float sub_w = F.in[I_SUBLN][lane] * 0.8f;
    if (DIFF) for (int it = gw; it < BATCH * 8 * SEQ; it += NGW) {
        const int bh = it >> 12, r = it & 4095, i = (bh & 1) ? 4095 - r : r, b = bh >> 3, h = bh & 7;
        const size_t rowq = (size_t)(b * SEQ + i) * 3072;
        const float slope2 = exp2f(-0.5f * (float)(h + 1)) * LOG2E;
        float res[2];
#pragma unroll
        for (int mp = 0; mp < 2; ++mp) {
            float q[32];
#pragma unroll
            for (int d8 = 0; d8 < 4; ++d8) ld8h(QKV + rowq + h * 64 + mp * 32 + d8 * 8, q + d8 * 8);
            float acc[64];
#pragma unroll
            for (int d = 0; d < 64; ++d) acc[d] = 0.f;
            float mrun = -INFINITY, l = 0.f;
            for (int j = lane; j <= i; j += 64) {
                const size_t rowk = (size_t)(b * SEQ + j) * 3072;
                float s = 0.f;
#pragma unroll
                for (int d8 = 0; d8 < 4; ++d8) { float kf[8]; ld8h(QKV + rowk + 512 + h * 64 + mp * 32 + d8 * 8, kf);
#pragma unroll
                    for (int e = 0; e < 8; ++e) s += q[d8 * 8 + e] * kf[e]; }
                s -= slope2 * (float)(i - j);
                const float mn = fmaxf(mrun, s), alpha = ex2(mrun - mn), p = ex2(s - mn);
                l = l * alpha + p; mrun = mn;
#pragma unroll
                for (int d8 = 0; d8 < 8; ++d8) { float vf[8]; ld8h(QKV + rowk + 1024 + h * 64 + d8 * 8, vf);
#pragma unroll
                    for (int e = 0; e < 8; ++e) acc[d8 * 8 + e] = acc[d8 * 8 + e] * alpha + p * vf[e]; }
            }
            const float Mx = wave_max(mrun), scl = (mrun == -INFINITY) ? 0.f : ex2(mrun - Mx), L = wave_sum(l * scl);
#pragma unroll
            for (int d = 0; d < 64; ++d) acc[d] *= scl;
            const float mine = lane_reduce64(acc, lane);
            res[mp] = mine / L;
        }
        const float o = res[0] - lam * res[1];
        const float ss = wave_sum(o * o);
        const float y = o * (1.0f / sqrtf(ss * (1.0f / 64.0f) + LN_EPS)) * sub_w;
        O[(size_t)(b * SEQ + i) * D + h * 64 + lane] = (h16)(pk2h(y, 0.f) & 0xffffu);
    }
    if (DIL) for (int it = gw; it < BATCH * 8 * SEQ; it += NGW) {
        const int bh = it >> 12, i = it & 4095, b = bh >> 3, h = bh & 7;
        const size_t rowq = (size_t)(b * SEQ + i) * 3072;
        const float slope2 = exp2f(-0.5f * (float)(h + 9)) * LOG2E;
        float q[64];
#pragma unroll
        for (int d8 = 0; d8 < 8; ++d8) ld8h(QKV + rowq + 1536 + h * 64 + d8 * 8, q + d8 * 8);
        float og[3], lse[3];
#pragma unroll
        for (int g = 0; g < 3; ++g) {
            const int dil = (g == 0) ? 1 : (g == 1) ? 4 : 16;
            float acc[64];
#pragma unroll
            for (int d = 0; d < 64; ++d) acc[d] = 0.f;
            float mrun = -INFINITY, l = 0.f;
            for (int jj = lane; jj <= 128; jj += 64) {
                const int t = i - jj * dil;
                if (t >= 0) {
                    const size_t rowk = (size_t)(b * SEQ + t) * 3072;
                    float s = 0.f;
#pragma unroll
                    for (int d8 = 0; d8 < 8; ++d8) { float kf[8]; ld8h(QKV + rowk + 2048 + h * 64 + d8 * 8, kf);
#pragma unroll
                        for (int e = 0; e < 8; ++e) s += q[d8 * 8 + e] * kf[e]; }
                    s -= slope2 * (float)(jj * dil);
                    const float mn = fmaxf(mrun, s), alpha = ex2(mrun - mn), p = ex2(s - mn);
                    l = l * alpha + p; mrun = mn;
#pragma unroll
                    for (int d8 = 0; d8 < 8; ++d8) { float vf[8]; ld8h(QKV + rowk + 2560 + h * 64 + d8 * 8, vf);
#pragma unroll
                        for (int e = 0; e < 8; ++e) acc[d8 * 8 + e] = acc[d8 * 8 + e] * alpha + p * vf[e]; }
                }
            }
            const float Mx = wave_max(mrun), scl = (mrun == -INFINITY) ? 0.f : ex2(mrun - Mx), L = wave_sum(l * scl);
#pragma unroll
            for (int d = 0; d < 64; ++d) acc[d] *= scl;
            const float mine = lane_reduce64(acc, lane);
            og[g] = mine / L; lse[g] = Mx + log2f(L);
        }
        const float mx = fmaxf(lse[0], fmaxf(lse[1], lse[2]));
        const float w0 = ex2(lse[0] - mx), w1 = ex2(lse[1] - mx), w2 = ex2(lse[2] - mx);
        const float y = (w0 * og[0] + w1 * og[1] + w2 * og[2]) / (w0 + w1 + w2);
        O[(size_t)(b * SEQ + i) * D + 512 + h * 64 + lane] = (h16)(pk2h(y, 0.f) & 0xffffu);
    }
}


typedef _Float16 hf8 __attribute__((ext_vector_type(8)));
typedef float f32x16 __attribute__((ext_vector_type(16)));
__device__ __forceinline__ hf8 ldf8(const h16* p) { return __builtin_bit_cast(hf8, *(const v4u*)p); }
#define MFMA32(a, b, c) __builtin_amdgcn_mfma_f32_32x32x16_f16((a), (b), (c), 0, 0, 0)
typedef short v4i16_t __attribute__((ext_vector_type(4)));
typedef _Float16 hf4 __attribute__((ext_vector_type(4)));
__device__ __forceinline__ void v_stage(LAS unsigned char* vl, const v4u (&vn)[4], int lane) {
#pragma unroll
    for (int i = 0; i < 4; ++i) *(LAS v4u*)(vl + ((lane & 7) >> 2) * 2048 + ((lane >> 3) + 8 * i) * 64 + (lane & 3) * 16) = vn[i];
}
__device__ __forceinline__ hf8 v_frag(const LAS unsigned char* trb, int dt, int s) {
    const v4i16_t lo = __builtin_amdgcn_ds_read_tr16_b64_v4i16((LAS v4i16_t*)(trb + dt * 2048 + (16 * s) * 64));
    const v4i16_t hi = __builtin_amdgcn_ds_read_tr16_b64_v4i16((LAS v4i16_t*)(trb + dt * 2048 + (16 * s + 4) * 64));
    return __builtin_shufflevector(__builtin_bit_cast(hf4, lo), __builtin_bit_cast(hf4, hi), 0, 1, 2, 3, 4, 5, 6, 7);
}
__device__ __forceinline__ float rowmax16(const f32x16& s) {
    float m;
    asm("s_nop 15\n\ts_nop 7\n\t"
                 "v_max3_f32 %0, %1, %2, %3\n\tv_max3_f32 %0, %0, %4, %5\n\tv_max3_f32 %0, %0, %6, %7\n\tv_max3_f32 %0, %0, %8, %9\n\t"
                 "v_max3_f32 %0, %0, %10, %11\n\tv_max3_f32 %0, %0, %12, %13\n\tv_max3_f32 %0, %0, %14, %15\n\tv_max_f32 %0, %0, %16"
                 : "=&v"(m)
                 : "v"(s[0]), "v"(s[1]), "v"(s[2]), "v"(s[3]), "v"(s[4]), "v"(s[5]), "v"(s[6]), "v"(s[7]), "v"(s[8]), "v"(s[9]), "v"(s[10]), "v"(s[11]), "v"(s[12]), "v"(s[13]), "v"(s[14]), "v"(s[15]));
    return m;
}
constexpr float LAZY_THR = 8.0f;
__device__ __forceinline__ float half_max(float v) { auto rr = __builtin_amdgcn_permlane32_swap(__float_as_uint(v), __float_as_uint(v), false, false); return fmaxf(__uint_as_float(rr[0]), __uint_as_float(rr[1])); }
__device__ __forceinline__ float half_sum(float v) { auto rr = __builtin_amdgcn_permlane32_swap(__float_as_uint(v), __float_as_uint(v), false, false); return __uint_as_float(rr[0]) + __uint_as_float(rr[1]); }
constexpr float SKIP_BITS = 30.0f;
__device__ __forceinline__ void ph4_diff_mfma(Frame& F) {
    const h16* QKV = (const h16*)(F.ws + WS_A); const h16* KA = (const h16*)(F.ws + WS_KA); h16* O = (h16*)(F.ws + WS_B);
    int lane_ = F.lane; asm volatile("" : "+v"(lane_));
    const int gw = F.vcu * NWAVES + F.wave, NGW = F.G * NWAVES, lane = lane_, r32 = lane & 31, hi = lane >> 5;
    const float lam = lam_value(F);
    LAS unsigned char* vl = F.lds + RING_OFF + F.wave * 4096;
    const LAS unsigned char* trb = vl + (8 * hi + ((lane & 15) >> 2)) * 64 + (16 * ((lane >> 4) & 1) + 4 * (lane & 3)) * 2;
    for (int k = 0; k < 4; ++k) {
        if (gw >= 2048) break;
        const int ty = gw & 1, qp = (gw >> 1) & 127, b = gw >> 8;
        const int h = (ty == 0) ? ((k == 0) ? 7 : (k == 1) ? 0 : (k == 2) ? 4 : 3) : ((k == 0) ? 6 : (k == 1) ? 1 : (k == 2) ? 5 : 2);
        const int bh = b * 8 + h, qt = (k & 1) ? 127 - qp : qp, i0 = qt * 32;
        const float slope2 = exp2f(-0.5f * (float)(h + 1)) * LOG2E;
        const h16* qrow = QKV + (size_t)(b * SEQ + i0 + r32) * 3072 + h * 64 + 8 * hi;
        hf8 qf[2][2];
#pragma unroll
        for (int mp = 0; mp < 2; ++mp)
#pragma unroll
            for (int sl = 0; sl < 2; ++sl) qf[mp][sl] = ldf8(qrow + mp * 32 + sl * 16);
        float need;
        { float sq[2];
#pragma unroll
            for (int mp = 0; mp < 2; ++mp) { float a = 0.f;
#pragma unroll
                for (int sl = 0; sl < 2; ++sl)
#pragma unroll
                    for (int e = 0; e < 8; ++e) { const float v = (float)qf[mp][sl][e]; a += v * v; }
                a = half_sum(a);
                const float km = __uint_as_float(__hip_atomic_load(F.ctl + CW_KMAX + (b * 8 + h) * 2 + mp, RLX_AGENT));
                sq[mp] = sqrtf(a * km) * 1.001f + 0.01f; }
            need = fmaxf(sq[0], sq[1]) + SKIP_BITS - log2f(1.0f - exp2f(-slope2)); }
        float coff[16];
#pragma unroll
        for (int r = 0; r < 16; ++r) coff[r] = slope2 * (float)(16 * (r >> 3) + 8 * hi + (r & 7));
        f32x16 o[2][2];
#pragma unroll
        for (int mp = 0; mp < 2; ++mp)
#pragma unroll
            for (int dt = 0; dt < 2; ++dt)
#pragma unroll
                for (int r = 0; r < 16; ++r) o[mp][dt][r] = 0.f;
        float mrun[2] = {0.f, 0.f}, lrun[2] = {0.f, 0.f};
        const h16* kbase = KA + ((size_t)(bh * 128) * 4 * 64 + lane) * 8;
        const h16* vbase = QKV + (size_t)(b * SEQ + (lane >> 3)) * 3072 + 1024 + h * 64 + 8 * (lane & 7);
        hf8 kn[2][2]; v4u vn[4];
        { const h16* kb2 = kbase + (size_t)(qt * 4) * 512; const h16* vb2 = vbase + (size_t)(32 * qt) * 3072;
#pragma unroll
            for (int mp = 0; mp < 2; ++mp)
#pragma unroll
                for (int sl = 0; sl < 2; ++sl) kn[mp][sl] = ldf8(kb2 + (mp * 2 + sl) * 512);
#pragma unroll
            for (int i = 0; i < 4; ++i) vn[i] = *(const v4u*)(vb2 + (size_t)(8 * i) * 3072); }
        for (int kt = qt; kt >= 0; --kt) {
            hf8 kf[2][2];
#pragma unroll
            for (int a = 0; a < 2; ++a)
#pragma unroll
                for (int c = 0; c < 2; ++c) kf[a][c] = kn[a][c];
            asm volatile("" ::: "memory");
            v_stage(vl, vn, lane);
            asm volatile("" ::: "memory");
            if (kt > 0) {
                const h16* kb2 = kbase + (size_t)((kt - 1) * 4) * 512; const h16* vb2 = vbase + (size_t)(32 * (kt - 1)) * 3072;
#pragma unroll
                for (int mp = 0; mp < 2; ++mp)
#pragma unroll
                    for (int sl = 0; sl < 2; ++sl) kn[mp][sl] = ldf8(kb2 + (mp * 2 + sl) * 512);
#pragma unroll
                for (int i = 0; i < 4; ++i) vn[i] = *(const v4u*)(vb2 + (size_t)(8 * i) * 3072);
            }
            hf8 vf[2][2];
#pragma unroll
            for (int dt = 0; dt < 2; ++dt)
#pragma unroll
                for (int s2 = 0; s2 < 2; ++s2) vf[dt][s2] = v_frag(trb, dt, s2);
            asm volatile("" ::: "memory");
            const float tb = slope2 * (float)(32 * kt - i0);
            const bool diag = (kt == qt);
            f32x16 sc[2];
#pragma unroll
            for (int mp = 0; mp < 2; ++mp) { const float tbm = tb - mrun[mp];
#pragma unroll
                for (int r = 0; r < 16; ++r) sc[mp][r] = coff[r] + tbm;
                if (diag) {
#pragma unroll
                    for (int r = 0; r < 16; ++r) if (16 * (r >> 3) + 8 * hi + (r & 7) > r32) sc[mp][r] = -INFINITY;
                } }
            sc[0] = MFMA32(kf[0][0], qf[0][0], sc[0]); sc[1] = MFMA32(kf[1][0], qf[1][0], sc[1]);
            sc[0] = MFMA32(kf[0][1], qf[0][1], sc[0]); sc[1] = MFMA32(kf[1][1], qf[1][1], sc[1]);
            hf8 pb[2][2];
#pragma unroll
            for (int mp = 0; mp < 2; ++mp) {
                const float mx = half_max(rowmax16(sc[mp]));
                if (diag || __any(mx > LAZY_THR)) {
                    const float dl = diag ? mx : fmaxf(mx, 0.f), alpha = ex2(-dl); mrun[mp] += dl; lrun[mp] *= alpha;
#pragma unroll
                    for (int r = 0; r < 16; ++r) sc[mp][r] -= dl;
#pragma unroll
                    for (int dt = 0; dt < 2; ++dt)
#pragma unroll
                        for (int r = 0; r < 16; ++r) o[mp][dt][r] *= alpha; }
                float ls = 0.f;
#pragma unroll
                for (int r = 0; r < 16; ++r) { sc[mp][r] = ex2(sc[mp][r]); ls += sc[mp][r]; }
                lrun[mp] += ls;
                v4u p0, p1;
                p0.x = pk2h(sc[mp][0], sc[mp][1]); p0.y = pk2h(sc[mp][2], sc[mp][3]); p0.z = pk2h(sc[mp][4], sc[mp][5]); p0.w = pk2h(sc[mp][6], sc[mp][7]);
                p1.x = pk2h(sc[mp][8], sc[mp][9]); p1.y = pk2h(sc[mp][10], sc[mp][11]); p1.z = pk2h(sc[mp][12], sc[mp][13]); p1.w = pk2h(sc[mp][14], sc[mp][15]);
                pb[mp][0] = __builtin_bit_cast(hf8, p0); pb[mp][1] = __builtin_bit_cast(hf8, p1);
            }
#pragma unroll
            for (int s2 = 0; s2 < 2; ++s2)
#pragma unroll
                for (int mp = 0; mp < 2; ++mp)
#pragma unroll
                    for (int dt = 0; dt < 2; ++dt) o[mp][dt] = MFMA32(vf[dt][s2], pb[mp][s2], o[mp][dt]);
            if (__all(slope2 * (float)(i0 + 1 - 32 * kt) >= need - fminf(mrun[0], mrun[1]))) break;
        }
        const float l0 = half_sum(lrun[0]), l1 = half_sum(lrun[1]);
        const float i0l = 1.0f / l0, i1l = lam / l1;
        float ss = 0.f;
#pragma unroll
        for (int dt = 0; dt < 2; ++dt)
#pragma unroll
            for (int r = 0; r < 16; ++r) { const float v = o[0][dt][r] * i0l - o[1][dt][r] * i1l; o[0][dt][r] = v; ss += v * v; }
        ss = half_sum(ss);
        const float rstd = 0.8f / sqrtf(ss * (1.0f / 64.0f) + LN_EPS);
        h16* orow = O + (size_t)(b * SEQ + i0 + r32) * D + h * 64;
#pragma unroll
        for (int dt = 0; dt < 2; ++dt)
#pragma unroll
            for (int gp = 0; gp < 2; ++gp) { v2u w[2];
#pragma unroll
                for (int e = 0; e < 2; ++e) { const int g = 2 * gp + e, d = 32 * dt + 8 * g + 4 * hi; const f32x4 sw = *(const f32x4*)(F.in[I_SUBLN] + d);
                    w[e].x = pk2h(o[0][dt][4 * g] * rstd * sw[0], o[0][dt][4 * g + 1] * rstd * sw[1]); w[e].y = pk2h(o[0][dt][4 * g + 2] * rstd * sw[2], o[0][dt][4 * g + 3] * rstd * sw[3]); }
                const auto sx = __builtin_amdgcn_permlane32_swap(w[0].x, w[1].x, false, false), sy = __builtin_amdgcn_permlane32_swap(w[0].y, w[1].y, false, false);
                *(v4u*)(orow + 32 * dt + 16 * gp + 8 * hi) = (v4u){sx[0], sy[0], sx[1], sy[1]}; }
    }
}

template <int MODE> __device__ __forceinline__ void dil_pass(Frame& F) {
    constexpr int STR = (MODE == 0) ? 1 : (MODE == 1) ? 4 : 16, NT = (MODE == 0) ? 5 : 4, LO = (MODE == 0) ? 0 : 33, NU = BATCH * 8 * 128;
    const h16* QKV = (const h16*)(F.ws + WS_A); h16* O = (h16*)(F.ws + WS_B);
    const h16* KB = (MODE == 0) ? (const h16*)(F.ws + WS_KB1) : (MODE == 1) ? (const h16*)(F.ws + WS_KB4) : (const h16*)(F.ws + WS_KB16);
    h16* PO1 = (h16*)F.out; h16* PO2 = PO1 + (size_t)BATCH * 8 * SEQ * 64; float* PM1 = (float*)(PO2 + (size_t)BATCH * 8 * SEQ * 64); float* PM2 = PM1 + (size_t)BATCH * 8 * SEQ * 2;
    int lane_ = F.lane; asm volatile("" : "+v"(lane_));
    const int gw = F.vcu * NWAVES + F.wave, NGW = F.G * NWAVES, lane = lane_, r32 = lane & 31, hi = lane >> 5;
    LAS unsigned char* vl = F.lds + RING_OFF + F.wave * 4096;
    const LAS unsigned char* trb = vl + (8 * hi + ((lane & 15) >> 2)) * 64 + (16 * ((lane >> 4) & 1) + 4 * (lane & 3)) * 2;
#define DU_BH(i) ((i) >> 7)
#define DU_RR(i) ((MODE == 0) ? 0 : (MODE == 1) ? (((i) & 127) >> 5) : (((i) & 127) >> 3))
#define DU_QB(i) ((MODE == 0) ? ((i) & 127) : (MODE == 1) ? ((i) & 31) : ((i) & 7))
#define DU_KB0(i) ((MODE == 0) ? DU_QB(i) : DU_QB(i) - 1)
#define DU_NT(i) ((DU_KB0(i) + 1 < NT) ? DU_KB0(i) + 1 : NT)
#define DU_LOADQ(i, q) do { const int bh_ = DU_BH(i), tq_ = STR * (32 * DU_QB(i) + r32) + DU_RR(i); \
        const h16* qr_ = QKV + (size_t)((bh_ >> 3) * SEQ + tq_) * 3072 + 1536 + (bh_ & 7) * 64 + 8 * hi; \
        _Pragma("unroll") for (int sl_ = 0; sl_ < 4; ++sl_) q[sl_] = ldf8(qr_ + sl_ * 16); } while (0)
#define DU_LOADKV(i, kb) do { const int bh_ = DU_BH(i), rr_ = DU_RR(i), ub_ = (MODE == 0) ? 0 : (MODE == 1) ? rr_ * 32 : rr_ * 8; \
        const h16* kp_ = KB + ((size_t)((bh_ * 128 + ub_ + (kb)) * 4) * 64 + lane) * 8; \
        const h16* vp_ = QKV + (size_t)((bh_ >> 3) * SEQ + STR * (32 * (kb) + (lane >> 3)) + rr_) * 3072 + 2560 + (bh_ & 7) * 64 + 8 * (lane & 7); \
        _Pragma("unroll") for (int sl_ = 0; sl_ < 4; ++sl_) kn[sl_] = ldf8(kp_ + sl_ * 512); \
        _Pragma("unroll") for (int i_ = 0; i_ < 4; ++i_) vn[i_] = *(const v4u*)(vp_ + (size_t)(STR * 8 * i_) * 3072); } while (0)
    int idx = gw; if (idx >= NU) return;
    hf8 kn[4]; v4u vn[4];
    if (DU_NT(idx) > 0) DU_LOADKV(idx, DU_KB0(idx));
    for (;;) {
        const int nidx = idx + NGW; const bool hn = nidx < NU;
        const int bh = DU_BH(idx), b = bh >> 3, h = bh & 7, rr = DU_RR(idx), qb = DU_QB(idx), kb0 = DU_KB0(idx), ntile = DU_NT(idx);
        const float sS = exp2f(-0.5f * (float)(h + 9)) * LOG2E * (float)STR;
        const int tq = STR * (32 * qb + r32) + rr;
        hf8 qf[4];
        DU_LOADQ(idx, qf);
        const size_t prw = (size_t)bh * SEQ + tq;
        float pm1 = 0.f, pl1 = 0.f, pm2 = 0.f, pl2 = 0.f;
        float cb[16];
#pragma unroll
        for (int r = 0; r < 16; ++r) { const int ko = 16 * (r >> 3) + 8 * hi + (r & 7), dd = r32 - ko;
            const float lg = (MODE == 0) ? (((dd & 15) == 0) ? 1.5849625007211562f : ((dd & 3) == 0) ? 1.0f : 0.0f) : (MODE == 1) ? (((dd & 3) == 0) ? 1.0f : 0.0f) : 0.0f;
            cb[r] = sS * (float)ko + lg; }
        f32x16 o[2];
#pragma unroll
        for (int dt = 0; dt < 2; ++dt)
#pragma unroll
            for (int r = 0; r < 16; ++r) o[dt][r] = 0.f;
        float mrun = 0.f, lrun = 0.f; bool started = false;
        for (int j = 0; j < ntile; ++j) {
            const int kb = kb0 - j;
            hf8 kf[4];
#pragma unroll
            for (int sl = 0; sl < 4; ++sl) kf[sl] = kn[sl];
            asm volatile("" ::: "memory");
            v_stage(vl, vn, lane);
            asm volatile("" ::: "memory");
            if (j + 1 < ntile) DU_LOADKV(idx, kb - 1);
            else if (hn && DU_NT(nidx) > 0) DU_LOADKV(nidx, DU_KB0(nidx));
            hf8 vf[2][2];
#pragma unroll
            for (int dt = 0; dt < 2; ++dt)
#pragma unroll
                for (int s2 = 0; s2 < 2; ++s2) vf[dt][s2] = v_frag(trb, dt, s2);
            asm volatile("" ::: "memory");
            const float tb = sS * (float)(32 * (kb - qb)) - mrun;
            f32x16 s;
#pragma unroll
            for (int r = 0; r < 16; ++r) s[r] = cb[r] + tb;
            if (j == 0 || j == NT - 1) {
                const int dl0 = 32 * (qb - kb) + r32;
#pragma unroll
                for (int r = 0; r < 16; ++r) { const int dl = dl0 - (16 * (r >> 3) + 8 * hi + (r & 7)); if (dl < LO || dl > 128) s[r] = -INFINITY; }
            }
#pragma unroll
            for (int sl = 0; sl < 4; ++sl) s = MFMA32(kf[sl], qf[sl], s);
            const float mx = half_max(rowmax16(s));
            const bool fresh = !started && mx > -INFINITY;
            if (__any(fresh || mx > LAZY_THR)) {
                const float dl = fresh ? mx : fmaxf(mx, 0.f), alpha = ex2(-dl); mrun += dl; lrun *= alpha; started = started || fresh;
#pragma unroll
                for (int r = 0; r < 16; ++r) s[r] -= dl;
#pragma unroll
                for (int dt = 0; dt < 2; ++dt)
#pragma unroll
                    for (int r = 0; r < 16; ++r) o[dt][r] *= alpha; }
            float ls = 0.f;
#pragma unroll
            for (int r = 0; r < 16; ++r) { s[r] = ex2(s[r]); ls += s[r]; }
            lrun += ls;
            v4u p0, p1;
            p0.x = pk2h(s[0], s[1]); p0.y = pk2h(s[2], s[3]); p0.z = pk2h(s[4], s[5]); p0.w = pk2h(s[6], s[7]);
            p1.x = pk2h(s[8], s[9]); p1.y = pk2h(s[10], s[11]); p1.z = pk2h(s[12], s[13]); p1.w = pk2h(s[14], s[15]);
            const hf8 pb0 = __builtin_bit_cast(hf8, p0), pb1 = __builtin_bit_cast(hf8, p1);
#pragma unroll
            for (int dt = 0; dt < 2; ++dt) { o[dt] = MFMA32(vf[dt][0], pb0, o[dt]); o[dt] = MFMA32(vf[dt][1], pb1, o[dt]); }
        }
        if (ntile == 0 && hn && DU_NT(nidx) > 0) DU_LOADKV(nidx, DU_KB0(nidx));
        const float l = half_sum(lrun), mt = (l > 0.f) ? mrun - sS * (float)r32 : -1.0e30f;
        if (MODE != 2) {
            const float il = (l > 0.f) ? 1.0f / l : 0.f;
            h16* po = ((MODE == 0) ? PO1 : PO2) + prw * 64; float* pm = ((MODE == 0) ? PM1 : PM2) + prw * 2;
#pragma unroll
            for (int dt = 0; dt < 2; ++dt)
#pragma unroll
                for (int gp = 0; gp < 2; ++gp) { v2u w[2];
#pragma unroll
                    for (int e = 0; e < 2; ++e) { const int g = 2 * gp + e; w[e].x = pk2h(o[dt][4 * g] * il, o[dt][4 * g + 1] * il); w[e].y = pk2h(o[dt][4 * g + 2] * il, o[dt][4 * g + 3] * il); }
                    const auto sx = __builtin_amdgcn_permlane32_swap(w[0].x, w[1].x, false, false), sy = __builtin_amdgcn_permlane32_swap(w[0].y, w[1].y, false, false);
                    *(v4u*)(po + 32 * dt + 16 * gp + 8 * hi) = (v4u){sx[0], sy[0], sx[1], sy[1]}; }
            if (hi == 0) { pm[0] = mt; pm[1] = l; }
        } else {
            pm1 = PM1[prw * 2]; pl1 = PM1[prw * 2 + 1]; pm2 = PM2[prw * 2]; pl2 = PM2[prw * 2 + 1];
            const float Mx = fmaxf(pm1, fmaxf(pm2, mt));
            const float w1 = pl1 * ex2(pm1 - Mx), w2 = pl2 * ex2(pm2 - Mx), w3 = ex2(mt - Mx), inv = 1.0f / (w1 + w2 + w3 * l);
            const h16* p1 = PO1 + prw * 64; const h16* p2 = PO2 + prw * 64;
            h16* orow = O + (size_t)(b * SEQ + tq) * D + 512 + h * 64;
#pragma unroll
            for (int dt = 0; dt < 2; ++dt)
#pragma unroll
                for (int gp = 0; gp < 2; ++gp) { v2u w[2];
#pragma unroll
                    for (int e2 = 0; e2 < 2; ++e2) { const int g = 2 * gp + e2, d = 32 * dt + 8 * g + 4 * hi; const f32x4 a = ld4h(p1 + d), c = ld4h(p2 + d);
                        float y[4];
#pragma unroll
                        for (int e = 0; e < 4; ++e) y[e] = (w1 * a[e] + w2 * c[e] + w3 * o[dt][4 * g + e]) * inv;
                        w[e2].x = pk2h(y[0], y[1]); w[e2].y = pk2h(y[2], y[3]); }
                    const auto sx = __builtin_amdgcn_permlane32_swap(w[0].x, w[1].x, false, false), sy = __builtin_amdgcn_permlane32_swap(w[0].y, w[1].y, false, false);
                    *(v4u*)(orow + 32 * dt + 16 * gp + 8 * hi) = (v4u){sx[0], sy[0], sx[1], sy[1]}; }
        }
        if (!hn) break;
        idx = nidx;
    }
#undef DU_BH
#undef DU_RR
#undef DU_QB
#undef DU_KB0
#undef DU_NT
#undef DU_LOADQ
#undef DU_LOADKV
}

struct RowLn { f32x4 n[4]; };
__device__ __forceinline__ void ln_rows(f32x4 (&v)[4], const float* lg, const float* lb, int lane) {
    float s = 0.f;
#pragma unroll
    for (int j = 0; j < 4; ++j) s += (v[j][0] + v[j][1]) + (v[j][2] + v[j][3]);
    const float mean = wave_sum(s) * (1.0f / D); float s2 = 0.f;
#pragma unroll
    for (int j = 0; j < 4; ++j) { v[j] = v[j] - mean; s2 += (v[j][0] * v[j][0] + v[j][1] * v[j][1]) + (v[j][2] * v[j][2] + v[j][3] * v[j][3]); }
    const float rstd = 1.0f / sqrtf(wave_sum(s2) * (1.0f / D) + LN_EPS);
#pragma unroll
    for (int j = 0; j < 4; ++j) { const int col = 4 * lane + 256 * j; v[j] = v[j] * rstd * *(const f32x4*)(lg + col) + *(const f32x4*)(lb + col); }
}
struct RowIn { f32x4 x[4]; v2u hx[4]; v2u y[4]; };
template <bool XF32> __device__ __forceinline__ void row_load(RowIn& r, const float* xin, const h16* hin, const h16* y, int lane) {
#pragma unroll
    for (int j = 0; j < 4; ++j) { const int col = 4 * lane + 256 * j; if (XF32) r.x[j] = *(const f32x4*)(xin + col); else r.hx[j] = *(const v2u*)(hin + col); r.y[j] = *(const v2u*)(y + col); }
}
__device__ __forceinline__ f32x4 cvt4(v2u w) { return (f32x4){hlo(w.x), hhi(w.x), hlo(w.y), hhi(w.y)}; }
struct RowVec { f32x4 rdiv[4], psh[4], gate1[4], lg[4], lb[4], sc1[4], sh[4]; };
template <bool XF32> __device__ __forceinline__ void rowvec_load(RowVec& q, const float* psc, const float* psh, const float* gate, const float* lg, const float* lb, const float* sc, const float* sh, int lane) {
#pragma unroll
    for (int j = 0; j < 4; ++j) { const int col = 4 * lane + 256 * j;
        if (!XF32) { const f32x4 d = 1.0f + *(const f32x4*)(psc + col); q.rdiv[j] = (f32x4){__builtin_amdgcn_rcpf(d[0]), __builtin_amdgcn_rcpf(d[1]), __builtin_amdgcn_rcpf(d[2]), __builtin_amdgcn_rcpf(d[3])}; q.psh[j] = *(const f32x4*)(psh + col); }
        q.gate1[j] = 1.0f + *(const f32x4*)(gate + col); q.lg[j] = *(const f32x4*)(lg + col); q.lb[j] = *(const f32x4*)(lb + col);
        q.sc1[j] = 1.0f + *(const f32x4*)(sc + col); q.sh[j] = *(const f32x4*)(sh + col); }
}
__device__ __forceinline__ void ln_rows_v(f32x4 (&v)[4], const RowVec& q) {
    float s = 0.f;
#pragma unroll
    for (int j = 0; j < 4; ++j) s += (v[j][0] + v[j][1]) + (v[j][2] + v[j][3]);
    const float mean = wave_sum(s) * (1.0f / D); float s2 = 0.f;
#pragma unroll
    for (int j = 0; j < 4; ++j) { v[j] = v[j] - mean; s2 += (v[j][0] * v[j][0] + v[j][1] * v[j][1]) + (v[j][2] * v[j][2] + v[j][3] * v[j][3]); }
    const float rstd = 1.0f / sqrtf(wave_sum(s2) * (1.0f / D) + LN_EPS);
#pragma unroll
    for (int j = 0; j < 4; ++j) v[j] = v[j] * rstd * q.lg[j] + q.lb[j];
}
template <bool XF32> __device__ __forceinline__ void row_block(const RowIn& in, const RowVec& q, h16* ho, f32x4 (&hv)[4], int lane) {
    f32x4 v[4];
#pragma unroll
    for (int j = 0; j < 4; ++j) { f32x4 xv; if (XF32) xv = in.x[j]; else xv = (cvt4(in.hx[j]) - q.psh[j]) * q.rdiv[j];
        v[j] = DN_ALPHA * xv + q.gate1[j] * cvt4(in.y[j]); }
    ln_rows_v(v, q);
#pragma unroll
    for (int j = 0; j < 4; ++j) { const int col = 4 * lane + 256 * j;
        hv[j] = v[j] * q.sc1[j] + q.sh[j];
        v2u o; o.x = pk2h(hv[j][0], hv[j][1]); o.y = pk2h(hv[j][2], hv[j][3]); *(v2u*)(ho + col) = o; }
}
template <bool XF32> __device__ __forceinline__ void ph_rows(Frame& F, const float* xin, const h16* HIN, const float* psc, const float* psh, const h16* Y, const float* modl_gate  ,
                                        const float* lg, const float* lb, const float* mod_sc, const float* mod_sh, h16* HO) {
    const int gw = F.vcu * NWAVES + F.wave, WPB = F.G;
    const int b = gw / WPB, r0 = gw % WPB; const size_t bo = (size_t)b * (6 * D);
    RowVec q; rowvec_load<XF32>(q, psc + bo, psh + bo, modl_gate + bo, lg, lb, mod_sc + bo, mod_sh + bo, F.lane);
    for (int t0 = r0; t0 < SEQ; t0 += 4 * WPB) {
        RowIn r[4];
#pragma unroll
        for (int i = 0; i < 4; ++i) { const int t = t0 + i * WPB; if (t < SEQ) { const size_t m = (size_t)b * SEQ + t; row_load<XF32>(r[i], xin + m * D, HIN + m * D, Y + m * D, F.lane); } }
#pragma unroll
        for (int i = 0; i < 4; ++i) { const int t = t0 + i * WPB; if (t < SEQ) { const size_t m = (size_t)b * SEQ + t; f32x4 hv[4];
            row_block<XF32>(r[i], q, HO + m * D, hv, F.lane); } }
    }
}

__device__ __forceinline__ void ph10_ssm_naive(Frame& F) {
    const h16* U = (const h16*)(F.ws + WS_B); h16* GY = (h16*)(F.ws + WS_C);
    const float* SA = (const float*)(F.ws + WS_SSMA); const float* SB = (const float*)(F.ws + WS_SSMB);
    const int gw = F.vcu * NWAVES + F.wave, NGW = F.G * NWAVES, lane = F.lane;
    for (int it = gw; it < BATCH * 64; it += NGW) {
        const int b = it >> 6, g = it & 63, gp = g * 64 + lane;
        const float abr = SA[gp * 2], abi = SA[gp * 2 + 1];
        float bbr[16], bbi[16], cr[16], ci[16];
#pragma unroll
        for (int c = 0; c < 16; ++c) { bbr[c] = SB[(gp * 16 + c) * 2]; bbi[c] = SB[(gp * 16 + c) * 2 + 1]; cr[c] = F.in[I_CRE][(g * 16 + c) * 64 + lane]; ci[c] = F.in[I_CIM][(g * 16 + c) * 64 + lane]; }
        const float dsk = F.in[I_DSKIP][g * 16 + (lane & 15)];
        float hr = 0.f, hi = 0.f;
        for (int t = 0; t < SEQ; ++t) {
            const h16* ur = U + (size_t)(b * SEQ + t) * D + g * 16;
            float u[16]; ld8h(ur, u); ld8h(ur + 8, u + 8);
            float xr = 0.f, xi = 0.f;
#pragma unroll
            for (int c = 0; c < 16; ++c) { xr += bbr[c] * u[c]; xi += bbi[c] * u[c]; }
            const float nhr = abr * hr - abi * hi + xr, nhi = abr * hi + abi * hr + xi; hr = nhr; hi = nhi;
            float mine = 0.f;
#pragma unroll
            for (int c = 0; c < 16; ++c) { const float yc = wave_sum(cr[c] * hr - ci[c] * hi); if (lane == c) mine = yc; }
            if (lane < 16) { const float val = mine + dsk * h2f(ur[lane]); GY[(size_t)(b * SEQ + t) * D + g * 16 + lane] = (h16)(pk2h(gelu_tanh(val), 0.f) & 0xffffu); }
        }
    }
}


__device__ __forceinline__ void ssm_prep(Frame& F) {
    typedef float f32x2v __attribute__((ext_vector_type(2)));
    const float* SA = (const float*)(F.ws + WS_SSMA); const float* SB = (const float*)(F.ws + WS_SSMB);
    LAS f32x2v* PW = (LAS f32x2v*)(F.lds + RING_OFF);
    LAS f32x2v* BB = (LAS f32x2v*)(F.lds + RING_OFF + 16384);
    LAS f32x2v* CC = (LAS f32x2v*)(F.lds + RING_OFF + 32768);
    LAS float* KL = (LAS float*)(F.lds + RING_OFF + 49152);
    const int tid = F.tid;
    LAS int* tsk = (LAS int*)(F.lds + RING_OFF + 65536);
    for (;;) {
        if (tid == 0) *tsk = (int)__hip_atomic_fetch_add(F.ctl + CW_PREP, 1u, RLX_AGENT);
        __syncthreads();
        const int task = *tsk;
        __syncthreads();
        if (task >= 256) break;
        const int g = task >> 2, part = task & 3;
        const float idt = 1.0f / expf(F.in[I_LOGDT][g]);
        if (tid < 64) { float pr = 1.0f, pi = 0.0f; const float ar = SA[(g * 64 + tid) * 2], ai = SA[(g * 64 + tid) * 2 + 1];
            for (int k = 0; k <= 16; ++k) { PW[k * 64 + tid] = (f32x2v){pr, pi}; const float nr = pr * ar - pi * ai, ni = pr * ai + pi * ar; pr = nr; pi = ni; } }
        for (int e = tid; e < 1024; e += NWAVES * 64) { BB[e] = (f32x2v){SB[(g * 1024 + e) * 2] * idt, SB[(g * 1024 + e) * 2 + 1] * idt};
            CC[e] = (f32x2v){F.in[I_CRE][g * 1024 + e], F.in[I_CIM][g * 1024 + e]}; }
        __syncthreads();
        h16* base = (h16*)((unsigned char*)F.out + 100 * MiB) + (size_t)g * 131072;
        if (part == 0) {
            for (int q = tid; q < 64 * 64; q += NWAVES * 64) { const int f = q >> 6, l = q & 63, rt = f >> 4, t = f & 15, r32 = l & 31, hi = l >> 5, p = 16 * rt + (r32 & 15), im = r32 >> 4;
                const f32x2v a = PW[(15 - t) * 64 + p]; hf8 v;
#pragma unroll
                for (int j = 0; j < 8; ++j) { const f32x2v bb = BB[p * 16 + 8 * hi + j]; v[j] = (_Float16)(im ? (a.x * bb.y + a.y * bb.x) : (a.x * bb.x - a.y * bb.y)); }
                *(v4u*)(base + (size_t)q * 8) = __builtin_bit_cast(v4u, v); }
        } else if (part == 1) {
            for (int q = tid; q < 64 * 64; q += NWAVES * 64) { const int f = q >> 6, l = q & 63, rtY = f >> 3, q8 = f & 7, rt = q8 >> 1, sIm = q8 & 1, r32 = l & 31, hi = l >> 5;
                const int t = 2 * rtY + (r32 >> 4), c = r32 & 15; hf8 v;
#pragma unroll
                for (int j = 0; j < 8; ++j) { const int p = 16 * rt + (j & 3) + 8 * (j >> 2) + 4 * hi; const f32x2v a = PW[(t + 1) * 64 + p], cc = CC[c * 64 + p];
                    const float zr = cc.x * a.x - cc.y * a.y, zi = cc.x * a.y + cc.y * a.x; v[j] = (_Float16)(sIm ? -zi : zr); }
                *(v4u*)(base + 32768 + (size_t)q * 8) = __builtin_bit_cast(v4u, v); }
        } else {
            { const int L = tid >> 5, c = (tid >> 1) & 15, c20 = (tid & 1) * 8; float acc8[8];
#pragma unroll
                for (int j = 0; j < 8; ++j) acc8[j] = 0.f;
                for (int p = 0; p < 64; ++p) { const f32x2v a = PW[L * 64 + p], cc = CC[c * 64 + p];
                    const float zr = cc.x * a.x - cc.y * a.y, zi = cc.x * a.y + cc.y * a.x;
#pragma unroll
                    for (int j = 0; j < 8; ++j) { const f32x2v bb = BB[p * 16 + c20 + j]; acc8[j] += zr * bb.x - zi * bb.y; } }
#pragma unroll
                for (int j = 0; j < 8; ++j) KL[L * 256 + c * 16 + c20 + j] = acc8[j]; }
            __syncthreads();
            const int q0 = (part - 2) * 4096;
            for (int q = q0 + tid; q < q0 + 4096; q += NWAVES * 64) { const int f = q >> 6, l = q & 63, rtY = f >> 4, s = f & 15, r32 = l & 31, hi = l >> 5;
                const int t = 2 * rtY + (r32 >> 4), c = r32 & 15, L = t - s; hf8 v;
#pragma unroll
                for (int j = 0; j < 8; ++j) v[j] = (_Float16)((L >= 0) ? KL[(L & 15) * 256 + c * 16 + 8 * hi + j] : 0.f);
                *(v4u*)(base + 65536 + (size_t)q * 8) = __builtin_bit_cast(v4u, v); }
        }
        __syncthreads();
    }
}
__device__ __forceinline__ void ph10_ssm_mfma(Frame& F) {
    const h16* U = (const h16*)(F.ws + WS_B); h16* GY = (h16*)(F.ws + WS_C);
    const float* SA = (const float*)(F.ws + WS_SSMA);
    typedef float f32x2v __attribute__((ext_vector_type(2)));
    LAS f32x2v* SL = (LAS f32x2v*)(F.lds + RING_OFF);
    LAS unsigned char* OPL = F.lds + RING_OFF;
    int tid_ = F.tid; asm volatile("" : "+v"(tid_));
    const int tid = tid_, lane = tid & 63, r32 = lane & 31, hi = lane >> 5, wave = F.wave;
    for (int unit = blockIdx.x; unit < BATCH * 64; unit += F.G) {
        const int b = unit >> 6, g = unit & 63;
        const float dt = expf(F.in[I_LOGDT][g]);
        const h16* MW1 = (const h16*)((const unsigned char*)F.out + 100 * MiB) + (size_t)g * 131072; const h16* MG = MW1 + 32768; const h16* MT = MW1 + 65536;
        const int ch = 32 * wave + r32;
        const h16* urow = U + (size_t)(b * SEQ + 16 * ch) * D + g * 16;
        { v4u w1[8];
#pragma unroll
            for (int i = 0; i < 8; ++i) w1[i] = *(const v4u*)(MW1 + (size_t)(i * 512 + tid) * 8);
#pragma unroll
            for (int i = 0; i < 8; ++i) *(LAS v4u*)(OPL + (size_t)(i * 512 + tid) * 16) = w1[i]; }
        __builtin_amdgcn_sched_barrier(0);
        hf8 ub[16];
#pragma unroll
        for (int t = 0; t < 16; ++t) ub[t] = ldf8(urow + (size_t)t * D + 8 * hi);
        __syncthreads();
        f32x16 acc[4];
#pragma unroll
        for (int rt = 0; rt < 4; ++rt)
#pragma unroll
            for (int r = 0; r < 16; ++r) acc[rt][r] = 0.f;
#pragma unroll
        for (int t = 0; t < 16; ++t)
        {
#pragma unroll
            for (int rt = 0; rt < 4; ++rt) acc[rt] = MFMA32(__builtin_bit_cast(hf8, *(const LAS v4u*)(OPL + (rt * 16 + t) * 1024 + lane * 16)), ub[t], acc[rt]);
            if ((t & 3) == 3) __builtin_amdgcn_sched_barrier(0); }
        __syncthreads();
#pragma unroll
        for (int rt = 0; rt < 4; ++rt)
#pragma unroll
            for (int r = 0; r < 8; ++r) { const int p = 16 * rt + (r & 3) + 8 * (r >> 2) + 4 * hi; SL[p * 257 + ch] = (f32x2v){acc[rt][r], acc[rt][r + 8]}; }
        __syncthreads();
        {
            const int p = tid & 63, sg = tid >> 6;
            float pr = SA[(g * 64 + p) * 2], pi = SA[(g * 64 + p) * 2 + 1];
#pragma unroll
            for (int q = 0; q < 4; ++q) { const float nr = pr * pr - pi * pi, ni = 2.0f * pr * pi; pr = nr; pi = ni; }
            const float aLr = pr, aLi = pi;
            float xr = 0.f, xi = 0.f;
            for (int j0 = 0; j0 < 32; j0 += 8) { f32x2v sv[8];
#pragma unroll
                for (int j = 0; j < 8; ++j) sv[j] = SL[p * 257 + 32 * sg + j0 + j];
#pragma unroll
                for (int j = 0; j < 8; ++j) { const float nr = aLr * xr - aLi * xi + sv[j].x, ni = aLr * xi + aLi * xr + sv[j].y; xr = nr; xi = ni; sv[j] = (f32x2v){xr, xi}; }
#pragma unroll
                for (int j = 0; j < 8; ++j) SL[p * 257 + 32 * sg + j0 + j] = sv[j]; }
#pragma unroll
            for (int q = 0; q < 5; ++q) { const float nr = pr * pr - pi * pi, ni = 2.0f * pr * pi; pr = nr; pi = ni; }
            __syncthreads();
            float cr = 0.f, ci = 0.f;
            for (int s2 = 0; s2 < sg; ++s2) { const int c2 = 32 * s2 + 31; const f32x2v ag = SL[p * 257 + c2];
                const float nr = pr * cr - pi * ci + ag.x, ni = pr * ci + pi * cr + ag.y; cr = nr; ci = ni; }
            __syncthreads();
            float prevr = 0.f, previ = 0.f, wr = 1.0f, wi = 0.0f;
            for (int j0 = 0; j0 < 32; j0 += 8) { f32x2v xv[8];
#pragma unroll
                for (int j = 0; j < 8; ++j) xv[j] = SL[p * 257 + 32 * sg + j0 + j];
#pragma unroll
                for (int j = 0; j < 8; ++j) { const f32x2v in = (f32x2v){prevr + wr * cr - wi * ci, previ + wr * ci + wi * cr};
                    prevr = xv[j].x; previ = xv[j].y; xv[j] = in; const float nr = wr * aLr - wi * aLi, ni = wr * aLi + wi * aLr; wr = nr; wi = ni; }
#pragma unroll
                for (int j = 0; j < 8; ++j) SL[p * 257 + 32 * sg + j0 + j] = xv[j]; }
        }
        __syncthreads();
        v4u ifw[8];
#pragma unroll
        for (int rt = 0; rt < 4; ++rt) { float re[8], im[8];
#pragma unroll
            for (int j = 0; j < 8; ++j) { const int p = 16 * rt + (j & 3) + 8 * (j >> 2) + 4 * hi; const f32x2v v = SL[p * 257 + ch]; re[j] = v.x; im[j] = v.y; }
            v4u w0, w1; w0.x = pk2h(re[0], re[1]); w0.y = pk2h(re[2], re[3]); w0.z = pk2h(re[4], re[5]); w0.w = pk2h(re[6], re[7]);
            w1.x = pk2h(im[0], im[1]); w1.y = pk2h(im[2], im[3]); w1.z = pk2h(im[4], im[5]); w1.w = pk2h(im[6], im[7]);
            ifw[2 * rt] = w0; ifw[2 * rt + 1] = w1; }
        LAS v4u* IFL = (LAS v4u*)(OPL + 49152 + wave * 8192);
        const f32x4 dk0 = *(const f32x4*)(F.in[I_DSKIP] + g * 16 + 4 * hi), dk1 = *(const f32x4*)(F.in[I_DSKIP] + g * 16 + 8 + 4 * hi);
        h16* yrow = GY + (size_t)(b * SEQ + 16 * ch) * D + g * 16;
        v4u pg, pt0, pt1;
        pg = *(const v4u*)(MG + (size_t)tid * 8); pt0 = *(const v4u*)(MT + (size_t)tid * 8); pt1 = pt0;
        __syncthreads();
#pragma unroll
        for (int q = 0; q < 8; ++q) IFL[q * 64 + lane] = ifw[q];
        *(LAS v4u*)(OPL + tid * 16) = pg; if (tid < 128) *(LAS v4u*)(OPL + 8192 + tid * 16) = pt0;
        __syncthreads();
#pragma unroll
        for (int rtY = 0; rtY < 8; ++rtY) {
            LAS unsigned char* cur = OPL + (rtY & 1) * 24576;
            if (rtY < 7) { const int nT = (2 * (rtY + 1) + 2) * 64;
                pg = *(const v4u*)(MG + (size_t)((rtY + 1) * 8 * 64 + tid) * 8);
                if (tid < nT) pt0 = *(const v4u*)(MT + (size_t)((rtY + 1) * 16 * 64 + tid) * 8);
                if (tid + 512 < nT) pt1 = *(const v4u*)(MT + (size_t)((rtY + 1) * 16 * 64 + tid + 512) * 8); }
            f32x16 y0, y1;
#pragma unroll
            for (int r = 0; r < 16; ++r) { y0[r] = 0.f; y1[r] = 0.f; }
#pragma unroll
            for (int q = 0; q < 8; ++q) { const hf8 af = __builtin_bit_cast(hf8, *(const LAS v4u*)(cur + q * 1024 + lane * 16)); const hf8 bf = __builtin_bit_cast(hf8, IFL[q * 64 + lane]); if (q & 1) y1 = MFMA32(af, bf, y1); else y0 = MFMA32(af, bf, y0); }
#pragma unroll
            for (int s2 = 0; s2 <= 2 * rtY + 1; ++s2) { const hf8 af = __builtin_bit_cast(hf8, *(const LAS v4u*)(cur + 8192 + s2 * 1024 + lane * 16)); if (s2 & 1) y1 = MFMA32(af, ub[s2], y1); else y0 = MFMA32(af, ub[s2], y0); }
#pragma unroll
            for (int tt = 0; tt < 2; ++tt) { const size_t ro = (size_t)(2 * rtY + tt) * D;
                const v4u uw = __builtin_bit_cast(v4u, ub[2 * rtY + tt]);
                const auto sw0 = __builtin_amdgcn_permlane32_swap(uw.x, uw.z, false, false), sw1 = __builtin_amdgcn_permlane32_swap(uw.y, uw.w, false, false);
                const f32x4 u0 = {hlo(sw0[0]), hhi(sw0[0]), hlo(sw1[0]), hhi(sw1[0])}, u1 = {hlo(sw0[1]), hhi(sw0[1]), hlo(sw1[1]), hhi(sw1[1])};
                float yv[8];
#pragma unroll
                for (int e = 0; e < 8; ++e) yv[e] = (y0[8 * tt + e] + y1[8 * tt + e]) * dt;
                v2u w0, w1;
                w0.x = pk2h(gelu_tanh(yv[0] + dk0[0] * u0[0]), gelu_tanh(yv[1] + dk0[1] * u0[1])); w0.y = pk2h(gelu_tanh(yv[2] + dk0[2] * u0[2]), gelu_tanh(yv[3] + dk0[3] * u0[3]));
                w1.x = pk2h(gelu_tanh(yv[4] + dk1[0] * u1[0]), gelu_tanh(yv[5] + dk1[1] * u1[1])); w1.y = pk2h(gelu_tanh(yv[6] + dk1[2] * u1[2]), gelu_tanh(yv[7] + dk1[3] * u1[3]));
                const auto sx = __builtin_amdgcn_permlane32_swap(w0.x, w1.x, false, false), sy = __builtin_amdgcn_permlane32_swap(w0.y, w1.y, false, false);
                *(v4u*)(yrow + ro + 8 * hi) = (v4u){sx[0], sy[0], sx[1], sy[1]}; }
            if (rtY < 7) { const int nT = (2 * (rtY + 1) + 2) * 64; LAS unsigned char* nxt = OPL + ((rtY + 1) & 1) * 24576;
                *(LAS v4u*)(nxt + tid * 16) = pg;
                if (tid < nT) *(LAS v4u*)(nxt + 8192 + tid * 16) = pt0;
                if (tid + 512 < nT) *(LAS v4u*)(nxt + 8192 + (tid + 512) * 16) = pt1; }
            __syncthreads();
        }
    }
}

__device__ __forceinline__ void ph12_rows_route(Frame& F) {
    const int gw = F.vcu * NWAVES + F.wave, NGW = F.G * NWAVES, lane = F.lane;
    const float* mod1 = (const float*)(F.ws + WS_MOD) + (size_t)BATCH * 6 * D;
    const h16* Y3 = (const h16*)(F.ws + WS_A); h16* H16 = (h16*)(F.ws + WS_VT1);
    int* tok_e = (int*)(F.ws + WS_TOKE); float* tok_g = (float*)(F.ws + WS_TOKG);
    LAS unsigned* lcnt = (LAS unsigned*)(F.lds + 1024);
    if (F.tid < 8) lcnt[F.tid] = 0u;
    __syncthreads();
    LAS f32x4* RWL = (LAS f32x4*)(F.lds + 4096);
    for (int e = F.tid; e < 2048; e += NWAVES * 64) { const int jih = e >> 6, l = e & 63, j = jih >> 3, i = (jih >> 1) & 3, hf = jih & 1;
        RWL[e] = *(const f32x4*)(F.in[I_RW] + (size_t)(4 * l + 256 * j + i) * 8 + 4 * hf); }
    __syncthreads();
    const f32x4 rb0 = *(const f32x4*)(F.in[I_RB]), rb1 = *(const f32x4*)(F.in[I_RB] + 4);
    const h16* UPREV = (const h16*)(F.ws + WS_B);
    const int WPB = F.G, bq = gw / WPB, r0 = gw % WPB; const size_t bo = (size_t)bq * (6 * D);
    RowVec q; rowvec_load<false>(q, mod1 + bo + 1 * D, mod1 + bo, mod1 + bo + 2 * D, F.in[I_LN1G1], F.in[I_LN1B1], mod1 + bo + 4 * D, mod1 + bo + 3 * D, lane);
    for (int t0 = r0; t0 < SEQ; t0 += WPB) {
        { const int m = bq * SEQ + t0;
        RowIn rr1; row_load<false>(rr1, nullptr, UPREV + (size_t)m * D, Y3 + (size_t)m * D, lane);
        f32x4 hv[4];
        row_block<false>(rr1, q, H16 + (size_t)m * D, hv, lane);
        f32x4 a0 = {0.f, 0.f, 0.f, 0.f}, a1 = a0;
#pragma unroll
        for (int j = 0; j < 4; ++j)
#pragma unroll
            for (int i = 0; i < 4; ++i) { a0 += hv[j][i] * RWL[((j * 4 + i) * 2 + 0) * 64 + lane]; a1 += hv[j][i] * RWL[((j * 4 + i) * 2 + 1) * 64 + lane]; }
        float lg[8];
#pragma unroll
        for (int e = 0; e < 4; ++e) { lg[e] = wave_sum(a0[e]) + rb0[e]; lg[4 + e] = wave_sum(a1[e]) + rb1[e]; }
        int e1 = 0; float v1 = lg[0];
#pragma unroll
        for (int e = 1; e < 8; ++e) if (lg[e] > v1) { v1 = lg[e]; e1 = e; }
        int e2 = -1; float v2 = -INFINITY;
#pragma unroll
        for (int e = 0; e < 8; ++e) if (e != e1 && lg[e] > v2) { v2 = lg[e]; e2 = e; }
        const float g1 = 1.0f / (1.0f + expf(v2 - v1)), g2 = 1.0f - g1;
        if (lane == 0) { tok_e[2 * m] = e1; tok_e[2 * m + 1] = e2; tok_g[2 * m] = g1; tok_g[2 * m + 1] = g2;
            __hip_atomic_fetch_add(lcnt + e1, 1u, __ATOMIC_RELAXED, __HIP_MEMORY_SCOPE_WORKGROUP); __hip_atomic_fetch_add(lcnt + e2, 1u, __ATOMIC_RELAXED, __HIP_MEMORY_SCOPE_WORKGROUP); }
        }
    }
    __syncthreads();
    if (F.tid < 8) __hip_atomic_fetch_add(F.ctl + CW_ECNT + F.tid, lcnt[F.tid], RLX_AGENT);
}
__device__ __forceinline__ void moe_prefix(Frame& F, int (&tp)[9]) {
    int acc = 0;
#pragma unroll
    for (int e = 0; e < 8; ++e) { tp[e] = acc; const unsigned c = __hip_atomic_load(F.ctl + CW_ECNT + e, RLX_AGENT); acc += (int)((c + 255u) >> 8); }
    tp[8] = acc;
}
__device__ __forceinline__ void ph13_gather(Frame& F) {
    const int gw = F.vcu * NWAVES + F.wave, NGW = F.G * NWAVES, lane = F.lane;
    int tp[9]; moe_prefix(F, tp);
    const int* tok_e = (const int*)(F.ws + WS_TOKE); int* tok_p = (int*)(F.ws + WS_TOKP);
    const h16* H16 = (const h16*)(F.ws + WS_VT1); h16* HG = (h16*)(F.ws + WS_B);
    for (int base = gw * 16; base < M; base += NGW * 16) {
        const bool own = lane < 16; const int m = base + (lane & 15);
        const int ea = own ? tok_e[2 * m] : -1, eb = own ? tok_e[2 * m + 1] : -1;
        const unsigned long long below = (lane == 0) ? 0ull : (~0ull >> (64 - lane));
        int ra = 0, rb = 0, mycnt = 0;
#pragma unroll
        for (int e = 0; e < 8; ++e) {
            const unsigned long long ma = __ballot(ea == e), mb = __ballot(eb == e);
            const int ca = __popcll(ma), cb = __popcll(mb);
            if (lane == e) mycnt = ca + cb;
            if (ea == e) ra = __popcll(ma & below);
            if (eb == e) rb = ca + __popcll(mb & below);
        }
        unsigned basee = 0u;
        if (lane < 8 && mycnt > 0) basee = __hip_atomic_fetch_add(F.ctl + CW_ECUR + lane, (unsigned)mycnt, RLX_AGENT);
        int tpl = 0;
#pragma unroll
        for (int e = 0; e < 8; ++e) if (lane == e) tpl = tp[e];
        const int segbase = tpl * 256 + (int)basee;
        const int pa = __shfl(segbase, ea & 7) + ra, pb = __shfl(segbase, eb & 7) + rb;
        if (own) { tok_p[2 * m] = pa; tok_p[2 * m + 1] = pb; }
#pragma unroll
        for (int t4 = 0; t4 < 16; t4 += 8) {
            v4u v0[8], v1[8]; int p1[8], p2[8];
#pragma unroll
            for (int i = 0; i < 8; ++i) { const h16* src = H16 + (size_t)(base + t4 + i) * D; v0[i] = *(const v4u*)(src + 8 * lane); v1[i] = *(const v4u*)(src + 512 + 8 * lane);
                p1[i] = __shfl(pa, t4 + i); p2[i] = __shfl(pb, t4 + i); }
#pragma unroll
            for (int i = 0; i < 8; ++i) {
                *(v4u*)(HG + (size_t)p1[i] * D + 8 * lane) = v0[i]; *(v4u*)(HG + (size_t)p1[i] * D + 512 + 8 * lane) = v1[i];
                *(v4u*)(HG + (size_t)p2[i] * D + 8 * lane) = v0[i]; *(v4u*)(HG + (size_t)p2[i] * D + 512 + 8 * lane) = v1[i]; }
        }
    }
}
__device__ __forceinline__ void ph16_final(Frame& F) {
    const int gw = F.vcu * NWAVES + F.wave, NGW = F.G * NWAVES, lane = F.lane;
    const float* mod1 = (const float*)(F.ws + WS_MOD) + (size_t)BATCH * 6 * D;
    const int* tok_p = (const int*)(F.ws + WS_TOKP); const float* tok_g = (const float*)(F.ws + WS_TOKG);
    const h16* YG = (const h16*)(F.ws + WS_B);
    const h16* H16 = (const h16*)(F.ws + WS_VT1);
    struct Row16 { v2u x[4]; v2u a[4], c[4]; float w1, w2; };
    auto load16 = [&](Row16& r, int m) {
        const int p1 = tok_p[2 * m], p2 = tok_p[2 * m + 1]; r.w1 = tok_g[2 * m]; r.w2 = tok_g[2 * m + 1];
#pragma unroll
        for (int j = 0; j < 4; ++j) { const int col = 4 * lane + 256 * j; r.x[j] = *(const v2u*)(H16 + (size_t)m * D + col);
            r.a[j] = *(const v2u*)(YG + (size_t)p1 * D + col); r.c[j] = *(const v2u*)(YG + (size_t)p2 * D + col); } };
    const int WPB = F.G, bq = gw / WPB, r0 = gw % WPB; const size_t bo = (size_t)bq * (6 * D);
    RowVec q; rowvec_load<false>(q, mod1 + bo + 4 * D, mod1 + bo + 3 * D, mod1 + bo + 5 * D, F.in[I_LN2G1], F.in[I_LN2B1], mod1 + bo, mod1 + bo, lane);
    for (int t0 = r0; t0 < SEQ; t0 += 4 * WPB) {
        Row16 rw4[4];
#pragma unroll
        for (int i = 0; i < 4; ++i) { const int t = t0 + i * WPB; if (t < SEQ) load16(rw4[i], bq * SEQ + t); }
#pragma unroll
        for (int i = 0; i < 4; ++i) { const int t = t0 + i * WPB; if (t >= SEQ) continue; const int m = bq * SEQ + t; const Row16& cur = rw4[i];
        f32x4 v[4];
#pragma unroll
        for (int j = 0; j < 4; ++j) {
            const f32x4 ya = {hlo(cur.a[j].x), hhi(cur.a[j].x), hlo(cur.a[j].y), hhi(cur.a[j].y)}, yc = {hlo(cur.c[j].x), hhi(cur.c[j].x), hlo(cur.c[j].y), hhi(cur.c[j].y)};
            const f32x4 x3 = (cvt4(cur.x[j]) - q.psh[j]) * q.rdiv[j];
            v[j] = DN_ALPHA * x3 + q.gate1[j] * (cur.w1 * ya + cur.w2 * yc); }
        ln_rows_v(v, q);
#pragma unroll
        for (int j = 0; j < 4; ++j) *(f32x4*)(F.out + (size_t)m * D + 4 * lane + 256 * j) = v[j];
        }
    }
}

struct Args { const float* in[39]; float* out; unsigned char* ws; int ph_lo, ph_hi; };
__global__ void __launch_bounds__(NWAVES * 64, 2) mk_fwd(Args args) {
    extern __shared__ __attribute__((aligned(16))) unsigned char lds[];
    Frame F;
    F.lds = (LAS unsigned char*)lds;
    F.MISC = (volatile LAS unsigned*)(F.lds + MISC_OFF);
    F.tid = threadIdx.x; F.lane = F.tid & 63; F.wave = __builtin_amdgcn_readfirstlane(F.tid >> 6);
    F.G = gridDim.x; { const int bx = blockIdx.x; F.vcu = (F.G % 8 == 0) ? (bx % 8) * (F.G / 8) + bx / 8 : bx; }
    F.ws = args.ws; F.out = args.out; F.ctl = (gu32*)(args.ws + WS_CTL);
#pragma unroll
    for (int i = 0; i < 39; ++i) F.in[i] = args.in[i];
    for (int u = F.tid; u < (LDS_BYTES - LDSCTL_OFF) / 4; u += NWAVES * 64) ((LAS unsigned*)(F.lds + LDSCTL_OFF))[u] = 0u;
    __syncthreads();
    XcdBarrier bar; bar.bar = (unsigned*)(F.ctl + CW_BAR); bar.x = 0; bar.st = nullptr;
    if (N_LAUNCHES == 1) bar = xcd_barrier_post((unsigned*)(F.ctl + CW_BAR), F.MISC + 8);
    const int lo = args.ph_lo, hi = args.ph_hi;
    unsigned char* ws = args.ws;
    const float* mod0 = (const float*)(ws + WS_MOD); const float* mod1 = mod0 + (size_t)BATCH * 6 * D;
#ifndef PH_MASK
#define PH_MASK 0x1ffff
#endif
#define IN(k) (((PH_MASK >> (k)) & 1) && lo <= (k) && (k) < hi)
#define SEAM(k) do { if (N_LAUNCHES == 1 && IN(k) && IN((k) + 1)) xcd_barrier(bar); } while (0)

    if (IN(0)) { ph0_mods(F); SEAM(0); }
    if (IN(1)) { ph1_prologue(F); SEAM(1); }
    if (IN(2)) {
        pg8::Gemm g{(const h16*)(ws + WS_B), (const h16*)(ws + WS_W_IN), M, 3 * D, D}; pg8::StaticOrder S; S.init(M, 3 * D, F.G, (int)blockIdx.x);
        pg8::EpiQKV E{(h16*)(ws + WS_A), (h16*)(ws + WS_KA), (h16*)(ws + WS_KB1), (h16*)(ws + WS_KB4), (h16*)(ws + WS_KB16), (unsigned*)(F.ctl + CW_KMAX), QSCALE_A, QSCALE_B};
        pg8::gemm_phase<pg8::EpiQKV, pg8::StaticOrder, true, true>(F.lds + RING_OFF, g, S, E);
        SEAM(2);
    }
    if (IN(4)) { ph4_diff_mfma(F); dil_pass<0>(F); dil_pass<1>(F);
        __syncthreads(); ssm_prep(F);
        xcd_barrier(bar); dil_pass<2>(F); SEAM(4); }
    if (IN(5)) {
        pg8::Gemm g{(const h16*)(ws + WS_B), (const h16*)(ws + WS_W_OUT), M, D, D}; pg8::StaticOrder S; S.init(M, D, F.G, (int)blockIdx.x);
        pg8::EpiF16 E{(h16*)(ws + WS_C), D, 4, 0.f, 0.f};
        pg8::gemm_phase<pg8::EpiF16, pg8::StaticOrder, true, true>(F.lds + RING_OFF, g, S, E);
        SEAM(5);
    }
    if (IN(6)) {
        ph_rows<true>(F, F.in[I_X], (const h16*)(ws + WS_B), mod0, mod0, (const h16*)(ws + WS_C), mod0 + 2 * D, F.in[I_LN1G0], F.in[I_LN1B0], mod0 + 4 * D, mod0 + 3 * D, (h16*)(ws + WS_B));
        SEAM(6);
    }
    if (IN(7)) {
        pg8::Gemm g{(const h16*)(ws + WS_B), (const h16*)(ws + WS_W_F1), M, 2 * DFF, D}; pg8::StaticOrder S; S.init(M, 2 * DFF, F.G, (int)blockIdx.x);
        pg8::EpiGated<0> E{(h16*)(ws + WS_A), DFF, 22, nullptr};
        pg8::gemm_phase<pg8::EpiGated<0>, pg8::StaticOrder, true, true>(F.lds + RING_OFF, g, S, E);
        SEAM(7);
    }
    if (IN(8)) {
        pg8::Gemm g{(const h16*)(ws + WS_A), (const h16*)(ws + WS_W_F2), M, D, DFF}; pg8::StaticOrder S; S.init(M, D, F.G, (int)blockIdx.x);
        pg8::EpiF16 E{(h16*)(ws + WS_C), D, 4, 0.f, 0.f};
        pg8::gemm_phase<pg8::EpiF16, pg8::StaticOrder, true, true>(F.lds + RING_OFF, g, S, E);
        SEAM(8);
    }
    if (IN(9)) {
        ph_rows<false>(F, nullptr, (const h16*)(ws + WS_B), mod0 + 4 * D, mod0 + 3 * D, (const h16*)(ws + WS_C), mod0 + 5 * D, F.in[I_LN2G0], F.in[I_LN2B0], mod1 + 1 * D, mod1 + 0 * D, (h16*)(ws + WS_B));
        SEAM(9);
    }
    if (IN(10)) { ph10_ssm_mfma(F); SEAM(10); }
    if (IN(11)) {
        pg8::Gemm g{(const h16*)(ws + WS_C), (const h16*)(ws + WS_W_GLU), M, 2 * D, D}; pg8::StaticOrder S; S.init(M, 2 * D, F.G, (int)blockIdx.x);
        pg8::EpiGated<1> E{(h16*)(ws + WS_A), D, 8, F.in[I_BGLU]};
        pg8::gemm_phase<pg8::EpiGated<1>, pg8::StaticOrder, true, true>(F.lds + RING_OFF, g, S, E);
        SEAM(11);
    }
    if (IN(12)) { ph12_rows_route(F); SEAM(12); }
    if (IN(13)) { ph13_gather(F); SEAM(13); }
    if (IN(14)) {
        pg8::MoeOrder S; moe_prefix(F, S.tp); S.nN = 11; S.G = F.G; S.c = (int)blockIdx.x;
        pg8::Gemm g{(const h16*)(ws + WS_B), (const h16*)(ws + WS_W_E1), 0, 2 * DFE, D};
        pg8::EpiGated<0> E{(h16*)(ws + WS_A), DFE, 11, nullptr};
        pg8::gemm_phase<pg8::EpiGated<0>, pg8::MoeOrder, true, true>(F.lds + RING_OFF, g, S, E);
        SEAM(14);
    }
    if (IN(15)) {
        pg8::MoeOrder S; moe_prefix(F, S.tp); S.nN = 4; S.G = F.G; S.c = (int)blockIdx.x;
        pg8::Gemm g{(const h16*)(ws + WS_A), (const h16*)(ws + WS_W_E2), 0, D, DFE};
        pg8::EpiF16 E{(h16*)(ws + WS_B), D, 4, 0.f, 0.f};
        pg8::gemm_phase<pg8::EpiF16, pg8::MoeOrder, true, true>(F.lds + RING_OFF, g, S, E);
        SEAM(15);
    }
    if (IN(16)) { ph16_final(F); }
#undef IN
#undef SEAM
}

extern "C" void kernel_launch(void* const* d_in, const int* in_sizes, int n_in, void* d_out, int out_size, void* d_ws, size_t ws_size, hipStream_t stream) {
    static int grid = 0;
    if (grid == 0) {
        if (n_in != 39 || in_sizes[0] != M * D || out_size != M * D || ws_size < WS_END) { fprintf(stderr, "kernel_launch: unexpected problem shape (n_in %d, in0 %d, out %d, ws %zu)\n", n_in, n_in > 0 ? in_sizes[0] : -1, out_size, ws_size); grid = -1; return; }
        int dev = 0, cus = 0, per_cu = 0;
        if (hipGetDevice(&dev) != hipSuccess || hipDeviceGetAttribute(&cus, hipDeviceAttributeMultiprocessorCount, dev) != hipSuccess) { grid = -1; return; }
        if (hipFuncSetAttribute((const void*)mk_fwd, hipFuncAttributeMaxDynamicSharedMemorySize, LDS_BYTES) != hipSuccess) { fprintf(stderr, "kernel_launch: hipFuncSetAttribute failed\n"); grid = -1; return; }
        if (hipOccupancyMaxActiveBlocksPerMultiprocessor(&per_cu, (const void*)mk_fwd, NWAVES * 64, LDS_BYTES) != hipSuccess || per_cu < 1) { fprintf(stderr, "kernel_launch: occupancy query says %d\n", per_cu); }
        (void)hipGetLastError();
        grid = cus;
    }
    if (grid < 0) return;
    if (hipMemsetAsync((char*)d_ws + WS_CTL, 0, CTL_ZERO_BYTES, stream) != hipSuccess) return;
    Args a{};
    for (int i = 0; i < 39; ++i) a.in[i] = (const float*)d_in[i];
    a.out = (float*)d_out; a.ws = (unsigned char*)d_ws;
    for (int li = 0; li < N_LAUNCHES; ++li) {
        a.ph_lo = (N_LAUNCHES == 1) ? 0 : li; a.ph_hi = (N_LAUNCHES == 1) ? NPH : li + 1;
        hipLaunchKernelGGL(mk_fwd, dim3(grid), dim3(NWAVES * 64), LDS_BYTES, stream, a);
        if (hipPeekAtLastError() != hipSuccess) { fprintf(stderr, "kernel_launch: launch %d failed\n", li); break; }
    }
}
```

```cpp
#include <hip/hip_runtime.h>
#include <cstdio>
#include <cstdint>

#ifndef MK_N_LAUNCHES
#define MK_N_LAUNCHES 1
#endif

namespace pg8 {
#define PG8_LAS __attribute__((address_space(3)))
typedef unsigned short h16_t;
typedef _Float16 f16x8 __attribute__((ext_vector_type(8)));
typedef _Float16 f16x2 __attribute__((ext_vector_type(2)));
typedef float f32x4 __attribute__((ext_vector_type(4)));
typedef unsigned u32x4 __attribute__((ext_vector_type(4)));
constexpr int BM = 256, BK = 64, HALF = 128, HTB = HALF * BK * 2  , STAGE_BYTES = 8 * HTB, NXCD = 8, WGM = 8;

__host__ __device__ __forceinline__ int lds_byte(int r, int c) { const int st = (r >> 4) * 2 + (c >> 5), rr = r & 15, cc = c & 31, ob = rr * 64 + cc * 2; return st * 1024 + (ob ^ (((ob >> 9) & 1) << 5)); }
__host__ __device__ __forceinline__ void stage_rc(int b, int& R, int& C) { const int st = b / 1024, sb = b % 1024, swz = sb ^ (((sb >> 9) & 1) << 5); R = (st >> 1) * 16 + swz / 64; C = (st & 1) * 32 + (swz % 64) / 2; }
__host__ __device__ __forceinline__ int perm32(int rho) { const int n = rho >> 4, i = rho & 15; return 8 * (i >> 2) + 4 * n + (i & 3); }

struct Unit { int pm, pn; };
struct Gemm { const h16_t* A; const h16_t* Bt; int M, N, K; };

struct StaticOrder {
    int nM, nN, nwg, G, c;
    __host__ __device__ void init(int M, int N, int G_, int c_) { nM = M / BM; nN = N / BM; nwg = nM * nN; G = G_; c = c_; }
    __host__ __device__ bool next(int i, Unit& u) const {
        const long L = (long)i * G + c; if (L >= nwg) return false;
        int wgid = (int)L; { const int q = nwg / NXCD, r = nwg % NXCD, xcd = wgid % NXCD, off = wgid / NXCD; wgid = (xcd < r ? xcd * (q + 1) : r * (q + 1) + (xcd - r) * q) + off; }
        const int nig = WGM * nN, gid = wgid / nig, fm = gid * WGM, gsz = (nM - fm) < WGM ? (nM - fm) : WGM;
        u.pm = fm + ((wgid % nig) % gsz); u.pn = (wgid % nig) / gsz; return true;
    }
    __device__ __forceinline__ void a_ready(const Unit&) const {}
    __device__ __forceinline__ void done(const Unit&) const {}
};
struct MoeOrder {
    int tp[9]; int nN, G, c;
    __device__ bool next(int i, Unit& u) const {
        const long L = (long)i * G + c; const int nM = tp[8], nwg = nM * nN; if (L >= nwg) return false;
        int wgid = (int)L; { const int q = nwg / NXCD, r = nwg % NXCD, xcd = wgid % NXCD, off = wgid / NXCD; wgid = (xcd < r ? xcd * (q + 1) : r * (q + 1) + (xcd - r) * q) + off; }
        const int nig = WGM * nN, gid = wgid / nig, fm = gid * WGM, gsz = (nM - fm) < WGM ? (nM - fm) : WGM;
        const int rt = fm + ((wgid % nig) % gsz), cn = (wgid % nig) / gsz; int e = 0;
#pragma unroll
        for (int k = 1; k < 8; ++k) e += (rt >= tp[k]) ? 1 : 0;
        u.pm = rt; u.pn = e * nN + cn; return true;
    }
    __device__ __forceinline__ void a_ready(const Unit&) const {}
    __device__ __forceinline__ void done(const Unit&) const {}
};

__device__ __forceinline__ unsigned pk2h(float lo, float hi) { f16x2 v = {(_Float16)lo, (_Float16)hi}; return __builtin_bit_cast(unsigned, v); }
__device__ __forceinline__ float fast_sigmoid(float v) { return __builtin_amdgcn_rcpf(1.0f + __builtin_amdgcn_exp2f(-1.4426950408889634f * v)); }

struct EpiF16 {
    static constexpr bool PERM = true, AFTER_DRAIN = false;
    h16_t* O; int ldc; int nmod; float sA; float sB;
    __device__ __forceinline__ void operator()(const f32x4 (&acc)[2][2][4][2], const Unit& u, int wr, int wc, int fr, int fq) const {
        const int row0 = u.pm * BM + wr * 64 + fr; const int pn = u.pn % nmod;
        float sc = 1.f; if (sA != 0.f) { if (pn < 2) sc = sA; else if (pn == 6 || pn == 7) sc = sB; }
        const int col0 = pn * BM + wc * 32 + 8 * fq;
#pragma unroll
        for (int ai = 0; ai < 2; ++ai)
#pragma unroll
            for (int m = 0; m < 4; ++m) { h16_t* rowp = O + (size_t)(row0 + ai * HALF + m * 16) * ldc + col0;
#pragma unroll
                for (int bj = 0; bj < 2; ++bj) { const f32x4 v0 = acc[ai][bj][m][0] * sc, v1 = acc[ai][bj][m][1] * sc;
                    u32x4 w; w.x = pk2h(v0[0], v0[1]); w.y = pk2h(v0[2], v0[3]); w.z = pk2h(v1[0], v1[1]); w.w = pk2h(v1[2], v1[3]);
                    *(u32x4*)(rowp + bj * HALF) = w; } }
    }
};

struct EpiQKV {
    static constexpr bool PERM = true, AFTER_DRAIN = false;
    h16_t* O; h16_t* KA; h16_t* KB1; h16_t* KB4; h16_t* KB16; unsigned* kmax; float sA, sB;
    __device__ __forceinline__ static int pi32(int r) { return (r & 0x13) | ((r & 4) << 1) | ((r & 8) >> 1); }
    __device__ __forceinline__ void operator()(const f32x4 (&acc)[2][2][4][2], const Unit& u, int wr, int wc, int fr, int fq) const {
        const int row0 = u.pm * BM + wr * 64 + fr, pn = u.pn;
        const bool isKA = (pn == 2 || pn == 3), isKB = (pn == 8 || pn == 9);
        if (!isKA && !isKB) {
            const float sc = (pn < 2) ? sA : (pn == 6 || pn == 7) ? sB : 1.0f;
            const int col0 = pn * BM + wc * 32 + 8 * fq;
#pragma unroll
            for (int ai = 0; ai < 2; ++ai)
#pragma unroll
                for (int m = 0; m < 4; ++m) { h16_t* rowp = O + (size_t)(row0 + ai * HALF + m * 16) * 3072 + col0;
#pragma unroll
                    for (int bj = 0; bj < 2; ++bj) { const f32x4 v0 = acc[ai][bj][m][0] * sc, v1 = acc[ai][bj][m][1] * sc;
                        u32x4 w; w.x = pk2h(v0[0], v0[1]); w.y = pk2h(v0[2], v0[3]); w.z = pk2h(v1[0], v1[1]); w.w = pk2h(v1[2], v1[3]);
                        *(u32x4*)(rowp + bj * HALF) = w; } }
            return;
        }
        const int b = u.pm >> 4;
        float mx[2] = {0.f, 0.f};
#pragma unroll
        for (int ai = 0; ai < 2; ++ai)
#pragma unroll
            for (int m = 0; m < 4; ++m) { const int t = (row0 + ai * HALF + m * 16) & 4095;
#pragma unroll
                for (int bj = 0; bj < 2; ++bj) { const f32x4 v0 = acc[ai][bj][m][0], v1 = acc[ai][bj][m][1];
                    u32x4 w; w.x = pk2h(v0[0], v0[1]); w.y = pk2h(v0[2], v0[3]); w.z = pk2h(v1[0], v1[1]); w.w = pk2h(v1[2], v1[3]);
                    const int cs = (pn & 1) * 256 + bj * HALF + wc * 32 + 8 * fq, h = cs >> 6, c8 = (cs & 63) >> 3, bh = b * 8 + h;
                    if (isKA) {
                        const int frag = (c8 >> 2) * 2 + ((c8 >> 1) & 1), hi = c8 & 1;
                        *(u32x4*)(KA + ((size_t)((bh * 128 + (t >> 5)) * 4 + frag) * 64 + hi * 32 + pi32(t & 31)) * 8) = w;
                        float q2 = (v0[0] * v0[0] + v0[1] * v0[1]) + (v0[2] * v0[2] + v0[3] * v0[3]) + (v1[0] * v1[0] + v1[1] * v1[1]) + (v1[2] * v1[2] + v1[3] * v1[3]);
                        q2 += __shfl_xor(q2, 16); q2 += __shfl_xor(q2, 32);
                        mx[bj] = fmaxf(mx[bj], q2);
                    } else {
                        const int sl = c8 >> 1, hi = c8 & 1;
                        { const int uu = t >> 5, r = t & 31; *(u32x4*)(KB1 + ((size_t)((bh * 128 + uu) * 4 + sl) * 64 + hi * 32 + pi32(r)) * 8) = w; }
                        { const int i = t >> 2, uu = (t & 3) * 32 + (i >> 5), r = i & 31; *(u32x4*)(KB4 + ((size_t)((bh * 128 + uu) * 4 + sl) * 64 + hi * 32 + pi32(r)) * 8) = w; }
                        { const int i = t >> 4, uu = (t & 15) * 8 + (i >> 5), r = i & 31; *(u32x4*)(KB16 + ((size_t)((bh * 128 + uu) * 4 + sl) * 64 + hi * 32 + pi32(r)) * 8) = w; }
                    } } }
        if (isKA) {
#pragma unroll
            for (int bj = 0; bj < 2; ++bj) { float v = mx[bj];
                v = fmaxf(v, __shfl_xor(v, 1)); v = fmaxf(v, __shfl_xor(v, 2)); v = fmaxf(v, __shfl_xor(v, 4)); v = fmaxf(v, __shfl_xor(v, 8));
                const int cs = (pn & 1) * 256 + bj * HALF + wc * 32;
                if ((threadIdx.x & 63) == 0) __hip_atomic_fetch_max(kmax + (b * 8 + (cs >> 6)) * 2 + ((cs >> 5) & 1), __float_as_uint(v * 1.002f), __ATOMIC_RELAXED, __HIP_MEMORY_SCOPE_AGENT); }
        }
    }
};

template <int MODE> struct EpiGated {
    static constexpr bool PERM = true, AFTER_DRAIN = false;
    h16_t* O; int ldc; int nmod; const float* bias;
    __device__ __forceinline__ void operator()(const f32x4 (&acc)[2][2][4][2], const Unit& u, int wr, int wc, int fr, int fq) const {
        const int row0 = u.pm * BM + wr * 64 + fr; const int pn = u.pn % nmod;
        const int col0 = pn * HALF + wc * 32 + 8 * fq;
        f32x4 ba[2], bb[2];
#pragma unroll
        for (int n = 0; n < 2; ++n) { if (MODE == 1) { ba[n] = *(const f32x4*)(bias + col0 + 4 * n); bb[n] = *(const f32x4*)(bias + 1024 + col0 + 4 * n); } else { ba[n] = (f32x4){0.f, 0.f, 0.f, 0.f}; bb[n] = ba[n]; } }
#pragma unroll
        for (int ai = 0; ai < 2; ++ai)
#pragma unroll
            for (int m = 0; m < 4; ++m) { h16_t* rowp = O + (size_t)(row0 + ai * HALF + m * 16) * ldc + col0;
                float r[8];
#pragma unroll
                for (int n = 0; n < 2; ++n)
#pragma unroll
                    for (int e = 0; e < 4; ++e) { const float a = acc[ai][0][m][n][e] + ba[n][e], b = acc[ai][1][m][n][e] + bb[n][e];
                        r[4 * n + e] = (MODE == 0) ? (a * fast_sigmoid(a)) * b : a * fast_sigmoid(b); }
                u32x4 w; w.x = pk2h(r[0], r[1]); w.y = pk2h(r[2], r[3]); w.z = pk2h(r[4], r[5]); w.w = pk2h(r[6], r[7]);
                *(u32x4*)rowp = w; }
    }
};

template <class Epi, class Sched, bool ALIGN_EPI = false, bool SP2 = false>
__device__ __forceinline__ void gemm_phase(PG8_LAS unsigned char* lds, const Gemm g, const Sched& S, const Epi& E) {
    const int tid = threadIdx.x, wid = __builtin_amdgcn_readfirstlane(tid >> 6), lane = tid & 63, wr = wid >> 2, wc = wid & 3, fr = lane & 15, fq = lane >> 4;
    const int K = g.K, nt = K / BK;
    unsigned voffA[2], voffB[2];
#pragma unroll
    for (int i = 0; i < 2; ++i) { int R, C; stage_rc(tid * 16 + i * 8192, R, C); const int Rb = Epi::PERM ? ((R & ~31) + perm32(R & 31)) : R;
        voffA[i] = (unsigned)(R * K + C) * 2u; voffB[i] = (unsigned)(Rb * K + C) * 2u; }
    const size_t kstep = (size_t)(BK * 2);
    const size_t hstep = (size_t)HALF * K * 2;
    const size_t tstep = 2 * hstep;
    const unsigned ldsw = (unsigned)wid * 1024u;
    const int aoff = lds_byte(wr * 64 + fr, fq * 8), boff = lds_byte(wc * 32 + fr, fq * 8);
#define PG8_SA(b, h) (((b) * 2 + (h)) * HTB)
#define PG8_SB(b, h) ((4 + (b) * 2 + (h)) * HTB)
#define PG8_STAGE(bufoff, gbase, voff) do { _Pragma("unroll") for (int _i = 0; _i < 2; ++_i) \
        __builtin_amdgcn_global_load_lds((const unsigned*)((const char*)(gbase) + (voff)[_i]), (PG8_LAS unsigned*)(lds + (bufoff) + ldsw + _i * 8192), 16, 0, 0); } while (0)
#define PG8_LDA(dst, b, h) do { _Pragma("unroll") for (int m = 0; m < 4; ++m) _Pragma("unroll") for (int k = 0; k < 2; ++k) dst[m][k] = *(const PG8_LAS f16x8*)(lds + PG8_SA(b, h) + aoff + m * 2048 + k * 1024); } while (0)
#define PG8_LDB(dst, b, h) do { _Pragma("unroll") for (int n = 0; n < 2; ++n) _Pragma("unroll") for (int k = 0; k < 2; ++k) dst[n][k] = *(const PG8_LAS f16x8*)(lds + PG8_SB(b, h) + boff + n * 2048 + k * 1024); } while (0)
#define PG8_MMA(ai, bj, At, Bt) do { __builtin_amdgcn_s_setprio(1); _Pragma("unroll") for (int m = 0; m < 4; ++m) _Pragma("unroll") for (int n = 0; n < 2; ++n) _Pragma("unroll") for (int k = 0; k < 2; ++k) \
        acc[ai][bj][m][n] = __builtin_amdgcn_mfma_f32_16x16x32_f16(Bt[n][k], At[m][k], acc[ai][bj][m][n], 0, 0, 0); __builtin_amdgcn_s_setprio(0); } while (0)
#define PG8_WAIT_V(n) asm volatile("s_waitcnt vmcnt(" #n ")" ::: "memory")
#define PG8_WAIT_L(n) asm volatile("s_waitcnt lgkmcnt(" #n ")" ::: "memory")
#define PG8_BAR __builtin_amdgcn_s_barrier()
#define PG8_SCHED __builtin_amdgcn_sched_barrier(0)
    Unit cur, nxt; int ui = 0;
    if (!S.next(0, cur)) return;
    f32x4 acc[2][2][4][2];
#pragma unroll
    for (int a = 0; a < 2; ++a)
#pragma unroll
        for (int b = 0; b < 2; ++b)
#pragma unroll
            for (int m = 0; m < 4; ++m)
#pragma unroll
                for (int n = 0; n < 2; ++n) acc[a][b][m][n] = (f32x4){0.f, 0.f, 0.f, 0.f};
    f16x8 At[4][2], B0[2][2], B1[2][2];
    const char* cA = (const char*)g.A + (size_t)cur.pm * tstep; const char* cB = (const char*)g.Bt + (size_t)cur.pn * tstep;
    S.a_ready(cur);
    if constexpr (SP2) {
        PG8_STAGE(PG8_SB(0, 0), cB, voffB); PG8_STAGE(PG8_SB(0, 1), cB + hstep, voffB); PG8_STAGE(PG8_SA(0, 0), cA, voffA); PG8_STAGE(PG8_SA(0, 1), cA + hstep, voffA);
        if (wr == 1) PG8_BAR;
        PG8_WAIT_V(2); PG8_BAR;
        PG8_STAGE(PG8_SB(1, 0), cB + kstep, voffB); PG8_STAGE(PG8_SA(1, 0), cA + kstep, voffA); PG8_STAGE(PG8_SB(1, 1), cB + hstep + kstep, voffB);
        PG8_WAIT_V(6); PG8_BAR;
    } else {
        PG8_STAGE(PG8_SB(0, 0), cB, voffB); PG8_STAGE(PG8_SA(0, 0), cA, voffA); PG8_STAGE(PG8_SB(0, 1), cB + hstep, voffB); PG8_STAGE(PG8_SA(0, 1), cA + hstep, voffA);
        if (wr == 1) PG8_BAR;
        PG8_WAIT_V(4); PG8_BAR;
        PG8_STAGE(PG8_SB(1, 0), cB + kstep, voffB); PG8_STAGE(PG8_SA(1, 0), cA + kstep, voffA); PG8_STAGE(PG8_SB(1, 1), cB + hstep + kstep, voffB);
        PG8_WAIT_V(6); PG8_BAR;
    }
    for (;;) {
        const bool has_next = S.next(ui + 1, nxt);
        const char* nA = has_next ? (const char*)g.A + (size_t)nxt.pm * tstep : cA; const char* nB = has_next ? (const char*)g.Bt + (size_t)nxt.pn * tstep : cB;
        for (int t = 0; t < nt; t += 2) {
            const bool last = (t == nt - 2);
            const char* a1 = cA + (size_t)(t + 1) * kstep;
            const char* a2 = last ? nA : cA + (size_t)(t + 2) * kstep; const char* b2 = last ? nB : cB + (size_t)(t + 2) * kstep;
            const char* a3 = a2 + kstep; const char* b3 = b2 + kstep;
            if (last && has_next) S.a_ready(nxt);
            if constexpr (SP2) {
            PG8_LDB(B0, 0, 0); PG8_LDB(B1, 0, 1); PG8_SCHED; PG8_LDA(At, 0, 0); PG8_STAGE(PG8_SA(1, 1), a1 + hstep, voffA);
            PG8_WAIT_V(8); PG8_WAIT_L(0); PG8_BAR; PG8_MMA(0, 0, At, B0); PG8_MMA(0, 1, At, B1); PG8_BAR; PG8_SCHED;
            PG8_LDA(At, 0, 1); PG8_STAGE(PG8_SB(0, 0), b2, voffB); PG8_STAGE(PG8_SB(0, 1), b2 + hstep, voffB); PG8_STAGE(PG8_SA(0, 0), a2, voffA);
            PG8_WAIT_V(8); PG8_WAIT_L(0); PG8_BAR; PG8_MMA(1, 0, At, B0); PG8_MMA(1, 1, At, B1); PG8_BAR; PG8_SCHED;
            PG8_LDB(B0, 1, 0); PG8_LDB(B1, 1, 1); PG8_SCHED; PG8_LDA(At, 1, 0); PG8_STAGE(PG8_SA(0, 1), a2 + hstep, voffA);
            PG8_WAIT_V(8); PG8_WAIT_L(0); PG8_BAR; PG8_MMA(0, 0, At, B0); PG8_MMA(0, 1, At, B1); PG8_BAR; PG8_SCHED;
            PG8_LDA(At, 1, 1); PG8_STAGE(PG8_SB(1, 0), b3, voffB); PG8_STAGE(PG8_SB(1, 1), b3 + hstep, voffB); PG8_STAGE(PG8_SA(1, 0), a3, voffA);
            PG8_WAIT_V(8); PG8_WAIT_L(0); PG8_BAR; PG8_MMA(1, 0, At, B0); PG8_MMA(1, 1, At, B1); PG8_BAR; PG8_SCHED;
            } else {
            PG8_LDB(B0, 0, 0); PG8_SCHED; PG8_LDA(At, 0, 0); PG8_STAGE(PG8_SA(1, 1), a1 + hstep, voffA);
            PG8_WAIT_L(8); PG8_BAR; PG8_WAIT_L(0); PG8_MMA(0, 0, At, B0); PG8_BAR; PG8_SCHED;
            PG8_LDB(B1, 0, 1); PG8_STAGE(PG8_SB(0, 0), b2, voffB);
            PG8_BAR; PG8_WAIT_L(0); PG8_MMA(0, 1, At, B1); PG8_BAR;
            PG8_LDA(At, 0, 1); PG8_STAGE(PG8_SA(0, 0), a2, voffA);
            PG8_BAR; PG8_WAIT_L(0); PG8_MMA(1, 0, At, B0); PG8_BAR; PG8_SCHED;
            PG8_STAGE(PG8_SB(0, 1), b2 + hstep, voffB);
            PG8_WAIT_V(6); PG8_BAR; PG8_MMA(1, 1, At, B1); PG8_BAR;
            PG8_LDB(B0, 1, 0); PG8_SCHED; PG8_LDA(At, 1, 0); PG8_STAGE(PG8_SA(0, 1), a2 + hstep, voffA);
            PG8_WAIT_L(8); PG8_BAR; PG8_WAIT_L(0); PG8_MMA(0, 0, At, B0); PG8_BAR; PG8_SCHED;
            PG8_LDB(B1, 1, 1); PG8_STAGE(PG8_SB(1, 0), b3, voffB);
            PG8_BAR; PG8_WAIT_L(0); PG8_MMA(0, 1, At, B1); PG8_BAR;
            PG8_LDA(At, 1, 1); PG8_STAGE(PG8_SA(1, 0), a3, voffA);
            PG8_BAR; PG8_WAIT_L(0); PG8_MMA(1, 0, At, B0); PG8_BAR; PG8_SCHED;
            PG8_STAGE(PG8_SB(1, 1), b3 + hstep, voffB);
            PG8_WAIT_V(6); PG8_BAR; PG8_MMA(1, 1, At, B1); PG8_BAR;
            }
        }
        if constexpr (ALIGN_EPI) { if (wr == 0) PG8_BAR; }
        if constexpr (!Epi::AFTER_DRAIN) { E(acc, cur, wr, wc, fr, fq); S.done(cur); }
        if (!has_next) break;
#pragma unroll
        for (int a = 0; a < 2; ++a)
#pragma unroll
            for (int b = 0; b < 2; ++b)
#pragma unroll
                for (int m = 0; m < 4; ++m)
#pragma unroll
                    for (int n = 0; n < 2; ++n) acc[a][b][m][n] = (f32x4){0.f, 0.f, 0.f, 0.f};
        cur = nxt; cA = nA; cB = nB; ++ui;
        if constexpr (ALIGN_EPI) { if (wr == 1) PG8_BAR; }
    }
    PG8_WAIT_V(0);
    if constexpr (!ALIGN_EPI) { if (wr == 0) PG8_BAR; }
    PG8_BAR;
    if constexpr (Epi::AFTER_DRAIN) { E.fused(acc, cur, wr, wc, fr, fq, lds, wid, lane); S.done(cur); }
#undef PG8_SA
#undef PG8_SB
#undef PG8_STAGE
#undef PG8_LDA
#undef PG8_LDB
#undef PG8_MMA
#undef PG8_WAIT_V
#undef PG8_WAIT_L
#undef PG8_BAR
#undef PG8_SCHED
}
}

constexpr int NWAVES = 8;
constexpr int BATCH = 8, SEQ = 4096, D = 1024, M = BATCH * SEQ;
constexpr int DFF = 2816, NEXP = 8, DFE = 1408;
constexpr int NPH = 17;
constexpr int N_LAUNCHES = MK_N_LAUNCHES;
static_assert(N_LAUNCHES == 1, "one launch only (PH4 has an inner grid barrier)");
constexpr float LN_EPS = 1e-5f, LOG2E = 1.4426950408889634f, DN_ALPHA = 1.4142135623730951f;
constexpr float QSCALE_A = 0.17677669529663687f * LOG2E;
constexpr float QSCALE_B = 0.125f * LOG2E;

constexpr size_t MiB = 1u << 20;
constexpr size_t WS_CTL = 0, CTL_ZERO_BYTES = 1 * MiB;
constexpr size_t WS_MOD = 1 * MiB;
constexpr size_t WS_SSMA = 1 * MiB + 512 * 1024;
constexpr size_t WS_SSMB = WS_SSMA + 64 * 1024;
constexpr size_t WS_TOKE = 2 * MiB + 512 * 1024;
constexpr size_t WS_TOKG = WS_TOKE + 256 * 1024;
constexpr size_t WS_TOKP = WS_TOKG + 256 * 1024;
constexpr size_t WS_W_IN = 4 * MiB, WS_W_OUT = 10 * MiB, WS_W_F1 = 12 * MiB, WS_W_F2 = 23 * MiB, WS_W_GLU = 28 * MiB + 512 * 1024;
constexpr size_t WS_W_E1 = 32 * MiB + 512 * 1024, WS_W_E2 = 76 * MiB + 512 * 1024;
constexpr size_t WS_A = 100 * MiB, WS_B = 292 * MiB, WS_C = 356 * MiB, WS_VT1 = 424 * MiB, WS_END = 488 * MiB;
constexpr size_t WS_UG = 228 * MiB;
constexpr size_t WS_SSMM = 196 * MiB;
constexpr size_t WS_KA = 356 * MiB, WS_KB1 = 388 * MiB, WS_KB4 = 420 * MiB, WS_KB16 = 452 * MiB;
constexpr int MOE_MAX_TILES = 264;
static_assert(WS_W_E2 + (size_t)NEXP * D * DFE * 2 <= WS_A, "weights fit");
static_assert((size_t)MOE_MAX_TILES * 256 * DFE * 2 <= WS_B - WS_A, "hidden_g fits region A");
static_assert(WS_B + (size_t)MOE_MAX_TILES * 256 * D * 2 <= WS_VT1, "gathered rows fit");
constexpr int CW_TMO = 0, CW_CODE = 1;
constexpr int CW_ECNT = 64;
constexpr int CW_ECUR = 128;
constexpr int CW_UQ = 1024;
constexpr int CW_TQ = 192;
constexpr int CW_PREP = 512;
constexpr int CW_KMAX = 256;
constexpr int CW_BAR = 4096;

constexpr int RING_OFF = 0, RING_BYTES = 131072;
constexpr int LDSCTL_OFF = RING_BYTES + 1024, MISC_OFF = LDSCTL_OFF + 320;
constexpr int LDS_BYTES = 147456;

#define GAS __attribute__((address_space(1)))
#define LAS __attribute__((address_space(3)))
typedef unsigned short h16;
typedef unsigned v4u __attribute__((ext_vector_type(4)));
typedef unsigned v2u __attribute__((ext_vector_type(2)));
typedef float f32x4 __attribute__((ext_vector_type(4)));
typedef GAS unsigned gu32;
#define RLX_AGENT __ATOMIC_RELAXED, __HIP_MEMORY_SCOPE_AGENT
#define LDS_WAIT() asm volatile("s_waitcnt lgkmcnt(0)" ::: "memory")
#define VM_WAIT() asm volatile("s_waitcnt vmcnt(0)" ::: "memory")
using pg8::pk2h;
__device__ __forceinline__ float h2f(unsigned short v) { return (float)__builtin_bit_cast(_Float16, v); }
__device__ __forceinline__ float hlo(unsigned w) { return h2f((unsigned short)(w & 0xffffu)); }
__device__ __forceinline__ float hhi(unsigned w) { return h2f((unsigned short)(w >> 16)); }
#define DPPF_(x, ctrl, rm) __builtin_bit_cast(float, __builtin_amdgcn_update_dpp(0, __builtin_bit_cast(int, (x)), (ctrl), (rm), 0xf, false))
__device__ __forceinline__ float wave_sum(float v) {
    v += DPPF_(v, 0xb1, 0xf);
    v += DPPF_(v, 0x4e, 0xf);
    v += DPPF_(v, 0x124, 0xf);
    v += DPPF_(v, 0x128, 0xf);
    v += DPPF_(v, 0x142, 0xa);
    v += DPPF_(v, 0x143, 0xc);
    return __builtin_bit_cast(float, __builtin_amdgcn_readlane(__builtin_bit_cast(int, v), 63));
}
__device__ __forceinline__ float wave_max(float v) {
#pragma unroll
    for (int o = 1; o < 64; o <<= 1) v = fmaxf(v, __shfl_xor(v, o));
    return v;
}
__device__ __forceinline__ float ex2(float v) { return __builtin_amdgcn_exp2f(v); }
__device__ __forceinline__ float gelu_tanh(float v) {
    const float z = 0.7978845608028654f * (v + 0.044715f * v * v * v);
    const float e = ex2(2.0f * LOG2E * z);
    const float th = 1.0f - 2.0f * __builtin_amdgcn_rcpf(1.0f + e);
    return 0.5f * v * (1.0f + th);
}

#define XB_TMO      128
#define XB_XCNT(j)  (256  + 64 * (j))
#define XB_XSUB(j)  (1280 + 64 * (j))
#define XB_XGEN(j)  (2304 + 64 * (j))
#define XB_TOP      3328
#define XB_TOPGEN   3392
#define XCD_BAR_WORDS 3456
#define XB_SPIN_CAP (1u << 18)

__device__ __forceinline__ unsigned xb_ld(unsigned* p)              { return __hip_atomic_load(p, __ATOMIC_RELAXED, __HIP_MEMORY_SCOPE_AGENT); }
__device__ __forceinline__ unsigned xb_add(unsigned* p, unsigned v) { return __hip_atomic_fetch_add(p, v, __ATOMIC_RELAXED, __HIP_MEMORY_SCOPE_AGENT); }
__device__ __forceinline__ unsigned xb_xcc_id() { return (unsigned)__builtin_amdgcn_s_getreg((3 << 11) | 20) & 0xFu; }
#define XB_SPIN(cond, bar) do { unsigned _sp = 0; while (cond) { __builtin_amdgcn_s_sleep(1); \
    if ((++_sp & 255u) == 0u) { if (xb_ld(&(bar)[XB_TMO])) break; if (_sp > XB_SPIN_CAP) { atomicAdd(&(bar)[XB_TMO], 1u); break; } } } } while (0)

struct XcdBarrier {
    unsigned* bar; unsigned x;
    volatile LAS unsigned* st;
};

__device__ __forceinline__ XcdBarrier xcd_barrier_post(unsigned* bar, volatile LAS unsigned* st) {
    XcdBarrier b; b.bar = bar; b.x = xb_xcc_id(); b.st = st;
    if (threadIdx.x == 0) (void)xb_add(&bar[XB_XCNT(b.x)], 1u);
    return b;
}
__device__ __forceinline__ void xcd_barrier_complete(unsigned* bar, unsigned x, unsigned& nloc, unsigned& nx) {
    const unsigned G = gridDim.x * gridDim.y * gridDim.z;
    unsigned sum, cnt, mine, sp = 0u;
    for (;;) {
        sum = 0u; cnt = 0u; mine = 0u;
#pragma unroll
        for (unsigned j = 0; j < 16; ++j) { const unsigned c = xb_ld(&bar[XB_XCNT(j)]); sum += c; cnt += (c > 0u) ? 1u : 0u; mine = (j == x) ? c : mine; }
        if (sum == G) break;
        __builtin_amdgcn_s_sleep(1);
        if ((++sp & 255u) == 0u) { if (xb_ld(&bar[XB_TMO])) break; if (sp > XB_SPIN_CAP) { atomicAdd(&bar[XB_TMO], 1u); break; } }
    }
    nloc = mine > 0u ? mine : 1u; nx = cnt > 0u ? cnt : 1u;
}

__device__ __forceinline__ void xcd_barrier(const XcdBarrier& b) {
    asm volatile("s_waitcnt vmcnt(0)" ::: "memory");
    __syncthreads();
    if (threadIdx.x == 0) {
        unsigned* bar = b.bar;
        __builtin_amdgcn_s_waitcnt(0);
        unsigned nloc = b.st[0], nx = b.st[1];
        if (nloc == 0u) { xcd_barrier_complete(bar, b.x, nloc, nx); b.st[0] = nloc; b.st[1] = nx; }
        const unsigned old = xb_add(&bar[XB_XSUB(b.x)], 1u);
        const unsigned gen = old / nloc;
        if (old + 1u == (gen + 1u) * nloc) {
            __builtin_amdgcn_fence(__ATOMIC_RELEASE, "agent");
            asm volatile("s_waitcnt vmcnt(0)" ::: "memory");
            const unsigned og = xb_add(&bar[XB_TOP], 1u);
            const unsigned tg = og / nx;
            if (og + 1u == (tg + 1u) * nx) xb_add(&bar[XB_TOPGEN], 1u);
            else XB_SPIN(xb_ld(&bar[XB_TOPGEN]) == tg, bar);
            __builtin_amdgcn_fence(__ATOMIC_ACQUIRE, "agent");
            xb_add(&bar[XB_XGEN(b.x)], 1u);
            asm volatile("s_waitcnt vmcnt(0)" ::: "memory");
        } else {
            XB_SPIN(xb_ld(&bar[XB_XGEN(b.x)]) == gen, bar);
            __builtin_amdgcn_fence(__ATOMIC_ACQUIRE, "agent");
            asm volatile("s_waitcnt vmcnt(0)" ::: "memory");
        }
    }
    __syncthreads();
}

struct Frame {
    LAS unsigned char* lds;
    volatile LAS unsigned* MISC;
    gu32* ctl;
    int tid, lane, wave;
    int vcu, G;
    const float* in[39]; float* out; unsigned char* ws;
};
enum { I_X = 0, I_C, I_ADAW0, I_ADAB0, I_WIN, I_LQ1, I_LK1, I_LQ2, I_LK2, I_SUBLN, I_WOUT, I_LN1G0, I_LN1B0, I_FG, I_FU, I_FD, I_LN2G0, I_LN2B0,
       I_ADAW1, I_ADAB1, I_ARE, I_AIM, I_LOGDT, I_BRE, I_BIM, I_CRE, I_CIM, I_DSKIP, I_WGLU, I_BGLU, I_LN1G1, I_LN1B1, I_RW, I_RB, I_EG, I_EU, I_ED, I_LN2G1, I_LN2B1 };

__device__ __forceinline__ void ph0_mods(Frame& F) {
    LAS float* sc = (LAS float*)(F.lds);
    LAS float* part = (LAS float*)(F.lds + 32768);
    float* mod = (float*)(F.ws + WS_MOD);
    if ((int)blockIdx.x < 192) {
        const float* c = F.in[I_C];
        for (int i = F.tid; i < BATCH * D; i += NWAVES * 64) { const float v = c[i]; sc[i] = v / (1.0f + expf(-v)); }
        __syncthreads();
        for (int it = blockIdx.x; it < 192; it += F.G) {
            const int l = it / 96, j0 = (it % 96) * 64;
            const float* W = F.in[l ? I_ADAW1 : I_ADAW0]; const float* bias = F.in[l ? I_ADAB1 : I_ADAB0];
            float acc[8];
#pragma unroll
            for (int b = 0; b < 8; ++b) acc[b] = 0.f;
            const int k0 = F.wave * 128;
            for (int kk = k0; kk < k0 + 128; kk += 16) { float w[16];
#pragma unroll
                for (int i = 0; i < 16; ++i) w[i] = W[(size_t)(kk + i) * (6 * D) + j0 + F.lane];
#pragma unroll
                for (int i = 0; i < 16; ++i)
#pragma unroll
                    for (int b = 0; b < 8; ++b) acc[b] += sc[b * D + kk + i] * w[i]; }
#pragma unroll
            for (int b = 0; b < 8; ++b) part[(F.wave * 8 + b) * 64 + F.lane] = acc[b];
            __syncthreads();
            float s = 0.f;
#pragma unroll
            for (int w2 = 0; w2 < 8; ++w2) s += part[(w2 * 8 + F.wave) * 64 + F.lane];
            mod[(size_t)(l * 8 + F.wave) * (6 * D) + j0 + F.lane] = s + bias[j0 + F.lane];
            __syncthreads();
        }
    }
    const int gid = ((int)blockIdx.x - ((F.G >= 200) ? 192 : 0)) * (NWAVES * 64) + F.tid;
    if (gid >= 0 && gid < 64 * 64) {
        const int g = gid >> 6;
        const float ar = F.in[I_ARE][gid], ai = F.in[I_AIM][gid], dt = expf(F.in[I_LOGDT][g]);
        const float mag = expf(dt * ar); float sn, cs; sincosf(dt * ai, &sn, &cs);
        const float abr = mag * cs, abi = mag * sn, den = ar * ar + ai * ai, nr = abr - 1.0f, ni = abi;
        const float zr = (nr * ar + ni * ai) / den, zi = (ni * ar - nr * ai) / den;
        float* SA = (float*)(F.ws + WS_SSMA); float* SB = (float*)(F.ws + WS_SSMB);
        SA[gid * 2] = abr; SA[gid * 2 + 1] = abi;
#pragma unroll
        for (int c = 0; c < 16; ++c) { const float br = F.in[I_BRE][gid * 16 + c], bi = F.in[I_BIM][gid * 16 + c];
            SB[(gid * 16 + c) * 2] = zr * br - zi * bi; SB[(gid * 16 + c) * 2 + 1] = zr * bi + zi * br; }
    }
}

struct TItem { const float* src; h16* dst; int ldw, K; };
__device__ __forceinline__ void titem_make(TItem& t, const float* W, int ldw, int K, int N, h16* WT, int rowmap, int item, int lane) {
    const int nblk = N / 32, kb = item / nblk, nb = item % nblk, k0 = 64 * kb, n0 = 32 * nb;
    const int r0 = rowmap == 0 ? n0 : ((n0 >> 7) * 256 + (n0 & 127) + (rowmap == 2 ? 128 : 0));
    t.src = W + (size_t)(k0 + (lane >> 5)) * ldw + n0 + (lane & 31); t.ldw = ldw; t.K = K;
    t.dst = WT + (size_t)(r0 + (lane >> 3)) * K + k0 + 8 * (lane & 7);
}
__device__ __forceinline__ void titem_decode(Frame& F, TItem& t, int it, int lane) {
    constexpr int I_0 = 16 * 96, I_1 = 16 * 32, I_2 = 16 * 88, I_3 = 16 * 88, I_4 = 44 * 32, I_5 = 16 * 32, I_6 = 16 * 32;
    constexpr int I_7 = 16 * 44, I_8 = 16 * 44, I_9 = 22 * 32;
    unsigned char* ws = F.ws; int r = it;
    if (r < I_0) { titem_make(t, F.in[I_WIN], 3 * D, D, 3 * D, (h16*)(ws + WS_W_IN), 0, r, lane); return; } r -= I_0;
    if (r < I_1) { titem_make(t, F.in[I_WOUT], D, D, D, (h16*)(ws + WS_W_OUT), 0, r, lane); return; } r -= I_1;
    if (r < I_2) { titem_make(t, F.in[I_FG], DFF, D, DFF, (h16*)(ws + WS_W_F1), 1, r, lane); return; } r -= I_2;
    if (r < I_3) { titem_make(t, F.in[I_FU], DFF, D, DFF, (h16*)(ws + WS_W_F1), 2, r, lane); return; } r -= I_3;
    if (r < I_4) { titem_make(t, F.in[I_FD], D, DFF, D, (h16*)(ws + WS_W_F2), 0, r, lane); return; } r -= I_4;
    if (r < I_5) { titem_make(t, F.in[I_WGLU], 2 * D, D, D, (h16*)(ws + WS_W_GLU), 1, r, lane); return; } r -= I_5;
    if (r < I_6) { titem_make(t, F.in[I_WGLU] + D, 2 * D, D, D, (h16*)(ws + WS_W_GLU), 2, r, lane); return; } r -= I_6;
    const int e = r / (I_7 + I_8 + I_9); r -= e * (I_7 + I_8 + I_9);
    if (r < I_7) { titem_make(t, F.in[I_EG] + (size_t)e * D * DFE, DFE, D, DFE, (h16*)(ws + WS_W_E1) + (size_t)e * 2 * DFE * D, 1, r, lane); return; } r -= I_7;
    if (r < I_8) { titem_make(t, F.in[I_EU] + (size_t)e * D * DFE, DFE, D, DFE, (h16*)(ws + WS_W_E1) + (size_t)e * 2 * DFE * D, 2, r, lane); return; } r -= I_8;
    titem_make(t, F.in[I_ED] + (size_t)e * DFE * D, D, DFE, D, (h16*)(ws + WS_W_E2) + (size_t)e * D * DFE, 0, r, lane);
}
constexpr int NIT_L0 = 16 * 96 + 16 * 32 + 2 * 16 * 88 + 44 * 32;
constexpr int NIT_ALL = NIT_L0 + 2 * 16 * 32 + NEXP * (2 * 16 * 44 + 22 * 32);
__device__ __forceinline__ void transpose_items(Frame& F, int it0, int it1, LAS float* scr) {
    const int gw = F.vcu * NWAVES + F.wave, NGW = F.G * NWAVES, lane = F.lane;
    const int NITEMS = it1;
    if (it0 + gw < NITEMS) {
        TItem cur; titem_decode(F, cur, it0 + gw, lane);
        float cv[32];
#pragma unroll
        for (int i = 0; i < 32; ++i) cv[i] = cur.src[(size_t)(2 * i) * cur.ldw];
        for (int it = it0 + gw; it < NITEMS; it += NGW) {
            TItem nxt = cur; float nv[32];
            const bool hn = it + NGW < NITEMS;
            if (hn) { titem_decode(F, nxt, it + NGW, lane);
#pragma unroll
                for (int i = 0; i < 32; ++i) nv[i] = nxt.src[(size_t)(2 * i) * nxt.ldw]; }
#pragma unroll
            for (int i = 0; i < 32; ++i) scr[(2 * i + (lane >> 5)) * 33 + (lane & 31)] = cv[i];
            LDS_WAIT(); asm volatile("" ::: "memory");
            const int c = lane & 7;
#pragma unroll
            for (int j = 0; j < 4; ++j) { const int n = (lane >> 3) + 8 * j; const LAS float* sp = scr + (8 * c) * 33 + n;
                v4u o; o.x = pk2h(sp[0 * 33], sp[1 * 33]); o.y = pk2h(sp[2 * 33], sp[3 * 33]); o.z = pk2h(sp[4 * 33], sp[5 * 33]); o.w = pk2h(sp[6 * 33], sp[7 * 33]);
                *(GAS v4u*)(cur.dst + (size_t)(8 * j) * cur.K) = o; }
            LDS_WAIT(); asm volatile("" ::: "memory");
            if (hn) {
#pragma unroll
                for (int i = 0; i < 32; ++i) cv[i] = nv[i];
                cur = nxt; }
        }
    }
}
__device__ __forceinline__ void ph1_prologue(Frame& F) {
    const int gw = F.vcu * NWAVES + F.wave, NGW = F.G * NWAVES, lane = F.lane;
    unsigned char* ws = F.ws;
    transpose_items(F, 0, NIT_ALL, (LAS float*)(F.lds + RING_OFF + F.wave * 16384));
    const float* mod0 = (const float*)(ws + WS_MOD);
    h16* H0 = (h16*)(ws + WS_B);
    {
        const int WPB = F.G, bq = gw / WPB, r0 = gw % WPB; const float* mb = mod0 + (size_t)bq * (6 * D);
        f32x4 sc1[4], shv[4];
#pragma unroll
        for (int j = 0; j < 4; ++j) { const int col = 4 * lane + 256 * j; shv[j] = *(const f32x4*)(mb + col); sc1[j] = 1.0f + *(const f32x4*)(mb + D + col); }
        for (int t0 = r0; t0 < SEQ; t0 += 8 * WPB) {
            f32x4 xr[8][4];
#pragma unroll
            for (int i = 0; i < 8; ++i) { const int t = t0 + i * WPB; if (t < SEQ) {
#pragma unroll
                for (int j = 0; j < 4; ++j) xr[i][j] = *(const f32x4*)(F.in[I_X] + ((size_t)bq * SEQ + t) * D + 4 * lane + 256 * j); } }
#pragma unroll
            for (int i = 0; i < 8; ++i) { const int t = t0 + i * WPB; if (t < SEQ) {
#pragma unroll
                for (int j = 0; j < 4; ++j) { const int col = 4 * lane + 256 * j;
                    const f32x4 h = xr[i][j] * sc1[j] + shv[j]; v2u o; o.x = pk2h(h[0], h[1]); o.y = pk2h(h[2], h[3]);
                    *(v2u*)(H0 + ((size_t)bq * SEQ + t) * D + col) = o; } } }
        }
    }
}

__device__ __forceinline__ f32x4 ld4h(const h16* p) { const v2u w = *(const v2u*)p; return (f32x4){hlo(w.x), hhi(w.x), hlo(w.y), hhi(w.y)}; }
__device__ __forceinline__ void ld8h(const h16* p, float* f) { const v4u w = *(const v4u*)p; f[0] = hlo(w.x); f[1] = hhi(w.x); f[2] = hlo(w.y); f[3] = hhi(w.y); f[4] = hlo(w.z); f[5] = hhi(w.z); f[6] = hlo(w.w); f[7] = hhi(w.w); }
__device__ __forceinline__ float lane_reduce64(float (&v)[64], int lane) {
#pragma unroll
    for (int s = 0; s < 6; ++s) { const int half = 32 >> s; const bool up = (lane & half) != 0;
#pragma unroll
        for (int i = 0; i < half; ++i) { const float lo = v[i], hi = v[i + half]; const float send = up ? lo : hi, keep = up ? hi : lo; v[i] = keep + __shfl_xor(send, half); } }
    return v[0];
}
__device__ __forceinline__ float lam_value(Frame& F) {
    float s1 = 0.f, s2 = 0.f;
#pragma unroll 4
    for (int i = 0; i < 32; ++i) { s1 += F.in[I_LQ1][i] * F.in[I_LK1][i]; s2 += F.in[I_LQ2][i] * F.in[I_LK2][i]; }
    return expf(s1) - expf(s2) + 0.2f;
}
template <bool DIFF, bool DIL> __device__ __forceinline__ void ph4_attn_naive(Frame& F) {
    const h16* QKV = (const h16*)(F.ws + WS_A); h16* O = (h16*)(F.ws + WS_B);
    const int gw = F.vcu * NWAVES + F.wave, NGW = F.G * NWAVES, lane = F.lane;
    const float lam = lam_value(F);
    const float sub_w = F.in[I_SUBLN][lane] * 0.8f;
    if (DIFF) for (int it = gw; it < BATCH * 8 * SEQ; it += NGW) {
        const int bh = it >> 12, r = it & 4095, i = (bh & 1) ? 4095 - r : r, b = bh >> 3, h = bh & 7;
        const size_t rowq = (size_t)(b * SEQ + i) * 3072;
        const float slope2 = exp2f(-0.5f * (float)(h + 1)) * LOG2E;
        float res[2];
#pragma unroll
        for (int mp = 0; mp < 2; ++mp) {
            float q[32];
#pragma unroll
            for (int d8 = 0; d8 < 4; ++d8) ld8h(QKV + rowq + h * 64 + mp * 32 + d8 * 8, q + d8 * 8);
            float acc[64];
#pragma unroll
            for (int d = 0; d < 64; ++d) acc[d] = 0.f;
            float mrun = -INFINITY, l = 0.f;
            for (int j = lane; j <= i; j += 64) {
                const size_t rowk = (size_t)(b * SEQ + j) * 3072;
                float s = 0.f;
#pragma unroll
                for (int d8 = 0; d8 < 4; ++d8) { float kf[8]; ld8h(QKV + rowk + 512 + h * 64 + mp * 32 + d8 * 8, kf);
#pragma unroll
                    for (int e = 0; e < 8; ++e) s += q[d8 * 8 + e] * kf[e]; }
                s -= slope2 * (float)(i - j);
                const float mn = fmaxf(mrun, s), alpha = ex2(mrun - mn), p = ex2(s - mn);
                l = l * alpha + p; mrun = mn;
#pragma unroll
                for (int d8 = 0; d8 < 8; ++d8) { float vf[8]; ld8h(QKV + rowk + 1024 + h * 64 + d8 * 8, vf);
#pragma unroll
                    for (int e = 0; e < 8; ++e) acc[d8 * 8 + e] = acc[d8 * 8 + e] * alpha + p * vf[e]; }
            }
            const float Mx = wave_max(mrun), scl = (mrun == -INFINITY) ? 0.f : ex2(mrun - Mx), L = wave_sum(l * scl);
#pragma unroll
            for (int d = 0; d < 64; ++d) acc[d] *= scl;
            const float mine = lane_reduce64(acc, lane);
            res[mp] = mine / L;
        }
        const float o = res[0] - lam * res[1];
        const float ss = wave_sum(o * o);
        const float y = o * (1.0f / sqrtf(ss * (1.0f / 64.0f) + LN_EPS)) * sub_w;
        O[(size_t)(b * SEQ + i) * D + h * 64 + lane] = (h16)(pk2h(y, 0.f) & 0xffffu);
    }
    if (DIL) for (int it = gw; it < BATCH * 8 * SEQ; it += NGW) {
        const int bh = it >> 12, i = it & 4095, b = bh >> 3, h = bh & 7;
        const size_t rowq = (size_t)(b * SEQ + i) * 3072;
        const float slope2 = exp2f(-0.5f * (float)(h + 9)) * LOG2E;
        float q[64];
#pragma unroll
        for (int d8 = 0; d8 < 8; ++d8) ld8h(QKV + rowq + 1536 + h * 64 + d8 * 8, q + d8 * 8);
        float og[3], lse[3];
#pragma unroll
        for (int g = 0; g < 3; ++g) {
            const int dil = (g == 0) ? 1 : (g == 1) ? 4 : 16;
            float acc[64];
#pragma unroll
            for (int d = 0; d < 64; ++d) acc[d] = 0.f;
            float mrun = -INFINITY, l = 0.f;
            for (int jj = lane; jj <= 128; jj += 64) {
                const int t = i - jj * dil;
                if (t >= 0) {
                    const size_t rowk = (size_t)(b * SEQ + t) * 3072;
                    float s = 0.f;
#pragma unroll
                    for (int d8 = 0; d8 < 8; ++d8) { float kf[8]; ld8h(QKV + rowk + 2048 + h * 64 + d8 * 8, kf);
#pragma unroll
                        for (int e = 0; e < 8; ++e) s += q[d8 * 8 + e] * kf[e]; }
                    s -= slope2 * (float)(jj * dil);
                    const float mn = fmaxf(mrun, s), alpha = ex2(mrun - mn), p = ex2(s - mn);
                    l = l * alpha + p; mrun = mn;
#pragma unroll
                    for (int d8 = 0; d8 < 8; ++d8) { float vf[8]; ld8h(QKV + rowk + 2560 + h * 64 + d8 * 8, vf);
#pragma unroll
                        for (int e = 0; e < 8; ++e) acc[d8 * 8 + e] = acc[d8 * 8 + e] * alpha + p * vf[e]; }
                }
            }
            const float Mx = wave_max(mrun), scl = (mrun == -INFINITY) ? 0.f : ex2(mrun - Mx), L = wave_sum(l * scl);
#pragma unroll
            for (int d = 0; d < 64; ++d) acc[d] *= scl;
            const float mine = lane_reduce64(acc, lane);
            og[g] = mine / L; lse[g] = Mx + log2f(L);
        }
        const float mx = fmaxf(lse[0], fmaxf(lse[1], lse[2]));
        const float w0 = ex2(lse[0] - mx), w1 = ex2(lse[1] - mx), w2 = ex2(lse[2] - mx);
        const float y = (w0 * og[0] + w1 * og[1] + w2 * og[2]) / (w0 + w1 + w2);
        O[(size_t)(b * SEQ + i) * D + 512 + h * 64 + lane] = (h16)(pk2h(y, 0.f) & 0xffffu);
    }
}


typedef _Float16 hf8 __attribute__((ext_vector_type(8)));
typedef float f32x16 __attribute__((ext_vector_type(16)));
__device__ __forceinline__ hf8 ldf8(const h16* p) { return __builtin_bit_cast(hf8, *(const v4u*)p); }
#define MFMA32(a, b, c) __builtin_amdgcn_mfma_f32_32x32x16_f16((a), (b), (c), 0, 0, 0)
typedef short v4i16_t __attribute__((ext_vector_type(4)));
typedef _Float16 hf4 __attribute__((ext_vector_type(4)));
__device__ __forceinline__ void v_stage(LAS unsigned char* vl, const v4u (&vn)[4], int lane) {
#pragma unroll
    for (int i = 0; i < 4; ++i) *(LAS v4u*)(vl + ((lane & 7) >> 2) * 2048 + ((lane >> 3) + 8 * i) * 64 + (lane & 3) * 16) = vn[i];
}
__device__ __forceinline__ hf8 v_frag(const LAS unsigned char* trb, int dt, int s) {
    const v4i16_t lo = __builtin_amdgcn_ds_read_tr16_b64_v4i16((LAS v4i16_t*)(trb + dt * 2048 + (16 * s) * 64));
    const v4i16_t hi = __builtin_amdgcn_ds_read_tr16_b64_v4i16((LAS v4i16_t*)(trb + dt * 2048 + (16 * s + 4) * 64));
    return __builtin_shufflevector(__builtin_bit_cast(hf4, lo), __builtin_bit_cast(hf4, hi), 0, 1, 2, 3, 4, 5, 6, 7);
}
__device__ __forceinline__ float rowmax16(const f32x16& s) {
    float m;
    asm("s_nop 15\n\ts_nop 7\n\t"
                 "v_max3_f32 %0, %1, %2, %3\n\tv_max3_f32 %0, %0, %4, %5\n\tv_max3_f32 %0, %0, %6, %7\n\tv_max3_f32 %0, %0, %8, %9\n\t"
                 "v_max3_f32 %0, %0, %10, %11\n\tv_max3_f32 %0, %0, %12, %13\n\tv_max3_f32 %0, %0, %14, %15\n\tv_max_f32 %0, %0, %16"
                 : "=&v"(m)
                 : "v"(s[0]), "v"(s[1]), "v"(s[2]), "v"(s[3]), "v"(s[4]), "v"(s[5]), "v"(s[6]), "v"(s[7]), "v"(s[8]), "v"(s[9]), "v"(s[10]), "v"(s[11]), "v"(s[12]), "v"(s[13]), "v"(s[14]), "v"(s[15]));
    return m;
}
constexpr float LAZY_THR = 8.0f;
__device__ __forceinline__ float half_max(float v) { auto rr = __builtin_amdgcn_permlane32_swap(__float_as_uint(v), __float_as_uint(v), false, false); return fmaxf(__uint_as_float(rr[0]), __uint_as_float(rr[1])); }
__device__ __forceinline__ float half_sum(float v) { auto rr = __builtin_amdgcn_permlane32_swap(__float_as_uint(v), __float_as_uint(v), false, false); return __uint_as_float(rr[0]) + __uint_as_float(rr[1]); }
constexpr float SKIP_BITS = 30.0f;
__device__ __forceinline__ void ph4_diff_mfma(Frame& F) {
    const h16* QKV = (const h16*)(F.ws + WS_A); const h16* KA = (const h16*)(F.ws + WS_KA); h16* O = (h16*)(F.ws + WS_B);
    int lane_ = F.lane; asm volatile("" : "+v"(lane_));
    const int gw = F.vcu * NWAVES + F.wave, NGW = F.G * NWAVES, lane = lane_, r32 = lane & 31, hi = lane >> 5;
    const float lam = lam_value(F);
    LAS unsigned char* vl = F.lds + RING_OFF + F.wave * 4096;
    const LAS unsigned char* trb = vl + (8 * hi + ((lane & 15) >> 2)) * 64 + (16 * ((lane >> 4) & 1) + 4 * (lane & 3)) * 2;
    for (int k = 0; k < 4; ++k) {
        if (gw >= 2048) break;
        const int ty = gw & 1, qp = (gw >> 1) & 127, b = gw >> 8;
        const int h = (ty == 0) ? ((k == 0) ? 7 : (k == 1) ? 0 : (k == 2) ? 4 : 3) : ((k == 0) ? 6 : (k == 1) ? 1 : (k == 2) ? 5 : 2);
        const int bh = b * 8 + h, qt = (k & 1) ? 127 - qp : qp, i0 = qt * 32;
        const float slope2 = exp2f(-0.5f * (float)(h + 1)) * LOG2E;
        const h16* qrow = QKV + (size_t)(b * SEQ + i0 + r32) * 3072 + h * 64 + 8 * hi;
        hf8 qf[2][2];
#pragma unroll
        for (int mp = 0; mp < 2; ++mp)
#pragma unroll
            for (int sl = 0; sl < 2; ++sl) qf[mp][sl] = ldf8(qrow + mp * 32 + sl * 16);
        float need;
        { float sq[2];
#pragma unroll
            for (int mp = 0; mp < 2; ++mp) { float a = 0.f;
#pragma unroll
                for (int sl = 0; sl < 2; ++sl)
#pragma unroll
                    for (int e = 0; e < 8; ++e) { const float v = (float)qf[mp][sl][e]; a += v * v; }
                a = half_sum(a);
                const float km = __uint_as_float(__hip_atomic_load(F.ctl + CW_KMAX + (b * 8 + h) * 2 + mp, RLX_AGENT));
                sq[mp] = sqrtf(a * km) * 1.001f + 0.01f; }
            need = fmaxf(sq[0], sq[1]) + SKIP_BITS - log2f(1.0f - exp2f(-slope2)); }
        float coff[16];
#pragma unroll
        for (int r = 0; r < 16; ++r) coff[r] = slope2 * (float)(16 * (r >> 3) + 8 * hi + (r & 7));
        f32x16 o[2][2];
#pragma unroll
        for (int mp = 0; mp < 2; ++mp)
#pragma unroll
            for (int dt = 0; dt < 2; ++dt)
#pragma unroll
                for (int r = 0; r < 16; ++r) o[mp][dt][r] = 0.f;
        float mrun[2] = {0.f, 0.f}, lrun[2] = {0.f, 0.f};
        const h16* kbase = KA + ((size_t)(bh * 128) * 4 * 64 + lane) * 8;
        const h16* vbase = QKV + (size_t)(b * SEQ + (lane >> 3)) * 3072 + 1024 + h * 64 + 8 * (lane & 7);
        hf8 kn[2][2]; v4u vn[4];
        { const h16* kb2 = kbase + (size_t)(qt * 4) * 512; const h16* vb2 = vbase + (size_t)(32 * qt) * 3072;
#pragma unroll
            for (int mp = 0; mp < 2; ++mp)
#pragma unroll
                for (int sl = 0; sl < 2; ++sl) kn[mp][sl] = ldf8(kb2 + (mp * 2 + sl) * 512);
#pragma unroll
            for (int i = 0; i < 4; ++i) vn[i] = *(const v4u*)(vb2 + (size_t)(8 * i) * 3072); }
        for (int kt = qt; kt >= 0; --kt) {
            hf8 kf[2][2];
#pragma unroll
            for (int a = 0; a < 2; ++a)
#pragma unroll
                for (int c = 0; c < 2; ++c) kf[a][c] = kn[a][c];
            asm volatile("" ::: "memory");
            v_stage(vl, vn, lane);
            asm volatile("" ::: "memory");
            if (kt > 0) {
                const h16* kb2 = kbase + (size_t)((kt - 1) * 4) * 512; const h16* vb2 = vbase + (size_t)(32 * (kt - 1)) * 3072;
#pragma unroll
                for (int mp = 0; mp < 2; ++mp)
#pragma unroll
                    for (int sl = 0; sl < 2; ++sl) kn[mp][sl] = ldf8(kb2 + (mp * 2 + sl) * 512);
#pragma unroll
                for (int i = 0; i < 4; ++i) vn[i] = *(const v4u*)(vb2 + (size_t)(8 * i) * 3072);
            }
            hf8 vf[2][2];
#pragma unroll
            for (int dt = 0; dt < 2; ++dt)
#pragma unroll
                for (int s2 = 0; s2 < 2; ++s2) vf[dt][s2] = v_frag(trb, dt, s2);
            asm volatile("" ::: "memory");
            const float tb = slope2 * (float)(32 * kt - i0);
            const bool diag = (kt == qt);
            f32x16 sc[2];
#pragma unroll
            for (int mp = 0; mp < 2; ++mp) { const float tbm = tb - mrun[mp];
#pragma unroll
                for (int r = 0; r < 16; ++r) sc[mp][r] = coff[r] + tbm;
                if (diag) {
#pragma unroll
                    for (int r = 0; r < 16; ++r) if (16 * (r >> 3) + 8 * hi + (r & 7) > r32) sc[mp][r] = -INFINITY;
                } }
            sc[0] = MFMA32(kf[0][0], qf[0][0], sc[0]); sc[1] = MFMA32(kf[1][0], qf[1][0], sc[1]);
            sc[0] = MFMA32(kf[0][1], qf[0][1], sc[0]); sc[1] = MFMA32(kf[1][1], qf[1][1], sc[1]);
            hf8 pb[2][2];
#pragma unroll
            for (int mp = 0; mp < 2; ++mp) {
                const float mx = half_max(rowmax16(sc[mp]));
                if (diag || __any(mx > LAZY_THR)) {
                    const float dl = diag ? mx : fmaxf(mx, 0.f), alpha = ex2(-dl); mrun[mp] += dl; lrun[mp] *= alpha;
#pragma unroll
                    for (int r = 0; r < 16; ++r) sc[mp][r] -= dl;
#pragma unroll
                    for (int dt = 0; dt < 2; ++dt)
#pragma unroll
                        for (int r = 0; r < 16; ++r) o[mp][dt][r] *= alpha; }
                float ls = 0.f;
#pragma unroll
                for (int r = 0; r < 16; ++r) { sc[mp][r] = ex2(sc[mp][r]); ls += sc[mp][r]; }
                lrun[mp] += ls;
                v4u p0, p1;
                p0.x = pk2h(sc[mp][0], sc[mp][1]); p0.y = pk2h(sc[mp][2], sc[mp][3]); p0.z = pk2h(sc[mp][4], sc[mp][5]); p0.w = pk2h(sc[mp][6], sc[mp][7]);
                p1.x = pk2h(sc[mp][8], sc[mp][9]); p1.y = pk2h(sc[mp][10], sc[mp][11]); p1.z = pk2h(sc[mp][12], sc[mp][13]); p1.w = pk2h(sc[mp][14], sc[mp][15]);
                pb[mp][0] = __builtin_bit_cast(hf8, p0); pb[mp][1] = __builtin_bit_cast(hf8, p1);
            }
#pragma unroll
            for (int s2 = 0; s2 < 2; ++s2)
#pragma unroll
                for (int mp = 0; mp < 2; ++mp)
#pragma unroll
                    for (int dt = 0; dt < 2; ++dt) o[mp][dt] = MFMA32(vf[dt][s2], pb[mp][s2], o[mp][dt]);
            if (__all(slope2 * (float)(i0 + 1 - 32 * kt) >= need - fminf(mrun[0], mrun[1]))) break;
        }
        const float l0 = half_sum(lrun[0]), l1 = half_sum(lrun[1]);
        const float i0l = 1.0f / l0, i1l = lam / l1;
        float ss = 0.f;
#pragma unroll
        for (int dt = 0; dt < 2; ++dt)
#pragma unroll
            for (int r = 0; r < 16; ++r) { const float v = o[0][dt][r] * i0l - o[1][dt][r] * i1l; o[0][dt][r] = v; ss += v * v; }
        ss = half_sum(ss);
        const float rstd = 0.8f / sqrtf(ss * (1.0f / 64.0f) + LN_EPS);
        h16* orow = O + (size_t)(b * SEQ + i0 + r32) * D + h * 64;
#pragma unroll
        for (int dt = 0; dt < 2; ++dt)
#pragma unroll
            for (int gp = 0; gp < 2; ++gp) { v2u w[2];
#pragma unroll
                for (int e = 0; e < 2; ++e) { const int g = 2 * gp + e, d = 32 * dt + 8 * g + 4 * hi; const f32x4 sw = *(const f32x4*)(F.in[I_SUBLN] + d);
                    w[e].x = pk2h(o[0][dt][4 * g] * rstd * sw[0], o[0][dt][4 * g + 1] * rstd * sw[1]); w[e].y = pk2h(o[0][dt][4 * g + 2] * rstd * sw[2], o[0][dt][4 * g + 3] * rstd * sw[3]); }
                const auto sx = __builtin_amdgcn_permlane32_swap(w[0].x, w[1].x, false, false), sy = __builtin_amdgcn_permlane32_swap(w[0].y, w[1].y, false, false);
                *(v4u*)(orow + 32 * dt + 16 * gp + 8 * hi) = (v4u){sx[0], sy[0], sx[1], sy[1]}; }
    }
}

template <int MODE> __device__ __forceinline__ void dil_pass(Frame& F) {
    constexpr int STR = (MODE == 0) ? 1 : (MODE == 1) ? 4 : 16, NT = (MODE == 0) ? 5 : 4, LO = (MODE == 0) ? 0 : 33, NU = BATCH * 8 * 128;
    const h16* QKV = (const h16*)(F.ws + WS_A); h16* O = (h16*)(F.ws + WS_B);
    const h16* KB = (MODE == 0) ? (const h16*)(F.ws + WS_KB1) : (MODE == 1) ? (const h16*)(F.ws + WS_KB4) : (const h16*)(F.ws + WS_KB16);
    h16* PO1 = (h16*)F.out; h16* PO2 = PO1 + (size_t)BATCH * 8 * SEQ * 64; float* PM1 = (float*)(PO2 + (size_t)BATCH * 8 * SEQ * 64); float* PM2 = PM1 + (size_t)BATCH * 8 * SEQ * 2;
    int lane_ = F.lane; asm volatile("" : "+v"(lane_));
    const int gw = F.vcu * NWAVES + F.wave, NGW = F.G * NWAVES, lane = lane_, r32 = lane & 31, hi = lane >> 5;
    LAS unsigned char* vl = F.lds + RING_OFF + F.wave * 4096;
    const LAS unsigned char* trb = vl + (8 * hi + ((lane & 15) >> 2)) * 64 + (16 * ((lane >> 4) & 1) + 4 * (lane & 3)) * 2;
#define DU_BH(i) ((i) >> 7)
#define DU_RR(i) ((MODE == 0) ? 0 : (MODE == 1) ? (((i) & 127) >> 5) : (((i) & 127) >> 3))
#define DU_QB(i) ((MODE == 0) ? ((i) & 127) : (MODE == 1) ? ((i) & 31) : ((i) & 7))
#define DU_KB0(i) ((MODE == 0) ? DU_QB(i) : DU_QB(i) - 1)
#define DU_NT(i) ((DU_KB0(i) + 1 < NT) ? DU_KB0(i) + 1 : NT)
#define DU_LOADQ(i, q) do { const int bh_ = DU_BH(i), tq_ = STR * (32 * DU_QB(i) + r32) + DU_RR(i); \
        const h16* qr_ = QKV + (size_t)((bh_ >> 3) * SEQ + tq_) * 3072 + 1536 + (bh_ & 7) * 64 + 8 * hi; \
        _Pragma("unroll") for (int sl_ = 0; sl_ < 4; ++sl_) q[sl_] = ldf8(qr_ + sl_ * 16); } while (0)
#define DU_LOADKV(i, kb) do { const int bh_ = DU_BH(i), rr_ = DU_RR(i), ub_ = (MODE == 0) ? 0 : (MODE == 1) ? rr_ * 32 : rr_ * 8; \
        const h16* kp_ = KB + ((size_t)((bh_ * 128 + ub_ + (kb)) * 4) * 64 + lane) * 8; \
        const h16* vp_ = QKV + (size_t)((bh_ >> 3) * SEQ + STR * (32 * (kb) + (lane >> 3)) + rr_) * 3072 + 2560 + (bh_ & 7) * 64 + 8 * (lane & 7); \
        _Pragma("unroll") for (int sl_ = 0; sl_ < 4; ++sl_) kn[sl_] = ldf8(kp_ + sl_ * 512); \
        _Pragma("unroll") for (int i_ = 0; i_ < 4; ++i_) vn[i_] = *(const v4u*)(vp_ + (size_t)(STR * 8 * i_) * 3072); } while (0)
    int idx = gw; if (idx >= NU) return;
    hf8 kn[4]; v4u vn[4];
    if (DU_NT(idx) > 0) DU_LOADKV(idx, DU_KB0(idx));
    for (;;) {
        const int nidx = idx + NGW; const bool hn = nidx < NU;
        const int bh = DU_BH(idx), b = bh >> 3, h = bh & 7, rr = DU_RR(idx), qb = DU_QB(idx), kb0 = DU_KB0(idx), ntile = DU_NT(idx);
        const float sS = exp2f(-0.5f * (float)(h + 9)) * LOG2E * (float)STR;
        const int tq = STR * (32 * qb + r32) + rr;
        hf8 qf[4];
        DU_LOADQ(idx, qf);
        const size_t prw = (size_t)bh * SEQ + tq;
        float pm1 = 0.f, pl1 = 0.f, pm2 = 0.f, pl2 = 0.f;
        float cb[16];
#pragma unroll
        for (int r = 0; r < 16; ++r) { const int ko = 16 * (r >> 3) + 8 * hi + (r & 7), dd = r32 - ko;
            const float lg = (MODE == 0) ? (((dd & 15) == 0) ? 1.5849625007211562f : ((dd & 3) == 0) ? 1.0f : 0.0f) : (MODE == 1) ? (((dd & 3) == 0) ? 1.0f : 0.0f) : 0.0f;
            cb[r] = sS * (float)ko + lg; }
        f32x16 o[2];
#pragma unroll
        for (int dt = 0; dt < 2; ++dt)
#pragma unroll
            for (int r = 0; r < 16; ++r) o[dt][r] = 0.f;
        float mrun = 0.f, lrun = 0.f; bool started = false;
        for (int j = 0; j < ntile; ++j) {
            const int kb = kb0 - j;
            hf8 kf[4];
#pragma unroll
            for (int sl = 0; sl < 4; ++sl) kf[sl] = kn[sl];
            asm volatile("" ::: "memory");
            v_stage(vl, vn, lane);
            asm volatile("" ::: "memory");
            if (j + 1 < ntile) DU_LOADKV(idx, kb - 1);
            else if (hn && DU_NT(nidx) > 0) DU_LOADKV(nidx, DU_KB0(nidx));
            hf8 vf[2][2];
#pragma unroll
            for (int dt = 0; dt < 2; ++dt)
#pragma unroll
                for (int s2 = 0; s2 < 2; ++s2) vf[dt][s2] = v_frag(trb, dt, s2);
            asm volatile("" ::: "memory");
            const float tb = sS * (float)(32 * (kb - qb)) - mrun;
            f32x16 s;
#pragma unroll
            for (int r = 0; r < 16; ++r) s[r] = cb[r] + tb;
            if (j == 0 || j == NT - 1) {
                const int dl0 = 32 * (qb - kb) + r32;
#pragma unroll
                for (int r = 0; r < 16; ++r) { const int dl = dl0 - (16 * (r >> 3) + 8 * hi + (r & 7)); if (dl < LO || dl > 128) s[r] = -INFINITY; }
            }
#pragma unroll
            for (int sl = 0; sl < 4; ++sl) s = MFMA32(kf[sl], qf[sl], s);
            const float mx = half_max(rowmax16(s));
            const bool fresh = !started && mx > -INFINITY;
            if (__any(fresh || mx > LAZY_THR)) {
                const float dl = fresh ? mx : fmaxf(mx, 0.f), alpha = ex2(-dl); mrun += dl; lrun *= alpha; started = started || fresh;
#pragma unroll
                for (int r = 0; r < 16; ++r) s[r] -= dl;
#pragma unroll
                for (int dt = 0; dt < 2; ++dt)
#pragma unroll
                    for (int r = 0; r < 16; ++r) o[dt][r] *= alpha; }
            float ls = 0.f;
#pragma unroll
            for (int r = 0; r < 16; ++r) { s[r] = ex2(s[r]); ls += s[r]; }
            lrun += ls;
            v4u p0, p1;
            p0.x = pk2h(s[0], s[1]); p0.y = pk2h(s[2], s[3]); p0.z = pk2h(s[4], s[5]); p0.w = pk2h(s[6], s[7]);
            p1.x = pk2h(s[8], s[9]); p1.y = pk2h(s[10], s[11]); p1.z = pk2h(s[12], s[13]); p1.w = pk2h(s[14], s[15]);
            const hf8 pb0 = __builtin_bit_cast(hf8, p0), pb1 = __builtin_bit_cast(hf8, p1);
#pragma unroll
            for (int dt = 0; dt < 2; ++dt) { o[dt] = MFMA32(vf[dt][0], pb0, o[dt]); o[dt] = MFMA32(vf[dt][1], pb1, o[dt]); }
        }
        if (ntile == 0 && hn && DU_NT(nidx) > 0) DU_LOADKV(nidx, DU_KB0(nidx));
        const float l = half_sum(lrun), mt = (l > 0.f) ? mrun - sS * (float)r32 : -1.0e30f;
        if (MODE != 2) {
            const float il = (l > 0.f) ? 1.0f / l : 0.f;
            h16* po = ((MODE == 0) ? PO1 : PO2) + prw * 64; float* pm = ((MODE == 0) ? PM1 : PM2) + prw * 2;
#pragma unroll
            for (int dt = 0; dt < 2; ++dt)
#pragma unroll
                for (int gp = 0; gp < 2; ++gp) { v2u w[2];
#pragma unroll
                    for (int e = 0; e < 2; ++e) { const int g = 2 * gp + e; w[e].x = pk2h(o[dt][4 * g] * il, o[dt][4 * g + 1] * il); w[e].y = pk2h(o[dt][4 * g + 2] * il, o[dt][4 * g + 3] * il); }
                    const auto sx = __builtin_amdgcn_permlane32_swap(w[0].x, w[1].x, false, false), sy = __builtin_amdgcn_permlane32_swap(w[0].y, w[1].y, false, false);
                    *(v4u*)(po + 32 * dt + 16 * gp + 8 * hi) = (v4u){sx[0], sy[0], sx[1], sy[1]}; }
            if (hi == 0) { pm[0] = mt; pm[1] = l; }
        } else {
            pm1 = PM1[prw * 2]; pl1 = PM1[prw * 2 + 1]; pm2 = PM2[prw * 2]; pl2 = PM2[prw * 2 + 1];
            const float Mx = fmaxf(pm1, fmaxf(pm2, mt));
            const float w1 = pl1 * ex2(pm1 - Mx), w2 = pl2 * ex2(pm2 - Mx), w3 = ex2(mt - Mx), inv = 1.0f / (w1 + w2 + w3 * l);
            const h16* p1 = PO1 + prw * 64; const h16* p2 = PO2 + prw * 64;
            h16* orow = O + (size_t)(b * SEQ + tq) * D + 512 + h * 64;
#pragma unroll
            for (int dt = 0; dt < 2; ++dt)
#pragma unroll
                for (int gp = 0; gp < 2; ++gp) { v2u w[2];
#pragma unroll
                    for (int e2 = 0; e2 < 2; ++e2) { const int g = 2 * gp + e2, d = 32 * dt + 8 * g + 4 * hi; const f32x4 a = ld4h(p1 + d), c = ld4h(p2 + d);
                        float y[4];
#pragma unroll
                        for (int e = 0; e < 4; ++e) y[e] = (w1 * a[e] + w2 * c[e] + w3 * o[dt][4 * g + e]) * inv;
                        w[e2].x = pk2h(y[0], y[1]); w[e2].y = pk2h(y[2], y[3]); }
                    const auto sx = __builtin_amdgcn_permlane32_swap(w[0].x, w[1].x, false, false), sy = __builtin_amdgcn_permlane32_swap(w[0].y, w[1].y, false, false);
                    *(v4u*)(orow + 32 * dt + 16 * gp + 8 * hi) = (v4u){sx[0], sy[0], sx[1], sy[1]}; }
        }
        if (!hn) break;
        idx = nidx;
    }
#undef DU_BH
#undef DU_RR
#undef DU_QB
#undef DU_KB0
#undef DU_NT
#undef DU_LOADQ
#undef DU_LOADKV
}

struct RowLn { f32x4 n[4]; };
__device__ __forceinline__ void ln_rows(f32x4 (&v)[4], const float* lg, const float* lb, int lane) {
    float s = 0.f;
#pragma unroll
    for (int j = 0; j < 4; ++j) s += (v[j][0] + v[j][1]) + (v[j][2] + v[j][3]);
    const float mean = wave_sum(s) * (1.0f / D); float s2 = 0.f;
#pragma unroll
    for (int j = 0; j < 4; ++j) { v[j] = v[j] - mean; s2 += (v[j][0] * v[j][0] + v[j][1] * v[j][1]) + (v[j][2] * v[j][2] + v[j][3] * v[j][3]); }
    const float rstd = 1.0f / sqrtf(wave_sum(s2) * (1.0f / D) + LN_EPS);
#pragma unroll
    for (int j = 0; j < 4; ++j) { const int col = 4 * lane + 256 * j; v[j] = v[j] * rstd * *(const f32x4*)(lg + col) + *(const f32x4*)(lb + col); }
}
struct RowIn { f32x4 x[4]; v2u hx[4]; v2u y[4]; };
template <bool XF32> __device__ __forceinline__ void row_load(RowIn& r, const float* xin, const h16* hin, const h16* y, int lane) {
#pragma unroll
    for (int j = 0; j < 4; ++j) { const int col = 4 * lane + 256 * j; if (XF32) r.x[j] = *(const f32x4*)(xin + col); else r.hx[j] = *(const v2u*)(hin + col); r.y[j] = *(const v2u*)(y + col); }
}
__device__ __forceinline__ f32x4 cvt4(v2u w) { return (f32x4){hlo(w.x), hhi(w.x), hlo(w.y), hhi(w.y)}; }
struct RowVec { f32x4 rdiv[4], psh[4], gate1[4], lg[4], lb[4], sc1[4], sh[4]; };
template <bool XF32> __device__ __forceinline__ void rowvec_load(RowVec& q, const float* psc, const float* psh, const float* gate, const float* lg, const float* lb, const float* sc, const float* sh, int lane) {
#pragma unroll
    for (int j = 0; j < 4; ++j) { const int col = 4 * lane + 256 * j;
        if (!XF32) { const f32x4 d = 1.0f + *(const f32x4*)(psc + col); q.rdiv[j] = (f32x4){__builtin_amdgcn_rcpf(d[0]), __builtin_amdgcn_rcpf(d[1]), __builtin_amdgcn_rcpf(d[2]), __builtin_amdgcn_rcpf(d[3])}; q.psh[j] = *(const f32x4*)(psh + col); }
        q.gate1[j] = 1.0f + *(const f32x4*)(gate + col); q.lg[j] = *(const f32x4*)(lg + col); q.lb[j] = *(const f32x4*)(lb + col);
        q.sc1[j] = 1.0f + *(const f32x4*)(sc + col); q.sh[j] = *(const f32x4*)(sh + col); }
}
__device__ __forceinline__ void ln_rows_v(f32x4 (&v)[4], const RowVec& q) {
    float s = 0.f;
#pragma unroll
    for (int j = 0; j < 4; ++j) s += (v[j][0] + v[j][1]) + (v[j][2] + v[j][3]);
    const float mean = wave_sum(s) * (1.0f / D); float s2 = 0.f;
#pragma unroll
    for (int j = 0; j < 4; ++j) { v[j] = v[j] - mean; s2 += (v[j][0] * v[j][0] + v[j][1] * v[j][1]) + (v[j][2] * v[j][2] + v[j][3] * v[j][3]); }
    const float rstd = 1.0f / sqrtf(wave_sum(s2) * (1.0f / D) + LN_EPS);
#pragma unroll
    for (int j = 0; j < 4; ++j) v[j] = v[j] * rstd * q.lg[j] + q.lb[j];
}
template <bool XF32> __device__ __forceinline__ void row_block(const RowIn& in, const RowVec& q, h16* ho, f32x4 (&hv)[4], int lane) {
    f32x4 v[4];
#pragma unroll
    for (int j = 0; j < 4; ++j) { f32x4 xv; if (XF32) xv = in.x[j]; else xv = (cvt4(in.hx[j]) - q.psh[j]) * q.rdiv[j];
        v[j] = DN_ALPHA * xv + q.gate1[j] * cvt4(in.y[j]); }
    ln_rows_v(v, q);
#pragma unroll
    for (int j = 0; j < 4; ++j) { const int col = 4 * lane + 256 * j;
        hv[j] = v[j] * q.sc1[j] + q.sh[j];
        v2u o; o.x = pk2h(hv[j][0], hv[j][1]); o.y = pk2h(hv[j][2], hv[j][3]); *(v2u*)(ho + col) = o; }
}
template <bool XF32> __device__ __forceinline__ void ph_rows(Frame& F, const float* xin, const h16* HIN, const float* psc, const float* psh, const h16* Y, const float* modl_gate  ,
                                        const float* lg, const float* lb, const float* mod_sc, const float* mod_sh, h16* HO) {
    const int gw = F.vcu * NWAVES + F.wave, WPB = F.G;
    const int b = gw / WPB, r0 = gw % WPB; const size_t bo = (size_t)b * (6 * D);
    RowVec q; rowvec_load<XF32>(q, psc + bo, psh + bo, modl_gate + bo, lg, lb, mod_sc + bo, mod_sh + bo, F.lane);
    for (int t0 = r0; t0 < SEQ; t0 += 4 * WPB) {
        RowIn r[4];
#pragma unroll
        for (int i = 0; i < 4; ++i) { const int t = t0 + i * WPB; if (t < SEQ) { const size_t m = (size_t)b * SEQ + t; row_load<XF32>(r[i], xin + m * D, HIN + m * D, Y + m * D, F.lane); } }
#pragma unroll
        for (int i = 0; i < 4; ++i) { const int t = t0 + i * WPB; if (t < SEQ) { const size_t m = (size_t)b * SEQ + t; f32x4 hv[4];
            row_block<XF32>(r[i], q, HO + m * D, hv, F.lane); } }
    }
}

__device__ __forceinline__ void ph10_ssm_naive(Frame& F) {
    const h16* U = (const h16*)(F.ws + WS_B); h16* GY = (h16*)(F.ws + WS_C);
    const float* SA = (const float*)(F.ws + WS_SSMA); const float* SB = (const float*)(F.ws + WS_SSMB);
    const int gw = F.vcu * NWAVES + F.wave, NGW = F.G * NWAVES, lane = F.lane;
    for (int it = gw; it < BATCH * 64; it += NGW) {
        const int b = it >> 6, g = it & 63, gp = g * 64 + lane;
        const float abr = SA[gp * 2], abi = SA[gp * 2 + 1];
        float bbr[16], bbi[16], cr[16], ci[16];
#pragma unroll
        for (int c = 0; c < 16; ++c) { bbr[c] = SB[(gp * 16 + c) * 2]; bbi[c] = SB[(gp * 16 + c) * 2 + 1]; cr[c] = F.in[I_CRE][(g * 16 + c) * 64 + lane]; ci[c] = F.in[I_CIM][(g * 16 + c) * 64 + lane]; }
        const float dsk = F.in[I_DSKIP][g * 16 + (lane & 15)];
        float hr = 0.f, hi = 0.f;
        for (int t = 0; t < SEQ; ++t) {
            const h16* ur = U + (size_t)(b * SEQ + t) * D + g * 16;
            float u[16]; ld8h(ur, u); ld8h(ur + 8, u + 8);
            float xr = 0.f, xi = 0.f;
#pragma unroll
            for (int c = 0; c < 16; ++c) { xr += bbr[c] * u[c]; xi += bbi[c] * u[c]; }
            const float nhr = abr * hr - abi * hi + xr, nhi = abr * hi + abi * hr + xi; hr = nhr; hi = nhi;
            float mine = 0.f;
#pragma unroll
            for (int c = 0; c < 16; ++c) { const float yc = wave_sum(cr[c] * hr - ci[c] * hi); if (lane == c) mine = yc; }
            if (lane < 16) { const float val = mine + dsk * h2f(ur[lane]); GY[(size_t)(b * SEQ + t) * D + g * 16 + lane] = (h16)(pk2h(gelu_tanh(val), 0.f) & 0xffffu); }
        }
    }
}


__device__ __forceinline__ void ssm_prep(Frame& F) {
    typedef float f32x2v __attribute__((ext_vector_type(2)));
    const float* SA = (const float*)(F.ws + WS_SSMA); const float* SB = (const float*)(F.ws + WS_SSMB);
    LAS f32x2v* PW = (LAS f32x2v*)(F.lds + RING_OFF);
    LAS f32x2v* BB = (LAS f32x2v*)(F.lds + RING_OFF + 16384);
    LAS f32x2v* CC = (LAS f32x2v*)(F.lds + RING_OFF + 32768);
    LAS float* KL = (LAS float*)(F.lds + RING_OFF + 49152);
    const int tid = F.tid;
    LAS int* tsk = (LAS int*)(F.lds + RING_OFF + 65536);
    for (;;) {
        if (tid == 0) *tsk = (int)__hip_atomic_fetch_add(F.ctl + CW_PREP, 1u, RLX_AGENT);
        __syncthreads();
        const int task = *tsk;
        __syncthreads();
        if (task >= 256) break;
        const int g = task >> 2, part = task & 3;
        const float idt = 1.0f / expf(F.in[I_LOGDT][g]);
        if (tid < 64) { float pr = 1.0f, pi = 0.0f; const float ar = SA[(g * 64 + tid) * 2], ai = SA[(g * 64 + tid) * 2 + 1];
            for (int k = 0; k <= 16; ++k) { PW[k * 64 + tid] = (f32x2v){pr, pi}; const float nr = pr * ar - pi * ai, ni = pr * ai + pi * ar; pr = nr; pi = ni; } }
        for (int e = tid; e < 1024; e += NWAVES * 64) { BB[e] = (f32x2v){SB[(g * 1024 + e) * 2] * idt, SB[(g * 1024 + e) * 2 + 1] * idt};
            CC[e] = (f32x2v){F.in[I_CRE][g * 1024 + e], F.in[I_CIM][g * 1024 + e]}; }
        __syncthreads();
        h16* base = (h16*)((unsigned char*)F.out + 100 * MiB) + (size_t)g * 131072;
        if (part == 0) {
            for (int q = tid; q < 64 * 64; q += NWAVES * 64) { const int f = q >> 6, l = q & 63, rt = f >> 4, t = f & 15, r32 = l & 31, hi = l >> 5, p = 16 * rt + (r32 & 15), im = r32 >> 4;
                const f32x2v a = PW[(15 - t) * 64 + p]; hf8 v;
#pragma unroll
                for (int j = 0; j < 8; ++j) { const f32x2v bb = BB[p * 16 + 8 * hi + j]; v[j] = (_Float16)(im ? (a.x * bb.y + a.y * bb.x) : (a.x * bb.x - a.y * bb.y)); }
                *(v4u*)(base + (size_t)q * 8) = __builtin_bit_cast(v4u, v); }
        } else if (part == 1) {
            for (int q = tid; q < 64 * 64; q += NWAVES * 64) { const int f = q >> 6, l = q & 63, rtY = f >> 3, q8 = f & 7, rt = q8 >> 1, sIm = q8 & 1, r32 = l & 31, hi = l >> 5;
                const int t = 2 * rtY + (r32 >> 4), c = r32 & 15; hf8 v;
#pragma unroll
                for (int j = 0; j < 8; ++j) { const int p = 16 * rt + (j & 3) + 8 * (j >> 2) + 4 * hi; const f32x2v a = PW[(t + 1) * 64 + p], cc = CC[c * 64 + p];
                    const float zr = cc.x * a.x - cc.y * a.y, zi = cc.x * a.y + cc.y * a.x; v[j] = (_Float16)(sIm ? -zi : zr); }
                *(v4u*)(base + 32768 + (size_t)q * 8) = __builtin_bit_cast(v4u, v); }
        } else {
            { const int L = tid >> 5, c = (tid >> 1) & 15, c20 = (tid & 1) * 8; float acc8[8];
#pragma unroll
                for (int j = 0; j < 8; ++j) acc8[j] = 0.f;
                for (int p = 0; p < 64; ++p) { const f32x2v a = PW[L * 64 + p], cc = CC[c * 64 + p];
                    const float zr = cc.x * a.x - cc.y * a.y, zi = cc.x * a.y + cc.y * a.x;
#pragma unroll
                    for (int j = 0; j < 8; ++j) { const f32x2v bb = BB[p * 16 + c20 + j]; acc8[j] += zr * bb.x - zi * bb.y; } }
#pragma unroll
                for (int j = 0; j < 8; ++j) KL[L * 256 + c * 16 + c20 + j] = acc8[j]; }
            __syncthreads();
            const int q0 = (part - 2) * 4096;
            for (int q = q0 + tid; q < q0 + 4096; q += NWAVES * 64) { const int f = q >> 6, l = q & 63, rtY = f >> 4, s = f & 15, r32 = l & 31, hi = l >> 5;
                const int t = 2 * rtY + (r32 >> 4), c = r32 & 15, L = t - s; hf8 v;
#pragma unroll
                for (int j = 0; j < 8; ++j) v[j] = (_Float16)((L >= 0) ? KL[(L & 15) * 256 + c * 16 + 8 * hi + j] : 0.f);
                *(v4u*)(base + 65536 + (size_t)q * 8) = __builtin_bit_cast(v4u, v); }
        }
        __syncthreads();
    }
}
__device__ __forceinline__ void ph10_ssm_mfma(Frame& F) {
    const h16* U = (const h16*)(F.ws + WS_B); h16* GY = (h16*)(F.ws + WS_C);
    const float* SA = (const float*)(F.ws + WS_SSMA);
    typedef float f32x2v __attribute__((ext_vector_type(2)));
    LAS f32x2v* SL = (LAS f32x2v*)(F.lds + RING_OFF);
    LAS unsigned char* OPL = F.lds + RING_OFF;
    int tid_ = F.tid; asm volatile("" : "+v"(tid_));
    const int tid = tid_, lane = tid & 63, r32 = lane & 31, hi = lane >> 5, wave = F.wave;
    for (int unit = blockIdx.x; unit < BATCH * 64; unit += F.G) {
        const int b = unit >> 6, g = unit & 63;
        const float dt = expf(F.in[I_LOGDT][g]);
        const h16* MW1 = (const h16*)((const unsigned char*)F.out + 100 * MiB) + (size_t)g * 131072; const h16* MG = MW1 + 32768; const h16* MT = MW1 + 65536;
        const int ch = 32 * wave + r32;
        const h16* urow = U + (size_t)(b * SEQ + 16 * ch) * D + g * 16;
        { v4u w1[8];
#pragma unroll
            for (int i = 0; i < 8; ++i) w1[i] = *(const v4u*)(MW1 + (size_t)(i * 512 + tid) * 8);
#pragma unroll
            for (int i = 0; i < 8; ++i) *(LAS v4u*)(OPL + (size_t)(i * 512 + tid) * 16) = w1[i]; }
        __builtin_amdgcn_sched_barrier(0);
        hf8 ub[16];
#pragma unroll
        for (int t = 0; t < 16; ++t) ub[t] = ldf8(urow + (size_t)t * D + 8 * hi);
        __syncthreads();
        f32x16 acc[4];
#pragma unroll
        for (int rt = 0; rt < 4; ++rt)
#pragma unroll
            for (int r = 0; r < 16; ++r) acc[rt][r] = 0.f;
#pragma unroll
        for (int t = 0; t < 16; ++t)
        {
#pragma unroll
            for (int rt = 0; rt < 4; ++rt) acc[rt] = MFMA32(__builtin_bit_cast(hf8, *(const LAS v4u*)(OPL + (rt * 16 + t) * 1024 + lane * 16)), ub[t], acc[rt]);
            if ((t & 3) == 3) __builtin_amdgcn_sched_barrier(0); }
        __syncthreads();
#pragma unroll
        for (int rt = 0; rt < 4; ++rt)
#pragma unroll
            for (int r = 0; r < 8; ++r) { const int p = 16 * rt + (r & 3) + 8 * (r >> 2) + 4 * hi; SL[p * 257 + ch] = (f32x2v){acc[rt][r], acc[rt][r + 8]}; }
        __syncthreads();
        {
            const int p = tid & 63, sg = tid >> 6;
            float pr = SA[(g * 64 + p) * 2], pi = SA[(g * 64 + p) * 2 + 1];
#pragma unroll
            for (int q = 0; q < 4; ++q) { const float nr = pr * pr - pi * pi, ni = 2.0f * pr * pi; pr = nr; pi = ni; }
            const float aLr = pr, aLi = pi;
            float xr = 0.f, xi = 0.f;
            for (int j0 = 0; j0 < 32; j0 += 8) { f32x2v sv[8];
#pragma unroll
                for (int j = 0; j < 8; ++j) sv[j] = SL[p * 257 + 32 * sg + j0 + j];
#pragma unroll
                for (int j = 0; j < 8; ++j) { const float nr = aLr * xr - aLi * xi + sv[j].x, ni = aLr * xi + aLi * xr + sv[j].y; xr = nr; xi = ni; sv[j] = (f32x2v){xr, xi}; }
#pragma unroll
                for (int j = 0; j < 8; ++j) SL[p * 257 + 32 * sg + j0 + j] = sv[j]; }
#pragma unroll
            for (int q = 0; q < 5; ++q) { const float nr = pr * pr - pi * pi, ni = 2.0f * pr * pi; pr = nr; pi = ni; }
            __syncthreads();
            float cr = 0.f, ci = 0.f;
            for (int s2 = 0; s2 < sg; ++s2) { const int c2 = 32 * s2 + 31; const f32x2v ag = SL[p * 257 + c2];
                const float nr = pr * cr - pi * ci + ag.x, ni = pr * ci + pi * cr + ag.y; cr = nr; ci = ni; }
            __syncthreads();
            float prevr = 0.f, previ = 0.f, wr = 1.0f, wi = 0.0f;
            for (int j0 = 0; j0 < 32; j0 += 8) { f32x2v xv[8];
#pragma unroll
                for (int j = 0; j < 8; ++j) xv[j] = SL[p * 257 + 32 * sg + j0 + j];
#pragma unroll
                for (int j = 0; j < 8; ++j) { const f32x2v in = (f32x2v){prevr + wr * cr - wi * ci, previ + wr * ci + wi * cr};
                    prevr = xv[j].x; previ = xv[j].y; xv[j] = in; const float nr = wr * aLr - wi * aLi, ni = wr * aLi + wi * aLr; wr = nr; wi = ni; }
#pragma unroll
                for (int j = 0; j < 8; ++j) SL[p * 257 + 32 * sg + j0 + j] = xv[j]; }
        }
        __syncthreads();
        v4u ifw[8];
#pragma unroll
        for (int rt = 0; rt < 4; ++rt) { float re[8], im[8];
#pragma unroll
            for (int j = 0; j < 8; ++j) { const int p = 16 * rt + (j & 3) + 8 * (j >> 2) + 4 * hi; const f32x2v v = SL[p * 257 + ch]; re[j] = v.x; im[j] = v.y; }
            v4u w0, w1; w0.x = pk2h(re[0], re[1]); w0.y = pk2h(re[2], re[3]); w0.z = pk2h(re[4], re[5]); w0.w = pk2h(re[6], re[7]);
            w1.x = pk2h(im[0], im[1]); w1.y = pk2h(im[2], im[3]); w1.z = pk2h(im[4], im[5]); w1.w = pk2h(im[6], im[7]);
            ifw[2 * rt] = w0; ifw[2 * rt + 1] = w1; }
        LAS v4u* IFL = (LAS v4u*)(OPL + 49152 + wave * 8192);
        const f32x4 dk0 = *(const f32x4*)(F.in[I_DSKIP] + g * 16 + 4 * hi), dk1 = *(const f32x4*)(F.in[I_DSKIP] + g * 16 + 8 + 4 * hi);
        h16* yrow = GY + (size_t)(b * SEQ + 16 * ch) * D + g * 16;
        v4u pg, pt0, pt1;
        pg = *(const v4u*)(MG + (size_t)tid * 8); pt0 = *(const v4u*)(MT + (size_t)tid * 8); pt1 = pt0;
        __syncthreads();
#pragma unroll
        for (int q = 0; q < 8; ++q) IFL[q * 64 + lane] = ifw[q];
        *(LAS v4u*)(OPL + tid * 16) = pg; if (tid < 128) *(LAS v4u*)(OPL + 8192 + tid * 16) = pt0;
        __syncthreads();
#pragma unroll
        for (int rtY = 0; rtY < 8; ++rtY) {
            LAS unsigned char* cur = OPL + (rtY & 1) * 24576;
            if (rtY < 7) { const int nT = (2 * (rtY + 1) + 2) * 64;
                pg = *(const v4u*)(MG + (size_t)((rtY + 1) * 8 * 64 + tid) * 8);
                if (tid < nT) pt0 = *(const v4u*)(MT + (size_t)((rtY + 1) * 16 * 64 + tid) * 8);
                if (tid + 512 < nT) pt1 = *(const v4u*)(MT + (size_t)((rtY + 1) * 16 * 64 + tid + 512) * 8); }
            f32x16 y0, y1;
#pragma unroll
            for (int r = 0; r < 16; ++r) { y0[r] = 0.f; y1[r] = 0.f; }
#pragma unroll
            for (int q = 0; q < 8; ++q) { const hf8 af = __builtin_bit_cast(hf8, *(const LAS v4u*)(cur + q * 1024 + lane * 16)); const hf8 bf = __builtin_bit_cast(hf8, IFL[q * 64 + lane]); if (q & 1) y1 = MFMA32(af, bf, y1); else y0 = MFMA32(af, bf, y0); }
#pragma unroll
            for (int s2 = 0; s2 <= 2 * rtY + 1; ++s2) { const hf8 af = __builtin_bit_cast(hf8, *(const LAS v4u*)(cur + 8192 + s2 * 1024 + lane * 16)); if (s2 & 1) y1 = MFMA32(af, ub[s2], y1); else y0 = MFMA32(af, ub[s2], y0); }
#pragma unroll
            for (int tt = 0; tt < 2; ++tt) { const size_t ro = (size_t)(2 * rtY + tt) * D;
                const v4u uw = __builtin_bit_cast(v4u, ub[2 * rtY + tt]);
                const auto sw0 = __builtin_amdgcn_permlane32_swap(uw.x, uw.z, false, false), sw1 = __builtin_amdgcn_permlane32_swap(uw.y, uw.w, false, false);
                const f32x4 u0 = {hlo(sw0[0]), hhi(sw0[0]), hlo(sw1[0]), hhi(sw1[0])}, u1 = {hlo(sw0[1]), hhi(sw0[1]), hlo(sw1[1]), hhi(sw1[1])};
                float yv[8];
#pragma unroll
                for (int e = 0; e < 8; ++e) yv[e] = (y0[8 * tt + e] + y1[8 * tt + e]) * dt;
                v2u w0, w1;
                w0.x = pk2h(gelu_tanh(yv[0] + dk0[0] * u0[0]), gelu_tanh(yv[1] + dk0[1] * u0[1])); w0.y = pk2h(gelu_tanh(yv[2] + dk0[2] * u0[2]), gelu_tanh(yv[3] + dk0[3] * u0[3]));
                w1.x = pk2h(gelu_tanh(yv[4] + dk1[0] * u1[0]), gelu_tanh(yv[5] + dk1[1] * u1[1])); w1.y = pk2h(gelu_tanh(yv[6] + dk1[2] * u1[2]), gelu_tanh(yv[7] + dk1[3] * u1[3]));
                const auto sx = __builtin_amdgcn_permlane32_swap(w0.x, w1.x, false, false), sy = __builtin_amdgcn_permlane32_swap(w0.y, w1.y, false, false);
                *(v4u*)(yrow + ro + 8 * hi) = (v4u){sx[0], sy[0], sx[1], sy[1]}; }
            if (rtY < 7) { const int nT = (2 * (rtY + 1) + 2) * 64; LAS unsigned char* nxt = OPL + ((rtY + 1) & 1) * 24576;
                *(LAS v4u*)(nxt + tid * 16) = pg;
                if (tid < nT) *(LAS v4u*)(nxt + 8192 + tid * 16) = pt0;
                if (tid + 512 < nT) *(LAS v4u*)(nxt + 8192 + (tid + 512) * 16) = pt1; }
            __syncthreads();
        }
    }
}

__device__ __forceinline__ void ph12_rows_route(Frame& F) {
    const int gw = F.vcu * NWAVES + F.wave, NGW = F.G * NWAVES, lane = F.lane;
    const float* mod1 = (const float*)(F.ws + WS_MOD) + (size_t)BATCH * 6 * D;
    const h16* Y3 = (const h16*)(F.ws + WS_A); h16* H16 = (h16*)(F.ws + WS_VT1);
    int* tok_e = (int*)(F.ws + WS_TOKE); float* tok_g = (float*)(F.ws + WS_TOKG);
    LAS unsigned* lcnt = (LAS unsigned*)(F.lds + 1024);
    if (F.tid < 8) lcnt[F.tid] = 0u;
    __syncthreads();
    LAS f32x4* RWL = (LAS f32x4*)(F.lds + 4096);
    for (int e = F.tid; e < 2048; e += NWAVES * 64) { const int jih = e >> 6, l = e & 63, j = jih >> 3, i = (jih >> 1) & 3, hf = jih & 1;
        RWL[e] = *(const f32x4*)(F.in[I_RW] + (size_t)(4 * l + 256 * j + i) * 8 + 4 * hf); }
    __syncthreads();
    const f32x4 rb0 = *(const f32x4*)(F.in[I_RB]), rb1 = *(const f32x4*)(F.in[I_RB] + 4);
    const h16* UPREV = (const h16*)(F.ws + WS_B);
    const int WPB = F.G, bq = gw / WPB, r0 = gw % WPB; const size_t bo = (size_t)bq * (6 * D);
    RowVec q; rowvec_load<false>(q, mod1 + bo + 1 * D, mod1 + bo, mod1 + bo + 2 * D, F.in[I_LN1G1], F.in[I_LN1B1], mod1 + bo + 4 * D, mod1 + bo + 3 * D, lane);
    for (int t0 = r0; t0 < SEQ; t0 += WPB) {
        { const int m = bq * SEQ + t0;
        RowIn rr1; row_load<false>(rr1, nullptr, UPREV + (size_t)m * D, Y3 + (size_t)m * D, lane);
        f32x4 hv[4];
        row_block<false>(rr1, q, H16 + (size_t)m * D, hv, lane);
        f32x4 a0 = {0.f, 0.f, 0.f, 0.f}, a1 = a0;
#pragma unroll
        for (int j = 0; j < 4; ++j)
#pragma unroll
            for (int i = 0; i < 4; ++i) { a0 += hv[j][i] * RWL[((j * 4 + i) * 2 + 0) * 64 + lane]; a1 += hv[j][i] * RWL[((j * 4 + i) * 2 + 1) * 64 + lane]; }
        float lg[8];
#pragma unroll
        for (int e = 0; e < 4; ++e) { lg[e] = wave_sum(a0[e]) + rb0[e]; lg[4 + e] = wave_sum(a1[e]) + rb1[e]; }
        int e1 = 0; float v1 = lg[0];
#pragma unroll
        for (int e = 1; e < 8; ++e) if (lg[e] > v1) { v1 = lg[e]; e1 = e; }
        int e2 = -1; float v2 = -INFINITY;
#pragma unroll
        for (int e = 0; e < 8; ++e) if (e != e1 && lg[e] > v2) { v2 = lg[e]; e2 = e; }
        const float g1 = 1.0f / (1.0f + expf(v2 - v1)), g2 = 1.0f - g1;
        if (lane == 0) { tok_e[2 * m] = e1; tok_e[2 * m + 1] = e2; tok_g[2 * m] = g1; tok_g[2 * m + 1] = g2;
            __hip_atomic_fetch_add(lcnt + e1, 1u, __ATOMIC_RELAXED, __HIP_MEMORY_SCOPE_WORKGROUP); __hip_atomic_fetch_add(lcnt + e2, 1u, __ATOMIC_RELAXED, __HIP_MEMORY_SCOPE_WORKGROUP); }
        }
    }
    __syncthreads();
    if (F.tid < 8) __hip_atomic_fetch_add(F.ctl + CW_ECNT + F.tid, lcnt[F.tid], RLX_AGENT);
}
__device__ __forceinline__ void moe_prefix(Frame& F, int (&tp)[9]) {
    int acc = 0;
#pragma unroll
    for (int e = 0; e < 8; ++e) { tp[e] = acc; const unsigned c = __hip_atomic_load(F.ctl + CW_ECNT + e, RLX_AGENT); acc += (int)((c + 255u) >> 8); }
    tp[8] = acc;
}
__device__ __forceinline__ void ph13_gather(Frame& F) {
    const int gw = F.vcu * NWAVES + F.wave, NGW = F.G * NWAVES, lane = F.lane;
    int tp[9]; moe_prefix(F, tp);
    const int* tok_e = (const int*)(F.ws + WS_TOKE); int* tok_p = (int*)(F.ws + WS_TOKP);
    const h16* H16 = (const h16*)(F.ws + WS_VT1); h16* HG = (h16*)(F.ws + WS_B);
    for (int base = gw * 16; base < M; base += NGW * 16) {
        const bool own = lane < 16; const int m = base + (lane & 15);
        const int ea = own ? tok_e[2 * m] : -1, eb = own ? tok_e[2 * m + 1] : -1;
        const unsigned long long below = (lane == 0) ? 0ull : (~0ull >> (64 - lane));
        int ra = 0, rb = 0, mycnt = 0;
#pragma unroll
        for (int e = 0; e < 8; ++e) {
            const unsigned long long ma = __ballot(ea == e), mb = __ballot(eb == e);
            const int ca = __popcll(ma), cb = __popcll(mb);
            if (lane == e) mycnt = ca + cb;
            if (ea == e) ra = __popcll(ma & below);
            if (eb == e) rb = ca + __popcll(mb & below);
        }
        unsigned basee = 0u;
        if (lane < 8 && mycnt > 0) basee = __hip_atomic_fetch_add(F.ctl + CW_ECUR + lane, (unsigned)mycnt, RLX_AGENT);
        int tpl = 0;
#pragma unroll
        for (int e = 0; e < 8; ++e) if (lane == e) tpl = tp[e];
        const int segbase = tpl * 256 + (int)basee;
        const int pa = __shfl(segbase, ea & 7) + ra, pb = __shfl(segbase, eb & 7) + rb;
        if (own) { tok_p[2 * m] = pa; tok_p[2 * m + 1] = pb; }
#pragma unroll
        for (int t4 = 0; t4 < 16; t4 += 8) {
            v4u v0[8], v1[8]; int p1[8], p2[8];
#pragma unroll
            for (int i = 0; i < 8; ++i) { const h16* src = H16 + (size_t)(base + t4 + i) * D; v0[i] = *(const v4u*)(src + 8 * lane); v1[i] = *(const v4u*)(src + 512 + 8 * lane);
                p1[i] = __shfl(pa, t4 + i); p2[i] = __shfl(pb, t4 + i); }
#pragma unroll
            for (int i = 0; i < 8; ++i) {
                *(v4u*)(HG + (size_t)p1[i] * D + 8 * lane) = v0[i]; *(v4u*)(HG + (size_t)p1[i] * D + 512 + 8 * lane) = v1[i];
                *(v4u*)(HG + (size_t)p2[i] * D + 8 * lane) = v0[i]; *(v4u*)(HG + (size_t)p2[i] * D + 512 + 8 * lane) = v1[i]; }
        }
    }
}
__device__ __forceinline__ void ph16_final(Frame& F) {
    const int gw = F.vcu * NWAVES + F.wave, NGW = F.G * NWAVES, lane = F.lane;
    const float* mod1 = (const float*)(F.ws + WS_MOD) + (size_t)BATCH * 6 * D;
    const int* tok_p = (const int*)(F.ws + WS_TOKP); const float* tok_g = (const float*)(F.ws + WS_TOKG);
    const h16* YG = (const h16*)(F.ws + WS_B);
    const h16* H16 = (const h16*)(F.ws + WS_VT1);
    struct Row16 { v2u x[4]; v2u a[4], c[4]; float w1, w2; };
    auto load16 = [&](Row16& r, int m) {
        const int p1 = tok_p[2 * m], p2 = tok_p[2 * m + 1]; r.w1 = tok_g[2 * m]; r.w2 = tok_g[2 * m + 1];
#pragma unroll
        for (int j = 0; j < 4; ++j) { const int col = 4 * lane + 256 * j; r.x[j] = *(const v2u*)(H16 + (size_t)m * D + col);
            r.a[j] = *(const v2u*)(YG + (size_t)p1 * D + col); r.c[j] = *(const v2u*)(YG + (size_t)p2 * D + col); } };
    const int WPB = F.G, bq = gw / WPB, r0 = gw % WPB; const size_t bo = (size_t)bq * (6 * D);
    RowVec q; rowvec_load<false>(q, mod1 + bo + 4 * D, mod1 + bo + 3 * D, mod1 + bo + 5 * D, F.in[I_LN2G1], F.in[I_LN2B1], mod1 + bo, mod1 + bo, lane);
    for (int t0 = r0; t0 < SEQ; t0 += 4 * WPB) {
        Row16 rw4[4];
#pragma unroll
        for (int i = 0; i < 4; ++i) { const int t = t0 + i * WPB; if (t < SEQ) load16(rw4[i], bq * SEQ + t); }
#pragma unroll
        for (int i = 0; i < 4; ++i) { const int t = t0 + i * WPB; if (t >= SEQ) continue; const int m = bq * SEQ + t; const Row16& cur = rw4[i];
        f32x4 v[4];
#pragma unroll
        for (int j = 0; j < 4; ++j) {
            const f32x4 ya = {hlo(cur.a[j].x), hhi(cur.a[j].x), hlo(cur.a[j].y), hhi(cur.a[j].y)}, yc = {hlo(cur.c[j].x), hhi(cur.c[j].x), hlo(cur.c[j].y), hhi(cur.c[j].y)};
            const f32x4 x3 = (cvt4(cur.x[j]) - q.psh[j]) * q.rdiv[j];
            v[j] = DN_ALPHA * x3 + q.gate1[j] * (cur.w1 * ya + cur.w2 * yc); }
        ln_rows_v(v, q);
#pragma unroll
        for (int j = 0; j < 4; ++j) *(f32x4*)(F.out + (size_t)m * D + 4 * lane + 256 * j) = v[j];
        }
    }
}

struct Args { const float* in[39]; float* out; unsigned char* ws; int ph_lo, ph_hi; };
__global__ void __launch_bounds__(NWAVES * 64, 2) mk_fwd(Args args) {
    extern __shared__ __attribute__((aligned(16))) unsigned char lds[];
    Frame F;
    F.lds = (LAS unsigned char*)lds;
    F.MISC = (volatile LAS unsigned*)(F.lds + MISC_OFF);
    F.tid = threadIdx.x; F.lane = F.tid & 63; F.wave = __builtin_amdgcn_readfirstlane(F.tid >> 6);
    F.G = gridDim.x; { const int bx = blockIdx.x; F.vcu = (F.G % 8 == 0) ? (bx % 8) * (F.G / 8) + bx / 8 : bx; }
    F.ws = args.ws; F.out = args.out; F.ctl = (gu32*)(args.ws + WS_CTL);
#pragma unroll
    for (int i = 0; i < 39; ++i) F.in[i] = args.in[i];
    for (int u = F.tid; u < (LDS_BYTES - LDSCTL_OFF) / 4; u += NWAVES * 64) ((LAS unsigned*)(F.lds + LDSCTL_OFF))[u] = 0u;
    __syncthreads();
    XcdBarrier bar; bar.bar = (unsigned*)(F.ctl + CW_BAR); bar.x = 0; bar.st = nullptr;
    if (N_LAUNCHES == 1) bar = xcd_barrier_post((unsigned*)(F.ctl + CW_BAR), F.MISC + 8);
    const int lo = args.ph_lo, hi = args.ph_hi;
    unsigned char* ws = args.ws;
    const float* mod0 = (const float*)(ws + WS_MOD); const float* mod1 = mod0 + (size_t)BATCH * 6 * D;
#ifndef PH_MASK
#define PH_MASK 0x1ffff
#endif
#define IN(k) (((PH_MASK >> (k)) & 1) && lo <= (k) && (k) < hi)
#define SEAM(k) do { if (N_LAUNCHES == 1 && IN(k) && IN((k) + 1)) xcd_barrier(bar); } while (0)

    if (IN(0)) { ph0_mods(F); SEAM(0); }
    if (IN(1)) { ph1_prologue(F); SEAM(1); }
    if (IN(2)) {
        pg8::Gemm g{(const h16*)(ws + WS_B), (const h16*)(ws + WS_W_IN), M, 3 * D, D}; pg8::StaticOrder S; S.init(M, 3 * D, F.G, (int)blockIdx.x);
        pg8::EpiQKV E{(h16*)(ws + WS_A), (h16*)(ws + WS_KA), (h16*)(ws + WS_KB1), (h16*)(ws + WS_KB4), (h16*)(ws + WS_KB16), (unsigned*)(F.ctl + CW_KMAX), QSCALE_A, QSCALE_B};
        pg8::gemm_phase<pg8::EpiQKV, pg8::StaticOrder, true, true>(F.lds + RING_OFF, g, S, E);
        SEAM(2);
    }
    if (IN(4)) { ph4_diff_mfma(F); dil_pass<0>(F); dil_pass<1>(F);
        __syncthreads(); ssm_prep(F);
        xcd_barrier(bar); dil_pass<2>(F); SEAM(4); }
    if (IN(5)) {
        pg8::Gemm g{(const h16*)(ws + WS_B), (const h16*)(ws + WS_W_OUT), M, D, D}; pg8::StaticOrder S; S.init(M, D, F.G, (int)blockIdx.x);
        pg8::EpiF16 E{(h16*)(ws + WS_C), D, 4, 0.f, 0.f};
        pg8::gemm_phase<pg8::EpiF16, pg8::StaticOrder, true, true>(F.lds + RING_OFF, g, S, E);
        SEAM(5);
    }
    if (IN(6)) {
        ph_rows<true>(F, F.in[I_X], (const h16*)(ws + WS_B), mod0, mod0, (const h16*)(ws + WS_C), mod0 + 2 * D, F.in[I_LN1G0], F.in[I_LN1B0], mod0 + 4 * D, mod0 + 3 * D, (h16*)(ws + WS_B));
        SEAM(6);
    }
    if (IN(7)) {
        pg8::Gemm g{(const h16*)(ws + WS_B), (const h16*)(ws + WS_W_F1), M, 2 * DFF, D}; pg8::StaticOrder S; S.init(M, 2 * DFF, F.G, (int)blockIdx.x);
        pg8::EpiGated<0> E{(h16*)(ws + WS_A), DFF, 22, nullptr};
        pg8::gemm_phase<pg8::EpiGated<0>, pg8::StaticOrder, true, true>(F.lds + RING_OFF, g, S, E);
        SEAM(7);
    }
    if (IN(8)) {
        pg8::Gemm g{(const h16*)(ws + WS_A), (const h16*)(ws + WS_W_F2), M, D, DFF}; pg8::StaticOrder S; S.init(M, D, F.G, (int)blockIdx.x);
        pg8::EpiF16 E{(h16*)(ws + WS_C), D, 4, 0.f, 0.f};
        pg8::gemm_phase<pg8::EpiF16, pg8::StaticOrder, true, true>(F.lds + RING_OFF, g, S, E);
        SEAM(8);
    }
    if (IN(9)) {
        ph_rows<false>(F, nullptr, (const h16*)(ws + WS_B), mod0 + 4 * D, mod0 + 3 * D, (const h16*)(ws + WS_C), mod0 + 5 * D, F.in[I_LN2G0], F.in[I_LN2B0], mod1 + 1 * D, mod1 + 0 * D, (h16*)(ws + WS_B));
        SEAM(9);
    }
    if (IN(10)) { ph10_ssm_mfma(F); SEAM(10); }
    if (IN(11)) {
        pg8::Gemm g{(const h16*)(ws + WS_C), (const h16*)(ws + WS_W_GLU), M, 2 * D, D}; pg8::StaticOrder S; S.init(M, 2 * D, F.G, (int)blockIdx.x);
        pg8::EpiGated<1> E{(h16*)(ws + WS_A), D, 8, F.in[I_BGLU]};
        pg8::gemm_phase<pg8::EpiGated<1>, pg8::StaticOrder, true, true>(F.lds + RING_OFF, g, S, E);
        SEAM(11);
    }
    if (IN(12)) { ph12_rows_route(F); SEAM(12); }
    if (IN(13)) { ph13_gather(F); SEAM(13); }
    if (IN(14)) {
        pg8::MoeOrder S; moe_prefix(F, S.tp); S.nN = 11; S.G = F.G; S.c = (int)blockIdx.x;
        pg8::Gemm g{(const h16*)(ws + WS_B), (const h16*)(ws + WS_W_E1), 0, 2 * DFE, D};
        pg8::EpiGated<0> E{(h16*)(ws + WS_A), DFE, 11, nullptr};
        pg8::gemm_phase<pg8::EpiGated<0>, pg8::MoeOrder, true, true>(F.lds + RING_OFF, g, S, E);
        SEAM(14);
    }
    if (IN(15)) {
        pg8::MoeOrder S; moe_prefix(F, S.tp); S.nN = 4; S.G = F.G; S.c = (int)blockIdx.x;
        pg8::Gemm g{(const h16*)(ws + WS_A), (const h16*)(ws + WS_W_E2), 0, D, DFE};
        pg8::EpiF16 E{(h16*)(ws + WS_B), D, 4, 0.f, 0.f};
        pg8::gemm_phase<pg8::EpiF16, pg8::MoeOrder, true, true>(F.lds + RING_OFF, g, S, E);
        SEAM(15);
    }
    if (IN(16)) { ph16_final(F); }
#undef IN
#undef SEAM
}

extern "C" void kernel_launch(void* const* d_in, const int* in_sizes, int n_in, void* d_out, int out_size, void* d_ws, size_t ws_size, hipStream_t stream) {
    static int grid = 0;
    if (grid == 0) {
        if (n_in != 39 || in_sizes[0] != M * D || out_size != M * D || ws_size < WS_END) { fprintf(stderr, "kernel_launch: unexpected problem shape (n_in %d, in0 %d, out %d, ws %zu)\n", n_in, n_in > 0 ? in_sizes[0] : -1, out_size, ws_size); grid = -1; return; }
        int dev = 0, cus = 0, per_cu = 0;
        if (hipGetDevice(&dev) != hipSuccess || hipDeviceGetAttribute(&cus, hipDeviceAttributeMultiprocessorCount, dev) != hipSuccess) { grid = -1; return; }
        if (hipFuncSetAttribute((const void*)mk_fwd, hipFuncAttributeMaxDynamicSharedMemorySize, LDS_BYTES) != hipSuccess) { fprintf(stderr, "kernel_launch: hipFuncSetAttribute failed\n"); grid = -1; return; }
        if (hipOccupancyMaxActiveBlocksPerMultiprocessor(&per_cu, (const void*)mk_fwd, NWAVES * 64, LDS_BYTES) != hipSuccess || per_cu < 1) { fprintf(stderr, "kernel_launch: occupancy query says %d\n", per_cu); }
        (void)hipGetLastError();
        grid = cus;
    }
    if (grid < 0) return;
    if (hipMemsetAsync((char*)d_ws + WS_CTL, 0, CTL_ZERO_BYTES, stream) != hipSuccess) return;
    Args a{};
    for (int i = 0; i < 39; ++i) a.in[i] = (const float*)d_in[i];
    a.out = (float*)d_out; a.ws = (unsigned char*)d_ws;
    for (int li = 0; li < N_LAUNCHES; ++li) {
        a.ph_lo = (N_LAUNCHES == 1) ? 0 : li; a.ph_hi = (N_LAUNCHES == 1) ? NPH : li + 1;
        hipLaunchKernelGGL(mk_fwd, dim3(grid), dim3(NWAVES * 64), LDS_BYTES, stream, a);
        if (hipPeekAtLastError() != hipSuccess) { fprintf(stderr, "kernel_launch: launch %d failed\n", li); break; }
    }
}
```

```cpp
#include <hip/hip_runtime.h>
#include <cstdio>
#include <cstdint>

#ifndef MK_N_LAUNCHES
#define MK_N_LAUNCHES 1
#endif

namespace pg8 {
#define PG8_LAS __attribute__((address_space(3)))
typedef unsigned short h16_t;
typedef _Float16 f16x8 __attribute__((ext_vector_type(8)));
typedef _Float16 f16x2 __attribute__((ext_vector_type(2)));
typedef float f32x4 __attribute__((ext_vector_type(4)));
typedef float f32x16 __attribute__((ext_vector_type(16)));
typedef unsigned u32x4 __attribute__((ext_vector_type(4)));
constexpr int BM = 256, BK = 64, HALF = 128, HTB = HALF * BK * 2  , STAGE_BYTES = 8 * HTB, NXCD = 8, WGM = 8;

__host__ __device__ __forceinline__ int lds_byte(int r, int c) { const int st = (r >> 4) * 2 + (c >> 5), rr = r & 15, cc = c & 31, ob = rr * 64 + cc * 2; return st * 1024 + (ob ^ (((ob >> 9) & 1) << 5)); }
__host__ __device__ __forceinline__ void stage_rc(int b, int& R, int& C) { const int st = b / 1024, sb = b % 1024, swz = sb ^ (((sb >> 9) & 1) << 5); R = (st >> 1) * 16 + swz / 64; C = (st & 1) * 32 + (swz % 64) / 2; }
__host__ __device__ __forceinline__ int perm32(int rho) { const int n = rho >> 4, i = rho & 15; return 8 * (i >> 2) + 4 * n + (i & 3); }

struct Unit { int pm, pn; };
struct Gemm { const h16_t* A; const h16_t* Bt; int M, N, K; };

struct StaticOrder {
    int nM, nN, nwg, G, c;
    __host__ __device__ void init(int M, int N, int G_, int c_) { nM = M / BM; nN = N / BM; nwg = nM * nN; G = G_; c = c_; }
    __host__ __device__ bool next(int i, Unit& u) const {
        const long L = (long)i * G + c; if (L >= nwg) return false;
        int wgid = (int)L; { const int q = nwg / NXCD, r = nwg % NXCD, xcd = wgid % NXCD, off = wgid / NXCD; wgid = (xcd < r ? xcd * (q + 1) : r * (q + 1) + (xcd - r) * q) + off; }
        const int nig = WGM * nN, gid = wgid / nig, fm = gid * WGM, gsz = (nM - fm) < WGM ? (nM - fm) : WGM;
        u.pm = fm + ((wgid % nig) % gsz); u.pn = (wgid % nig) / gsz; return true;
    }
    __device__ __forceinline__ void a_ready(const Unit&) const {}
    __device__ __forceinline__ void done(const Unit&) const {}
};
struct MoeOrder {
    int tp[9]; int nN, G, c;
    __device__ bool next(int i, Unit& u) const {
        const long L = (long)i * G + c; const int nM = tp[8], nwg = nM * nN; if (L >= nwg) return false;
        int wgid = (int)L; { const int q = nwg / NXCD, r = nwg % NXCD, xcd = wgid % NXCD, off = wgid / NXCD; wgid = (xcd < r ? xcd * (q + 1) : r * (q + 1) + (xcd - r) * q) + off; }
        const int nig = WGM * nN, gid = wgid / nig, fm = gid * WGM, gsz = (nM - fm) < WGM ? (nM - fm) : WGM;
        const int rt = fm + ((wgid % nig) % gsz), cn = (wgid % nig) / gsz; int e = 0;
#pragma unroll
        for (int k = 1; k < 8; ++k) e += (rt >= tp[k]) ? 1 : 0;
        u.pm = rt; u.pn = e * nN + cn; return true;
    }
    __device__ __forceinline__ void a_ready(const Unit&) const {}
    __device__ __forceinline__ void done(const Unit&) const {}
};

__device__ __forceinline__ unsigned pk2h(float lo, float hi) { f16x2 v = {(_Float16)lo, (_Float16)hi}; return __builtin_bit_cast(unsigned, v); }
typedef int i32x4 __attribute__((ext_vector_type(4)));
typedef int i32x8 __attribute__((ext_vector_type(8)));
__device__ __forceinline__ unsigned pk4f8(float a, float b, float c, float d) {
    a = __builtin_amdgcn_fmed3f(a, -448.f, 448.f); b = __builtin_amdgcn_fmed3f(b, -448.f, 448.f); c = __builtin_amdgcn_fmed3f(c, -448.f, 448.f); d = __builtin_amdgcn_fmed3f(d, -448.f, 448.f);
    int w = __builtin_amdgcn_cvt_pk_fp8_f32(a, b, 0, false); w = __builtin_amdgcn_cvt_pk_fp8_f32(c, d, w, true); return (unsigned)w;
}
__device__ __forceinline__ float fast_sigmoid(float v) { return __builtin_amdgcn_rcpf(1.0f + __builtin_amdgcn_exp2f(-1.4426950408889634f * v)); }

struct EpiF16 {
    static constexpr bool PERM = true, AFTER_DRAIN = false;
    h16_t* O; int ldc; int nmod; float sA; float sB;
    __device__ __forceinline__ void operator()(const f32x4 (&acc)[2][2][4][2], const Unit& u, int wr, int wc, int fr, int fq) const {
        const int row0 = u.pm * BM + wr * 64 + fr; const int pn = u.pn % nmod;
        float sc = 1.f; if (sA != 0.f) { if (pn < 2) sc = sA; else if (pn == 6 || pn == 7) sc = sB; }
        const int col0 = pn * BM + wc * 32 + 8 * fq;
#pragma unroll
        for (int ai = 0; ai < 2; ++ai)
#pragma unroll
            for (int m = 0; m < 4; ++m) { h16_t* rowp = O + (size_t)(row0 + ai * HALF + m * 16) * ldc + col0;
#pragma unroll
                for (int bj = 0; bj < 2; ++bj) { const f32x4 v0 = acc[ai][bj][m][0] * sc, v1 = acc[ai][bj][m][1] * sc;
                    u32x4 w; w.x = pk2h(v0[0], v0[1]); w.y = pk2h(v0[2], v0[3]); w.z = pk2h(v1[0], v1[1]); w.w = pk2h(v1[2], v1[3]);
                    *(u32x4*)(rowp + bj * HALF) = w; } }
    }
};

struct EpiQKV {
    static constexpr bool PERM = true, AFTER_DRAIN = false;
    h16_t* O; h16_t* KA; h16_t* KB1; h16_t* KB4; h16_t* KB16; unsigned* kmax; float sA, sB;
    __device__ __forceinline__ static int pi32(int r) { return (r & 0x13) | ((r & 4) << 1) | ((r & 8) >> 1); }
    __device__ __forceinline__ void operator()(const f32x4 (&acc)[2][2][4][2], const Unit& u, int wr, int wc, int fr, int fq) const {
        const int row0 = u.pm * BM + wr * 64 + fr, pn = u.pn;
        const bool isKA = (pn == 2 || pn == 3), isKB = (pn == 8 || pn == 9);
        if (!isKA && !isKB) {
            const float sc = (pn < 2) ? sA : (pn == 6 || pn == 7) ? sB : 1.0f;
            const int col0 = pn * BM + wc * 32 + 8 * fq;
#pragma unroll
            for (int ai = 0; ai < 2; ++ai)
#pragma unroll
                for (int m = 0; m < 4; ++m) { h16_t* rowp = O + (size_t)(row0 + ai * HALF + m * 16) * 3072 + col0;
#pragma unroll
                    for (int bj = 0; bj < 2; ++bj) { const f32x4 v0 = acc[ai][bj][m][0] * sc, v1 = acc[ai][bj][m][1] * sc;
                        u32x4 w; w.x = pk2h(v0[0], v0[1]); w.y = pk2h(v0[2], v0[3]); w.z = pk2h(v1[0], v1[1]); w.w = pk2h(v1[2], v1[3]);
                        *(u32x4*)(rowp + bj * HALF) = w; } }
            return;
        }
        const int b = u.pm >> 4;
        float mx[2] = {0.f, 0.f};
#pragma unroll
        for (int ai = 0; ai < 2; ++ai)
#pragma unroll
            for (int m = 0; m < 4; ++m) { const int t = (row0 + ai * HALF + m * 16) & 4095;
#pragma unroll
                for (int bj = 0; bj < 2; ++bj) { const f32x4 v0 = acc[ai][bj][m][0], v1 = acc[ai][bj][m][1];
                    u32x4 w; w.x = pk2h(v0[0], v0[1]); w.y = pk2h(v0[2], v0[3]); w.z = pk2h(v1[0], v1[1]); w.w = pk2h(v1[2], v1[3]);
                    const int cs = (pn & 1) * 256 + bj * HALF + wc * 32 + 8 * fq, h = cs >> 6, c8 = (cs & 63) >> 3, bh = b * 8 + h;
                    if (isKA) {
                        const int frag = (c8 >> 2) * 2 + ((c8 >> 1) & 1), hi = c8 & 1;
                        *(u32x4*)(KA + ((size_t)((bh * 128 + (t >> 5)) * 4 + frag) * 64 + hi * 32 + pi32(t & 31)) * 8) = w;
                        float q2 = (v0[0] * v0[0] + v0[1] * v0[1]) + (v0[2] * v0[2] + v0[3] * v0[3]) + (v1[0] * v1[0] + v1[1] * v1[1]) + (v1[2] * v1[2] + v1[3] * v1[3]);
                        q2 += __shfl_xor(q2, 16); q2 += __shfl_xor(q2, 32);
                        mx[bj] = fmaxf(mx[bj], q2);
                    } else {
                        const int sl = c8 >> 1, hi = c8 & 1;
                        { const int uu = t >> 5, r = t & 31; *(u32x4*)(KB1 + ((size_t)((bh * 128 + uu) * 4 + sl) * 64 + hi * 32 + pi32(r)) * 8) = w; }
                        { const int i = t >> 2, uu = (t & 3) * 32 + (i >> 5), r = i & 31; *(u32x4*)(KB4 + ((size_t)((bh * 128 + uu) * 4 + sl) * 64 + hi * 32 + pi32(r)) * 8) = w; }
                        { const int i = t >> 4, uu = (t & 15) * 8 + (i >> 5), r = i & 31; *(u32x4*)(KB16 + ((size_t)((bh * 128 + uu) * 4 + sl) * 64 + hi * 32 + pi32(r)) * 8) = w; }
                    } } }
        if (isKA) {
#pragma unroll
            for (int bj = 0; bj < 2; ++bj) { float v = mx[bj];
                v = fmaxf(v, __shfl_xor(v, 1)); v = fmaxf(v, __shfl_xor(v, 2)); v = fmaxf(v, __shfl_xor(v, 4)); v = fmaxf(v, __shfl_xor(v, 8));
                const int cs = (pn & 1) * 256 + bj * HALF + wc * 32;
                if ((threadIdx.x & 63) == 0) __hip_atomic_fetch_max(kmax + (b * 8 + (cs >> 6)) * 2 + ((cs >> 5) & 1), __float_as_uint(v * 1.002f), __ATOMIC_RELAXED, __HIP_MEMORY_SCOPE_AGENT); }
        }
    }
};

template <int MODE> struct EpiGated {
    static constexpr bool PERM = true, AFTER_DRAIN = false;
    h16_t* O; int ldc; int nmod; const float* bias;
    __device__ __forceinline__ void operator()(const f32x4 (&acc)[2][2][4][2], const Unit& u, int wr, int wc, int fr, int fq) const {
        const int row0 = u.pm * BM + wr * 64 + fr; const int pn = u.pn % nmod;
        const int col0 = pn * HALF + wc * 32 + 8 * fq;
        f32x4 ba[2], bb[2];
#pragma unroll
        for (int n = 0; n < 2; ++n) { if (MODE == 1) { ba[n] = *(const f32x4*)(bias + col0 + 4 * n); bb[n] = *(const f32x4*)(bias + 1024 + col0 + 4 * n); } else { ba[n] = (f32x4){0.f, 0.f, 0.f, 0.f}; bb[n] = ba[n]; } }
#pragma unroll
        for (int ai = 0; ai < 2; ++ai)
#pragma unroll
            for (int m = 0; m < 4; ++m) { h16_t* rowp = O + (size_t)(row0 + ai * HALF + m * 16) * ldc + col0;
                float r[8];
#pragma unroll
                for (int n = 0; n < 2; ++n)
#pragma unroll
                    for (int e = 0; e < 4; ++e) { const float a = acc[ai][0][m][n][e] + ba[n][e], b = acc[ai][1][m][n][e] + bb[n][e];
                        r[4 * n + e] = (MODE == 0) ? (a * fast_sigmoid(a)) * b : a * fast_sigmoid(b); }
                u32x4 w; w.x = pk2h(r[0], r[1]); w.y = pk2h(r[2], r[3]); w.z = pk2h(r[4], r[5]); w.w = pk2h(r[6], r[7]);
                *(u32x4*)rowp = w; }
    }
};

struct EpiF16S {
    static constexpr bool PERM = true, AFTER_DRAIN = false;
    h16_t* O; int ldc; int nmod; float s;
    __device__ __forceinline__ void operator()(const f32x4 (&acc)[2][2][4][2], const Unit& u, int wr, int wc, int fr, int fq) const {
        const int row0 = u.pm * BM + wr * 64 + fr; const int pn = u.pn % nmod;
        const int col0 = pn * BM + wc * 32 + 8 * fq;
#pragma unroll
        for (int ai = 0; ai < 2; ++ai)
#pragma unroll
            for (int m = 0; m < 4; ++m) { h16_t* rowp = O + (size_t)(row0 + ai * HALF + m * 16) * ldc + col0;
#pragma unroll
                for (int bj = 0; bj < 2; ++bj) { const f32x4 v0 = acc[ai][bj][m][0] * s, v1 = acc[ai][bj][m][1] * s;
                    u32x4 w; w.x = pk2h(v0[0], v0[1]); w.y = pk2h(v0[2], v0[3]); w.z = pk2h(v1[0], v1[1]); w.w = pk2h(v1[2], v1[3]);
                    *(u32x4*)(rowp + bj * HALF) = w; } }
    }
};
template <int MODE, bool PADLAST> struct EpiGated8 {
    static constexpr bool PERM = true, AFTER_DRAIN = false;
    unsigned char* O; int ldc; int nmod; const float* bias; float sin, so;
    __device__ __forceinline__ void operator()(const f32x4 (&acc)[2][2][4][2], const Unit& u, int wr, int wc, int fr, int fq) const {
        const int row0 = u.pm * BM + wr * 64 + fr; const int pn = u.pn % nmod;
        const int col0 = pn * HALF + wc * 32 + 8 * fq;
        f32x4 ba[2], bb[2];
#pragma unroll
        for (int n = 0; n < 2; ++n) { if (MODE == 1) { ba[n] = *(const f32x4*)(bias + col0 + 4 * n); bb[n] = *(const f32x4*)(bias + 1024 + col0 + 4 * n); } else { ba[n] = (f32x4){0.f, 0.f, 0.f, 0.f}; bb[n] = ba[n]; } }
#pragma unroll
        for (int ai = 0; ai < 2; ++ai)
#pragma unroll
            for (int m = 0; m < 4; ++m) { unsigned char* rowp = O + (size_t)(row0 + ai * HALF + m * 16) * ldc + col0;
                float r[8];
#pragma unroll
                for (int n = 0; n < 2; ++n)
#pragma unroll
                    for (int e = 0; e < 4; ++e) { const float a = acc[ai][0][m][n][e] * sin + ba[n][e], b = acc[ai][1][m][n][e] * sin + bb[n][e];
                        r[4 * n + e] = (MODE == 0) ? (a * fast_sigmoid(a)) * (b * so) : (a * so) * fast_sigmoid(b); }
                typedef unsigned u32x2 __attribute__((ext_vector_type(2)));
                u32x2 w; w.x = pk4f8(r[0], r[1], r[2], r[3]); w.y = pk4f8(r[4], r[5], r[6], r[7]);
                *(u32x2*)rowp = w;
                if (PADLAST) { if (pn == nmod - 1) *(u32x2*)(rowp + HALF) = (u32x2){0u, 0u}; } }
    }
};

template <class Epi, class Sched, bool ALIGN_EPI = false, bool SP2 = false, bool F8 = false>
__device__ __forceinline__ void gemm_phase(PG8_LAS unsigned char* lds, const Gemm g, const Sched& S, const Epi& E) {
    const int tid = threadIdx.x, wid = __builtin_amdgcn_readfirstlane(tid >> 6), lane = tid & 63, wr = wid >> 2, wc = wid & 3, fr = lane & 15, fq = lane >> 4;
    const int K = g.K, nt = K / BK;
    unsigned voffA[2], voffB[2];
#pragma unroll
    for (int i = 0; i < 2; ++i) { int R, C; stage_rc(tid * 16 + i * 8192, R, C); const int Rb = Epi::PERM ? ((R & ~31) + perm32(R & 31)) : R;
        voffA[i] = (unsigned)(R * K + C) * 2u; voffB[i] = (unsigned)(Rb * K + C) * 2u; }
    const size_t kstep = (size_t)(BK * 2);
    const size_t hstep = (size_t)HALF * K * 2;
    const size_t qstep = (size_t)64 * K * 2;
    const size_t tstep = 2 * hstep;
    const unsigned ldsw = (unsigned)wid * 1024u;
    const int aoff = lds_byte(wr * 64 + fr, fq * 8); int boff = lds_byte(wc * 32 + fr, fq * 8);
    if constexpr (F8) { boff += 4 * HTB; asm volatile("" : "+v"(boff)); }
#define PG8_SA(b, h) (((b) * 2 + (h)) * HTB)
#define PG8_SB(b, h) ((4 + (b) * 2 + (h)) * HTB)
#define PG8_SBR(b, h) ((F8 ? 0 : 4 * HTB) + ((b) * 2 + (h)) * HTB)
#define PG8_STAGE(bufoff, gbase, voff) do { _Pragma("unroll") for (int _i = 0; _i < 2; ++_i) { \
        if constexpr (F8) __builtin_amdgcn_global_load_lds((const unsigned*)((const char*)(gbase) + (size_t)_i * qstep + (voff)[0]), (PG8_LAS unsigned*)(lds + (bufoff) + ldsw + _i * 8192), 16, 0, 0); \
        else __builtin_amdgcn_global_load_lds((const unsigned*)((const char*)(gbase) + (voff)[_i]), (PG8_LAS unsigned*)(lds + (bufoff) + ldsw + _i * 8192), 16, 0, 0); } } while (0)
#define PG8_LD8(off) __builtin_shufflevector(*(const PG8_LAS i32x4*)(lds + (off)), *(const PG8_LAS i32x4*)(lds + (off) + 1024), 0, 1, 2, 3, 4, 5, 6, 7)
#define PG8_LDA(dst, b, h) do { _Pragma("unroll") for (int m = 0; m < 4; ++m) { if constexpr (F8) dst##8[m] = PG8_LD8(PG8_SA(b, h) + aoff + m * 2048); \
        else { _Pragma("unroll") for (int k = 0; k < 2; ++k) dst[m][k] = *(const PG8_LAS f16x8*)(lds + PG8_SA(b, h) + aoff + m * 2048 + k * 1024); } } } while (0)
#define PG8_LDB(dst, b, h) do { _Pragma("unroll") for (int n = 0; n < 2; ++n) { if constexpr (F8) dst##8[n] = PG8_LD8(PG8_SBR(b, h) + boff + n * 2048); \
        else { _Pragma("unroll") for (int k = 0; k < 2; ++k) dst[n][k] = *(const PG8_LAS f16x8*)(lds + PG8_SBR(b, h) + boff + n * 2048 + k * 1024); } } } while (0)
#define PG8_MMA(ai, bj, At, Bt) do { __builtin_amdgcn_s_setprio(1); _Pragma("unroll") for (int m = 0; m < 4; ++m) _Pragma("unroll") for (int n = 0; n < 2; ++n) { \
        if constexpr (F8) { f32x4 c_ = {acc16[ai][bj][n][4 * m], acc16[ai][bj][n][4 * m + 1], acc16[ai][bj][n][4 * m + 2], acc16[ai][bj][n][4 * m + 3]}; \
            c_ = __builtin_amdgcn_mfma_scale_f32_16x16x128_f8f6f4(Bt##8[n], At##8[m], c_, 0, 0, 0, 0, 0, 0); \
            acc16[ai][bj][n][4 * m] = c_[0]; acc16[ai][bj][n][4 * m + 1] = c_[1]; acc16[ai][bj][n][4 * m + 2] = c_[2]; acc16[ai][bj][n][4 * m + 3] = c_[3]; } \
        else { _Pragma("unroll") for (int k = 0; k < 2; ++k) acc[ai][bj][m][n] = __builtin_amdgcn_mfma_f32_16x16x32_f16(Bt[n][k], At[m][k], acc[ai][bj][m][n], 0, 0, 0); } } \
        __builtin_amdgcn_s_setprio(0); } while (0)
#define PG8_WAIT_V(n) asm volatile("s_waitcnt vmcnt(" #n ")" ::: "memory")
#define PG8_WAIT_L(n) asm volatile("s_waitcnt lgkmcnt(" #n ")" ::: "memory")
#define PG8_BAR __builtin_amdgcn_s_barrier()
#define PG8_SCHED __builtin_amdgcn_sched_barrier(0)
    Unit cur, nxt; int ui = 0;
    if (!S.next(0, cur)) return;
    f32x4 acc[2][2][4][2]; f32x16 acc16[2][2][2];
#define PG8_ZERO_ACC do { _Pragma("unroll") for (int a = 0; a < 2; ++a) _Pragma("unroll") for (int b = 0; b < 2; ++b) { \
        if constexpr (F8) { _Pragma("unroll") for (int n = 0; n < 2; ++n) _Pragma("unroll") for (int r = 0; r < 16; ++r) acc16[a][b][n][r] = 0.f; } \
        else { _Pragma("unroll") for (int m = 0; m < 4; ++m) _Pragma("unroll") for (int n = 0; n < 2; ++n) acc[a][b][m][n] = (f32x4){0.f, 0.f, 0.f, 0.f}; } } } while (0)
    PG8_ZERO_ACC;
    f16x8 At[4][2], B0[2][2], B1[2][2]; i32x8 At8[4], B08[2], B18[2];
    const char* cA = (const char*)g.A + (size_t)cur.pm * tstep; const char* cB = (const char*)g.Bt + (size_t)cur.pn * tstep;
    S.a_ready(cur);
    if constexpr (SP2) {
        PG8_STAGE(PG8_SB(0, 0), cB, voffB); PG8_STAGE(PG8_SB(0, 1), cB + hstep, voffB); PG8_STAGE(PG8_SA(0, 0), cA, voffA); PG8_STAGE(PG8_SA(0, 1), cA + hstep, voffA);
        if (wr == 1) PG8_BAR;
        PG8_WAIT_V(2); PG8_BAR;
        PG8_STAGE(PG8_SB(1, 0), cB + kstep, voffB); PG8_STAGE(PG8_SA(1, 0), cA + kstep, voffA); PG8_STAGE(PG8_SB(1, 1), cB + hstep + kstep, voffB);
        PG8_WAIT_V(6); PG8_BAR;
    } else {
        PG8_STAGE(PG8_SB(0, 0), cB, voffB); PG8_STAGE(PG8_SA(0, 0), cA, voffA); PG8_STAGE(PG8_SB(0, 1), cB + hstep, voffB); PG8_STAGE(PG8_SA(0, 1), cA + hstep, voffA);
        if (wr == 1) PG8_BAR;
        PG8_WAIT_V(4); PG8_BAR;
        PG8_STAGE(PG8_SB(1, 0), cB + kstep, voffB); PG8_STAGE(PG8_SA(1, 0), cA + kstep, voffA); PG8_STAGE(PG8_SB(1, 1), cB + hstep + kstep, voffB);
        PG8_WAIT_V(6); PG8_BAR;
    }
    for (;;) {
        const bool has_next = S.next(ui + 1, nxt);
        const char* nA = has_next ? (const char*)g.A + (size_t)nxt.pm * tstep : cA; const char* nB = has_next ? (const char*)g.Bt + (size_t)nxt.pn * tstep : cB;
        for (int t = 0; t < nt; t += 2) {
            const bool last = (t == nt - 2);
            const char* a1 = cA + (size_t)(t + 1) * kstep;
            const char* a2 = last ? nA : cA + (size_t)(t + 2) * kstep; const char* b2 = last ? nB : cB + (size_t)(t + 2) * kstep;
            const char* a3 = a2 + kstep; const char* b3 = b2 + kstep;
            if (last && has_next) S.a_ready(nxt);
            if constexpr (SP2) {
            PG8_LDB(B0, 0, 0); PG8_LDB(B1, 0, 1); PG8_SCHED; PG8_LDA(At, 0, 0); PG8_STAGE(PG8_SA(1, 1), a1 + hstep, voffA);
            PG8_WAIT_V(8); PG8_WAIT_L(0); PG8_BAR; PG8_MMA(0, 0, At, B0); PG8_MMA(0, 1, At, B1); PG8_BAR; PG8_SCHED;
            PG8_LDA(At, 0, 1); PG8_STAGE(PG8_SB(0, 0), b2, voffB); PG8_STAGE(PG8_SB(0, 1), b2 + hstep, voffB); PG8_STAGE(PG8_SA(0, 0), a2, voffA);
            PG8_WAIT_V(8); PG8_WAIT_L(0); PG8_BAR; PG8_MMA(1, 0, At, B0); PG8_MMA(1, 1, At, B1); PG8_BAR; PG8_SCHED;
            PG8_LDB(B0, 1, 0); PG8_LDB(B1, 1, 1); PG8_SCHED; PG8_LDA(At, 1, 0); PG8_STAGE(PG8_SA(0, 1), a2 + hstep, voffA);
            PG8_WAIT_V(8); PG8_WAIT_L(0); PG8_BAR; PG8_MMA(0, 0, At, B0); PG8_MMA(0, 1, At, B1); PG8_BAR; PG8_SCHED;
            PG8_LDA(At, 1, 1); PG8_STAGE(PG8_SB(1, 0), b3, voffB); PG8_STAGE(PG8_SB(1, 1), b3 + hstep, voffB); PG8_STAGE(PG8_SA(1, 0), a3, voffA);
            PG8_WAIT_V(8); PG8_WAIT_L(0); PG8_BAR; PG8_MMA(1, 0, At, B0); PG8_MMA(1, 1, At, B1); PG8_BAR; PG8_SCHED;
            } else {
            PG8_LDB(B0, 0, 0); PG8_SCHED; PG8_LDA(At, 0, 0); PG8_STAGE(PG8_SA(1, 1), a1 + hstep, voffA);
            PG8_WAIT_L(8); PG8_BAR; PG8_WAIT_L(0); PG8_MMA(0, 0, At, B0); PG8_BAR; PG8_SCHED;
            PG8_LDB(B1, 0, 1); PG8_STAGE(PG8_SB(0, 0), b2, voffB);
            PG8_BAR; PG8_WAIT_L(0); PG8_MMA(0, 1, At, B1); PG8_BAR;
            PG8_LDA(At, 0, 1); PG8_STAGE(PG8_SA(0, 0), a2, voffA);
            PG8_BAR; PG8_WAIT_L(0); PG8_MMA(1, 0, At, B0); PG8_BAR; PG8_SCHED;
            PG8_STAGE(PG8_SB(0, 1), b2 + hstep, voffB);
            PG8_WAIT_V(6); PG8_BAR; PG8_MMA(1, 1, At, B1); PG8_BAR;
            PG8_LDB(B0, 1, 0); PG8_SCHED; PG8_LDA(At, 1, 0); PG8_STAGE(PG8_SA(0, 1), a2 + hstep, voffA);
            PG8_WAIT_L(8); PG8_BAR; PG8_WAIT_L(0); PG8_MMA(0, 0, At, B0); PG8_BAR; PG8_SCHED;
            PG8_LDB(B1, 1, 1); PG8_STAGE(PG8_SB(1, 0), b3, voffB);
            PG8_BAR; PG8_WAIT_L(0); PG8_MMA(0, 1, At, B1); PG8_BAR;
            PG8_LDA(At, 1, 1); PG8_STAGE(PG8_SA(1, 0), a3, voffA);
            PG8_BAR; PG8_WAIT_L(0); PG8_MMA(1, 0, At, B0); PG8_BAR; PG8_SCHED;
            PG8_STAGE(PG8_SB(1, 1), b3 + hstep, voffB);
            PG8_WAIT_V(6); PG8_BAR; PG8_MMA(1, 1, At, B1); PG8_BAR;
            }
        }
        if constexpr (ALIGN_EPI) { if (wr == 0) PG8_BAR; }
        if constexpr (F8) {
#pragma unroll
            for (int a = 0; a < 2; ++a)
#pragma unroll
                for (int b = 0; b < 2; ++b)
#pragma unroll
                    for (int m = 0; m < 4; ++m)
#pragma unroll
                        for (int n = 0; n < 2; ++n) acc[a][b][m][n] = (f32x4){acc16[a][b][n][4 * m], acc16[a][b][n][4 * m + 1], acc16[a][b][n][4 * m + 2], acc16[a][b][n][4 * m + 3]};
        }
        if constexpr (!Epi::AFTER_DRAIN) { E(acc, cur, wr, wc, fr, fq); S.done(cur); }
        if (!has_next) break;
        PG8_ZERO_ACC;
        cur = nxt; cA = nA; cB = nB; ++ui;
        if constexpr (ALIGN_EPI) { if (wr == 1) PG8_BAR; }
    }
    PG8_WAIT_V(0);
    if constexpr (!ALIGN_EPI) { if (wr == 0) PG8_BAR; }
    PG8_BAR;
    if constexpr (Epi::AFTER_DRAIN) { E.fused(acc, cur, wr, wc, fr, fq, lds, wid, lane); S.done(cur); }
#undef PG8_SA
#undef PG8_SB
#undef PG8_SBR
#undef PG8_STAGE
#undef PG8_LDA
#undef PG8_LDB
#undef PG8_MMA
#undef PG8_ZERO_ACC
#undef PG8_LD8
#undef PG8_WAIT_V
#undef PG8_WAIT_L
#undef PG8_BAR
#undef PG8_SCHED
}
}

constexpr int NWAVES = 8;
constexpr int BATCH = 8, SEQ = 4096, D = 1024, M = BATCH * SEQ;
constexpr int DFF = 2816, NEXP = 8, DFE = 1408;
constexpr int NPH = 17;
constexpr int N_LAUNCHES = MK_N_LAUNCHES;
static_assert(N_LAUNCHES == 1, "one launch only (PH4 has an inner grid barrier)");
constexpr int DFE_PAD = 1536;
constexpr float S8_H = 8.0f, S8_HID = 8.0f, S8_WE1 = 512.0f, S8_WE2 = 1024.0f;
constexpr float LN_EPS = 1e-5f, LOG2E = 1.4426950408889634f, DN_ALPHA = 1.4142135623730951f;
constexpr float QSCALE_A = 0.17677669529663687f * LOG2E;
constexpr float QSCALE_B = 0.125f * LOG2E;

constexpr size_t MiB = 1u << 20;
constexpr size_t WS_CTL = 0, CTL_ZERO_BYTES = 1 * MiB;
constexpr size_t WS_MOD = 1 * MiB;
constexpr size_t WS_SSMA = 1 * MiB + 512 * 1024;
constexpr size_t WS_SSMB = WS_SSMA + 64 * 1024;
constexpr size_t WS_TOKE = 2 * MiB + 512 * 1024;
constexpr size_t WS_TOKG = WS_TOKE + 256 * 1024;
constexpr size_t WS_TOKP = WS_TOKG + 256 * 1024;
constexpr size_t WS_W_IN = 4 * MiB, WS_W_OUT = 10 * MiB, WS_W_F1 = 12 * MiB, WS_W_F2 = 23 * MiB, WS_W_GLU = 28 * MiB + 512 * 1024;
constexpr size_t WS_W_E1 = 32 * MiB + 512 * 1024, WS_W_E2 = 76 * MiB + 512 * 1024;
constexpr size_t WS_A = 100 * MiB, WS_B = 292 * MiB, WS_C = 356 * MiB, WS_VT1 = 424 * MiB, WS_END = 488 * MiB;
constexpr size_t WS_UG = 228 * MiB;
constexpr size_t WS_SSMM = 196 * MiB;
constexpr size_t WS_KA = 356 * MiB, WS_KB1 = 388 * MiB, WS_KB4 = 420 * MiB, WS_KB16 = 452 * MiB;
constexpr int MOE_MAX_TILES = 264;
static_assert(WS_W_E2 + (size_t)NEXP * D * DFE * 2 <= WS_A, "weights fit");
static_assert((size_t)MOE_MAX_TILES * 256 * DFE * 2 <= WS_B - WS_A, "hidden_g fits region A");
static_assert(WS_B + (size_t)MOE_MAX_TILES * 256 * D * 2 <= WS_VT1, "gathered rows fit");
constexpr int CW_TMO = 0, CW_CODE = 1;
constexpr int CW_ECNT = 64;
constexpr int CW_ECUR = 128;
constexpr int CW_UQ = 1024;
constexpr int CW_TQ = 192;
constexpr int CW_PREP = 512;
constexpr int CW_KMAX = 256;
constexpr int CW_BAR = 4096;

constexpr int RING_OFF = 0, RING_BYTES = 131072;
constexpr int LDSCTL_OFF = RING_BYTES + 1024, MISC_OFF = LDSCTL_OFF + 320;
constexpr int LDS_BYTES = 147456;

#define GAS __attribute__((address_space(1)))
#define LAS __attribute__((address_space(3)))
typedef unsigned short h16;
typedef unsigned v4u __attribute__((ext_vector_type(4)));
typedef unsigned v2u __attribute__((ext_vector_type(2)));
typedef float f32x4 __attribute__((ext_vector_type(4)));
typedef GAS unsigned gu32;
#define RLX_AGENT __ATOMIC_RELAXED, __HIP_MEMORY_SCOPE_AGENT
#define LDS_WAIT() asm volatile("s_waitcnt lgkmcnt(0)" ::: "memory")
#define VM_WAIT() asm volatile("s_waitcnt vmcnt(0)" ::: "memory")
using pg8::pk2h;
__device__ __forceinline__ float h2f(unsigned short v) { return (float)__builtin_bit_cast(_Float16, v); }
__device__ __forceinline__ float hlo(unsigned w) { return h2f((unsigned short)(w & 0xffffu)); }
__device__ __forceinline__ float hhi(unsigned w) { return h2f((unsigned short)(w >> 16)); }
#define DPPF_(x, ctrl, rm) __builtin_bit_cast(float, __builtin_amdgcn_update_dpp(0, __builtin_bit_cast(int, (x)), (ctrl), (rm), 0xf, false))
__device__ __forceinline__ float wave_sum(float v) {
    v += DPPF_(v, 0xb1, 0xf);
    v += DPPF_(v, 0x4e, 0xf);
    v += DPPF_(v, 0x124, 0xf);
    v += DPPF_(v, 0x128, 0xf);
    v += DPPF_(v, 0x142, 0xa);
    v += DPPF_(v, 0x143, 0xc);
    return __builtin_bit_cast(float, __builtin_amdgcn_readlane(__builtin_bit_cast(int, v), 63));
}
__device__ __forceinline__ float wave_max(float v) {
#pragma unroll
    for (int o = 1; o < 64; o <<= 1) v = fmaxf(v, __shfl_xor(v, o));
    return v;
}
__device__ __forceinline__ float ex2(float v) { return __builtin_amdgcn_exp2f(v); }
__device__ __forceinline__ float gelu_tanh(float v) {
    const float z = 0.7978845608028654f * (v + 0.044715f * v * v * v);
    const float e = ex2(2.0f * LOG2E * z);
    const float th = 1.0f - 2.0f * __builtin_amdgcn_rcpf(1.0f + e);
    return 0.5f * v * (1.0f + th);
}

#define XB_TMO      128
#define XB_XCNT(j)  (256  + 64 * (j))
#define XB_XSUB(j)  (1280 + 64 * (j))
#define XB_XGEN(j)  (2304 + 64 * (j))
#define XB_TOP      3328
#define XB_TOPGEN   3392
#define XCD_BAR_WORDS 3456
#define XB_SPIN_CAP (1u << 18)

__device__ __forceinline__ unsigned xb_ld(unsigned* p)              { return __hip_atomic_load(p, __ATOMIC_RELAXED, __HIP_MEMORY_SCOPE_AGENT); }
__device__ __forceinline__ unsigned xb_add(unsigned* p, unsigned v) { return __hip_atomic_fetch_add(p, v, __ATOMIC_RELAXED, __HIP_MEMORY_SCOPE_AGENT); }
__device__ __forceinline__ unsigned xb_xcc_id() { return (unsigned)__builtin_amdgcn_s_getreg((3 << 11) | 20) & 0xFu; }
#define XB_SPIN(cond, bar) do { unsigned _sp = 0; while (cond) { __builtin_amdgcn_s_sleep(1); \
    if ((++_sp & 255u) == 0u) { if (xb_ld(&(bar)[XB_TMO])) break; if (_sp > XB_SPIN_CAP) { atomicAdd(&(bar)[XB_TMO], 1u); break; } } } } while (0)

struct XcdBarrier {
    unsigned* bar; unsigned x;
    volatile LAS unsigned* st;
};

__device__ __forceinline__ XcdBarrier xcd_barrier_post(unsigned* bar, volatile LAS unsigned* st) {
    XcdBarrier b; b.bar = bar; b.x = xb_xcc_id(); b.st = st;
    if (threadIdx.x == 0) (void)xb_add(&bar[XB_XCNT(b.x)], 1u);
    return b;
}
__device__ __forceinline__ void xcd_barrier_complete(unsigned* bar, unsigned x, unsigned& nloc, unsigned& nx) {
    const unsigned G = gridDim.x * gridDim.y * gridDim.z;
    unsigned sum, cnt, mine, sp = 0u;
    for (;;) {
        sum = 0u; cnt = 0u; mine = 0u;
#pragma unroll
        for (unsigned j = 0; j < 16; ++j) { const unsigned c = xb_ld(&bar[XB_XCNT(j)]); sum += c; cnt += (c > 0u) ? 1u : 0u; mine = (j == x) ? c : mine; }
        if (sum == G) break;
        __builtin_amdgcn_s_sleep(1);
        if ((++sp & 255u) == 0u) { if (xb_ld(&bar[XB_TMO])) break; if (sp > XB_SPIN_CAP) { atomicAdd(&bar[XB_TMO], 1u); break; } }
    }
    nloc = mine > 0u ? mine : 1u; nx = cnt > 0u ? cnt : 1u;
}

__device__ __forceinline__ void xcd_barrier(const XcdBarrier& b) {
    asm volatile("s_waitcnt vmcnt(0)" ::: "memory");
    __syncthreads();
    if (threadIdx.x == 0) {
        unsigned* bar = b.bar;
        __builtin_amdgcn_s_waitcnt(0);
        unsigned nloc = b.st[0], nx = b.st[1];
        if (nloc == 0u) { xcd_barrier_complete(bar, b.x, nloc, nx); b.st[0] = nloc; b.st[1] = nx; }
        const unsigned old = xb_add(&bar[XB_XSUB(b.x)], 1u);
        const unsigned gen = old / nloc;
        if (old + 1u == (gen + 1u) * nloc) {
            __builtin_amdgcn_fence(__ATOMIC_RELEASE, "agent");
            asm volatile("s_waitcnt vmcnt(0)" ::: "memory");
            const unsigned og = xb_add(&bar[XB_TOP], 1u);
            const unsigned tg = og / nx;
            if (og + 1u == (tg + 1u) * nx) xb_add(&bar[XB_TOPGEN], 1u);
            else XB_SPIN(xb_ld(&bar[XB_TOPGEN]) == tg, bar);
            __builtin_amdgcn_fence(__ATOMIC_ACQUIRE, "agent");
            xb_add(&bar[XB_XGEN(b.x)], 1u);
            asm volatile("s_waitcnt vmcnt(0)" ::: "memory");
        } else {
            XB_SPIN(xb_ld(&bar[XB_XGEN(b.x)]) == gen, bar);
            __builtin_amdgcn_fence(__ATOMIC_ACQUIRE, "agent");
            asm volatile("s_waitcnt vmcnt(0)" ::: "memory");
        }
    }
    __syncthreads();
}

struct Frame {
    LAS unsigned char* lds;
    volatile LAS unsigned* MISC;
    gu32* ctl;
    int tid, lane, wave;
    int vcu, G;
    const float* in[39]; float* out; unsigned char* ws;
};
enum { I_X = 0, I_C, I_ADAW0, I_ADAB0, I_WIN, I_LQ1, I_LK1, I_LQ2, I_LK2, I_SUBLN, I_WOUT, I_LN1G0, I_LN1B0, I_FG, I_FU, I_FD, I_LN2G0, I_LN2B0,
       I_ADAW1, I_ADAB1, I_ARE, I_AIM, I_LOGDT, I_BRE, I_BIM, I_CRE, I_CIM, I_DSKIP, I_WGLU, I_BGLU, I_LN1G1, I_LN1B1, I_RW, I_RB, I_EG, I_EU, I_ED, I_LN2G1, I_LN2B1 };

__device__ __forceinline__ void ph0_mods(Frame& F) {
    LAS float* sc = (LAS float*)(F.lds);
    LAS float* part = (LAS float*)(F.lds + 32768);
    float* mod = (float*)(F.ws + WS_MOD);
    if ((int)blockIdx.x < 192) {
        const float* c = F.in[I_C];
        for (int i = F.tid; i < BATCH * D; i += NWAVES * 64) { const float v = c[i]; sc[i] = v / (1.0f + expf(-v)); }
        __syncthreads();
        for (int it = blockIdx.x; it < 192; it += F.G) {
            const int l = it / 96, j0 = (it % 96) * 64;
            const float* W = F.in[l ? I_ADAW1 : I_ADAW0]; const float* bias = F.in[l ? I_ADAB1 : I_ADAB0];
            float acc[8];
#pragma unroll
            for (int b = 0; b < 8; ++b) acc[b] = 0.f;
            const int k0 = F.wave * 128;
            for (int kk = k0; kk < k0 + 128; kk += 16) { float w[16];
#pragma unroll
                for (int i = 0; i < 16; ++i) w[i] = W[(size_t)(kk + i) * (6 * D) + j0 + F.lane];
#pragma unroll
                for (int i = 0; i < 16; ++i)
#pragma unroll
                    for (int b = 0; b < 8; ++b) acc[b] += sc[b * D + kk + i] * w[i]; }
#pragma unroll
            for (int b = 0; b < 8; ++b) part[(F.wave * 8 + b) * 64 + F.lane] = acc[b];
            __syncthreads();
            float s = 0.f;
#pragma unroll
            for (int w2 = 0; w2 < 8; ++w2) s += part[(w2 * 8 + F.wave) * 64 + F.lane];
            mod[(size_t)(l * 8 + F.wave) * (6 * D) + j0 + F.lane] = s + bias[j0 + F.lane];
            __syncthreads();
        }
    }
    const int gid = ((int)blockIdx.x - ((F.G >= 200) ? 192 : 0)) * (NWAVES * 64) + F.tid;
    if (gid >= 0 && gid < 64 * 64) {
        const int g = gid >> 6;
        const float ar = F.in[I_ARE][gid], ai = F.in[I_AIM][gid], dt = expf(F.in[I_LOGDT][g]);
        const float mag = expf(dt * ar); float sn, cs; sincosf(dt * ai, &sn, &cs);
        const float abr = mag * cs, abi = mag * sn, den = ar * ar + ai * ai, nr = abr - 1.0f, ni = abi;
        const float zr = (nr * ar + ni * ai) / den, zi = (ni * ar - nr * ai) / den;
        float* SA = (float*)(F.ws + WS_SSMA); float* SB = (float*)(F.ws + WS_SSMB);
        SA[gid * 2] = abr; SA[gid * 2 + 1] = abi;
#pragma unroll
        for (int c = 0; c < 16; ++c) { const float br = F.in[I_BRE][gid * 16 + c], bi = F.in[I_BIM][gid * 16 + c];
            SB[(gid * 16 + c) * 2] = zr * br - zi * bi; SB[(gid * 16 + c) * 2 + 1] = zr * bi + zi * br; }
    }
}

struct TItem { const float* src; unsigned char* dst; int ldw, rowb; float f8s; };
__device__ __forceinline__ void titem_make(TItem& t, const float* W, int ldw, int K, int N, unsigned char* WT, int rowmap, int item, int lane, float f8s = 0.f, int rowb = 0) {
    const int nblk = N / 32, kb = item / nblk, nb = item % nblk, k0 = 64 * kb, n0 = 32 * nb;
    const int r0 = rowmap == 0 ? n0 : ((n0 >> 7) * 256 + (n0 & 127) + (rowmap == 2 ? 128 : 0));
    const int esz = (f8s != 0.f) ? 1 : 2;
    t.src = W + (size_t)(k0 + (lane >> 5)) * ldw + n0 + (lane & 31); t.ldw = ldw; t.rowb = rowb ? rowb : K * esz; t.f8s = f8s;
    t.dst = WT + (size_t)(r0 + (lane >> 3)) * t.rowb + (size_t)(k0 + 8 * (lane & 7)) * esz;
}
__device__ __forceinline__ void titem_decode(Frame& F, TItem& t, int it, int lane) {
    constexpr int I_0 = 16 * 96, I_1 = 16 * 32, I_2 = 16 * 88, I_3 = 16 * 88, I_4 = 44 * 32, I_5 = 16 * 32, I_6 = 16 * 32;
    constexpr int I_7 = 16 * 44, I_8 = 16 * 44, I_9 = 22 * 32;
    unsigned char* ws = F.ws; int r = it;
    if (r < I_0) { titem_make(t, F.in[I_WIN], 3 * D, D, 3 * D, ws + WS_W_IN, 0, r, lane); return; } r -= I_0;
    if (r < I_1) { titem_make(t, F.in[I_WOUT], D, D, D, ws + WS_W_OUT, 0, r, lane); return; } r -= I_1;
    if (r < I_2) { titem_make(t, F.in[I_FG], DFF, D, DFF, ws + WS_W_F1, 1, r, lane); return; } r -= I_2;
    if (r < I_3) { titem_make(t, F.in[I_FU], DFF, D, DFF, ws + WS_W_F1, 2, r, lane); return; } r -= I_3;
    if (r < I_4) { titem_make(t, F.in[I_FD], D, DFF, D, ws + WS_W_F2, 0, r, lane); return; } r -= I_4;
    if (r < I_5) { titem_make(t, F.in[I_WGLU], 2 * D, D, D, ws + WS_W_GLU, 1, r, lane); return; } r -= I_5;
    if (r < I_6) { titem_make(t, F.in[I_WGLU] + D, 2 * D, D, D, ws + WS_W_GLU, 2, r, lane); return; } r -= I_6;
    const int e = r / (I_7 + I_8 + I_9); r -= e * (I_7 + I_8 + I_9);
    if (r < I_7) { titem_make(t, F.in[I_EG] + (size_t)e * D * DFE, DFE, D, DFE, ws + WS_W_E1 + (size_t)e * 2 * DFE * D, 1, r, lane, S8_WE1); return; } r -= I_7;
    if (r < I_8) { titem_make(t, F.in[I_EU] + (size_t)e * D * DFE, DFE, D, DFE, ws + WS_W_E1 + (size_t)e * 2 * DFE * D, 2, r, lane, S8_WE1); return; } r -= I_8;
    titem_make(t, F.in[I_ED] + (size_t)e * DFE * D, D, DFE, D, ws + WS_W_E2 + (size_t)e * D * DFE_PAD, 0, r, lane, S8_WE2, DFE_PAD);
}
constexpr int NIT_L0 = 16 * 96 + 16 * 32 + 2 * 16 * 88 + 44 * 32;
constexpr int NIT_ALL = NIT_L0 + 2 * 16 * 32 + NEXP * (2 * 16 * 44 + 22 * 32);
__device__ __forceinline__ void transpose_items(Frame& F, int it0, int it1, LAS float* scr) {
    const int gw = F.vcu * NWAVES + F.wave, NGW = F.G * NWAVES, lane = F.lane;
    const int NITEMS = it1;
    if (it0 + gw < NITEMS) {
        TItem cur; titem_decode(F, cur, it0 + gw, lane);
        float cv[32];
#pragma unroll
        for (int i = 0; i < 32; ++i) cv[i] = cur.src[(size_t)(2 * i) * cur.ldw];
        for (int it = it0 + gw; it < NITEMS; it += NGW) {
            TItem nxt = cur; float nv[32];
            const bool hn = it + NGW < NITEMS;
            if (hn) { titem_decode(F, nxt, it + NGW, lane);
#pragma unroll
                for (int i = 0; i < 32; ++i) nv[i] = nxt.src[(size_t)(2 * i) * nxt.ldw]; }
#pragma unroll
            for (int i = 0; i < 32; ++i) scr[(2 * i + (lane >> 5)) * 33 + (lane & 31)] = cv[i];
            LDS_WAIT(); asm volatile("" ::: "memory");
            const int c = lane & 7;
            if (cur.f8s == 0.f) {
#pragma unroll
                for (int j = 0; j < 4; ++j) { const int n = (lane >> 3) + 8 * j; const LAS float* sp = scr + (8 * c) * 33 + n;
                    v4u o; o.x = pk2h(sp[0 * 33], sp[1 * 33]); o.y = pk2h(sp[2 * 33], sp[3 * 33]); o.z = pk2h(sp[4 * 33], sp[5 * 33]); o.w = pk2h(sp[6 * 33], sp[7 * 33]);
                    *(GAS v4u*)(cur.dst + (size_t)(8 * j) * cur.rowb) = o; }
            } else { const float sw = cur.f8s;
#pragma unroll
                for (int j = 0; j < 4; ++j) { const int n = (lane >> 3) + 8 * j; const LAS float* sp = scr + (8 * c) * 33 + n;
                    v2u o; o.x = pg8::pk4f8(sp[0 * 33] * sw, sp[1 * 33] * sw, sp[2 * 33] * sw, sp[3 * 33] * sw); o.y = pg8::pk4f8(sp[4 * 33] * sw, sp[5 * 33] * sw, sp[6 * 33] * sw, sp[7 * 33] * sw);
                    *(GAS v2u*)(cur.dst + (size_t)(8 * j) * cur.rowb) = o; }
            }
            LDS_WAIT(); asm volatile("" ::: "memory");
            if (hn) {
#pragma unroll
                for (int i = 0; i < 32; ++i) cv[i] = nv[i];
                cur = nxt; }
        }
    }
}
__device__ __forceinline__ void ph1_prologue(Frame& F) {
    const int gw = F.vcu * NWAVES + F.wave, NGW = F.G * NWAVES, lane = F.lane;
    unsigned char* ws = F.ws;
    transpose_items(F, 0, NIT_ALL, (LAS float*)(F.lds + RING_OFF + F.wave * 16384));
    for (int i = (int)blockIdx.x * (NWAVES * 64) + F.tid; i < NEXP * D * 8; i += F.G * NWAVES * 64)
        *(v4u*)(ws + WS_W_E2 + (size_t)(i >> 3) * DFE_PAD + DFE + 16 * (i & 7)) = (v4u){0u, 0u, 0u, 0u};
    const float* mod0 = (const float*)(ws + WS_MOD);
    h16* H0 = (h16*)(ws + WS_B);
    {
        const int WPB = F.G, bq = gw / WPB, r0 = gw % WPB; const float* mb = mod0 + (size_t)bq * (6 * D);
        f32x4 sc1[4], shv[4];
#pragma unroll
        for (int j = 0; j < 4; ++j) { const int col = 4 * lane + 256 * j; shv[j] = *(const f32x4*)(mb + col); sc1[j] = 1.0f + *(const f32x4*)(mb + D + col); }
        for (int t0 = r0; t0 < SEQ; t0 += 8 * WPB) {
            f32x4 xr[8][4];
#pragma unroll
            for (int i = 0; i < 8; ++i) { const int t = t0 + i * WPB; if (t < SEQ) {
#pragma unroll
                for (int j = 0; j < 4; ++j) xr[i][j] = *(const f32x4*)(F.in[I_X] + ((size_t)bq * SEQ + t) * D + 4 * lane + 256 * j); } }
#pragma unroll
            for (int i = 0; i < 8; ++i) { const int t = t0 + i * WPB; if (t < SEQ) {
#pragma unroll
                for (int j = 0; j < 4; ++j) { const int col = 4 * lane + 256 * j;
                    const f32x4 h = xr[i][j] * sc1[j] + shv[j]; v2u o; o.x = pk2h(h[0], h[1]); o.y = pk2h(h[2], h[3]);
                    *(v2u*)(H0 + ((size_t)bq * SEQ + t) * D + col) = o; } } }
        }
    }
}

__device__ __forceinline__ f32x4 ld4h(const h16* p) { const v2u w = *(const v2u*)p; return (f32x4){hlo(w.x), hhi(w.x), hlo(w.y), hhi(w.y)}; }
__device__ __forceinline__ void ld8h(const h16* p, float* f) { const v4u w = *(const v4u*)p; f[0] = hlo(w.x); f[1] = hhi(w.x); f[2] = hlo(w.y); f[3] = hhi(w.y); f[4] = hlo(w.z); f[5] = hhi(w.z); f[6] = hlo(w.w); f[7] = hhi(w.w); }
__device__ __forceinline__ float lane_reduce64(float (&v)[64], int lane) {
#pragma unroll
    for (int s = 0; s < 6; ++s) { const int half = 32 >> s; const bool up = (lane & half) != 0;
#pragma unroll
        for (int i = 0; i < half; ++i) { const float lo = v[i], hi = v[i + half]; const float send = up ? lo : hi, keep = up ? hi : lo; v[i] = keep + __shfl_xor(send, half); } }
    return v[0];
}
__device__ __forceinline__ float lam_value(Frame& F) {
    float s1 = 0.f, s2 = 0.f;
#pragma unroll 4
    for (int i = 0; i < 32; ++i) { s1 += F.in[I_LQ1][i] * F.in[I_LK1][i]; s2 += F.in[I_LQ2][i] * F.in[I_LK2][i]; }
    return expf(s1) - expf(s2) + 0.2f;
}
template <bool DIFF, bool DIL> __device__ __forceinline__ void ph4_attn_naive(Frame& F) {
    const h16* QKV = (const h16*)(F.ws + WS_A); h16* O = (h16*)(F.ws + WS_B);
    const int gw = F.vcu * NWAVES + F.wave, NGW = F.G * NWAVES, lane = F.lane;
    const float lam = lam_value(F);
    const float sub_w = F.in[I_SUBLN][lane] * 0.8f;
    if (DIFF) for (int it = gw; it < BATCH * 8 * SEQ; it += NGW) {
        const int bh = it >> 12, r = it & 4095, i = (bh & 1) ? 4095 - r : r, b = bh >> 3, h = bh & 7;
        const size_t rowq = (size_t)(b * SEQ + i) * 3072;
        const float slope2 = exp2f(-0.5f * (float)(h + 1)) * LOG2E;
        float res[2];
#pragma unroll
        for (int mp = 0; mp < 2; ++mp) {
            float q[32];
#pragma unroll
            for (int d8 = 0; d8 < 4; ++d8) ld8h(QKV + rowq + h * 64 + mp * 32 + d8 * 8, q + d8 * 8);
            float acc[64];
#pragma unroll
            for (int d = 0; d < 64; ++d) acc[d] = 0.f;
            float mrun = -INFINITY, l = 0.f;
            for (int j = lane; j <= i; j += 64) {
                const size_t rowk = (size_t)(b * SEQ + j) * 3072;
                float s = 0.f;
#pragma unroll
                for (int d8 = 0; d8 < 4; ++d8) { float kf[8]; ld8h(QKV + rowk + 512 + h * 64 + mp * 32 + d8 * 8, kf);
#pragma unroll
                    for (int e = 0; e < 8; ++e) s += q[d8 * 8 + e] * kf[e]; }
                s -= slope2 * (float)(i - j);
                const float mn = fmaxf(mrun, s), alpha = ex2(mrun - mn), p = ex2(s - mn);
                l = l * alpha + p; mrun = mn;
#pragma unroll
                for (int d8 = 0; d8 < 8; ++d8) { float vf[8]; ld8h(QKV + rowk + 1024 + h * 64 + d8 * 8, vf);
#pragma unroll
                    for (int e = 0; e < 8; ++e) acc[d8 * 8 + e] = acc[d8 * 8 + e] * alpha + p * vf[e]; }
            }
            const float Mx = wave_max(mrun), scl = (mrun == -INFINITY) ? 0.f : ex2(mrun - Mx), L = wave_sum(l * scl);
#pragma unroll
            for (int d = 0; d < 64; ++d) acc[d] *= scl;
            const float mine = lane_reduce64(acc, lane);
            res[mp] = mine / L;
        }
        const float o = res[0] - lam * res[1];
        const float ss = wave_sum(o * o);
        const float y = o * (1.0f / sqrtf(ss * (1.0f / 64.0f) + LN_EPS)) * sub_w;
        O[(size_t)(b * SEQ + i) * D + h * 64 + lane] = (h16)(pk2h(y, 0.f) & 0xffffu);
    }
    if (DIL) for (int it = gw; it < BATCH * 8 * SEQ; it += NGW) {
        const int bh = it >> 12, i = it & 4095, b = bh >> 3, h = bh & 7;
        const size_t rowq = (size_t)(b * SEQ + i) * 3072;
        const float slope2 = exp2f(-0.5f * (float)(h + 9)) * LOG2E;
        float q[64];
#pragma unroll
        for (int d8 = 0; d8 < 8; ++d8) ld8h(QKV + rowq + 1536 + h * 64 + d8 * 8, q + d8 * 8);
        float og[3], lse[3];
#pragma unroll
        for (int g = 0; g < 3; ++g) {
            const int dil = (g == 0) ? 1 : (g == 1) ? 4 : 16;
            float acc[64];
#pragma unroll
            for (int d = 0; d < 64; ++d) acc[d] = 0.f;
            float mrun = -INFINITY, l = 0.f;
            for (int jj = lane; jj <= 128; jj += 64) {
                const int t = i - jj * dil;
                if (t >= 0) {
                    const size_t rowk = (size_t)(b * SEQ + t) * 3072;
                    float s = 0.f;
#pragma unroll
                    for (int d8 = 0; d8 < 8; ++d8) { float kf[8]; ld8h(QKV + rowk + 2048 + h * 64 + d8 * 8, kf);
#pragma unroll
                        for (int e = 0; e < 8; ++e) s += q[d8 * 8 + e] * kf[e]; }
                    s -= slope2 * (float)(jj * dil);
                    const float mn = fmaxf(mrun, s), alpha = ex2(mrun - mn), p = ex2(s - mn);
                    l = l * alpha + p; mrun = mn;
#pragma unroll
                    for (int d8 = 0; d8 < 8; ++d8) { float vf[8]; ld8h(QKV + rowk + 2560 + h * 64 + d8 * 8, vf);
#pragma unroll
                        for (int e = 0; e < 8; ++e) acc[d8 * 8 + e] = acc[d8 * 8 + e] * alpha + p * vf[e]; }
                }
            }
            const float Mx = wave_max(mrun), scl = (mrun == -INFINITY) ? 0.f : ex2(mrun - Mx), L = wave_sum(l * scl);
#pragma unroll
            for (int d = 0; d < 64; ++d) acc[d] *= scl;
            const float mine = lane_reduce64(acc, lane);
            og[g] = mine / L; lse[g] = Mx + log2f(L);
        }
        const float mx = fmaxf(lse[0], fmaxf(lse[1], lse[2]));
        const float w0 = ex2(lse[0] - mx), w1 = ex2(lse[1] - mx), w2 = ex2(lse[2] - mx);
        const float y = (w0 * og[0] + w1 * og[1] + w2 * og[2]) / (w0 + w1 + w2);
        O[(size_t)(b * SEQ + i) * D + 512 + h * 64 + lane] = (h16)(pk2h(y, 0.f) & 0xffffu);
    }
}


typedef _Float16 hf8 __attribute__((ext_vector_type(8)));
typedef float f32x16 __attribute__((ext_vector_type(16)));
__device__ __forceinline__ hf8 ldf8(const h16* p) { return __builtin_bit_cast(hf8, *(const v4u*)p); }
#define MFMA32(a, b, c) __builtin_amdgcn_mfma_f32_32x32x16_f16((a), (b), (c), 0, 0, 0)
typedef short v4i16_t __attribute__((ext_vector_type(4)));
typedef _Float16 hf4 __attribute__((ext_vector_type(4)));
__device__ __forceinline__ void v_stage(LAS unsigned char* vl, const v4u (&vn)[4], int lane) {
#pragma unroll
    for (int i = 0; i < 4; ++i) *(LAS v4u*)(vl + ((lane & 7) >> 2) * 2048 + ((lane >> 3) + 8 * i) * 64 + (lane & 3) * 16) = vn[i];
}
__device__ __forceinline__ hf8 v_frag(const LAS unsigned char* trb, int dt, int s) {
    const v4i16_t lo = __builtin_amdgcn_ds_read_tr16_b64_v4i16((LAS v4i16_t*)(trb + dt * 2048 + (16 * s) * 64));
    const v4i16_t hi = __builtin_amdgcn_ds_read_tr16_b64_v4i16((LAS v4i16_t*)(trb + dt * 2048 + (16 * s + 4) * 64));
    return __builtin_shufflevector(__builtin_bit_cast(hf4, lo), __builtin_bit_cast(hf4, hi), 0, 1, 2, 3, 4, 5, 6, 7);
}
__device__ __forceinline__ float rowmax16(const f32x16& s) {
    float m;
    asm("s_nop 15\n\ts_nop 7\n\t"
                 "v_max3_f32 %0, %1, %2, %3\n\tv_max3_f32 %0, %0, %4, %5\n\tv_max3_f32 %0, %0, %6, %7\n\tv_max3_f32 %0, %0, %8, %9\n\t"
                 "v_max3_f32 %0, %0, %10, %11\n\tv_max3_f32 %0, %0, %12, %13\n\tv_max3_f32 %0, %0, %14, %15\n\tv_max_f32 %0, %0, %16"
                 : "=&v"(m)
                 : "v"(s[0]), "v"(s[1]), "v"(s[2]), "v"(s[3]), "v"(s[4]), "v"(s[5]), "v"(s[6]), "v"(s[7]), "v"(s[8]), "v"(s[9]), "v"(s[10]), "v"(s[11]), "v"(s[12]), "v"(s[13]), "v"(s[14]), "v"(s[15]));
    return m;
}
constexpr float LAZY_THR = 8.0f;
__device__ __forceinline__ float half_max(float v) { auto rr = __builtin_amdgcn_permlane32_swap(__float_as_uint(v), __float_as_uint(v), false, false); return fmaxf(__uint_as_float(rr[0]), __uint_as_float(rr[1])); }
__device__ __forceinline__ float half_sum(float v) { auto rr = __builtin_amdgcn_permlane32_swap(__float_as_uint(v), __float_as_uint(v), false, false); return __uint_as_float(rr[0]) + __uint_as_float(rr[1]); }
constexpr float SKIP_BITS = 30.0f;
__device__ __forceinline__ void ph4_diff_mfma(Frame& F) {
    const h16* QKV = (const h16*)(F.ws + WS_A); const h16* KA = (const h16*)(F.ws + WS_KA); h16* O = (h16*)(F.ws + WS_B);
    int lane_ = F.lane; asm volatile("" : "+v"(lane_));
    const int gw = F.vcu * NWAVES + F.wave, NGW = F.G * NWAVES, lane = lane_, r32 = lane & 31, hi = lane >> 5;
    const float lam = lam_value(F);
    LAS unsigned char* vl = F.lds + RING_OFF + F.wave * 4096;
    const LAS unsigned char* trb = vl + (8 * hi + ((lane & 15) >> 2)) * 64 + (16 * ((lane >> 4) & 1) + 4 * (lane & 3)) * 2;
    for (int k = 0; k < 4; ++k) {
        if (gw >= 2048) break;
        const int ty = gw & 1, qp = (gw >> 1) & 127, b = gw >> 8;
        const int h = (ty == 0) ? ((k == 0) ? 7 : (k == 1) ? 0 : (k == 2) ? 4 : 3) : ((k == 0) ? 6 : (k == 1) ? 1 : (k == 2) ? 5 : 2);
        const int bh = b * 8 + h, qt = (k & 1) ? 127 - qp : qp, i0 = qt * 32;
        const float slope2 = exp2f(-0.5f * (float)(h + 1)) * LOG2E;
        const h16* qrow = QKV + (size_t)(b * SEQ + i0 + r32) * 3072 + h * 64 + 8 * hi;
        hf8 qf[2][2];
#pragma unroll
        for (int mp = 0; mp < 2; ++mp)
#pragma unroll
            for (int sl = 0; sl < 2; ++sl) qf[mp][sl] = ldf8(qrow + mp * 32 + sl * 16);
        float need;
        { float sq[2];
#pragma unroll
            for (int mp = 0; mp < 2; ++mp) { float a = 0.f;
#pragma unroll
                for (int sl = 0; sl < 2; ++sl)
#pragma unroll
                    for (int e = 0; e < 8; ++e) { const float v = (float)qf[mp][sl][e]; a += v * v; }
                a = half_sum(a);
                const float km = __uint_as_float(__hip_atomic_load(F.ctl + CW_KMAX + (b * 8 + h) * 2 + mp, RLX_AGENT));
                sq[mp] = sqrtf(a * km) * 1.001f + 0.01f; }
            need = fmaxf(sq[0], sq[1]) + SKIP_BITS - log2f(1.0f - exp2f(-slope2)); }
        float coff[16];
#pragma unroll
        for (int r = 0; r < 16; ++r) coff[r] = slope2 * (float)(16 * (r >> 3) + 8 * hi + (r & 7));
        f32x16 o[2][2];
#pragma unroll
        for (int mp = 0; mp < 2; ++mp)
#pragma unroll
            for (int dt = 0; dt < 2; ++dt)
#pragma unroll
                for (int r = 0; r < 16; ++r) o[mp][dt][r] = 0.f;
        float mrun[2] = {0.f, 0.f}, lrun[2] = {0.f, 0.f};
        const h16* kbase = KA + ((size_t)(bh * 128) * 4 * 64 + lane) * 8;
        const h16* vbase = QKV + (size_t)(b * SEQ + (lane >> 3)) * 3072 + 1024 + h * 64 + 8 * (lane & 7);
        hf8 kn[2][2]; v4u vn[4];
        { const h16* kb2 = kbase + (size_t)(qt * 4) * 512; const h16* vb2 = vbase + (size_t)(32 * qt) * 3072;
#pragma unroll
            for (int mp = 0; mp < 2; ++mp)
#pragma unroll
                for (int sl = 0; sl < 2; ++sl) kn[mp][sl] = ldf8(kb2 + (mp * 2 + sl) * 512);
#pragma unroll
            for (int i = 0; i < 4; ++i) vn[i] = *(const v4u*)(vb2 + (size_t)(8 * i) * 3072); }
        for (int kt = qt; kt >= 0; --kt) {
            hf8 kf[2][2];
#pragma unroll
            for (int a = 0; a < 2; ++a)
#pragma unroll
                for (int c = 0; c < 2; ++c) kf[a][c] = kn[a][c];
            asm volatile("" ::: "memory");
            v_stage(vl, vn, lane);
            asm volatile("" ::: "memory");
            if (kt > 0) {
                const h16* kb2 = kbase + (size_t)((kt - 1) * 4) * 512; const h16* vb2 = vbase + (size_t)(32 * (kt - 1)) * 3072;
#pragma unroll
                for (int mp = 0; mp < 2; ++mp)
#pragma unroll
                    for (int sl = 0; sl < 2; ++sl) kn[mp][sl] = ldf8(kb2 + (mp * 2 + sl) * 512);
#pragma unroll
                for (int i = 0; i < 4; ++i) vn[i] = *(const v4u*)(vb2 + (size_t)(8 * i) * 3072);
            }
            hf8 vf[2][2];
#pragma unroll
            for (int dt = 0; dt < 2; ++dt)
#pragma unroll
                for (int s2 = 0; s2 < 2; ++s2) vf[dt][s2] = v_frag(trb, dt, s2);
            asm volatile("" ::: "memory");
            const float tb = slope2 * (float)(32 * kt - i0);
            const bool diag = (kt == qt);
            f32x16 sc[2];
#pragma unroll
            for (int mp = 0; mp < 2; ++mp) { const float tbm = tb - mrun[mp];
#pragma unroll
                for (int r = 0; r < 16; ++r) sc[mp][r] = coff[r] + tbm;
                if (diag) {
#pragma unroll
                    for (int r = 0; r < 16; ++r) if (16 * (r >> 3) + 8 * hi + (r & 7) > r32) sc[mp][r] = -INFINITY;
                } }
            sc[0] = MFMA32(kf[0][0], qf[0][0], sc[0]); sc[1] = MFMA32(kf[1][0], qf[1][0], sc[1]);
            sc[0] = MFMA32(kf[0][1], qf[0][1], sc[0]); sc[1] = MFMA32(kf[1][1], qf[1][1], sc[1]);
            hf8 pb[2][2];
#pragma unroll
            for (int mp = 0; mp < 2; ++mp) {
                const float mx = half_max(rowmax16(sc[mp]));
                if (diag || __any(mx > LAZY_THR)) {
                    const float dl = diag ? mx : fmaxf(mx, 0.f), alpha = ex2(-dl); mrun[mp] += dl; lrun[mp] *= alpha;
#pragma unroll
                    for (int r = 0; r < 16; ++r) sc[mp][r] -= dl;
#pragma unroll
                    for (int dt = 0; dt < 2; ++dt)
#pragma unroll
                        for (int r = 0; r < 16; ++r) o[mp][dt][r] *= alpha; }
                float ls = 0.f;
#pragma unroll
                for (int r = 0; r < 16; ++r) { sc[mp][r] = ex2(sc[mp][r]); ls += sc[mp][r]; }
                lrun[mp] += ls;
                v4u p0, p1;
                p0.x = pk2h(sc[mp][0], sc[mp][1]); p0.y = pk2h(sc[mp][2], sc[mp][3]); p0.z = pk2h(sc[mp][4], sc[mp][5]); p0.w = pk2h(sc[mp][6], sc[mp][7]);
                p1.x = pk2h(sc[mp][8], sc[mp][9]); p1.y = pk2h(sc[mp][10], sc[mp][11]); p1.z = pk2h(sc[mp][12], sc[mp][13]); p1.w = pk2h(sc[mp][14], sc[mp][15]);
                pb[mp][0] = __builtin_bit_cast(hf8, p0); pb[mp][1] = __builtin_bit_cast(hf8, p1);
            }
#pragma unroll
            for (int s2 = 0; s2 < 2; ++s2)
#pragma unroll
                for (int mp = 0; mp < 2; ++mp)
#pragma unroll
                    for (int dt = 0; dt < 2; ++dt) o[mp][dt] = MFMA32(vf[dt][s2], pb[mp][s2], o[mp][dt]);
            if (__all(slope2 * (float)(i0 + 1 - 32 * kt) >= need - fminf(mrun[0], mrun[1]))) break;
        }
        const float l0 = half_sum(lrun[0]), l1 = half_sum(lrun[1]);
        const float i0l = 1.0f / l0, i1l = lam / l1;
        float ss = 0.f;
#pragma unroll
        for (int dt = 0; dt < 2; ++dt)
#pragma unroll
            for (int r = 0; r < 16; ++r) { const float v = o[0][dt][r] * i0l - o[1][dt][r] * i1l; o[0][dt][r] = v; ss += v * v; }
        ss = half_sum(ss);
        const float rstd = 0.8f / sqrtf(ss * (1.0f / 64.0f) + LN_EPS);
        h16* orow = O + (size_t)(b * SEQ + i0 + r32) * D + h * 64;
#pragma unroll
        for (int dt = 0; dt < 2; ++dt)
#pragma unroll
            for (int gp = 0; gp < 2; ++gp) { v2u w[2];
#pragma unroll
                for (int e = 0; e < 2; ++e) { const int g = 2 * gp + e, d = 32 * dt + 8 * g + 4 * hi; const f32x4 sw = *(const f32x4*)(F.in[I_SUBLN] + d);
                    w[e].x = pk2h(o[0][dt][4 * g] * rstd * sw[0], o[0][dt][4 * g + 1] * rstd * sw[1]); w[e].y = pk2h(o[0][dt][4 * g + 2] * rstd * sw[2], o[0][dt][4 * g + 3] * rstd * sw[3]); }
                const auto sx = __builtin_amdgcn_permlane32_swap(w[0].x, w[1].x, false, false), sy = __builtin_amdgcn_permlane32_swap(w[0].y, w[1].y, false, false);
                *(v4u*)(orow + 32 * dt + 16 * gp + 8 * hi) = (v4u){sx[0], sy[0], sx[1], sy[1]}; }
    }
}

template <int MODE> __device__ __forceinline__ void dil_pass(Frame& F) {
    constexpr int STR = (MODE == 0) ? 1 : (MODE == 1) ? 4 : 16, NT = (MODE == 0) ? 5 : 4, LO = (MODE == 0) ? 0 : 33, NU = BATCH * 8 * 128;
    const h16* QKV = (const h16*)(F.ws + WS_A); h16* O = (h16*)(F.ws + WS_B);
    const h16* KB = (MODE == 0) ? (const h16*)(F.ws + WS_KB1) : (MODE == 1) ? (const h16*)(F.ws + WS_KB4) : (const h16*)(F.ws + WS_KB16);
    h16* PO1 = (h16*)F.out; h16* PO2 = PO1 + (size_t)BATCH * 8 * SEQ * 64; float* PM1 = (float*)(PO2 + (size_t)BATCH * 8 * SEQ * 64); float* PM2 = PM1 + (size_t)BATCH * 8 * SEQ * 2;
    int lane_ = F.lane; asm volatile("" : "+v"(lane_));
    const int gw = F.vcu * NWAVES + F.wave, NGW = F.G * NWAVES, lane = lane_, r32 = lane & 31, hi = lane >> 5;
    LAS unsigned char* vl = F.lds + RING_OFF + F.wave * 4096;
    const LAS unsigned char* trb = vl + (8 * hi + ((lane & 15) >> 2)) * 64 + (16 * ((lane >> 4) & 1) + 4 * (lane & 3)) * 2;
#define DU_BH(i) ((i) >> 7)
#define DU_RR(i) ((MODE == 0) ? 0 : (MODE == 1) ? (((i) & 127) >> 5) : (((i) & 127) >> 3))
#define DU_QB(i) ((MODE == 0) ? ((i) & 127) : (MODE == 1) ? ((i) & 31) : ((i) & 7))
#define DU_KB0(i) ((MODE == 0) ? DU_QB(i) : DU_QB(i) - 1)
#define DU_NT(i) ((DU_KB0(i) + 1 < NT) ? DU_KB0(i) + 1 : NT)
#define DU_LOADQ(i, q) do { const int bh_ = DU_BH(i), tq_ = STR * (32 * DU_QB(i) + r32) + DU_RR(i); \
        const h16* qr_ = QKV + (size_t)((bh_ >> 3) * SEQ + tq_) * 3072 + 1536 + (bh_ & 7) * 64 + 8 * hi; \
        _Pragma("unroll") for (int sl_ = 0; sl_ < 4; ++sl_) q[sl_] = ldf8(qr_ + sl_ * 16); } while (0)
#define DU_LOADKV(i, kb) do { const int bh_ = DU_BH(i), rr_ = DU_RR(i), ub_ = (MODE == 0) ? 0 : (MODE == 1) ? rr_ * 32 : rr_ * 8; \
        const h16* kp_ = KB + ((size_t)((bh_ * 128 + ub_ + (kb)) * 4) * 64 + lane) * 8; \
        const h16* vp_ = QKV + (size_t)((bh_ >> 3) * SEQ + STR * (32 * (kb) + (lane >> 3)) + rr_) * 3072 + 2560 + (bh_ & 7) * 64 + 8 * (lane & 7); \
        _Pragma("unroll") for (int sl_ = 0; sl_ < 4; ++sl_) kn[sl_] = ldf8(kp_ + sl_ * 512); \
        _Pragma("unroll") for (int i_ = 0; i_ < 4; ++i_) vn[i_] = *(const v4u*)(vp_ + (size_t)(STR * 8 * i_) * 3072); } while (0)
    int idx = gw; if (idx >= NU) return;
    hf8 kn[4]; v4u vn[4];
    if (DU_NT(idx) > 0) DU_LOADKV(idx, DU_KB0(idx));
    for (;;) {
        const int nidx = idx + NGW; const bool hn = nidx < NU;
        const int bh = DU_BH(idx), b = bh >> 3, h = bh & 7, rr = DU_RR(idx), qb = DU_QB(idx), kb0 = DU_KB0(idx), ntile = DU_NT(idx);
        const float sS = exp2f(-0.5f * (float)(h + 9)) * LOG2E * (float)STR;
        const int tq = STR * (32 * qb + r32) + rr;
        hf8 qf[4];
        DU_LOADQ(idx, qf);
        const size_t prw = (size_t)bh * SEQ + tq;
        float pm1 = 0.f, pl1 = 0.f, pm2 = 0.f, pl2 = 0.f;
        float cb[16];
#pragma unroll
        for (int r = 0; r < 16; ++r) { const int ko = 16 * (r >> 3) + 8 * hi + (r & 7), dd = r32 - ko;
            const float lg = (MODE == 0) ? (((dd & 15) == 0) ? 1.5849625007211562f : ((dd & 3) == 0) ? 1.0f : 0.0f) : (MODE == 1) ? (((dd & 3) == 0) ? 1.0f : 0.0f) : 0.0f;
            cb[r] = sS * (float)ko + lg; }
        f32x16 o[2];
#pragma unroll
        for (int dt = 0; dt < 2; ++dt)
#pragma unroll
            for (int r = 0; r < 16; ++r) o[dt][r] = 0.f;
        float mrun = 0.f, lrun = 0.f; bool started = false;
        for (int j = 0; j < ntile; ++j) {
            const int kb = kb0 - j;
            hf8 kf[4];
#pragma unroll
            for (int sl = 0; sl < 4; ++sl) kf[sl] = kn[sl];
            asm volatile("" ::: "memory");
            v_stage(vl, vn, lane);
            asm volatile("" ::: "memory");
            if (j + 1 < ntile) DU_LOADKV(idx, kb - 1);
            else if (hn && DU_NT(nidx) > 0) DU_LOADKV(nidx, DU_KB0(nidx));
            hf8 vf[2][2];
#pragma unroll
            for (int dt = 0; dt < 2; ++dt)
#pragma unroll
                for (int s2 = 0; s2 < 2; ++s2) vf[dt][s2] = v_frag(trb, dt, s2);
            asm volatile("" ::: "memory");
            const float tb = sS * (float)(32 * (kb - qb)) - mrun;
            f32x16 s;
#pragma unroll
            for (int r = 0; r < 16; ++r) s[r] = cb[r] + tb;
            if (j == 0 || j == NT - 1) {
                const int dl0 = 32 * (qb - kb) + r32;
#pragma unroll
                for (int r = 0; r < 16; ++r) { const int dl = dl0 - (16 * (r >> 3) + 8 * hi + (r & 7)); if (dl < LO || dl > 128) s[r] = -INFINITY; }
            }
#pragma unroll
            for (int sl = 0; sl < 4; ++sl) s = MFMA32(kf[sl], qf[sl], s);
            const float mx = half_max(rowmax16(s));
            const bool fresh = !started && mx > -INFINITY;
            if (__any(fresh || mx > LAZY_THR)) {
                const float dl = fresh ? mx : fmaxf(mx, 0.f), alpha = ex2(-dl); mrun += dl; lrun *= alpha; started = started || fresh;
#pragma unroll
                for (int r = 0; r < 16; ++r) s[r] -= dl;
#pragma unroll
                for (int dt = 0; dt < 2; ++dt)
#pragma unroll
                    for (int r = 0; r < 16; ++r) o[dt][r] *= alpha; }
            float ls = 0.f;
#pragma unroll
            for (int r = 0; r < 16; ++r) { s[r] = ex2(s[r]); ls += s[r]; }
            lrun += ls;
            v4u p0, p1;
            p0.x = pk2h(s[0], s[1]); p0.y = pk2h(s[2], s[3]); p0.z = pk2h(s[4], s[5]); p0.w = pk2h(s[6], s[7]);
            p1.x = pk2h(s[8], s[9]); p1.y = pk2h(s[10], s[11]); p1.z = pk2h(s[12], s[13]); p1.w = pk2h(s[14], s[15]);
            const hf8 pb0 = __builtin_bit_cast(hf8, p0), pb1 = __builtin_bit_cast(hf8, p1);
#pragma unroll
            for (int dt = 0; dt < 2; ++dt) { o[dt] = MFMA32(vf[dt][0], pb0, o[dt]); o[dt] = MFMA32(vf[dt][1], pb1, o[dt]); }
        }
        if (ntile == 0 && hn && DU_NT(nidx) > 0) DU_LOADKV(nidx, DU_KB0(nidx));
        const float l = half_sum(lrun), mt = (l > 0.f) ? mrun - sS * (float)r32 : -1.0e30f;
        if (MODE != 2) {
            const float il = (l > 0.f) ? 1.0f / l : 0.f;
            h16* po = ((MODE == 0) ? PO1 : PO2) + prw * 64; float* pm = ((MODE == 0) ? PM1 : PM2) + prw * 2;
#pragma unroll
            for (int dt = 0; dt < 2; ++dt)
#pragma unroll
                for (int gp = 0; gp < 2; ++gp) { v2u w[2];
#pragma unroll
                    for (int e = 0; e < 2; ++e) { const int g = 2 * gp + e; w[e].x = pk2h(o[dt][4 * g] * il, o[dt][4 * g + 1] * il); w[e].y = pk2h(o[dt][4 * g + 2] * il, o[dt][4 * g + 3] * il); }
                    const auto sx = __builtin_amdgcn_permlane32_swap(w[0].x, w[1].x, false, false), sy = __builtin_amdgcn_permlane32_swap(w[0].y, w[1].y, false, false);
                    *(v4u*)(po + 32 * dt + 16 * gp + 8 * hi) = (v4u){sx[0], sy[0], sx[1], sy[1]}; }
            if (hi == 0) { pm[0] = mt; pm[1] = l; }
        } else {
            pm1 = PM1[prw * 2]; pl1 = PM1[prw * 2 + 1]; pm2 = PM2[prw * 2]; pl2 = PM2[prw * 2 + 1];
            const float Mx = fmaxf(pm1, fmaxf(pm2, mt));
            const float w1 = pl1 * ex2(pm1 - Mx), w2 = pl2 * ex2(pm2 - Mx), w3 = ex2(mt - Mx), inv = 1.0f / (w1 + w2 + w3 * l);
            const h16* p1 = PO1 + prw * 64; const h16* p2 = PO2 + prw * 64;
            h16* orow = O + (size_t)(b * SEQ + tq) * D + 512 + h * 64;
#pragma unroll
            for (int dt = 0; dt < 2; ++dt)
#pragma unroll
                for (int gp = 0; gp < 2; ++gp) { v2u w[2];
#pragma unroll
                    for (int e2 = 0; e2 < 2; ++e2) { const int g = 2 * gp + e2, d = 32 * dt + 8 * g + 4 * hi; const f32x4 a = ld4h(p1 + d), c = ld4h(p2 + d);
                        float y[4];
#pragma unroll
                        for (int e = 0; e < 4; ++e) y[e] = (w1 * a[e] + w2 * c[e] + w3 * o[dt][4 * g + e]) * inv;
                        w[e2].x = pk2h(y[0], y[1]); w[e2].y = pk2h(y[2], y[3]); }
                    const auto sx = __builtin_amdgcn_permlane32_swap(w[0].x, w[1].x, false, false), sy = __builtin_amdgcn_permlane32_swap(w[0].y, w[1].y, false, false);
                    *(v4u*)(orow + 32 * dt + 16 * gp + 8 * hi) = (v4u){sx[0], sy[0], sx[1], sy[1]}; }
        }
        if (!hn) break;
        idx = nidx;
    }
#undef DU_BH
#undef DU_RR
#undef DU_QB
#undef DU_KB0
#undef DU_NT
#undef DU_LOADQ
#undef DU_LOADKV
}

struct RowLn { f32x4 n[4]; };
__device__ __forceinline__ void ln_rows(f32x4 (&v)[4], const float* lg, const float* lb, int lane) {
    float s = 0.f;
#pragma unroll
    for (int j = 0; j < 4; ++j) s += (v[j][0] + v[j][1]) + (v[j][2] + v[j][3]);
    const float mean = wave_sum(s) * (1.0f / D); float s2 = 0.f;
#pragma unroll
    for (int j = 0; j < 4; ++j) { v[j] = v[j] - mean; s2 += (v[j][0] * v[j][0] + v[j][1] * v[j][1]) + (v[j][2] * v[j][2] + v[j][3] * v[j][3]); }
    const float rstd = 1.0f / sqrtf(wave_sum(s2) * (1.0f / D) + LN_EPS);
#pragma unroll
    for (int j = 0; j < 4; ++j) { const int col = 4 * lane + 256 * j; v[j] = v[j] * rstd * *(const f32x4*)(lg + col) + *(const f32x4*)(lb + col); }
}
struct RowIn { f32x4 x[4]; v2u hx[4]; v2u y[4]; };
template <bool XF32> __device__ __forceinline__ void row_load(RowIn& r, const float* xin, const h16* hin, const h16* y, int lane) {
#pragma unroll
    for (int j = 0; j < 4; ++j) { const int col = 4 * lane + 256 * j; if (XF32) r.x[j] = *(const f32x4*)(xin + col); else r.hx[j] = *(const v2u*)(hin + col); r.y[j] = *(const v2u*)(y + col); }
}
__device__ __forceinline__ f32x4 cvt4(v2u w) { return (f32x4){hlo(w.x), hhi(w.x), hlo(w.y), hhi(w.y)}; }
struct RowVec { f32x4 rdiv[4], psh[4], gate1[4], lg[4], lb[4], sc1[4], sh[4]; };
template <bool XF32> __device__ __forceinline__ void rowvec_load(RowVec& q, const float* psc, const float* psh, const float* gate, const float* lg, const float* lb, const float* sc, const float* sh, int lane) {
#pragma unroll
    for (int j = 0; j < 4; ++j) { const int col = 4 * lane + 256 * j;
        if (!XF32) { const f32x4 d = 1.0f + *(const f32x4*)(psc + col); q.rdiv[j] = (f32x4){__builtin_amdgcn_rcpf(d[0]), __builtin_amdgcn_rcpf(d[1]), __builtin_amdgcn_rcpf(d[2]), __builtin_amdgcn_rcpf(d[3])}; q.psh[j] = *(const f32x4*)(psh + col); }
        q.gate1[j] = 1.0f + *(const f32x4*)(gate + col); q.lg[j] = *(const f32x4*)(lg + col); q.lb[j] = *(const f32x4*)(lb + col);
        q.sc1[j] = 1.0f + *(const f32x4*)(sc + col); q.sh[j] = *(const f32x4*)(sh + col); }
}
__device__ __forceinline__ void ln_rows_v(f32x4 (&v)[4], const RowVec& q) {
    float s = 0.f;
#pragma unroll
    for (int j = 0; j < 4; ++j) s += (v[j][0] + v[j][1]) + (v[j][2] + v[j][3]);
    const float mean = wave_sum(s) * (1.0f / D); float s2 = 0.f;
#pragma unroll
    for (int j = 0; j < 4; ++j) { v[j] = v[j] - mean; s2 += (v[j][0] * v[j][0] + v[j][1] * v[j][1]) + (v[j][2] * v[j][2] + v[j][3] * v[j][3]); }
    const float rstd = 1.0f / sqrtf(wave_sum(s2) * (1.0f / D) + LN_EPS);
#pragma unroll
    for (int j = 0; j < 4; ++j) v[j] = v[j] * rstd * q.lg[j] + q.lb[j];
}
template <bool XF32> __device__ __forceinline__ void row_block(const RowIn& in, const RowVec& q, h16* ho, f32x4 (&hv)[4], int lane) {
    f32x4 v[4];
#pragma unroll
    for (int j = 0; j < 4; ++j) { f32x4 xv; if (XF32) xv = in.x[j]; else xv = (cvt4(in.hx[j]) - q.psh[j]) * q.rdiv[j];
        v[j] = DN_ALPHA * xv + q.gate1[j] * cvt4(in.y[j]); }
    ln_rows_v(v, q);
#pragma unroll
    for (int j = 0; j < 4; ++j) { const int col = 4 * lane + 256 * j;
        hv[j] = v[j] * q.sc1[j] + q.sh[j];
        v2u o; o.x = pk2h(hv[j][0], hv[j][1]); o.y = pk2h(hv[j][2], hv[j][3]); *(v2u*)(ho + col) = o; }
}
template <bool XF32> __device__ __forceinline__ void ph_rows(Frame& F, const float* xin, const h16* HIN, const float* psc, const float* psh, const h16* Y, const float* modl_gate  ,
                                        const float* lg, const float* lb, const float* mod_sc, const float* mod_sh, h16* HO) {
    const int gw = F.vcu * NWAVES + F.wave, WPB = F.G;
    const int b = gw / WPB, r0 = gw % WPB; const size_t bo = (size_t)b * (6 * D);
    RowVec q; rowvec_load<XF32>(q, psc + bo, psh + bo, modl_gate + bo, lg, lb, mod_sc + bo, mod_sh + bo, F.lane);
    for (int t0 = r0; t0 < SEQ; t0 += 4 * WPB) {
        RowIn r[4];
#pragma unroll
        for (int i = 0; i < 4; ++i) { const int t = t0 + i * WPB; if (t < SEQ) { const size_t m = (size_t)b * SEQ + t; row_load<XF32>(r[i], xin + m * D, HIN + m * D, Y + m * D, F.lane); } }
#pragma unroll
        for (int i = 0; i < 4; ++i) { const int t = t0 + i * WPB; if (t < SEQ) { const size_t m = (size_t)b * SEQ + t; f32x4 hv[4];
            row_block<XF32>(r[i], q, HO + m * D, hv, F.lane); } }
    }
}

__device__ __forceinline__ void ph10_ssm_naive(Frame& F) {
    const h16* U = (const h16*)(F.ws + WS_B); h16* GY = (h16*)(F.ws + WS_C);
    const float* SA = (const float*)(F.ws + WS_SSMA); const float* SB = (const float*)(F.ws + WS_SSMB);
    const int gw = F.vcu * NWAVES + F.wave, NGW = F.G * NWAVES, lane = F.lane;
    for (int it = gw; it < BATCH * 64; it += NGW) {
        const int b = it >> 6, g = it & 63, gp = g * 64 + lane;
        const float abr = SA[gp * 2], abi = SA[gp * 2 + 1];
        float bbr[16], bbi[16], cr[16], ci[16];
#pragma unroll
        for (int c = 0; c < 16; ++c) { bbr[c] = SB[(gp * 16 + c) * 2]; bbi[c] = SB[(gp * 16 + c) * 2 + 1]; cr[c] = F.in[I_CRE][(g * 16 + c) * 64 + lane]; ci[c] = F.in[I_CIM][(g * 16 + c) * 64 + lane]; }
        const float dsk = F.in[I_DSKIP][g * 16 + (lane & 15)];
        float hr = 0.f, hi = 0.f;
        for (int t = 0; t < SEQ; ++t) {
            const h16* ur = U + (size_t)(b * SEQ + t) * D + g * 16;
            float u[16]; ld8h(ur, u); ld8h(ur + 8, u + 8);
            float xr = 0.f, xi = 0.f;
#pragma unroll
            for (int c = 0; c < 16; ++c) { xr += bbr[c] * u[c]; xi += bbi[c] * u[c]; }
            const float nhr = abr * hr - abi * hi + xr, nhi = abr * hi + abi * hr + xi; hr = nhr; hi = nhi;
            float mine = 0.f;
#pragma unroll
            for (int c = 0; c < 16; ++c) { const float yc = wave_sum(cr[c] * hr - ci[c] * hi); if (lane == c) mine = yc; }
            if (lane < 16) { const float val = mine + dsk * h2f(ur[lane]); GY[(size_t)(b * SEQ + t) * D + g * 16 + lane] = (h16)(pk2h(gelu_tanh(val), 0.f) & 0xffffu); }
        }
    }
}


__device__ __forceinline__ void ssm_prep(Frame& F) {
    typedef float f32x2v __attribute__((ext_vector_type(2)));
    const float* SA = (const float*)(F.ws + WS_SSMA); const float* SB = (const float*)(F.ws + WS_SSMB);
    LAS f32x2v* PW = (LAS f32x2v*)(F.lds + RING_OFF);
    LAS f32x2v* BB = (LAS f32x2v*)(F.lds + RING_OFF + 16384);
    LAS f32x2v* CC = (LAS f32x2v*)(F.lds + RING_OFF + 32768);
    LAS float* KL = (LAS float*)(F.lds + RING_OFF + 49152);
    const int tid = F.tid;
    LAS int* tsk = (LAS int*)(F.lds + RING_OFF + 65536);
    for (;;) {
        if (tid == 0) *tsk = (int)__hip_atomic_fetch_add(F.ctl + CW_PREP, 1u, RLX_AGENT);
        __syncthreads();
        const int task = *tsk;
        __syncthreads();
        if (task >= 256) break;
        const int g = task >> 2, part = task & 3;
        const float idt = 1.0f / expf(F.in[I_LOGDT][g]);
        if (tid < 64) { float pr = 1.0f, pi = 0.0f; const float ar = SA[(g * 64 + tid) * 2], ai = SA[(g * 64 + tid) * 2 + 1];
            for (int k = 0; k <= 16; ++k) { PW[k * 64 + tid] = (f32x2v){pr, pi}; const float nr = pr * ar - pi * ai, ni = pr * ai + pi * ar; pr = nr; pi = ni; } }
        for (int e = tid; e < 1024; e += NWAVES * 64) { BB[e] = (f32x2v){SB[(g * 1024 + e) * 2] * idt, SB[(g * 1024 + e) * 2 + 1] * idt};
            CC[e] = (f32x2v){F.in[I_CRE][g * 1024 + e], F.in[I_CIM][g * 1024 + e]}; }
        __syncthreads();
        h16* base = (h16*)((unsigned char*)F.out + 100 * MiB) + (size_t)g * 131072;
        if (part == 0) {
            for (int q = tid; q < 64 * 64; q += NWAVES * 64) { const int f = q >> 6, l = q & 63, rt = f >> 4, t = f & 15, r32 = l & 31, hi = l >> 5, p = 16 * rt + (r32 & 15), im = r32 >> 4;
                const f32x2v a = PW[(15 - t) * 64 + p]; hf8 v;
#pragma unroll
                for (int j = 0; j < 8; ++j) { const f32x2v bb = BB[p * 16 + 8 * hi + j]; v[j] = (_Float16)(im ? (a.x * bb.y + a.y * bb.x) : (a.x * bb.x - a.y * bb.y)); }
                *(v4u*)(base + (size_t)q * 8) = __builtin_bit_cast(v4u, v); }
        } else if (part == 1) {
            for (int q = tid; q < 64 * 64; q += NWAVES * 64) { const int f = q >> 6, l = q & 63, rtY = f >> 3, q8 = f & 7, rt = q8 >> 1, sIm = q8 & 1, r32 = l & 31, hi = l >> 5;
                const int t = 2 * rtY + (r32 >> 4), c = r32 & 15; hf8 v;
#pragma unroll
                for (int j = 0; j < 8; ++j) { const int p = 16 * rt + (j & 3) + 8 * (j >> 2) + 4 * hi; const f32x2v a = PW[(t + 1) * 64 + p], cc = CC[c * 64 + p];
                    const float zr = cc.x * a.x - cc.y * a.y, zi = cc.x * a.y + cc.y * a.x; v[j] = (_Float16)(sIm ? -zi : zr); }
                *(v4u*)(base + 32768 + (size_t)q * 8) = __builtin_bit_cast(v4u, v); }
        } else {
            { const int L = tid >> 5, c = (tid >> 1) & 15, c20 = (tid & 1) * 8; float acc8[8];
#pragma unroll
                for (int j = 0; j < 8; ++j) acc8[j] = 0.f;
                for (int p = 0; p < 64; ++p) { const f32x2v a = PW[L * 64 + p], cc = CC[c * 64 + p];
                    const float zr = cc.x * a.x - cc.y * a.y, zi = cc.x * a.y + cc.y * a.x;
#pragma unroll
                    for (int j = 0; j < 8; ++j) { const f32x2v bb = BB[p * 16 + c20 + j]; acc8[j] += zr * bb.x - zi * bb.y; } }
#pragma unroll
                for (int j = 0; j < 8; ++j) KL[L * 256 + c * 16 + c20 + j] = acc8[j]; }
            __syncthreads();
            const int q0 = (part - 2) * 4096;
            for (int q = q0 + tid; q < q0 + 4096; q += NWAVES * 64) { const int f = q >> 6, l = q & 63, rtY = f >> 4, s = f & 15, r32 = l & 31, hi = l >> 5;
                const int t = 2 * rtY + (r32 >> 4), c = r32 & 15, L = t - s; hf8 v;
#pragma unroll
                for (int j = 0; j < 8; ++j) v[j] = (_Float16)((L >= 0) ? KL[(L & 15) * 256 + c * 16 + 8 * hi + j] : 0.f);
                *(v4u*)(base + 65536 + (size_t)q * 8) = __builtin_bit_cast(v4u, v); }
        }
        __syncthreads();
    }
}
__device__ __forceinline__ void ph10_ssm_mfma(Frame& F) {
    const h16* U = (const h16*)(F.ws + WS_B); h16* GY = (h16*)(F.ws + WS_C);
    const float* SA = (const float*)(F.ws + WS_SSMA);
    typedef float f32x2v __attribute__((ext_vector_type(2)));
    LAS f32x2v* SL = (LAS f32x2v*)(F.lds + RING_OFF);
    LAS unsigned char* OPL = F.lds + RING_OFF;
    int tid_ = F.tid; asm volatile("" : "+v"(tid_));
    const int tid = tid_, lane = tid & 63, r32 = lane & 31, hi = lane >> 5, wave = F.wave;
    for (int unit = blockIdx.x; unit < BATCH * 64; unit += F.G) {
        const int b = unit >> 6, g = unit & 63;
        const float dt = expf(F.in[I_LOGDT][g]);
        const h16* MW1 = (const h16*)((const unsigned char*)F.out + 100 * MiB) + (size_t)g * 131072; const h16* MG = MW1 + 32768; const h16* MT = MW1 + 65536;
        const int ch = 32 * wave + r32;
        const h16* urow = U + (size_t)(b * SEQ + 16 * ch) * D + g * 16;
        { v4u w1[8];
#pragma unroll
            for (int i = 0; i < 8; ++i) w1[i] = *(const v4u*)(MW1 + (size_t)(i * 512 + tid) * 8);
#pragma unroll
            for (int i = 0; i < 8; ++i) *(LAS v4u*)(OPL + (size_t)(i * 512 + tid) * 16) = w1[i]; }
        __builtin_amdgcn_sched_barrier(0);
        hf8 ub[16];
#pragma unroll
        for (int t = 0; t < 16; ++t) ub[t] = ldf8(urow + (size_t)t * D + 8 * hi);
        __syncthreads();
        f32x16 acc[4];
#pragma unroll
        for (int rt = 0; rt < 4; ++rt)
#pragma unroll
            for (int r = 0; r < 16; ++r) acc[rt][r] = 0.f;
#pragma unroll
        for (int t = 0; t < 16; ++t)
        {
#pragma unroll
            for (int rt = 0; rt < 4; ++rt) acc[rt] = MFMA32(__builtin_bit_cast(hf8, *(const LAS v4u*)(OPL + (rt * 16 + t) * 1024 + lane * 16)), ub[t], acc[rt]);
            if ((t & 3) == 3) __builtin_amdgcn_sched_barrier(0); }
        __syncthreads();
#pragma unroll
        for (int rt = 0; rt < 4; ++rt)
#pragma unroll
            for (int r = 0; r < 8; ++r) { const int p = 16 * rt + (r & 3) + 8 * (r >> 2) + 4 * hi; SL[p * 257 + ch] = (f32x2v){acc[rt][r], acc[rt][r + 8]}; }
        __syncthreads();
        {
            const int p = tid & 63, sg = tid >> 6;
            float pr = SA[(g * 64 + p) * 2], pi = SA[(g * 64 + p) * 2 + 1];
#pragma unroll
            for (int q = 0; q < 4; ++q) { const float nr = pr * pr - pi * pi, ni = 2.0f * pr * pi; pr = nr; pi = ni; }
            const float aLr = pr, aLi = pi;
            float xr = 0.f, xi = 0.f;
            for (int j0 = 0; j0 < 32; j0 += 8) { f32x2v sv[8];
#pragma unroll
                for (int j = 0; j < 8; ++j) sv[j] = SL[p * 257 + 32 * sg + j0 + j];
#pragma unroll
                for (int j = 0; j < 8; ++j) { const float nr = aLr * xr - aLi * xi + sv[j].x, ni = aLr * xi + aLi * xr + sv[j].y; xr = nr; xi = ni; sv[j] = (f32x2v){xr, xi}; }
#pragma unroll
                for (int j = 0; j < 8; ++j) SL[p * 257 + 32 * sg + j0 + j] = sv[j]; }
#pragma unroll
            for (int q = 0; q < 5; ++q) { const float nr = pr * pr - pi * pi, ni = 2.0f * pr * pi; pr = nr; pi = ni; }
            __syncthreads();
            float cr = 0.f, ci = 0.f;
            for (int s2 = 0; s2 < sg; ++s2) { const int c2 = 32 * s2 + 31; const f32x2v ag = SL[p * 257 + c2];
                const float nr = pr * cr - pi * ci + ag.x, ni = pr * ci + pi * cr + ag.y; cr = nr; ci = ni; }
            __syncthreads();
            float prevr = 0.f, previ = 0.f, wr = 1.0f, wi = 0.0f;
            for (int j0 = 0; j0 < 32; j0 += 8) { f32x2v xv[8];
#pragma unroll
                for (int j = 0; j < 8; ++j) xv[j] = SL[p * 257 + 32 * sg + j0 + j];
#pragma unroll
                for (int j = 0; j < 8; ++j) { const f32x2v in = (f32x2v){prevr + wr * cr - wi * ci, previ + wr * ci + wi * cr};
                    prevr = xv[j].x; previ = xv[j].y; xv[j] = in; const float nr = wr * aLr - wi * aLi, ni = wr * aLi + wi * aLr; wr = nr; wi = ni; }
#pragma unroll
                for (int j = 0; j < 8; ++j) SL[p * 257 + 32 * sg + j0 + j] = xv[j]; }
        }
        __syncthreads();
        v4u ifw[8];
#pragma unroll
        for (int rt = 0; rt < 4; ++rt) { float re[8], im[8];
#pragma unroll
            for (int j = 0; j < 8; ++j) { const int p = 16 * rt + (j & 3) + 8 * (j >> 2) + 4 * hi; const f32x2v v = SL[p * 257 + ch]; re[j] = v.x; im[j] = v.y; }
            v4u w0, w1; w0.x = pk2h(re[0], re[1]); w0.y = pk2h(re[2], re[3]); w0.z = pk2h(re[4], re[5]); w0.w = pk2h(re[6], re[7]);
            w1.x = pk2h(im[0], im[1]); w1.y = pk2h(im[2], im[3]); w1.z = pk2h(im[4], im[5]); w1.w = pk2h(im[6], im[7]);
            ifw[2 * rt] = w0; ifw[2 * rt + 1] = w1; }
        LAS v4u* IFL = (LAS v4u*)(OPL + 49152 + wave * 8192);
        const f32x4 dk0 = *(const f32x4*)(F.in[I_DSKIP] + g * 16 + 4 * hi), dk1 = *(const f32x4*)(F.in[I_DSKIP] + g * 16 + 8 + 4 * hi);
        h16* yrow = GY + (size_t)(b * SEQ + 16 * ch) * D + g * 16;
        v4u pg, pt0, pt1;
        pg = *(const v4u*)(MG + (size_t)tid * 8); pt0 = *(const v4u*)(MT + (size_t)tid * 8); pt1 = pt0;
        __syncthreads();
#pragma unroll
        for (int q = 0; q < 8; ++q) IFL[q * 64 + lane] = ifw[q];
        *(LAS v4u*)(OPL + tid * 16) = pg; if (tid < 128) *(LAS v4u*)(OPL + 8192 + tid * 16) = pt0;
        __syncthreads();
#pragma unroll
        for (int rtY = 0; rtY < 8; ++rtY) {
            LAS unsigned char* cur = OPL + (rtY & 1) * 24576;
            if (rtY < 7) { const int nT = (2 * (rtY + 1) + 2) * 64;
                pg = *(const v4u*)(MG + (size_t)((rtY + 1) * 8 * 64 + tid) * 8);
                if (tid < nT) pt0 = *(const v4u*)(MT + (size_t)((rtY + 1) * 16 * 64 + tid) * 8);
                if (tid + 512 < nT) pt1 = *(const v4u*)(MT + (size_t)((rtY + 1) * 16 * 64 + tid + 512) * 8); }
            f32x16 y0, y1;
#pragma unroll
            for (int r = 0; r < 16; ++r) { y0[r] = 0.f; y1[r] = 0.f; }
#pragma unroll
            for (int q = 0; q < 8; ++q) { const hf8 af = __builtin_bit_cast(hf8, *(const LAS v4u*)(cur + q * 1024 + lane * 16)); const hf8 bf = __builtin_bit_cast(hf8, IFL[q * 64 + lane]); if (q & 1) y1 = MFMA32(af, bf, y1); else y0 = MFMA32(af, bf, y0); }
#pragma unroll
            for (int s2 = 0; s2 <= 2 * rtY + 1; ++s2) { const hf8 af = __builtin_bit_cast(hf8, *(const LAS v4u*)(cur + 8192 + s2 * 1024 + lane * 16)); if (s2 & 1) y1 = MFMA32(af, ub[s2], y1); else y0 = MFMA32(af, ub[s2], y0); }
#pragma unroll
            for (int tt = 0; tt < 2; ++tt) { const size_t ro = (size_t)(2 * rtY + tt) * D;
                const v4u uw = __builtin_bit_cast(v4u, ub[2 * rtY + tt]);
                const auto sw0 = __builtin_amdgcn_permlane32_swap(uw.x, uw.z, false, false), sw1 = __builtin_amdgcn_permlane32_swap(uw.y, uw.w, false, false);
                const f32x4 u0 = {hlo(sw0[0]), hhi(sw0[0]), hlo(sw1[0]), hhi(sw1[0])}, u1 = {hlo(sw0[1]), hhi(sw0[1]), hlo(sw1[1]), hhi(sw1[1])};
                float yv[8];
#pragma unroll
                for (int e = 0; e < 8; ++e) yv[e] = (y0[8 * tt + e] + y1[8 * tt + e]) * dt;
                v2u w0, w1;
                w0.x = pk2h(gelu_tanh(yv[0] + dk0[0] * u0[0]), gelu_tanh(yv[1] + dk0[1] * u0[1])); w0.y = pk2h(gelu_tanh(yv[2] + dk0[2] * u0[2]), gelu_tanh(yv[3] + dk0[3] * u0[3]));
                w1.x = pk2h(gelu_tanh(yv[4] + dk1[0] * u1[0]), gelu_tanh(yv[5] + dk1[1] * u1[1])); w1.y = pk2h(gelu_tanh(yv[6] + dk1[2] * u1[2]), gelu_tanh(yv[7] + dk1[3] * u1[3]));
                const auto sx = __builtin_amdgcn_permlane32_swap(w0.x, w1.x, false, false), sy = __builtin_amdgcn_permlane32_swap(w0.y, w1.y, false, false);
                *(v4u*)(yrow + ro + 8 * hi) = (v4u){sx[0], sy[0], sx[1], sy[1]}; }
            if (rtY < 7) { const int nT = (2 * (rtY + 1) + 2) * 64; LAS unsigned char* nxt = OPL + ((rtY + 1) & 1) * 24576;
                *(LAS v4u*)(nxt + tid * 16) = pg;
                if (tid < nT) *(LAS v4u*)(nxt + 8192 + tid * 16) = pt0;
                if (tid + 512 < nT) *(LAS v4u*)(nxt + 8192 + (tid + 512) * 16) = pt1; }
            __syncthreads();
        }
    }
}

__device__ __forceinline__ void ph12_rows_route(Frame& F) {
    const int gw = F.vcu * NWAVES + F.wave, NGW = F.G * NWAVES, lane = F.lane;
    const float* mod1 = (const float*)(F.ws + WS_MOD) + (size_t)BATCH * 6 * D;
    const h16* Y3 = (const h16*)(F.ws + WS_A); h16* H16 = (h16*)(F.ws + WS_VT1);
    int* tok_e = (int*)(F.ws + WS_TOKE); float* tok_g = (float*)(F.ws + WS_TOKG);
    LAS unsigned* lcnt = (LAS unsigned*)(F.lds + 1024);
    if (F.tid < 8) lcnt[F.tid] = 0u;
    __syncthreads();
    LAS f32x4* RWL = (LAS f32x4*)(F.lds + 4096);
    for (int e = F.tid; e < 2048; e += NWAVES * 64) { const int jih = e >> 6, l = e & 63, j = jih >> 3, i = (jih >> 1) & 3, hf = jih & 1;
        RWL[e] = *(const f32x4*)(F.in[I_RW] + (size_t)(4 * l + 256 * j + i) * 8 + 4 * hf); }
    __syncthreads();
    const f32x4 rb0 = *(const f32x4*)(F.in[I_RB]), rb1 = *(const f32x4*)(F.in[I_RB] + 4);
    const h16* UPREV = (const h16*)(F.ws + WS_B);
    const int WPB = F.G, bq = gw / WPB, r0 = gw % WPB; const size_t bo = (size_t)bq * (6 * D);
    RowVec q; rowvec_load<false>(q, mod1 + bo + 1 * D, mod1 + bo, mod1 + bo + 2 * D, F.in[I_LN1G1], F.in[I_LN1B1], mod1 + bo + 4 * D, mod1 + bo + 3 * D, lane);
    for (int t0 = r0; t0 < SEQ; t0 += WPB) {
        { const int m = bq * SEQ + t0;
        RowIn rr1; row_load<false>(rr1, nullptr, UPREV + (size_t)m * D, Y3 + (size_t)m * D, lane);
        f32x4 hv[4];
        row_block<false>(rr1, q, H16 + (size_t)m * D, hv, lane);
        f32x4 a0 = {0.f, 0.f, 0.f, 0.f}, a1 = a0;
#pragma unroll
        for (int j = 0; j < 4; ++j)
#pragma unroll
            for (int i = 0; i < 4; ++i) { a0 += hv[j][i] * RWL[((j * 4 + i) * 2 + 0) * 64 + lane]; a1 += hv[j][i] * RWL[((j * 4 + i) * 2 + 1) * 64 + lane]; }
        float lg[8];
#pragma unroll
        for (int e = 0; e < 4; ++e) { lg[e] = wave_sum(a0[e]) + rb0[e]; lg[4 + e] = wave_sum(a1[e]) + rb1[e]; }
        int e1 = 0; float v1 = lg[0];
#pragma unroll
        for (int e = 1; e < 8; ++e) if (lg[e] > v1) { v1 = lg[e]; e1 = e; }
        int e2 = -1; float v2 = -INFINITY;
#pragma unroll
        for (int e = 0; e < 8; ++e) if (e != e1 && lg[e] > v2) { v2 = lg[e]; e2 = e; }
        const float g1 = 1.0f / (1.0f + expf(v2 - v1)), g2 = 1.0f - g1;
        if (lane == 0) { tok_e[2 * m] = e1; tok_e[2 * m + 1] = e2; tok_g[2 * m] = g1; tok_g[2 * m + 1] = g2;
            __hip_atomic_fetch_add(lcnt + e1, 1u, __ATOMIC_RELAXED, __HIP_MEMORY_SCOPE_WORKGROUP); __hip_atomic_fetch_add(lcnt + e2, 1u, __ATOMIC_RELAXED, __HIP_MEMORY_SCOPE_WORKGROUP); }
        }
    }
    __syncthreads();
    if (F.tid < 8) __hip_atomic_fetch_add(F.ctl + CW_ECNT + F.tid, lcnt[F.tid], RLX_AGENT);
}
__device__ __forceinline__ void moe_prefix(Frame& F, int (&tp)[9]) {
    int acc = 0;
#pragma unroll
    for (int e = 0; e < 8; ++e) { tp[e] = acc; const unsigned c = __hip_atomic_load(F.ctl + CW_ECNT + e, RLX_AGENT); acc += (int)((c + 255u) >> 8); }
    tp[8] = acc;
}
__device__ __forceinline__ unsigned f8of4h(unsigned w0, unsigned w1) { return pg8::pk4f8(hlo(w0) * S8_H, hhi(w0) * S8_H, hlo(w1) * S8_H, hhi(w1) * S8_H); }
__device__ __forceinline__ void ph13_gather(Frame& F) {
    const int gw = F.vcu * NWAVES + F.wave, NGW = F.G * NWAVES, lane = F.lane;
    int tp[9]; moe_prefix(F, tp);
    const int* tok_e = (const int*)(F.ws + WS_TOKE); int* tok_p = (int*)(F.ws + WS_TOKP);
    const h16* H16 = (const h16*)(F.ws + WS_VT1); unsigned char* HG = F.ws + WS_B;
    for (int base = gw * 16; base < M; base += NGW * 16) {
        const bool own = lane < 16; const int m = base + (lane & 15);
        const int ea = own ? tok_e[2 * m] : -1, eb = own ? tok_e[2 * m + 1] : -1;
        const unsigned long long below = (lane == 0) ? 0ull : (~0ull >> (64 - lane));
        int ra = 0, rb = 0, mycnt = 0;
#pragma unroll
        for (int e = 0; e < 8; ++e) {
            const unsigned long long ma = __ballot(ea == e), mb = __ballot(eb == e);
            const int ca = __popcll(ma), cb = __popcll(mb);
            if (lane == e) mycnt = ca + cb;
            if (ea == e) ra = __popcll(ma & below);
            if (eb == e) rb = ca + __popcll(mb & below);
        }
        unsigned basee = 0u;
        if (lane < 8 && mycnt > 0) basee = __hip_atomic_fetch_add(F.ctl + CW_ECUR + lane, (unsigned)mycnt, RLX_AGENT);
        int tpl = 0;
#pragma unroll
        for (int e = 0; e < 8; ++e) if (lane == e) tpl = tp[e];
        const int segbase = tpl * 256 + (int)basee;
        const int pa = __shfl(segbase, ea & 7) + ra, pb = __shfl(segbase, eb & 7) + rb;
        if (own) { tok_p[2 * m] = pa; tok_p[2 * m + 1] = pb; }
#pragma unroll
        for (int t4 = 0; t4 < 16; t4 += 8) {
            v4u v0[8], v1[8]; int p1[8], p2[8];
#pragma unroll
            for (int i = 0; i < 8; ++i) { const h16* src = H16 + (size_t)(base + t4 + i) * D + 16 * lane; v0[i] = *(const v4u*)src; v1[i] = *(const v4u*)(src + 8);
                p1[i] = __shfl(pa, t4 + i); p2[i] = __shfl(pb, t4 + i); }
#pragma unroll
            for (int i = 0; i < 8; ++i) {
                v4u o; o.x = f8of4h(v0[i].x, v0[i].y); o.y = f8of4h(v0[i].z, v0[i].w); o.z = f8of4h(v1[i].x, v1[i].y); o.w = f8of4h(v1[i].z, v1[i].w);
                *(v4u*)(HG + (size_t)p1[i] * D + 16 * lane) = o; *(v4u*)(HG + (size_t)p2[i] * D + 16 * lane) = o; }
        }
    }
}
__device__ __forceinline__ void ph16_final(Frame& F) {
    const int gw = F.vcu * NWAVES + F.wave, NGW = F.G * NWAVES, lane = F.lane;
    const float* mod1 = (const float*)(F.ws + WS_MOD) + (size_t)BATCH * 6 * D;
    const int* tok_p = (const int*)(F.ws + WS_TOKP); const float* tok_g = (const float*)(F.ws + WS_TOKG);
    const h16* YG = (const h16*)(F.ws + WS_B);
    const h16* H16 = (const h16*)(F.ws + WS_VT1);
    struct Row16 { v2u x[4]; v2u a[4], c[4]; float w1, w2; };
    auto load16 = [&](Row16& r, int m) {
        const int p1 = tok_p[2 * m], p2 = tok_p[2 * m + 1]; r.w1 = tok_g[2 * m]; r.w2 = tok_g[2 * m + 1];
#pragma unroll
        for (int j = 0; j < 4; ++j) { const int col = 4 * lane + 256 * j; r.x[j] = *(const v2u*)(H16 + (size_t)m * D + col);
            r.a[j] = *(const v2u*)(YG + (size_t)p1 * D + col); r.c[j] = *(const v2u*)(YG + (size_t)p2 * D + col); } };
    const int WPB = F.G, bq = gw / WPB, r0 = gw % WPB; const size_t bo = (size_t)bq * (6 * D);
    RowVec q; rowvec_load<false>(q, mod1 + bo + 4 * D, mod1 + bo + 3 * D, mod1 + bo + 5 * D, F.in[I_LN2G1], F.in[I_LN2B1], mod1 + bo, mod1 + bo, lane);
    for (int t0 = r0; t0 < SEQ; t0 += 4 * WPB) {
        Row16 rw4[4];
#pragma unroll
        for (int i = 0; i < 4; ++i) { const int t = t0 + i * WPB; if (t < SEQ) load16(rw4[i], bq * SEQ + t); }
#pragma unroll
        for (int i = 0; i < 4; ++i) { const int t = t0 + i * WPB; if (t >= SEQ) continue; const int m = bq * SEQ + t; const Row16& cur = rw4[i];
        f32x4 v[4];
#pragma unroll
        for (int j = 0; j < 4; ++j) {
            const f32x4 ya = {hlo(cur.a[j].x), hhi(cur.a[j].x), hlo(cur.a[j].y), hhi(cur.a[j].y)}, yc = {hlo(cur.c[j].x), hhi(cur.c[j].x), hlo(cur.c[j].y), hhi(cur.c[j].y)};
            const f32x4 x3 = (cvt4(cur.x[j]) - q.psh[j]) * q.rdiv[j];
            v[j] = DN_ALPHA * x3 + q.gate1[j] * (cur.w1 * ya + cur.w2 * yc); }
        ln_rows_v(v, q);
#pragma unroll
        for (int j = 0; j < 4; ++j) *(f32x4*)(F.out + (size_t)m * D + 4 * lane + 256 * j) = v[j];
        }
    }
}

struct Args { const float* in[39]; float* out; unsigned char* ws; int ph_lo, ph_hi; };
__global__ void __launch_bounds__(NWAVES * 64, 2) mk_fwd(Args args) {
    extern __shared__ __attribute__((aligned(16))) unsigned char lds[];
    Frame F;
    F.lds = (LAS unsigned char*)lds;
    F.MISC = (volatile LAS unsigned*)(F.lds + MISC_OFF);
    F.tid = threadIdx.x; F.lane = F.tid & 63; F.wave = __builtin_amdgcn_readfirstlane(F.tid >> 6);
    F.G = gridDim.x; { const int bx = blockIdx.x; F.vcu = (F.G % 8 == 0) ? (bx % 8) * (F.G / 8) + bx / 8 : bx; }
    F.ws = args.ws; F.out = args.out; F.ctl = (gu32*)(args.ws + WS_CTL);
#pragma unroll
    for (int i = 0; i < 39; ++i) F.in[i] = args.in[i];
    for (int u = F.tid; u < (LDS_BYTES - LDSCTL_OFF) / 4; u += NWAVES * 64) ((LAS unsigned*)(F.lds + LDSCTL_OFF))[u] = 0u;
    __syncthreads();
    XcdBarrier bar; bar.bar = (unsigned*)(F.ctl + CW_BAR); bar.x = 0; bar.st = nullptr;
    if (N_LAUNCHES == 1) bar = xcd_barrier_post((unsigned*)(F.ctl + CW_BAR), F.MISC + 8);
    const int lo = args.ph_lo, hi = args.ph_hi;
    unsigned char* ws = args.ws;
    const float* mod0 = (const float*)(ws + WS_MOD); const float* mod1 = mod0 + (size_t)BATCH * 6 * D;
#ifndef PH_MASK
#define PH_MASK 0x1ffff
#endif
#define IN(k) (((PH_MASK >> (k)) & 1) && lo <= (k) && (k) < hi)
#define SEAM(k) do { if (N_LAUNCHES == 1 && IN(k) && IN((k) + 1)) xcd_barrier(bar); } while (0)

    if (IN(0)) { ph0_mods(F); SEAM(0); }
    if (IN(1)) { ph1_prologue(F); SEAM(1); }
    if (IN(2)) {
        pg8::Gemm g{(const h16*)(ws + WS_B), (const h16*)(ws + WS_W_IN), M, 3 * D, D}; pg8::StaticOrder S; S.init(M, 3 * D, F.G, (int)blockIdx.x);
        pg8::EpiQKV E{(h16*)(ws + WS_A), (h16*)(ws + WS_KA), (h16*)(ws + WS_KB1), (h16*)(ws + WS_KB4), (h16*)(ws + WS_KB16), (unsigned*)(F.ctl + CW_KMAX), QSCALE_A, QSCALE_B};
        pg8::gemm_phase<pg8::EpiQKV, pg8::StaticOrder, true, true>(F.lds + RING_OFF, g, S, E);
        SEAM(2);
    }
    if (IN(4)) { ph4_diff_mfma(F); dil_pass<0>(F); dil_pass<1>(F);
        __syncthreads(); ssm_prep(F);
        xcd_barrier(bar); dil_pass<2>(F); SEAM(4); }
    if (IN(5)) {
        pg8::Gemm g{(const h16*)(ws + WS_B), (const h16*)(ws + WS_W_OUT), M, D, D}; pg8::StaticOrder S; S.init(M, D, F.G, (int)blockIdx.x);
        pg8::EpiF16 E{(h16*)(ws + WS_C), D, 4, 0.f, 0.f};
        pg8::gemm_phase<pg8::EpiF16, pg8::StaticOrder, true, true>(F.lds + RING_OFF, g, S, E);
        SEAM(5);
    }
    if (IN(6)) {
        ph_rows<true>(F, F.in[I_X], (const h16*)(ws + WS_B), mod0, mod0, (const h16*)(ws + WS_C), mod0 + 2 * D, F.in[I_LN1G0], F.in[I_LN1B0], mod0 + 4 * D, mod0 + 3 * D, (h16*)(ws + WS_B));
        SEAM(6);
    }
    if (IN(7)) {
        pg8::Gemm g{(const h16*)(ws + WS_B), (const h16*)(ws + WS_W_F1), M, 2 * DFF, D}; pg8::StaticOrder S; S.init(M, 2 * DFF, F.G, (int)blockIdx.x);
        pg8::EpiGated<0> E{(h16*)(ws + WS_A), DFF, 22, nullptr};
        pg8::gemm_phase<pg8::EpiGated<0>, pg8::StaticOrder, true, true>(F.lds + RING_OFF, g, S, E);
        SEAM(7);
    }
    if (IN(8)) {
        pg8::Gemm g{(const h16*)(ws + WS_A), (const h16*)(ws + WS_W_F2), M, D, DFF}; pg8::StaticOrder S; S.init(M, D, F.G, (int)blockIdx.x);
        pg8::EpiF16 E{(h16*)(ws + WS_C), D, 4, 0.f, 0.f};
        pg8::gemm_phase<pg8::EpiF16, pg8::StaticOrder, true, true>(F.lds + RING_OFF, g, S, E);
        SEAM(8);
    }
    if (IN(9)) {
        ph_rows<false>(F, nullptr, (const h16*)(ws + WS_B), mod0 + 4 * D, mod0 + 3 * D, (const h16*)(ws + WS_C), mod0 + 5 * D, F.in[I_LN2G0], F.in[I_LN2B0], mod1 + 1 * D, mod1 + 0 * D, (h16*)(ws + WS_B));
        SEAM(9);
    }
    if (IN(10)) { ph10_ssm_mfma(F); SEAM(10); }
    if (IN(11)) {
        pg8::Gemm g{(const h16*)(ws + WS_C), (const h16*)(ws + WS_W_GLU), M, 2 * D, D}; pg8::StaticOrder S; S.init(M, 2 * D, F.G, (int)blockIdx.x);
        pg8::EpiGated<1> E{(h16*)(ws + WS_A), D, 8, F.in[I_BGLU]};
        pg8::gemm_phase<pg8::EpiGated<1>, pg8::StaticOrder, true, true>(F.lds + RING_OFF, g, S, E);
        SEAM(11);
    }
    if (IN(12)) { ph12_rows_route(F); SEAM(12); }
    if (IN(13)) { ph13_gather(F); SEAM(13); }
    if (IN(14)) {
        pg8::MoeOrder S; moe_prefix(F, S.tp); S.nN = 11; S.G = F.G; S.c = (int)blockIdx.x;
        pg8::Gemm g{(const h16*)(ws + WS_B), (const h16*)(ws + WS_W_E1), 0, 2 * DFE, D / 2};
        pg8::EpiGated8<0, true> E{ws + WS_A, DFE_PAD, 11, nullptr, 1.0f / (S8_H * S8_WE1), S8_HID};
        pg8::gemm_phase<pg8::EpiGated8<0, true>, pg8::MoeOrder, true, true, true>(F.lds + RING_OFF, g, S, E);
        SEAM(14);
    }
    if (IN(15)) {
        pg8::MoeOrder S; moe_prefix(F, S.tp); S.nN = 4; S.G = F.G; S.c = (int)blockIdx.x;
        pg8::Gemm g{(const h16*)(ws + WS_A), (const h16*)(ws + WS_W_E2), 0, D, DFE_PAD / 2};
        pg8::EpiF16S E{(h16*)(ws + WS_B), D, 4, 1.0f / (S8_HID * S8_WE2)};
        pg8::gemm_phase<pg8::EpiF16S, pg8::MoeOrder, true, true, true>(F.lds + RING_OFF, g, S, E);
        SEAM(15);
    }
    if (IN(16)) { ph16_final(F); }
#undef IN
#undef SEAM
}

extern "C" void kernel_launch(void* const* d_in, const int* in_sizes, int n_in, void* d_out, int out_size, void* d_ws, size_t ws_size, hipStream_t stream) {
    static int grid = 0;
    if (grid == 0) {
        if (n_in != 39 || in_sizes[0] != M * D || out_size != M * D || ws_size < WS_END) { fprintf(stderr, "kernel_launch: unexpected problem shape (n_in %d, in0 %d, out %d, ws %zu)\n", n_in, n_in > 0 ? in_sizes[0] : -1, out_size, ws_size); grid = -1; return; }
        int dev = 0, cus = 0, per_cu = 0;
        if (hipGetDevice(&dev) != hipSuccess || hipDeviceGetAttribute(&cus, hipDeviceAttributeMultiprocessorCount, dev) != hipSuccess) { grid = -1; return; }
        if (hipFuncSetAttribute((const void*)mk_fwd, hipFuncAttributeMaxDynamicSharedMemorySize, LDS_BYTES) != hipSuccess) { fprintf(stderr, "kernel_launch: hipFuncSetAttribute failed\n"); grid = -1; return; }
        if (hipOccupancyMaxActiveBlocksPerMultiprocessor(&per_cu, (const void*)mk_fwd, NWAVES * 64, LDS_BYTES) != hipSuccess || per_cu < 1) { fprintf(stderr, "kernel_launch: occupancy query says %d\n", per_cu); }
        (void)hipGetLastError();
        grid = cus;
    }
    if (grid < 0) return;
    if (hipMemsetAsync((char*)d_ws + WS_CTL, 0, CTL_ZERO_BYTES, stream) != hipSuccess) return;
    Args a{};
    for (int i = 0; i < 39; ++i) a.in[i] = (const float*)d_in[i];
    a.out = (float*)d_out; a.ws = (unsigned char*)d_ws;
    for (int li = 0; li < N_LAUNCHES; ++li) {
        a.ph_lo = (N_LAUNCHES == 1) ? 0 : li; a.ph_hi = (N_LAUNCHES == 1) ? NPH : li + 1;
        hipLaunchKernelGGL(mk_fwd, dim3(grid), dim3(NWAVES * 64), LDS_BYTES, stream, a);
        if (hipPeekAtLastError() != hipSuccess) { fprintf(stderr, "kernel_launch: launch %d failed\n", li); break; }
    }
}
```

```cpp
#include <hip/hip_runtime.h>
#include <cstdio>
#include <cstdint>

#ifndef MK_N_LAUNCHES
#define MK_N_LAUNCHES 1
#endif

namespace pg8 {
#define PG8_LAS __attribute__((address_space(3)))
typedef unsigned short h16_t;
typedef _Float16 f16x8 __attribute__((ext_vector_type(8)));
typedef _Float16 f16x2 __attribute__((ext_vector_type(2)));
typedef float f32x4 __attribute__((ext_vector_type(4)));
typedef float f32x16 __attribute__((ext_vector_type(16)));
typedef unsigned u32x4 __attribute__((ext_vector_type(4)));
constexpr int BM = 256, BK = 64, HALF = 128, HTB = HALF * BK * 2  , STAGE_BYTES = 8 * HTB, NXCD = 8, WGM = 8;

__host__ __device__ __forceinline__ int lds_byte(int r, int c) { const int st = (r >> 4) * 2 + (c >> 5), rr = r & 15, cc = c & 31, ob = rr * 64 + cc * 2; return st * 1024 + (ob ^ (((ob >> 9) & 1) << 5)); }
__host__ __device__ __forceinline__ void stage_rc(int b, int& R, int& C) { const int st = b / 1024, sb = b % 1024, swz = sb ^ (((sb >> 9) & 1) << 5); R = (st >> 1) * 16 + swz / 64; C = (st & 1) * 32 + (swz % 64) / 2; }
__host__ __device__ __forceinline__ int perm32(int rho) { const int n = rho >> 4, i = rho & 15; return 8 * (i >> 2) + 4 * n + (i & 3); }

struct Unit { int pm, pn; };
struct Gemm { const h16_t* A; const h16_t* Bt; int M, N, K; };

struct StaticOrder {
    int nM, nN, nwg, G, c;
    __host__ __device__ void init(int M, int N, int G_, int c_) { nM = M / BM; nN = N / BM; nwg = nM * nN; G = G_; c = c_; }
    __host__ __device__ bool next(int i, Unit& u) const {
        const long L = (long)i * G + c; if (L >= nwg) return false;
        int wgid = (int)L; { const int q = nwg / NXCD, r = nwg % NXCD, xcd = wgid % NXCD, off = wgid / NXCD; wgid = (xcd < r ? xcd * (q + 1) : r * (q + 1) + (xcd - r) * q) + off; }
        const int nig = WGM * nN, gid = wgid / nig, fm = gid * WGM, gsz = (nM - fm) < WGM ? (nM - fm) : WGM;
        u.pm = fm + ((wgid % nig) % gsz); u.pn = (wgid % nig) / gsz; return true;
    }
    __device__ __forceinline__ void a_ready(const Unit&) const {}
    __device__ __forceinline__ void done(const Unit&) const {}
};
struct MoeOrder {
    int tp[9]; int nN, G, c;
    __device__ bool next(int i, Unit& u) const {
        const long L = (long)i * G + c; const int nM = tp[8], nwg = nM * nN; if (L >= nwg) return false;
        int wgid = (int)L; { const int q = nwg / NXCD, r = nwg % NXCD, xcd = wgid % NXCD, off = wgid / NXCD; wgid = (xcd < r ? xcd * (q + 1) : r * (q + 1) + (xcd - r) * q) + off; }
        const int nig = WGM * nN, gid = wgid / nig, fm = gid * WGM, gsz = (nM - fm) < WGM ? (nM - fm) : WGM;
        const int rt = fm + ((wgid % nig) % gsz), cn = (wgid % nig) / gsz; int e = 0;
#pragma unroll
        for (int k = 1; k < 8; ++k) e += (rt >= tp[k]) ? 1 : 0;
        u.pm = rt; u.pn = e * nN + cn; return true;
    }
    __device__ __forceinline__ void a_ready(const Unit&) const {}
    __device__ __forceinline__ void done(const Unit&) const {}
};

__device__ __forceinline__ unsigned pk2h(float lo, float hi) { f16x2 v = {(_Float16)lo, (_Float16)hi}; return __builtin_bit_cast(unsigned, v); }
typedef int i32x4 __attribute__((ext_vector_type(4)));
typedef int i32x8 __attribute__((ext_vector_type(8)));
__device__ __forceinline__ unsigned pk4f8(float a, float b, float c, float d) {
    a = __builtin_amdgcn_fmed3f(a, -448.f, 448.f); b = __builtin_amdgcn_fmed3f(b, -448.f, 448.f); c = __builtin_amdgcn_fmed3f(c, -448.f, 448.f); d = __builtin_amdgcn_fmed3f(d, -448.f, 448.f);
    int w = __builtin_amdgcn_cvt_pk_fp8_f32(a, b, 0, false); w = __builtin_amdgcn_cvt_pk_fp8_f32(c, d, w, true); return (unsigned)w;
}
__device__ __forceinline__ float fast_sigmoid(float v) { return __builtin_amdgcn_rcpf(1.0f + __builtin_amdgcn_exp2f(-1.4426950408889634f * v)); }

struct EpiF16 {
    static constexpr bool PERM = true, AFTER_DRAIN = false;
    h16_t* O; int ldc; int nmod; float sA; float sB;
    __device__ __forceinline__ void operator()(const f32x4 (&acc)[2][2][4][2], const Unit& u, int wr, int wc, int fr, int fq) const {
        const int row0 = u.pm * BM + wr * 64 + fr; const int pn = u.pn % nmod;
        float sc = 1.f; if (sA != 0.f) { if (pn < 2) sc = sA; else if (pn == 6 || pn == 7) sc = sB; }
        const int col0 = pn * BM + wc * 32 + 8 * fq;
#pragma unroll
        for (int ai = 0; ai < 2; ++ai)
#pragma unroll
            for (int m = 0; m < 4; ++m) { h16_t* rowp = O + (size_t)(row0 + ai * HALF + m * 16) * ldc + col0;
#pragma unroll
                for (int bj = 0; bj < 2; ++bj) { const f32x4 v0 = acc[ai][bj][m][0] * sc, v1 = acc[ai][bj][m][1] * sc;
                    u32x4 w; w.x = pk2h(v0[0], v0[1]); w.y = pk2h(v0[2], v0[3]); w.z = pk2h(v1[0], v1[1]); w.w = pk2h(v1[2], v1[3]);
                    *(u32x4*)(rowp + bj * HALF) = w; } }
    }
};

struct EpiQKV {
    static constexpr bool PERM = true, AFTER_DRAIN = false;
    h16_t* O; h16_t* KA; h16_t* KB1; h16_t* KB4; h16_t* KB16; unsigned* kmax; float sA, sB;
    __device__ __forceinline__ static int pi32(int r) { return (r & 0x13) | ((r & 4) << 1) | ((r & 8) >> 1); }
    __device__ __forceinline__ void operator()(const f32x4 (&acc)[2][2][4][2], const Unit& u, int wr, int wc, int fr, int fq) const {
        const int row0 = u.pm * BM + wr * 64 + fr, pn = u.pn;
        const bool isKA = (pn == 2 || pn == 3), isKB = (pn == 8 || pn == 9);
        if (!isKA && !isKB) {
            const float sc = (pn < 2) ? sA : (pn == 6 || pn == 7) ? sB : 1.0f;
            const int col0 = pn * BM + wc * 32 + 8 * fq;
#pragma unroll
            for (int ai = 0; ai < 2; ++ai)
#pragma unroll
                for (int m = 0; m < 4; ++m) { h16_t* rowp = O + (size_t)(row0 + ai * HALF + m * 16) * 3072 + col0;
#pragma unroll
                    for (int bj = 0; bj < 2; ++bj) { const f32x4 v0 = acc[ai][bj][m][0] * sc, v1 = acc[ai][bj][m][1] * sc;
                        u32x4 w; w.x = pk2h(v0[0], v0[1]); w.y = pk2h(v0[2], v0[3]); w.z = pk2h(v1[0], v1[1]); w.w = pk2h(v1[2], v1[3]);
                        *(u32x4*)(rowp + bj * HALF) = w; } }
            return;
        }
        const int b = u.pm >> 4;
        float mx[2] = {0.f, 0.f};
#pragma unroll
        for (int ai = 0; ai < 2; ++ai)
#pragma unroll
            for (int m = 0; m < 4; ++m) { const int t = (row0 + ai * HALF + m * 16) & 4095;
#pragma unroll
                for (int bj = 0; bj < 2; ++bj) { const f32x4 v0 = acc[ai][bj][m][0], v1 = acc[ai][bj][m][1];
                    u32x4 w; w.x = pk2h(v0[0], v0[1]); w.y = pk2h(v0[2], v0[3]); w.z = pk2h(v1[0], v1[1]); w.w = pk2h(v1[2], v1[3]);
                    const int cs = (pn & 1) * 256 + bj * HALF + wc * 32 + 8 * fq, h = cs >> 6, c8 = (cs & 63) >> 3, bh = b * 8 + h;
                    if (isKA) {
                        const int frag = (c8 >> 2) * 2 + ((c8 >> 1) & 1), hi = c8 & 1;
                        *(u32x4*)(KA + ((size_t)((bh * 128 + (t >> 5)) * 4 + frag) * 64 + hi * 32 + pi32(t & 31)) * 8) = w;
                        float q2 = (v0[0] * v0[0] + v0[1] * v0[1]) + (v0[2] * v0[2] + v0[3] * v0[3]) + (v1[0] * v1[0] + v1[1] * v1[1]) + (v1[2] * v1[2] + v1[3] * v1[3]);
                        q2 += __shfl_xor(q2, 16); q2 += __shfl_xor(q2, 32);
                        mx[bj] = fmaxf(mx[bj], q2);
                    } else {
                        const int sl = c8 >> 1, hi = c8 & 1;
                        { const int uu = t >> 5, r = t & 31; *(u32x4*)(KB1 + ((size_t)((bh * 128 + uu) * 4 + sl) * 64 + hi * 32 + pi32(r)) * 8) = w; }
                        { const int i = t >> 2, uu = (t & 3) * 32 + (i >> 5), r = i & 31; *(u32x4*)(KB4 + ((size_t)((bh * 128 + uu) * 4 + sl) * 64 + hi * 32 + pi32(r)) * 8) = w; }
                        { const int i = t >> 4, uu = (t & 15) * 8 + (i >> 5), r = i & 31; *(u32x4*)(KB16 + ((size_t)((bh * 128 + uu) * 4 + sl) * 64 + hi * 32 + pi32(r)) * 8) = w; }
                    } } }
        if (isKA) {
#pragma unroll
            for (int bj = 0; bj < 2; ++bj) { float v = mx[bj];
                v = fmaxf(v, __shfl_xor(v, 1)); v = fmaxf(v, __shfl_xor(v, 2)); v = fmaxf(v, __shfl_xor(v, 4)); v = fmaxf(v, __shfl_xor(v, 8));
                const int cs = (pn & 1) * 256 + bj * HALF + wc * 32;
                if ((threadIdx.x & 63) == 0) __hip_atomic_fetch_max(kmax + (b * 8 + (cs >> 6)) * 2 + ((cs >> 5) & 1), __float_as_uint(v * 1.002f), __ATOMIC_RELAXED, __HIP_MEMORY_SCOPE_AGENT); }
        }
    }
};

template <int MODE> struct EpiGated {
    static constexpr bool PERM = true, AFTER_DRAIN = false;
    h16_t* O; int ldc; int nmod; const float* bias; float sin;
    __device__ __forceinline__ void operator()(const f32x4 (&acc)[2][2][4][2], const Unit& u, int wr, int wc, int fr, int fq) const {
        const int row0 = u.pm * BM + wr * 64 + fr; const int pn = u.pn % nmod;
        const int col0 = pn * HALF + wc * 32 + 8 * fq;
        f32x4 ba[2], bb[2];
#pragma unroll
        for (int n = 0; n < 2; ++n) { if (MODE == 1) { ba[n] = *(const f32x4*)(bias + col0 + 4 * n); bb[n] = *(const f32x4*)(bias + 1024 + col0 + 4 * n); } else { ba[n] = (f32x4){0.f, 0.f, 0.f, 0.f}; bb[n] = ba[n]; } }
#pragma unroll
        for (int ai = 0; ai < 2; ++ai)
#pragma unroll
            for (int m = 0; m < 4; ++m) { h16_t* rowp = O + (size_t)(row0 + ai * HALF + m * 16) * ldc + col0;
                float r[8];
#pragma unroll
                for (int n = 0; n < 2; ++n)
#pragma unroll
                    for (int e = 0; e < 4; ++e) { const float a = acc[ai][0][m][n][e] * sin + ba[n][e], b = acc[ai][1][m][n][e] * sin + bb[n][e];
                        r[4 * n + e] = (MODE == 0) ? (a * fast_sigmoid(a)) * b : a * fast_sigmoid(b); }
                u32x4 w; w.x = pk2h(r[0], r[1]); w.y = pk2h(r[2], r[3]); w.z = pk2h(r[4], r[5]); w.w = pk2h(r[6], r[7]);
                *(u32x4*)rowp = w; }
    }
};

struct EpiF16S {
    static constexpr bool PERM = true, AFTER_DRAIN = false;
    h16_t* O; int ldc; int nmod; float s;
    __device__ __forceinline__ void operator()(const f32x4 (&acc)[2][2][4][2], const Unit& u, int wr, int wc, int fr, int fq) const {
        const int row0 = u.pm * BM + wr * 64 + fr; const int pn = u.pn % nmod;
        const int col0 = pn * BM + wc * 32 + 8 * fq;
#pragma unroll
        for (int ai = 0; ai < 2; ++ai)
#pragma unroll
            for (int m = 0; m < 4; ++m) { h16_t* rowp = O + (size_t)(row0 + ai * HALF + m * 16) * ldc + col0;
#pragma unroll
                for (int bj = 0; bj < 2; ++bj) { const f32x4 v0 = acc[ai][bj][m][0] * s, v1 = acc[ai][bj][m][1] * s;
                    u32x4 w; w.x = pk2h(v0[0], v0[1]); w.y = pk2h(v0[2], v0[3]); w.z = pk2h(v1[0], v1[1]); w.w = pk2h(v1[2], v1[3]);
                    *(u32x4*)(rowp + bj * HALF) = w; } }
    }
};
template <int MODE, bool PADLAST> struct EpiGated8 {
    static constexpr bool PERM = true, AFTER_DRAIN = false;
    unsigned char* O; int ldc; int nmod; const float* bias; float sin, so;
    __device__ __forceinline__ void operator()(const f32x4 (&acc)[2][2][4][2], const Unit& u, int wr, int wc, int fr, int fq) const {
        const int row0 = u.pm * BM + wr * 64 + fr; const int pn = u.pn % nmod;
        const int col0 = pn * HALF + wc * 32 + 8 * fq;
        f32x4 ba[2], bb[2];
#pragma unroll
        for (int n = 0; n < 2; ++n) { if (MODE == 1) { ba[n] = *(const f32x4*)(bias + col0 + 4 * n); bb[n] = *(const f32x4*)(bias + 1024 + col0 + 4 * n); } else { ba[n] = (f32x4){0.f, 0.f, 0.f, 0.f}; bb[n] = ba[n]; } }
#pragma unroll
        for (int ai = 0; ai < 2; ++ai)
#pragma unroll
            for (int m = 0; m < 4; ++m) { unsigned char* rowp = O + (size_t)(row0 + ai * HALF + m * 16) * ldc + col0;
                float r[8];
#pragma unroll
                for (int n = 0; n < 2; ++n)
#pragma unroll
                    for (int e = 0; e < 4; ++e) { const float a = acc[ai][0][m][n][e] * sin + ba[n][e], b = acc[ai][1][m][n][e] * sin + bb[n][e];
                        r[4 * n + e] = (MODE == 0) ? (a * fast_sigmoid(a)) * (b * so) : (a * so) * fast_sigmoid(b); }
                typedef unsigned u32x2 __attribute__((ext_vector_type(2)));
                u32x2 w; w.x = pk4f8(r[0], r[1], r[2], r[3]); w.y = pk4f8(r[4], r[5], r[6], r[7]);
                *(u32x2*)rowp = w;
                if (PADLAST) { if (pn == nmod - 1) *(u32x2*)(rowp + HALF) = (u32x2){0u, 0u}; } }
    }
};

template <class Epi, class Sched, bool ALIGN_EPI = false, bool SP2 = false, bool F8 = false>
__device__ __forceinline__ void gemm_phase(PG8_LAS unsigned char* lds, const Gemm g, const Sched& S, const Epi& E) {
    const int tid = threadIdx.x, wid = __builtin_amdgcn_readfirstlane(tid >> 6), lane = tid & 63, wr = wid >> 2, wc = wid & 3, fr = lane & 15, fq = lane >> 4;
    const int K = g.K, nt = K / BK;
    unsigned voffA[2], voffB[2];
#pragma unroll
    for (int i = 0; i < 2; ++i) { int R, C; stage_rc(tid * 16 + i * 8192, R, C); const int Rb = Epi::PERM ? ((R & ~31) + perm32(R & 31)) : R;
        voffA[i] = (unsigned)(R * K + C) * 2u; voffB[i] = (unsigned)(Rb * K + C) * 2u; }
    const size_t kstep = (size_t)(BK * 2);
    const size_t hstep = (size_t)HALF * K * 2;
    const size_t qstep = (size_t)64 * K * 2;
    const size_t tstep = 2 * hstep;
    const unsigned ldsw = (unsigned)wid * 1024u;
    const int aoff = lds_byte(wr * 64 + fr, fq * 8); int boff = lds_byte(wc * 32 + fr, fq * 8);
    if constexpr (F8) { boff += 4 * HTB; asm volatile("" : "+v"(boff)); }
#define PG8_SA(b, h) (((b) * 2 + (h)) * HTB)
#define PG8_SB(b, h) ((4 + (b) * 2 + (h)) * HTB)
#define PG8_SBR(b, h) ((F8 ? 0 : 4 * HTB) + ((b) * 2 + (h)) * HTB)
#define PG8_STAGE(bufoff, gbase, voff) do { _Pragma("unroll") for (int _i = 0; _i < 2; ++_i) { \
        if constexpr (F8) __builtin_amdgcn_global_load_lds((const unsigned*)((const char*)(gbase) + (size_t)_i * qstep + (voff)[0]), (PG8_LAS unsigned*)(lds + (bufoff) + ldsw + _i * 8192), 16, 0, 0); \
        else __builtin_amdgcn_global_load_lds((const unsigned*)((const char*)(gbase) + (voff)[_i]), (PG8_LAS unsigned*)(lds + (bufoff) + ldsw + _i * 8192), 16, 0, 0); } } while (0)
#define PG8_LD8(off) __builtin_shufflevector(*(const PG8_LAS i32x4*)(lds + (off)), *(const PG8_LAS i32x4*)(lds + (off) + 1024), 0, 1, 2, 3, 4, 5, 6, 7)
#define PG8_LDA(dst, b, h) do { _Pragma("unroll") for (int m = 0; m < 4; ++m) { if constexpr (F8) dst##8[m] = PG8_LD8(PG8_SA(b, h) + aoff + m * 2048); \
        else { _Pragma("unroll") for (int k = 0; k < 2; ++k) dst[m][k] = *(const PG8_LAS f16x8*)(lds + PG8_SA(b, h) + aoff + m * 2048 + k * 1024); } } } while (0)
#define PG8_LDB(dst, b, h) do { _Pragma("unroll") for (int n = 0; n < 2; ++n) { if constexpr (F8) dst##8[n] = PG8_LD8(PG8_SBR(b, h) + boff + n * 2048); \
        else { _Pragma("unroll") for (int k = 0; k < 2; ++k) dst[n][k] = *(const PG8_LAS f16x8*)(lds + PG8_SBR(b, h) + boff + n * 2048 + k * 1024); } } } while (0)
#define PG8_MMA(ai, bj, At, Bt) do { __builtin_amdgcn_s_setprio(1); _Pragma("unroll") for (int m = 0; m < 4; ++m) _Pragma("unroll") for (int n = 0; n < 2; ++n) { \
        if constexpr (F8) { f32x4 c_ = {acc16[ai][bj][n][4 * m], acc16[ai][bj][n][4 * m + 1], acc16[ai][bj][n][4 * m + 2], acc16[ai][bj][n][4 * m + 3]}; \
            c_ = __builtin_amdgcn_mfma_scale_f32_16x16x128_f8f6f4(Bt##8[n], At##8[m], c_, 0, 0, 0, 0, 0, 0); \
            acc16[ai][bj][n][4 * m] = c_[0]; acc16[ai][bj][n][4 * m + 1] = c_[1]; acc16[ai][bj][n][4 * m + 2] = c_[2]; acc16[ai][bj][n][4 * m + 3] = c_[3]; } \
        else { _Pragma("unroll") for (int k = 0; k < 2; ++k) acc[ai][bj][m][n] = __builtin_amdgcn_mfma_f32_16x16x32_f16(Bt[n][k], At[m][k], acc[ai][bj][m][n], 0, 0, 0); } } \
        __builtin_amdgcn_s_setprio(0); } while (0)
#define PG8_WAIT_V(n) asm volatile("s_waitcnt vmcnt(" #n ")" ::: "memory")
#define PG8_WAIT_L(n) asm volatile("s_waitcnt lgkmcnt(" #n ")" ::: "memory")
#define PG8_BAR __builtin_amdgcn_s_barrier()
#define PG8_SCHED __builtin_amdgcn_sched_barrier(0)
    Unit cur, nxt; int ui = 0;
    if (!S.next(0, cur)) return;
    f32x4 acc[2][2][4][2]; f32x16 acc16[2][2][2];
#define PG8_ZERO_ACC do { _Pragma("unroll") for (int a = 0; a < 2; ++a) _Pragma("unroll") for (int b = 0; b < 2; ++b) { \
        if constexpr (F8) { _Pragma("unroll") for (int n = 0; n < 2; ++n) _Pragma("unroll") for (int r = 0; r < 16; ++r) acc16[a][b][n][r] = 0.f; } \
        else { _Pragma("unroll") for (int m = 0; m < 4; ++m) _Pragma("unroll") for (int n = 0; n < 2; ++n) acc[a][b][m][n] = (f32x4){0.f, 0.f, 0.f, 0.f}; } } } while (0)
    PG8_ZERO_ACC;
    f16x8 At[4][2], B0[2][2], B1[2][2]; i32x8 At8[4], B08[2], B18[2];
    const char* cA = (const char*)g.A + (size_t)cur.pm * tstep; const char* cB = (const char*)g.Bt + (size_t)cur.pn * tstep;
    S.a_ready(cur);
    if constexpr (SP2) {
        PG8_STAGE(PG8_SB(0, 0), cB, voffB); PG8_STAGE(PG8_SB(0, 1), cB + hstep, voffB); PG8_STAGE(PG8_SA(0, 0), cA, voffA); PG8_STAGE(PG8_SA(0, 1), cA + hstep, voffA);
        if (wr == 1) PG8_BAR;
        PG8_WAIT_V(2); PG8_BAR;
        PG8_STAGE(PG8_SB(1, 0), cB + kstep, voffB); PG8_STAGE(PG8_SA(1, 0), cA + kstep, voffA); PG8_STAGE(PG8_SB(1, 1), cB + hstep + kstep, voffB);
        PG8_WAIT_V(6); PG8_BAR;
    } else {
        PG8_STAGE(PG8_SB(0, 0), cB, voffB); PG8_STAGE(PG8_SA(0, 0), cA, voffA); PG8_STAGE(PG8_SB(0, 1), cB + hstep, voffB); PG8_STAGE(PG8_SA(0, 1), cA + hstep, voffA);
        if (wr == 1) PG8_BAR;
        PG8_WAIT_V(4); PG8_BAR;
        PG8_STAGE(PG8_SB(1, 0), cB + kstep, voffB); PG8_STAGE(PG8_SA(1, 0), cA + kstep, voffA); PG8_STAGE(PG8_SB(1, 1), cB + hstep + kstep, voffB);
        PG8_WAIT_V(6); PG8_BAR;
    }
    for (;;) {
        const bool has_next = S.next(ui + 1, nxt);
        const char* nA = has_next ? (const char*)g.A + (size_t)nxt.pm * tstep : cA; const char* nB = has_next ? (const char*)g.Bt + (size_t)nxt.pn * tstep : cB;
        for (int t = 0; t < nt; t += 2) {
            const bool last = (t == nt - 2);
            const char* a1 = cA + (size_t)(t + 1) * kstep;
            const char* a2 = last ? nA : cA + (size_t)(t + 2) * kstep; const char* b2 = last ? nB : cB + (size_t)(t + 2) * kstep;
            const char* a3 = a2 + kstep; const char* b3 = b2 + kstep;
            if (last && has_next) S.a_ready(nxt);
            if constexpr (SP2) {
            PG8_LDB(B0, 0, 0); PG8_LDB(B1, 0, 1); PG8_SCHED; PG8_LDA(At, 0, 0); PG8_STAGE(PG8_SA(1, 1), a1 + hstep, voffA);
            PG8_WAIT_V(8); PG8_WAIT_L(0); PG8_BAR; PG8_MMA(0, 0, At, B0); PG8_MMA(0, 1, At, B1); PG8_BAR; PG8_SCHED;
            PG8_LDA(At, 0, 1); PG8_STAGE(PG8_SB(0, 0), b2, voffB); PG8_STAGE(PG8_SB(0, 1), b2 + hstep, voffB); PG8_STAGE(PG8_SA(0, 0), a2, voffA);
            PG8_WAIT_V(8); PG8_WAIT_L(0); PG8_BAR; PG8_MMA(1, 0, At, B0); PG8_MMA(1, 1, At, B1); PG8_BAR; PG8_SCHED;
            PG8_LDB(B0, 1, 0); PG8_LDB(B1, 1, 1); PG8_SCHED; PG8_LDA(At, 1, 0); PG8_STAGE(PG8_SA(0, 1), a2 + hstep, voffA);
            PG8_WAIT_V(8); PG8_WAIT_L(0); PG8_BAR; PG8_MMA(0, 0, At, B0); PG8_MMA(0, 1, At, B1); PG8_BAR; PG8_SCHED;
            PG8_LDA(At, 1, 1); PG8_STAGE(PG8_SB(1, 0), b3, voffB); PG8_STAGE(PG8_SB(1, 1), b3 + hstep, voffB); PG8_STAGE(PG8_SA(1, 0), a3, voffA);
            PG8_WAIT_V(8); PG8_WAIT_L(0); PG8_BAR; PG8_MMA(1, 0, At, B0); PG8_MMA(1, 1, At, B1); PG8_BAR; PG8_SCHED;
            } else {
            PG8_LDB(B0, 0, 0); PG8_SCHED; PG8_LDA(At, 0, 0); PG8_STAGE(PG8_SA(1, 1), a1 + hstep, voffA);
            PG8_WAIT_L(8); PG8_BAR; PG8_WAIT_L(0); PG8_MMA(0, 0, At, B0); PG8_BAR; PG8_SCHED;
            PG8_LDB(B1, 0, 1); PG8_STAGE(PG8_SB(0, 0), b2, voffB);
            PG8_BAR; PG8_WAIT_L(0); PG8_MMA(0, 1, At, B1); PG8_BAR;
            PG8_LDA(At, 0, 1); PG8_STAGE(PG8_SA(0, 0), a2, voffA);
            PG8_BAR; PG8_WAIT_L(0); PG8_MMA(1, 0, At, B0); PG8_BAR; PG8_SCHED;
            PG8_STAGE(PG8_SB(0, 1), b2 + hstep, voffB);
            PG8_WAIT_V(6); PG8_BAR; PG8_MMA(1, 1, At, B1); PG8_BAR;
            PG8_LDB(B0, 1, 0); PG8_SCHED; PG8_LDA(At, 1, 0); PG8_STAGE(PG8_SA(0, 1), a2 + hstep, voffA);
            PG8_WAIT_L(8); PG8_BAR; PG8_WAIT_L(0); PG8_MMA(0, 0, At, B0); PG8_BAR; PG8_SCHED;
            PG8_LDB(B1, 1, 1); PG8_STAGE(PG8_SB(1, 0), b3, voffB);
            PG8_BAR; PG8_WAIT_L(0); PG8_MMA(0, 1, At, B1); PG8_BAR;
            PG8_LDA(At, 1, 1); PG8_STAGE(PG8_SA(1, 0), a3, voffA);
            PG8_BAR; PG8_WAIT_L(0); PG8_MMA(1, 0, At, B0); PG8_BAR; PG8_SCHED;
            PG8_STAGE(PG8_SB(1, 1), b3 + hstep, voffB);
            PG8_WAIT_V(6); PG8_BAR; PG8_MMA(1, 1, At, B1); PG8_BAR;
            }
        }
        if constexpr (ALIGN_EPI) { if (wr == 0) PG8_BAR; }
        if constexpr (F8) {
#pragma unroll
            for (int a = 0; a < 2; ++a)
#pragma unroll
                for (int b = 0; b < 2; ++b)
#pragma unroll
                    for (int m = 0; m < 4; ++m)
#pragma unroll
                        for (int n = 0; n < 2; ++n) acc[a][b][m][n] = (f32x4){acc16[a][b][n][4 * m], acc16[a][b][n][4 * m + 1], acc16[a][b][n][4 * m + 2], acc16[a][b][n][4 * m + 3]};
        }
        if constexpr (!Epi::AFTER_DRAIN) { E(acc, cur, wr, wc, fr, fq); S.done(cur); }
        if (!has_next) break;
        PG8_ZERO_ACC;
        cur = nxt; cA = nA; cB = nB; ++ui;
        if constexpr (ALIGN_EPI) { if (wr == 1) PG8_BAR; }
    }
    PG8_WAIT_V(0);
    if constexpr (!ALIGN_EPI) { if (wr == 0) PG8_BAR; }
    PG8_BAR;
    if constexpr (Epi::AFTER_DRAIN) { E.fused(acc, cur, wr, wc, fr, fq, lds, wid, lane); S.done(cur); }
#undef PG8_SA
#undef PG8_SB
#undef PG8_SBR
#undef PG8_STAGE
#undef PG8_LDA
#undef PG8_LDB
#undef PG8_MMA
#undef PG8_ZERO_ACC
#undef PG8_LD8
#undef PG8_WAIT_V
#undef PG8_WAIT_L
#undef PG8_BAR
#undef PG8_SCHED
}
}

constexpr int NWAVES = 8;
constexpr int BATCH = 8, SEQ = 4096, D = 1024, M = BATCH * SEQ;
constexpr int DFF = 2816, NEXP = 8, DFE = 1408;
constexpr int NPH = 17;
constexpr int N_LAUNCHES = MK_N_LAUNCHES;
static_assert(N_LAUNCHES == 1, "one launch only (PH4 has an inner grid barrier)");
constexpr int DFE_PAD = 1536;
constexpr float S8_H = 8.0f, S8_HID = 8.0f, S8_WE1 = 512.0f, S8_WE2 = 1024.0f, S8_WF1 = 512.0f, S8_WF2 = 1024.0f, S8_WGLU = 1024.0f, S8_GY = 16.0f;
constexpr float LN_EPS = 1e-5f, LOG2E = 1.4426950408889634f, DN_ALPHA = 1.4142135623730951f;
constexpr float QSCALE_A = 0.17677669529663687f * LOG2E;
constexpr float QSCALE_B = 0.125f * LOG2E;

constexpr size_t MiB = 1u << 20;
constexpr size_t WS_CTL = 0, CTL_ZERO_BYTES = 1 * MiB;
constexpr size_t WS_MOD = 1 * MiB;
constexpr size_t WS_SSMA = 1 * MiB + 512 * 1024;
constexpr size_t WS_SSMB = WS_SSMA + 64 * 1024;
constexpr size_t WS_TOKE = 2 * MiB + 512 * 1024;
constexpr size_t WS_TOKG = WS_TOKE + 256 * 1024;
constexpr size_t WS_TOKP = WS_TOKG + 256 * 1024;
constexpr size_t WS_W_IN = 4 * MiB, WS_W_OUT = 10 * MiB, WS_W_F1 = 12 * MiB, WS_W_F2 = 23 * MiB, WS_W_GLU = 28 * MiB + 512 * 1024;
constexpr size_t WS_W_E1 = 32 * MiB + 512 * 1024, WS_W_E2 = 76 * MiB + 512 * 1024;
constexpr size_t WS_A = 100 * MiB, WS_B = 292 * MiB, WS_C = 356 * MiB, WS_VT1 = 424 * MiB, WS_END = 488 * MiB;
constexpr size_t WS_UG = 228 * MiB;
constexpr size_t WS_SSMM = 196 * MiB;
constexpr size_t WS_KA = 356 * MiB, WS_KB1 = 388 * MiB, WS_KB4 = 420 * MiB, WS_KB16 = 452 * MiB;
constexpr int MOE_MAX_TILES = 264;
static_assert(WS_W_E2 + (size_t)NEXP * D * DFE * 2 <= WS_A, "weights fit");
static_assert((size_t)MOE_MAX_TILES * 256 * DFE * 2 <= WS_B - WS_A, "hidden_g fits region A");
static_assert(WS_B + (size_t)MOE_MAX_TILES * 256 * D * 2 <= WS_VT1, "gathered rows fit");
constexpr int CW_TMO = 0, CW_CODE = 1;
constexpr int CW_ECNT = 64;
constexpr int CW_ECUR = 128;
constexpr int CW_UQ = 1024;
constexpr int CW_TQ = 192;
constexpr int CW_PREP = 512;
constexpr int CW_KMAX = 256;
constexpr int CW_BAR = 4096;

constexpr int RING_OFF = 0, RING_BYTES = 131072;
constexpr int LDSCTL_OFF = RING_BYTES + 1024, MISC_OFF = LDSCTL_OFF + 320;
constexpr int LDS_BYTES = 147456;

#define GAS __attribute__((address_space(1)))
#define LAS __attribute__((address_space(3)))
typedef unsigned short h16;
typedef unsigned v4u __attribute__((ext_vector_type(4)));
typedef unsigned v2u __attribute__((ext_vector_type(2)));
typedef float f32x4 __attribute__((ext_vector_type(4)));
typedef GAS unsigned gu32;
#define RLX_AGENT __ATOMIC_RELAXED, __HIP_MEMORY_SCOPE_AGENT
#define LDS_WAIT() asm volatile("s_waitcnt lgkmcnt(0)" ::: "memory")
#define VM_WAIT() asm volatile("s_waitcnt vmcnt(0)" ::: "memory")
using pg8::pk2h;
__device__ __forceinline__ float h2f(unsigned short v) { return (float)__builtin_bit_cast(_Float16, v); }
__device__ __forceinline__ float hlo(unsigned w) { return h2f((unsigned short)(w & 0xffffu)); }
__device__ __forceinline__ float hhi(unsigned w) { return h2f((unsigned short)(w >> 16)); }
#define DPPF_(x, ctrl, rm) __builtin_bit_cast(float, __builtin_amdgcn_update_dpp(0, __builtin_bit_cast(int, (x)), (ctrl), (rm), 0xf, false))
__device__ __forceinline__ float wave_sum(float v) {
    v += DPPF_(v, 0xb1, 0xf);
    v += DPPF_(v, 0x4e, 0xf);
    v += DPPF_(v, 0x124, 0xf);
    v += DPPF_(v, 0x128, 0xf);
    v += DPPF_(v, 0x142, 0xa);
    v += DPPF_(v, 0x143, 0xc);
    return __builtin_bit_cast(float, __builtin_amdgcn_readlane(__builtin_bit_cast(int, v), 63));
}
__device__ __forceinline__ float wave_max(float v) {
#pragma unroll
    for (int o = 1; o < 64; o <<= 1) v = fmaxf(v, __shfl_xor(v, o));
    return v;
}
__device__ __forceinline__ float ex2(float v) { return __builtin_amdgcn_exp2f(v); }
__device__ __forceinline__ float gelu_tanh(float v) {
    const float z = 0.7978845608028654f * (v + 0.044715f * v * v * v);
    const float e = ex2(2.0f * LOG2E * z);
    const float th = 1.0f - 2.0f * __builtin_amdgcn_rcpf(1.0f + e);
    return 0.5f * v * (1.0f + th);
}

#define XB_TMO      128
#define XB_XCNT(j)  (256  + 64 * (j))
#define XB_XSUB(j)  (1280 + 64 * (j))
#define XB_XGEN(j)  (2304 + 64 * (j))
#define XB_TOP      3328
#define XB_TOPGEN   3392
#define XCD_BAR_WORDS 3456
#define XB_SPIN_CAP (1u << 18)

__device__ __forceinline__ unsigned xb_ld(unsigned* p)              { return __hip_atomic_load(p, __ATOMIC_RELAXED, __HIP_MEMORY_SCOPE_AGENT); }
__device__ __forceinline__ unsigned xb_add(unsigned* p, unsigned v) { return __hip_atomic_fetch_add(p, v, __ATOMIC_RELAXED, __HIP_MEMORY_SCOPE_AGENT); }
__device__ __forceinline__ unsigned xb_xcc_id() { return (unsigned)__builtin_amdgcn_s_getreg((3 << 11) | 20) & 0xFu; }
#define XB_SPIN(cond, bar) do { unsigned _sp = 0; while (cond) { __builtin_amdgcn_s_sleep(1); \
    if ((++_sp & 255u) == 0u) { if (xb_ld(&(bar)[XB_TMO])) break; if (_sp > XB_SPIN_CAP) { atomicAdd(&(bar)[XB_TMO], 1u); break; } } } } while (0)

struct XcdBarrier {
    unsigned* bar; unsigned x;
    volatile LAS unsigned* st;
};

__device__ __forceinline__ XcdBarrier xcd_barrier_post(unsigned* bar, volatile LAS unsigned* st) {
    XcdBarrier b; b.bar = bar; b.x = xb_xcc_id(); b.st = st;
    if (threadIdx.x == 0) (void)xb_add(&bar[XB_XCNT(b.x)], 1u);
    return b;
}
__device__ __forceinline__ void xcd_barrier_complete(unsigned* bar, unsigned x, unsigned& nloc, unsigned& nx) {
    const unsigned G = gridDim.x * gridDim.y * gridDim.z;
    unsigned sum, cnt, mine, sp = 0u;
    for (;;) {
        sum = 0u; cnt = 0u; mine = 0u;
#pragma unroll
        for (unsigned j = 0; j < 16; ++j) { const unsigned c = xb_ld(&bar[XB_XCNT(j)]); sum += c; cnt += (c > 0u) ? 1u : 0u; mine = (j == x) ? c : mine; }
        if (sum == G) break;
        __builtin_amdgcn_s_sleep(1);
        if ((++sp & 255u) == 0u) { if (xb_ld(&bar[XB_TMO])) break; if (sp > XB_SPIN_CAP) { atomicAdd(&bar[XB_TMO], 1u); break; } }
    }
    nloc = mine > 0u ? mine : 1u; nx = cnt > 0u ? cnt : 1u;
}

__device__ __forceinline__ void xcd_barrier(const XcdBarrier& b) {
    asm volatile("s_waitcnt vmcnt(0)" ::: "memory");
    __syncthreads();
    if (threadIdx.x == 0) {
        unsigned* bar = b.bar;
        __builtin_amdgcn_s_waitcnt(0);
        unsigned nloc = b.st[0], nx = b.st[1];
        if (nloc == 0u) { xcd_barrier_complete(bar, b.x, nloc, nx); b.st[0] = nloc; b.st[1] = nx; }
        const unsigned old = xb_add(&bar[XB_XSUB(b.x)], 1u);
        const unsigned gen = old / nloc;
        if (old + 1u == (gen + 1u) * nloc) {
            __builtin_amdgcn_fence(__ATOMIC_RELEASE, "agent");
            asm volatile("s_waitcnt vmcnt(0)" ::: "memory");
            const unsigned og = xb_add(&bar[XB_TOP], 1u);
            const unsigned tg = og / nx;
            if (og + 1u == (tg + 1u) * nx) xb_add(&bar[XB_TOPGEN], 1u);
            else XB_SPIN(xb_ld(&bar[XB_TOPGEN]) == tg, bar);
            __builtin_amdgcn_fence(__ATOMIC_ACQUIRE, "agent");
            xb_add(&bar[XB_XGEN(b.x)], 1u);
            asm volatile("s_waitcnt vmcnt(0)" ::: "memory");
        } else {
            XB_SPIN(xb_ld(&bar[XB_XGEN(b.x)]) == gen, bar);
            __builtin_amdgcn_fence(__ATOMIC_ACQUIRE, "agent");
            asm volatile("s_waitcnt vmcnt(0)" ::: "memory");
        }
    }
    __syncthreads();
}

struct Frame {
    LAS unsigned char* lds;
    volatile LAS unsigned* MISC;
    gu32* ctl;
    int tid, lane, wave;
    int vcu, G;
    const float* in[39]; float* out; unsigned char* ws;
};
enum { I_X = 0, I_C, I_ADAW0, I_ADAB0, I_WIN, I_LQ1, I_LK1, I_LQ2, I_LK2, I_SUBLN, I_WOUT, I_LN1G0, I_LN1B0, I_FG, I_FU, I_FD, I_LN2G0, I_LN2B0,
       I_ADAW1, I_ADAB1, I_ARE, I_AIM, I_LOGDT, I_BRE, I_BIM, I_CRE, I_CIM, I_DSKIP, I_WGLU, I_BGLU, I_LN1G1, I_LN1B1, I_RW, I_RB, I_EG, I_EU, I_ED, I_LN2G1, I_LN2B1 };

__device__ __forceinline__ void ph0_mods(Frame& F) {
    LAS float* sc = (LAS float*)(F.lds);
    LAS float* part = (LAS float*)(F.lds + 32768);
    float* mod = (float*)(F.ws + WS_MOD);
    if ((int)blockIdx.x < 192) {
        const float* c = F.in[I_C];
        for (int i = F.tid; i < BATCH * D; i += NWAVES * 64) { const float v = c[i]; sc[i] = v / (1.0f + expf(-v)); }
        __syncthreads();
        for (int it = blockIdx.x; it < 192; it += F.G) {
            const int l = it / 96, j0 = (it % 96) * 64;
            const float* W = F.in[l ? I_ADAW1 : I_ADAW0]; const float* bias = F.in[l ? I_ADAB1 : I_ADAB0];
            float acc[8];
#pragma unroll
            for (int b = 0; b < 8; ++b) acc[b] = 0.f;
            const int k0 = F.wave * 128;
            for (int kk = k0; kk < k0 + 128; kk += 16) { float w[16];
#pragma unroll
                for (int i = 0; i < 16; ++i) w[i] = W[(size_t)(kk + i) * (6 * D) + j0 + F.lane];
#pragma unroll
                for (int i = 0; i < 16; ++i)
#pragma unroll
                    for (int b = 0; b < 8; ++b) acc[b] += sc[b * D + kk + i] * w[i]; }
#pragma unroll
            for (int b = 0; b < 8; ++b) part[(F.wave * 8 + b) * 64 + F.lane] = acc[b];
            __syncthreads();
            float s = 0.f;
#pragma unroll
            for (int w2 = 0; w2 < 8; ++w2) s += part[(w2 * 8 + F.wave) * 64 + F.lane];
            mod[(size_t)(l * 8 + F.wave) * (6 * D) + j0 + F.lane] = s + bias[j0 + F.lane];
            __syncthreads();
        }
    }
    const int gid = ((int)blockIdx.x - ((F.G >= 200) ? 192 : 0)) * (NWAVES * 64) + F.tid;
    if (gid >= 0 && gid < 64 * 64) {
        const int g = gid >> 6;
        const float ar = F.in[I_ARE][gid], ai = F.in[I_AIM][gid], dt = expf(F.in[I_LOGDT][g]);
        const float mag = expf(dt * ar); float sn, cs; sincosf(dt * ai, &sn, &cs);
        const float abr = mag * cs, abi = mag * sn, den = ar * ar + ai * ai, nr = abr - 1.0f, ni = abi;
        const float zr = (nr * ar + ni * ai) / den, zi = (ni * ar - nr * ai) / den;
        float* SA = (float*)(F.ws + WS_SSMA); float* SB = (float*)(F.ws + WS_SSMB);
        SA[gid * 2] = abr; SA[gid * 2 + 1] = abi;
#pragma unroll
        for (int c = 0; c < 16; ++c) { const float br = F.in[I_BRE][gid * 16 + c], bi = F.in[I_BIM][gid * 16 + c];
            SB[(gid * 16 + c) * 2] = zr * br - zi * bi; SB[(gid * 16 + c) * 2 + 1] = zr * bi + zi * br; }
    }
}

struct TItem { const float* src; unsigned char* dst; int ldw, rowb; float f8s; };
__device__ __forceinline__ void titem_make(TItem& t, const float* W, int ldw, int K, int N, unsigned char* WT, int rowmap, int item, int lane, float f8s = 0.f, int rowb = 0) {
    const int nblk = N / 32, kb = item / nblk, nb = item % nblk, k0 = 64 * kb, n0 = 32 * nb;
    const int r0 = rowmap == 0 ? n0 : ((n0 >> 7) * 256 + (n0 & 127) + (rowmap == 2 ? 128 : 0));
    const int esz = (f8s != 0.f) ? 1 : 2;
    t.src = W + (size_t)(k0 + (lane >> 5)) * ldw + n0 + (lane & 31); t.ldw = ldw; t.rowb = rowb ? rowb : K * esz; t.f8s = f8s;
    t.dst = WT + (size_t)(r0 + (lane >> 3)) * t.rowb + (size_t)(k0 + 8 * (lane & 7)) * esz;
}
__device__ __forceinline__ void titem_decode(Frame& F, TItem& t, int it, int lane) {
    constexpr int I_0 = 16 * 96, I_1 = 16 * 32, I_2 = 16 * 88, I_3 = 16 * 88, I_4 = 44 * 32, I_5 = 16 * 32, I_6 = 16 * 32;
    constexpr int I_7 = 16 * 44, I_8 = 16 * 44, I_9 = 22 * 32;
    unsigned char* ws = F.ws; int r = it;
    if (r < I_0) { titem_make(t, F.in[I_WIN], 3 * D, D, 3 * D, ws + WS_W_IN, 0, r, lane); return; } r -= I_0;
    if (r < I_1) { titem_make(t, F.in[I_WOUT], D, D, D, ws + WS_W_OUT, 0, r, lane); return; } r -= I_1;
    if (r < I_2) { titem_make(t, F.in[I_FG], DFF, D, DFF, ws + WS_W_F1, 1, r, lane); return; } r -= I_2;
    if (r < I_3) { titem_make(t, F.in[I_FU], DFF, D, DFF, ws + WS_W_F1, 2, r, lane); return; } r -= I_3;
    if (r < I_4) { titem_make(t, F.in[I_FD], D, DFF, D, ws + WS_W_F2, 0, r, lane, S8_WF2); return; } r -= I_4;
    if (r < I_5) { titem_make(t, F.in[I_WGLU], 2 * D, D, D, ws + WS_W_GLU, 1, r, lane, S8_WGLU); return; } r -= I_5;
    if (r < I_6) { titem_make(t, F.in[I_WGLU] + D, 2 * D, D, D, ws + WS_W_GLU, 2, r, lane, S8_WGLU); return; } r -= I_6;
    const int e = r / (I_7 + I_8 + I_9); r -= e * (I_7 + I_8 + I_9);
    if (r < I_7) { titem_make(t, F.in[I_EG] + (size_t)e * D * DFE, DFE, D, DFE, ws + WS_W_E1 + (size_t)e * 2 * DFE * D, 1, r, lane, S8_WE1); return; } r -= I_7;
    if (r < I_8) { titem_make(t, F.in[I_EU] + (size_t)e * D * DFE, DFE, D, DFE, ws + WS_W_E1 + (size_t)e * 2 * DFE * D, 2, r, lane, S8_WE1); return; } r -= I_8;
    titem_make(t, F.in[I_ED] + (size_t)e * DFE * D, D, DFE, D, ws + WS_W_E2 + (size_t)e * D * DFE_PAD, 0, r, lane, S8_WE2, DFE_PAD);
}
constexpr int NIT_L0 = 16 * 96 + 16 * 32 + 2 * 16 * 88 + 44 * 32;
constexpr int NIT_ALL = NIT_L0 + 2 * 16 * 32 + NEXP * (2 * 16 * 44 + 22 * 32);
__device__ __forceinline__ void transpose_items(Frame& F, int it0, int it1, LAS float* scr) {
    const int gw = F.vcu * NWAVES + F.wave, NGW = F.G * NWAVES, lane = F.lane;
    const int NITEMS = it1;
    if (it0 + gw < NITEMS) {
        TItem cur; titem_decode(F, cur, it0 + gw, lane);
        float cv[32];
#pragma unroll
        for (int i = 0; i < 32; ++i) cv[i] = cur.src[(size_t)(2 * i) * cur.ldw];
        for (int it = it0 + gw; it < NITEMS; it += NGW) {
            TItem nxt = cur; float nv[32];
            const bool hn = it + NGW < NITEMS;
            if (hn) { titem_decode(F, nxt, it + NGW, lane);
#pragma unroll
                for (int i = 0; i < 32; ++i) nv[i] = nxt.src[(size_t)(2 * i) * nxt.ldw]; }
#pragma unroll
            for (int i = 0; i < 32; ++i) scr[(2 * i + (lane >> 5)) * 33 + (lane & 31)] = cv[i];
            LDS_WAIT(); asm volatile("" ::: "memory");
            const int c = lane & 7;
            if (cur.f8s == 0.f) {
#pragma unroll
                for (int j = 0; j < 4; ++j) { const int n = (lane >> 3) + 8 * j; const LAS float* sp = scr + (8 * c) * 33 + n;
                    v4u o; o.x = pk2h(sp[0 * 33], sp[1 * 33]); o.y = pk2h(sp[2 * 33], sp[3 * 33]); o.z = pk2h(sp[4 * 33], sp[5 * 33]); o.w = pk2h(sp[6 * 33], sp[7 * 33]);
                    *(GAS v4u*)(cur.dst + (size_t)(8 * j) * cur.rowb) = o; }
            } else { const float sw = cur.f8s;
#pragma unroll
                for (int j = 0; j < 4; ++j) { const int n = (lane >> 3) + 8 * j; const LAS float* sp = scr + (8 * c) * 33 + n;
                    v2u o; o.x = pg8::pk4f8(sp[0 * 33] * sw, sp[1 * 33] * sw, sp[2 * 33] * sw, sp[3 * 33] * sw); o.y = pg8::pk4f8(sp[4 * 33] * sw, sp[5 * 33] * sw, sp[6 * 33] * sw, sp[7 * 33] * sw);
                    *(GAS v2u*)(cur.dst + (size_t)(8 * j) * cur.rowb) = o; }
            }
            LDS_WAIT(); asm volatile("" ::: "memory");
            if (hn) {
#pragma unroll
                for (int i = 0; i < 32; ++i) cv[i] = nv[i];
                cur = nxt; }
        }
    }
}
__device__ __forceinline__ void ph1_prologue(Frame& F) {
    const int gw = F.vcu * NWAVES + F.wave, NGW = F.G * NWAVES, lane = F.lane;
    unsigned char* ws = F.ws;
    transpose_items(F, 0, NIT_ALL, (LAS float*)(F.lds + RING_OFF + F.wave * 16384));
    for (int i = (int)blockIdx.x * (NWAVES * 64) + F.tid; i < NEXP * D * 8; i += F.G * NWAVES * 64)
        *(v4u*)(ws + WS_W_E2 + (size_t)(i >> 3) * DFE_PAD + DFE + 16 * (i & 7)) = (v4u){0u, 0u, 0u, 0u};
    const float* mod0 = (const float*)(ws + WS_MOD);
    h16* H0 = (h16*)(ws + WS_B);
    {
        const int WPB = F.G, bq = gw / WPB, r0 = gw % WPB; const float* mb = mod0 + (size_t)bq * (6 * D);
        f32x4 sc1[4], shv[4];
#pragma unroll
        for (int j = 0; j < 4; ++j) { const int col = 4 * lane + 256 * j; shv[j] = *(const f32x4*)(mb + col); sc1[j] = 1.0f + *(const f32x4*)(mb + D + col); }
        for (int t0 = r0; t0 < SEQ; t0 += 8 * WPB) {
            f32x4 xr[8][4];
#pragma unroll
            for (int i = 0; i < 8; ++i) { const int t = t0 + i * WPB; if (t < SEQ) {
#pragma unroll
                for (int j = 0; j < 4; ++j) xr[i][j] = *(const f32x4*)(F.in[I_X] + ((size_t)bq * SEQ + t) * D + 4 * lane + 256 * j); } }
#pragma unroll
            for (int i = 0; i < 8; ++i) { const int t = t0 + i * WPB; if (t < SEQ) {
#pragma unroll
                for (int j = 0; j < 4; ++j) { const int col = 4 * lane + 256 * j;
                    const f32x4 h = xr[i][j] * sc1[j] + shv[j]; v2u o; o.x = pk2h(h[0], h[1]); o.y = pk2h(h[2], h[3]);
                    *(v2u*)(H0 + ((size_t)bq * SEQ + t) * D + col) = o; } } }
        }
    }
}

__device__ __forceinline__ f32x4 ld4h(const h16* p) { const v2u w = *(const v2u*)p; return (f32x4){hlo(w.x), hhi(w.x), hlo(w.y), hhi(w.y)}; }
__device__ __forceinline__ void ld8h(const h16* p, float* f) { const v4u w = *(const v4u*)p; f[0] = hlo(w.x); f[1] = hhi(w.x); f[2] = hlo(w.y); f[3] = hhi(w.y); f[4] = hlo(w.z); f[5] = hhi(w.z); f[6] = hlo(w.w); f[7] = hhi(w.w); }
__device__ __forceinline__ float lane_reduce64(float (&v)[64], int lane) {
#pragma unroll
    for (int s = 0; s < 6; ++s) { const int half = 32 >> s; const bool up = (lane & half) != 0;
#pragma unroll
        for (int i = 0; i < half; ++i) { const float lo = v[i], hi = v[i + half]; const float send = up ? lo : hi, keep = up ? hi : lo; v[i] = keep + __shfl_xor(send, half); } }
    return v[0];
}
__device__ __forceinline__ float lam_value(Frame& F) {
    float s1 = 0.f, s2 = 0.f;
#pragma unroll 4
    for (int i = 0; i < 32; ++i) { s1 += F.in[I_LQ1][i] * F.in[I_LK1][i]; s2 += F.in[I_LQ2][i] * F.in[I_LK2][i]; }
    return expf(s1) - expf(s2) + 0.2f;
}
template <bool DIFF, bool DIL> __device__ __forceinline__ void ph4_attn_naive(Frame& F) {
    const h16* QKV = (const h16*)(F.ws + WS_A); h16* O = (h16*)(F.ws + WS_B);
    const int gw = F.vcu * NWAVES + F.wave, NGW = F.G * NWAVES, lane = F.lane;
    const float lam = lam_value(F);
    const float sub_w = F.in[I_SUBLN][lane] * 0.8f;
    if (DIFF) for (int it = gw; it < BATCH * 8 * SEQ; it += NGW) {
        const int bh = it >> 12, r = it & 4095, i = (bh & 1) ? 4095 - r : r, b = bh >> 3, h = bh & 7;
        const size_t rowq = (size_t)(b * SEQ + i) * 3072;
        const float slope2 = exp2f(-0.5f * (float)(h + 1)) * LOG2E;
        float res[2];
#pragma unroll
        for (int mp = 0; mp < 2; ++mp) {
            float q[32];
#pragma unroll
            for (int d8 = 0; d8 < 4; ++d8) ld8h(QKV + rowq + h * 64 + mp * 32 + d8 * 8, q + d8 * 8);
            float acc[64];
#pragma unroll
            for (int d = 0; d < 64; ++d) acc[d] = 0.f;
            float mrun = -INFINITY, l = 0.f;
            for (int j = lane; j <= i; j += 64) {
                const size_t rowk = (size_t)(b * SEQ + j) * 3072;
                float s = 0.f;
#pragma unroll
                for (int d8 = 0; d8 < 4; ++d8) { float kf[8]; ld8h(QKV + rowk + 512 + h * 64 + mp * 32 + d8 * 8, kf);
#pragma unroll
                    for (int e = 0; e < 8; ++e) s += q[d8 * 8 + e] * kf[e]; }
                s -= slope2 * (float)(i - j);
                const float mn = fmaxf(mrun, s), alpha = ex2(mrun - mn), p = ex2(s - mn);
                l = l * alpha + p; mrun = mn;
#pragma unroll
                for (int d8 = 0; d8 < 8; ++d8) { float vf[8]; ld8h(QKV + rowk + 1024 + h * 64 + d8 * 8, vf);
#pragma unroll
                    for (int e = 0; e < 8; ++e) acc[d8 * 8 + e] = acc[d8 * 8 + e] * alpha + p * vf[e]; }
            }
            const float Mx = wave_max(mrun), scl = (mrun == -INFINITY) ? 0.f : ex2(mrun - Mx), L = wave_sum(l * scl);
#pragma unroll
            for (int d = 0; d < 64; ++d) acc[d] *= scl;
            const float mine = lane_reduce64(acc, lane);
            res[mp] = mine / L;
        }
        const float o = res[0] - lam * res[1];
        const float ss = wave_sum(o * o);
        const float y = o * (1.0f / sqrtf(ss * (1.0f / 64.0f) + LN_EPS)) * sub_w;
        O[(size_t)(b * SEQ + i) * D + h * 64 + lane] = (h16)(pk2h(y, 0.f) & 0xffffu);
    }
    if (DIL) for (int it = gw; it < BATCH * 8 * SEQ; it += NGW) {
        const int bh = it >> 12, i = it & 4095, b = bh >> 3, h = bh & 7;
        const size_t rowq = (size_t)(b * SEQ + i) * 3072;
        const float slope2 = exp2f(-0.5f * (float)(h + 9)) * LOG2E;
        float q[64];
#pragma unroll
        for (int d8 = 0; d8 < 8; ++d8) ld8h(QKV + rowq + 1536 + h * 64 + d8 * 8, q + d8 * 8);
        float og[3], lse[3];
#pragma unroll
        for (int g = 0; g < 3; ++g) {
            const int dil = (g == 0) ? 1 : (g == 1) ? 4 : 16;
            float acc[64];
#pragma unroll
            for (int d = 0; d < 64; ++d) acc[d] = 0.f;
            float mrun = -INFINITY, l = 0.f;
            for (int jj = lane; jj <= 128; jj += 64) {
                const int t = i - jj * dil;
                if (t >= 0) {
                    const size_t rowk = (size_t)(b * SEQ + t) * 3072;
                    float s = 0.f;
#pragma unroll
                    for (int d8 = 0; d8 < 8; ++d8) { float kf[8]; ld8h(QKV + rowk + 2048 + h * 64 + d8 * 8, kf);
#pragma unroll
                        for (int e = 0; e < 8; ++e) s += q[d8 * 8 + e] * kf[e]; }
                    s -= slope2 * (float)(jj * dil);
                    const float mn = fmaxf(mrun, s), alpha = ex2(mrun - mn), p = ex2(s - mn);
                    l = l * alpha + p; mrun = mn;
#pragma unroll
                    for (int d8 = 0; d8 < 8; ++d8) { float vf[8]; ld8h(QKV + rowk + 2560 + h * 64 + d8 * 8, vf);
#pragma unroll
                        for (int e = 0; e < 8; ++e) acc[d8 * 8 + e] = acc[d8 * 8 + e] * alpha + p * vf[e]; }
                }
            }
            const float Mx = wave_max(mrun), scl = (mrun == -INFINITY) ? 0.f : ex2(mrun - Mx), L = wave_sum(l * scl);
#pragma unroll
            for (int d = 0; d < 64; ++d) acc[d] *= scl;
            const float mine = lane_reduce64(acc, lane);
            og[g] = mine / L; lse[g] = Mx + log2f(L);
        }
        const float mx = fmaxf(lse[0], fmaxf(lse[1], lse[2]));
        const float w0 = ex2(lse[0] - mx), w1 = ex2(lse[1] - mx), w2 = ex2(lse[2] - mx);
        const float y = (w0 * og[0] + w1 * og[1] + w2 * og[2]) / (w0 + w1 + w2);
        O[(size_t)(b * SEQ + i) * D + 512 + h * 64 + lane] = (h16)(pk2h(y, 0.f) & 0xffffu);
    }
}


typedef _Float16 hf8 __attribute__((ext_vector_type(8)));
typedef float f32x16 __attribute__((ext_vector_type(16)));
__device__ __forceinline__ hf8 ldf8(const h16* p) { return __builtin_bit_cast(hf8, *(const v4u*)p); }
#define MFMA32(a, b, c) __builtin_amdgcn_mfma_f32_32x32x16_f16((a), (b), (c), 0, 0, 0)
typedef short v4i16_t __attribute__((ext_vector_type(4)));
typedef _Float16 hf4 __attribute__((ext_vector_type(4)));
__device__ __forceinline__ void v_stage(LAS unsigned char* vl, const v4u (&vn)[4], int lane) {
#pragma unroll
    for (int i = 0; i < 4; ++i) *(LAS v4u*)(vl + ((lane & 7) >> 2) * 2048 + ((lane >> 3) + 8 * i) * 64 + (lane & 3) * 16) = vn[i];
}
__device__ __forceinline__ hf8 v_frag(const LAS unsigned char* trb, int dt, int s) {
    const v4i16_t lo = __builtin_amdgcn_ds_read_tr16_b64_v4i16((LAS v4i16_t*)(trb + dt * 2048 + (16 * s) * 64));
    const v4i16_t hi = __builtin_amdgcn_ds_read_tr16_b64_v4i16((LAS v4i16_t*)(trb + dt * 2048 + (16 * s + 4) * 64));
    return __builtin_shufflevector(__builtin_bit_cast(hf4, lo), __builtin_bit_cast(hf4, hi), 0, 1, 2, 3, 4, 5, 6, 7);
}
__device__ __forceinline__ float rowmax16(const f32x16& s) {
    float m;
    asm("s_nop 15\n\ts_nop 7\n\t"
                 "v_max3_f32 %0, %1, %2, %3\n\tv_max3_f32 %0, %0, %4, %5\n\tv_max3_f32 %0, %0, %6, %7\n\tv_max3_f32 %0, %0, %8, %9\n\t"
                 "v_max3_f32 %0, %0, %10, %11\n\tv_max3_f32 %0, %0, %12, %13\n\tv_max3_f32 %0, %0, %14, %15\n\tv_max_f32 %0, %0, %16"
                 : "=&v"(m)
                 : "v"(s[0]), "v"(s[1]), "v"(s[2]), "v"(s[3]), "v"(s[4]), "v"(s[5]), "v"(s[6]), "v"(s[7]), "v"(s[8]), "v"(s[9]), "v"(s[10]), "v"(s[11]), "v"(s[12]), "v"(s[13]), "v"(s[14]), "v"(s[15]));
    return m;
}
constexpr float LAZY_THR = 8.0f;
__device__ __forceinline__ float half_max(float v) { auto rr = __builtin_amdgcn_permlane32_swap(__float_as_uint(v), __float_as_uint(v), false, false); return fmaxf(__uint_as_float(rr[0]), __uint_as_float(rr[1])); }
__device__ __forceinline__ float half_sum(float v) { auto rr = __builtin_amdgcn_permlane32_swap(__float_as_uint(v), __float_as_uint(v), false, false); return __uint_as_float(rr[0]) + __uint_as_float(rr[1]); }
constexpr float SKIP_BITS = 30.0f;
__device__ __forceinline__ void ph4_diff_mfma(Frame& F) {
    const h16* QKV = (const h16*)(F.ws + WS_A); const h16* KA = (const h16*)(F.ws + WS_KA); h16* O = (h16*)(F.ws + WS_B);
    int lane_ = F.lane; asm volatile("" : "+v"(lane_));
    const int gw = F.vcu * NWAVES + F.wave, NGW = F.G * NWAVES, lane = lane_, r32 = lane & 31, hi = lane >> 5;
    const float lam = lam_value(F);
    LAS unsigned char* vl = F.lds + RING_OFF + F.wave * 4096;
    const LAS unsigned char* trb = vl + (8 * hi + ((lane & 15) >> 2)) * 64 + (16 * ((lane >> 4) & 1) + 4 * (lane & 3)) * 2;
    for (int k = 0; k < 4; ++k) {
        if (gw >= 2048) break;
        const int ty = gw & 1, qp = (gw >> 1) & 127, b = gw >> 8;
        const int h = (ty == 0) ? ((k == 0) ? 7 : (k == 1) ? 0 : (k == 2) ? 4 : 3) : ((k == 0) ? 6 : (k == 1) ? 1 : (k == 2) ? 5 : 2);
        const int bh = b * 8 + h, qt = (k & 1) ? 127 - qp : qp, i0 = qt * 32;
        const float slope2 = exp2f(-0.5f * (float)(h + 1)) * LOG2E;
        const h16* qrow = QKV + (size_t)(b * SEQ + i0 + r32) * 3072 + h * 64 + 8 * hi;
        hf8 qf[2][2];
#pragma unroll
        for (int mp = 0; mp < 2; ++mp)
#pragma unroll
            for (int sl = 0; sl < 2; ++sl) qf[mp][sl] = ldf8(qrow + mp * 32 + sl * 16);
        float need;
        { float sq[2];
#pragma unroll
            for (int mp = 0; mp < 2; ++mp) { float a = 0.f;
#pragma unroll
                for (int sl = 0; sl < 2; ++sl)
#pragma unroll
                    for (int e = 0; e < 8; ++e) { const float v = (float)qf[mp][sl][e]; a += v * v; }
                a = half_sum(a);
                const float km = __uint_as_float(__hip_atomic_load(F.ctl + CW_KMAX + (b * 8 + h) * 2 + mp, RLX_AGENT));
                sq[mp] = sqrtf(a * km) * 1.001f + 0.01f; }
            need = fmaxf(sq[0], sq[1]) + SKIP_BITS - log2f(1.0f - exp2f(-slope2)); }
        float coff[16];
#pragma unroll
        for (int r = 0; r < 16; ++r) coff[r] = slope2 * (float)(16 * (r >> 3) + 8 * hi + (r & 7));
        f32x16 o[2][2];
#pragma unroll
        for (int mp = 0; mp < 2; ++mp)
#pragma unroll
            for (int dt = 0; dt < 2; ++dt)
#pragma unroll
                for (int r = 0; r < 16; ++r) o[mp][dt][r] = 0.f;
        float mrun[2] = {0.f, 0.f}, lrun[2] = {0.f, 0.f};
        const h16* kbase = KA + ((size_t)(bh * 128) * 4 * 64 + lane) * 8;
        const h16* vbase = QKV + (size_t)(b * SEQ + (lane >> 3)) * 3072 + 1024 + h * 64 + 8 * (lane & 7);
        hf8 kn[2][2]; v4u vn[4];
        { const h16* kb2 = kbase + (size_t)(qt * 4) * 512; const h16* vb2 = vbase + (size_t)(32 * qt) * 3072;
#pragma unroll
            for (int mp = 0; mp < 2; ++mp)
#pragma unroll
                for (int sl = 0; sl < 2; ++sl) kn[mp][sl] = ldf8(kb2 + (mp * 2 + sl) * 512);
#pragma unroll
            for (int i = 0; i < 4; ++i) vn[i] = *(const v4u*)(vb2 + (size_t)(8 * i) * 3072); }
        for (int kt = qt; kt >= 0; --kt) {
            hf8 kf[2][2];
#pragma unroll
            for (int a = 0; a < 2; ++a)
#pragma unroll
                for (int c = 0; c < 2; ++c) kf[a][c] = kn[a][c];
            asm volatile("" ::: "memory");
            v_stage(vl, vn, lane);
            asm volatile("" ::: "memory");
            if (kt > 0) {
                const h16* kb2 = kbase + (size_t)((kt - 1) * 4) * 512; const h16* vb2 = vbase + (size_t)(32 * (kt - 1)) * 3072;
#pragma unroll
                for (int mp = 0; mp < 2; ++mp)
#pragma unroll
                    for (int sl = 0; sl < 2; ++sl) kn[mp][sl] = ldf8(kb2 + (mp * 2 + sl) * 512);
#pragma unroll
                for (int i = 0; i < 4; ++i) vn[i] = *(const v4u*)(vb2 + (size_t)(8 * i) * 3072);
            }
            hf8 vf[2][2];
#pragma unroll
            for (int dt = 0; dt < 2; ++dt)
#pragma unroll
                for (int s2 = 0; s2 < 2; ++s2) vf[dt][s2] = v_frag(trb, dt, s2);
            asm volatile("" ::: "memory");
            const float tb = slope2 * (float)(32 * kt - i0);
            const bool diag = (kt == qt);
            f32x16 sc[2];
#pragma unroll
            for (int mp = 0; mp < 2; ++mp) { const float tbm = tb - mrun[mp];
#pragma unroll
                for (int r = 0; r < 16; ++r) sc[mp][r] = coff[r] + tbm;
                if (diag) {
#pragma unroll
                    for (int r = 0; r < 16; ++r) if (16 * (r >> 3) + 8 * hi + (r & 7) > r32) sc[mp][r] = -INFINITY;
                } }
            sc[0] = MFMA32(kf[0][0], qf[0][0], sc[0]); sc[1] = MFMA32(kf[1][0], qf[1][0], sc[1]);
            sc[0] = MFMA32(kf[0][1], qf[0][1], sc[0]); sc[1] = MFMA32(kf[1][1], qf[1][1], sc[1]);
            hf8 pb[2][2];
#pragma unroll
            for (int mp = 0; mp < 2; ++mp) {
                const float mx = half_max(rowmax16(sc[mp]));
                if (diag || __any(mx > LAZY_THR)) {
                    const float dl = diag ? mx : fmaxf(mx, 0.f), alpha = ex2(-dl); mrun[mp] += dl; lrun[mp] *= alpha;
#pragma unroll
                    for (int r = 0; r < 16; ++r) sc[mp][r] -= dl;
#pragma unroll
                    for (int dt = 0; dt < 2; ++dt)
#pragma unroll
                        for (int r = 0; r < 16; ++r) o[mp][dt][r] *= alpha; }
                float ls = 0.f;
#pragma unroll
                for (int r = 0; r < 16; ++r) { sc[mp][r] = ex2(sc[mp][r]); ls += sc[mp][r]; }
                lrun[mp] += ls;
                v4u p0, p1;
                p0.x = pk2h(sc[mp][0], sc[mp][1]); p0.y = pk2h(sc[mp][2], sc[mp][3]); p0.z = pk2h(sc[mp][4], sc[mp][5]); p0.w = pk2h(sc[mp][6], sc[mp][7]);
                p1.x = pk2h(sc[mp][8], sc[mp][9]); p1.y = pk2h(sc[mp][10], sc[mp][11]); p1.z = pk2h(sc[mp][12], sc[mp][13]); p1.w = pk2h(sc[mp][14], sc[mp][15]);
                pb[mp][0] = __builtin_bit_cast(hf8, p0); pb[mp][1] = __builtin_bit_cast(hf8, p1);
            }
#pragma unroll
            for (int s2 = 0; s2 < 2; ++s2)
#pragma unroll
                for (int mp = 0; mp < 2; ++mp)
#pragma unroll
                    for (int dt = 0; dt < 2; ++dt) o[mp][dt] = MFMA32(vf[dt][s2], pb[mp][s2], o[mp][dt]);
            if (__all(slope2 * (float)(i0 + 1 - 32 * kt) >= need - fminf(mrun[0], mrun[1]))) break;
        }
        const float l0 = half_sum(lrun[0]), l1 = half_sum(lrun[1]);
        const float i0l = 1.0f / l0, i1l = lam / l1;
        float ss = 0.f;
#pragma unroll
        for (int dt = 0; dt < 2; ++dt)
#pragma unroll
            for (int r = 0; r < 16; ++r) { const float v = o[0][dt][r] * i0l - o[1][dt][r] * i1l; o[0][dt][r] = v; ss += v * v; }
        ss = half_sum(ss);
        const float rstd = 0.8f / sqrtf(ss * (1.0f / 64.0f) + LN_EPS);
        h16* orow = O + (size_t)(b * SEQ + i0 + r32) * D + h * 64;
#pragma unroll
        for (int dt = 0; dt < 2; ++dt)
#pragma unroll
            for (int gp = 0; gp < 2; ++gp) { v2u w[2];
#pragma unroll
                for (int e = 0; e < 2; ++e) { const int g = 2 * gp + e, d = 32 * dt + 8 * g + 4 * hi; const f32x4 sw = *(const f32x4*)(F.in[I_SUBLN] + d);
                    w[e].x = pk2h(o[0][dt][4 * g] * rstd * sw[0], o[0][dt][4 * g + 1] * rstd * sw[1]); w[e].y = pk2h(o[0][dt][4 * g + 2] * rstd * sw[2], o[0][dt][4 * g + 3] * rstd * sw[3]); }
                const auto sx = __builtin_amdgcn_permlane32_swap(w[0].x, w[1].x, false, false), sy = __builtin_amdgcn_permlane32_swap(w[0].y, w[1].y, false, false);
                *(v4u*)(orow + 32 * dt + 16 * gp + 8 * hi) = (v4u){sx[0], sy[0], sx[1], sy[1]}; }
    }
}

template <int MODE> __device__ __forceinline__ void dil_pass(Frame& F) {
    constexpr int STR = (MODE == 0) ? 1 : (MODE == 1) ? 4 : 16, NT = (MODE == 0) ? 5 : 4, LO = (MODE == 0) ? 0 : 33, NU = BATCH * 8 * 128;
    const h16* QKV = (const h16*)(F.ws + WS_A); h16* O = (h16*)(F.ws + WS_B);
    const h16* KB = (MODE == 0) ? (const h16*)(F.ws + WS_KB1) : (MODE == 1) ? (const h16*)(F.ws + WS_KB4) : (const h16*)(F.ws + WS_KB16);
    h16* PO1 = (h16*)F.out; h16* PO2 = PO1 + (size_t)BATCH * 8 * SEQ * 64; float* PM1 = (float*)(PO2 + (size_t)BATCH * 8 * SEQ * 64); float* PM2 = PM1 + (size_t)BATCH * 8 * SEQ * 2;
    int lane_ = F.lane; asm volatile("" : "+v"(lane_));
    const int gw = F.vcu * NWAVES + F.wave, NGW = F.G * NWAVES, lane = lane_, r32 = lane & 31, hi = lane >> 5;
    LAS unsigned char* vl = F.lds + RING_OFF + F.wave * 4096;
    const LAS unsigned char* trb = vl + (8 * hi + ((lane & 15) >> 2)) * 64 + (16 * ((lane >> 4) & 1) + 4 * (lane & 3)) * 2;
#define DU_BH(i) ((i) >> 7)
#define DU_RR(i) ((MODE == 0) ? 0 : (MODE == 1) ? (((i) & 127) >> 5) : (((i) & 127) >> 3))
#define DU_QB(i) ((MODE == 0) ? ((i) & 127) : (MODE == 1) ? ((i) & 31) : ((i) & 7))
#define DU_KB0(i) ((MODE == 0) ? DU_QB(i) : DU_QB(i) - 1)
#define DU_NT(i) ((DU_KB0(i) + 1 < NT) ? DU_KB0(i) + 1 : NT)
#define DU_LOADQ(i, q) do { const int bh_ = DU_BH(i), tq_ = STR * (32 * DU_QB(i) + r32) + DU_RR(i); \
        const h16* qr_ = QKV + (size_t)((bh_ >> 3) * SEQ + tq_) * 3072 + 1536 + (bh_ & 7) * 64 + 8 * hi; \
        _Pragma("unroll") for (int sl_ = 0; sl_ < 4; ++sl_) q[sl_] = ldf8(qr_ + sl_ * 16); } while (0)
#define DU_LOADKV(i, kb) do { const int bh_ = DU_BH(i), rr_ = DU_RR(i), ub_ = (MODE == 0) ? 0 : (MODE == 1) ? rr_ * 32 : rr_ * 8; \
        const h16* kp_ = KB + ((size_t)((bh_ * 128 + ub_ + (kb)) * 4) * 64 + lane) * 8; \
        const h16* vp_ = QKV + (size_t)((bh_ >> 3) * SEQ + STR * (32 * (kb) + (lane >> 3)) + rr_) * 3072 + 2560 + (bh_ & 7) * 64 + 8 * (lane & 7); \
        _Pragma("unroll") for (int sl_ = 0; sl_ < 4; ++sl_) kn[sl_] = ldf8(kp_ + sl_ * 512); \
        _Pragma("unroll") for (int i_ = 0; i_ < 4; ++i_) vn[i_] = *(const v4u*)(vp_ + (size_t)(STR * 8 * i_) * 3072); } while (0)
    int idx = gw; if (idx >= NU) return;
    hf8 kn[4]; v4u vn[4];
    if (DU_NT(idx) > 0) DU_LOADKV(idx, DU_KB0(idx));
    for (;;) {
        const int nidx = idx + NGW; const bool hn = nidx < NU;
        const int bh = DU_BH(idx), b = bh >> 3, h = bh & 7, rr = DU_RR(idx), qb = DU_QB(idx), kb0 = DU_KB0(idx), ntile = DU_NT(idx);
        const float sS = exp2f(-0.5f * (float)(h + 9)) * LOG2E * (float)STR;
        const int tq = STR * (32 * qb + r32) + rr;
        hf8 qf[4];
        DU_LOADQ(idx, qf);
        const size_t prw = (size_t)bh * SEQ + tq;
        float pm1 = 0.f, pl1 = 0.f, pm2 = 0.f, pl2 = 0.f;
        float cb[16];
#pragma unroll
        for (int r = 0; r < 16; ++r) { const int ko = 16 * (r >> 3) + 8 * hi + (r & 7), dd = r32 - ko;
            const float lg = (MODE == 0) ? (((dd & 15) == 0) ? 1.5849625007211562f : ((dd & 3) == 0) ? 1.0f : 0.0f) : (MODE == 1) ? (((dd & 3) == 0) ? 1.0f : 0.0f) : 0.0f;
            cb[r] = sS * (float)ko + lg; }
        f32x16 o[2];
#pragma unroll
        for (int dt = 0; dt < 2; ++dt)
#pragma unroll
            for (int r = 0; r < 16; ++r) o[dt][r] = 0.f;
        float mrun = 0.f, lrun = 0.f; bool started = false;
        for (int j = 0; j < ntile; ++j) {
            const int kb = kb0 - j;
            hf8 kf[4];
#pragma unroll
            for (int sl = 0; sl < 4; ++sl) kf[sl] = kn[sl];
            asm volatile("" ::: "memory");
            v_stage(vl, vn, lane);
            asm volatile("" ::: "memory");
            if (j + 1 < ntile) DU_LOADKV(idx, kb - 1);
            else if (hn && DU_NT(nidx) > 0) DU_LOADKV(nidx, DU_KB0(nidx));
            hf8 vf[2][2];
#pragma unroll
            for (int dt = 0; dt < 2; ++dt)
#pragma unroll
                for (int s2 = 0; s2 < 2; ++s2) vf[dt][s2] = v_frag(trb, dt, s2);
            asm volatile("" ::: "memory");
            const float tb = sS * (float)(32 * (kb - qb)) - mrun;
            f32x16 s;
#pragma unroll
            for (int r = 0; r < 16; ++r) s[r] = cb[r] + tb;
            if (j == 0 || j == NT - 1) {
                const int dl0 = 32 * (qb - kb) + r32;
#pragma unroll
                for (int r = 0; r < 16; ++r) { const int dl = dl0 - (16 * (r >> 3) + 8 * hi + (r & 7)); if (dl < LO || dl > 128) s[r] = -INFINITY; }
            }
#pragma unroll
            for (int sl = 0; sl < 4; ++sl) s = MFMA32(kf[sl], qf[sl], s);
            const float mx = half_max(rowmax16(s));
            const bool fresh = !started && mx > -INFINITY;
            if (__any(fresh || mx > LAZY_THR)) {
                const float dl = fresh ? mx : fmaxf(mx, 0.f), alpha = ex2(-dl); mrun += dl; lrun *= alpha; started = started || fresh;
#pragma unroll
                for (int r = 0; r < 16; ++r) s[r] -= dl;
#pragma unroll
                for (int dt = 0; dt < 2; ++dt)
#pragma unroll
                    for (int r = 0; r < 16; ++r) o[dt][r] *= alpha; }
            float ls = 0.f;
#pragma unroll
            for (int r = 0; r < 16; ++r) { s[r] = ex2(s[r]); ls += s[r]; }
            lrun += ls;
            v4u p0, p1;
            p0.x = pk2h(s[0], s[1]); p0.y = pk2h(s[2], s[3]); p0.z = pk2h(s[4], s[5]); p0.w = pk2h(s[6], s[7]);
            p1.x = pk2h(s[8], s[9]); p1.y = pk2h(s[10], s[11]); p1.z = pk2h(s[12], s[13]); p1.w = pk2h(s[14], s[15]);
            const hf8 pb0 = __builtin_bit_cast(hf8, p0), pb1 = __builtin_bit_cast(hf8, p1);
#pragma unroll
            for (int dt = 0; dt < 2; ++dt) { o[dt] = MFMA32(vf[dt][0], pb0, o[dt]); o[dt] = MFMA32(vf[dt][1], pb1, o[dt]); }
        }
        if (ntile == 0 && hn && DU_NT(nidx) > 0) DU_LOADKV(nidx, DU_KB0(nidx));
        const float l = half_sum(lrun), mt = (l > 0.f) ? mrun - sS * (float)r32 : -1.0e30f;
        if (MODE != 2) {
            const float il = (l > 0.f) ? 1.0f / l : 0.f;
            h16* po = ((MODE == 0) ? PO1 : PO2) + prw * 64; float* pm = ((MODE == 0) ? PM1 : PM2) + prw * 2;
#pragma unroll
            for (int dt = 0; dt < 2; ++dt)
#pragma unroll
                for (int gp = 0; gp < 2; ++gp) { v2u w[2];
#pragma unroll
                    for (int e = 0; e < 2; ++e) { const int g = 2 * gp + e; w[e].x = pk2h(o[dt][4 * g] * il, o[dt][4 * g + 1] * il); w[e].y = pk2h(o[dt][4 * g + 2] * il, o[dt][4 * g + 3] * il); }
                    const auto sx = __builtin_amdgcn_permlane32_swap(w[0].x, w[1].x, false, false), sy = __builtin_amdgcn_permlane32_swap(w[0].y, w[1].y, false, false);
                    *(v4u*)(po + 32 * dt + 16 * gp + 8 * hi) = (v4u){sx[0], sy[0], sx[1], sy[1]}; }
            if (hi == 0) { pm[0] = mt; pm[1] = l; }
        } else {
            pm1 = PM1[prw * 2]; pl1 = PM1[prw * 2 + 1]; pm2 = PM2[prw * 2]; pl2 = PM2[prw * 2 + 1];
            const float Mx = fmaxf(pm1, fmaxf(pm2, mt));
            const float w1 = pl1 * ex2(pm1 - Mx), w2 = pl2 * ex2(pm2 - Mx), w3 = ex2(mt - Mx), inv = 1.0f / (w1 + w2 + w3 * l);
            const h16* p1 = PO1 + prw * 64; const h16* p2 = PO2 + prw * 64;
            h16* orow = O + (size_t)(b * SEQ + tq) * D + 512 + h * 64;
#pragma unroll
            for (int dt = 0; dt < 2; ++dt)
#pragma unroll
                for (int gp = 0; gp < 2; ++gp) { v2u w[2];
#pragma unroll
                    for (int e2 = 0; e2 < 2; ++e2) { const int g = 2 * gp + e2, d = 32 * dt + 8 * g + 4 * hi; const f32x4 a = ld4h(p1 + d), c = ld4h(p2 + d);
                        float y[4];
#pragma unroll
                        for (int e = 0; e < 4; ++e) y[e] = (w1 * a[e] + w2 * c[e] + w3 * o[dt][4 * g + e]) * inv;
                        w[e2].x = pk2h(y[0], y[1]); w[e2].y = pk2h(y[2], y[3]); }
                    const auto sx = __builtin_amdgcn_permlane32_swap(w[0].x, w[1].x, false, false), sy = __builtin_amdgcn_permlane32_swap(w[0].y, w[1].y, false, false);
                    *(v4u*)(orow + 32 * dt + 16 * gp + 8 * hi) = (v4u){sx[0], sy[0], sx[1], sy[1]}; }
        }
        if (!hn) break;
        idx = nidx;
    }
#undef DU_BH
#undef DU_RR
#undef DU_QB
#undef DU_KB0
#undef DU_NT
#undef DU_LOADQ
#undef DU_LOADKV
}

struct RowLn { f32x4 n[4]; };
__device__ __forceinline__ void ln_rows(f32x4 (&v)[4], const float* lg, const float* lb, int lane) {
    float s = 0.f;
#pragma unroll
    for (int j = 0; j < 4; ++j) s += (v[j][0] + v[j][1]) + (v[j][2] + v[j][3]);
    const float mean = wave_sum(s) * (1.0f / D); float s2 = 0.f;
#pragma unroll
    for (int j = 0; j < 4; ++j) { v[j] = v[j] - mean; s2 += (v[j][0] * v[j][0] + v[j][1] * v[j][1]) + (v[j][2] * v[j][2] + v[j][3] * v[j][3]); }
    const float rstd = 1.0f / sqrtf(wave_sum(s2) * (1.0f / D) + LN_EPS);
#pragma unroll
    for (int j = 0; j < 4; ++j) { const int col = 4 * lane + 256 * j; v[j] = v[j] * rstd * *(const f32x4*)(lg + col) + *(const f32x4*)(lb + col); }
}
struct RowIn { f32x4 x[4]; v2u hx[4]; v2u y[4]; };
template <bool XF32> __device__ __forceinline__ void row_load(RowIn& r, const float* xin, const h16* hin, const h16* y, int lane) {
#pragma unroll
    for (int j = 0; j < 4; ++j) { const int col = 4 * lane + 256 * j; if (XF32) r.x[j] = *(const f32x4*)(xin + col); else r.hx[j] = *(const v2u*)(hin + col); r.y[j] = *(const v2u*)(y + col); }
}
__device__ __forceinline__ f32x4 cvt4(v2u w) { return (f32x4){hlo(w.x), hhi(w.x), hlo(w.y), hhi(w.y)}; }
struct RowVec { f32x4 rdiv[4], psh[4], gate1[4], lg[4], lb[4], sc1[4], sh[4]; };
template <bool XF32> __device__ __forceinline__ void rowvec_load(RowVec& q, const float* psc, const float* psh, const float* gate, const float* lg, const float* lb, const float* sc, const float* sh, int lane) {
#pragma unroll
    for (int j = 0; j < 4; ++j) { const int col = 4 * lane + 256 * j;
        if (!XF32) { const f32x4 d = 1.0f + *(const f32x4*)(psc + col); q.rdiv[j] = (f32x4){__builtin_amdgcn_rcpf(d[0]), __builtin_amdgcn_rcpf(d[1]), __builtin_amdgcn_rcpf(d[2]), __builtin_amdgcn_rcpf(d[3])}; q.psh[j] = *(const f32x4*)(psh + col); }
        q.gate1[j] = 1.0f + *(const f32x4*)(gate + col); q.lg[j] = *(const f32x4*)(lg + col); q.lb[j] = *(const f32x4*)(lb + col);
        q.sc1[j] = 1.0f + *(const f32x4*)(sc + col); q.sh[j] = *(const f32x4*)(sh + col); }
}
__device__ __forceinline__ void ln_rows_v(f32x4 (&v)[4], const RowVec& q) {
    float s = 0.f;
#pragma unroll
    for (int j = 0; j < 4; ++j) s += (v[j][0] + v[j][1]) + (v[j][2] + v[j][3]);
    const float mean = wave_sum(s) * (1.0f / D); float s2 = 0.f;
#pragma unroll
    for (int j = 0; j < 4; ++j) { v[j] = v[j] - mean; s2 += (v[j][0] * v[j][0] + v[j][1] * v[j][1]) + (v[j][2] * v[j][2] + v[j][3] * v[j][3]); }
    const float rstd = 1.0f / sqrtf(wave_sum(s2) * (1.0f / D) + LN_EPS);
#pragma unroll
    for (int j = 0; j < 4; ++j) v[j] = v[j] * rstd * q.lg[j] + q.lb[j];
}
template <bool XF32> __device__ __forceinline__ void row_block(const RowIn& in, const RowVec& q, h16* ho, f32x4 (&hv)[4], int lane, unsigned char* ho8 = nullptr) {
    f32x4 v[4];
#pragma unroll
    for (int j = 0; j < 4; ++j) { f32x4 xv; if (XF32) xv = in.x[j]; else xv = (cvt4(in.hx[j]) - q.psh[j]) * q.rdiv[j];
        v[j] = DN_ALPHA * xv + q.gate1[j] * cvt4(in.y[j]); }
    ln_rows_v(v, q);
#pragma unroll
    for (int j = 0; j < 4; ++j) { const int col = 4 * lane + 256 * j;
        hv[j] = v[j] * q.sc1[j] + q.sh[j];
        v2u o; o.x = pk2h(hv[j][0], hv[j][1]); o.y = pk2h(hv[j][2], hv[j][3]); *(v2u*)(ho + col) = o;
        if (ho8) *(unsigned*)(ho8 + col) = pg8::pk4f8(hv[j][0] * S8_H, hv[j][1] * S8_H, hv[j][2] * S8_H, hv[j][3] * S8_H); }
}
template <bool XF32> __device__ __forceinline__ void ph_rows(Frame& F, const float* xin, const h16* HIN, const float* psc, const float* psh, const h16* Y, const float* modl_gate  ,
                                        const float* lg, const float* lb, const float* mod_sc, const float* mod_sh, h16* HO, unsigned char* HO8 = nullptr) {
    const int gw = F.vcu * NWAVES + F.wave, WPB = F.G;
    const int b = gw / WPB, r0 = gw % WPB; const size_t bo = (size_t)b * (6 * D);
    RowVec q; rowvec_load<XF32>(q, psc + bo, psh + bo, modl_gate + bo, lg, lb, mod_sc + bo, mod_sh + bo, F.lane);
    for (int t0 = r0; t0 < SEQ; t0 += 4 * WPB) {
        RowIn r[4];
#pragma unroll
        for (int i = 0; i < 4; ++i) { const int t = t0 + i * WPB; if (t < SEQ) { const size_t m = (size_t)b * SEQ + t; row_load<XF32>(r[i], xin + m * D, HIN + m * D, Y + m * D, F.lane); } }
#pragma unroll
        for (int i = 0; i < 4; ++i) { const int t = t0 + i * WPB; if (t < SEQ) { const size_t m = (size_t)b * SEQ + t; f32x4 hv[4];
            row_block<XF32>(r[i], q, HO + m * D, hv, F.lane, HO8 ? HO8 + m * D : nullptr); } }
    }
}

__device__ __forceinline__ void ph10_ssm_naive(Frame& F) {
    const h16* U = (const h16*)(F.ws + WS_B); h16* GY = (h16*)(F.ws + WS_C);
    const float* SA = (const float*)(F.ws + WS_SSMA); const float* SB = (const float*)(F.ws + WS_SSMB);
    const int gw = F.vcu * NWAVES + F.wave, NGW = F.G * NWAVES, lane = F.lane;
    for (int it = gw; it < BATCH * 64; it += NGW) {
        const int b = it >> 6, g = it & 63, gp = g * 64 + lane;
        const float abr = SA[gp * 2], abi = SA[gp * 2 + 1];
        float bbr[16], bbi[16], cr[16], ci[16];
#pragma unroll
        for (int c = 0; c < 16; ++c) { bbr[c] = SB[(gp * 16 + c) * 2]; bbi[c] = SB[(gp * 16 + c) * 2 + 1]; cr[c] = F.in[I_CRE][(g * 16 + c) * 64 + lane]; ci[c] = F.in[I_CIM][(g * 16 + c) * 64 + lane]; }
        const float dsk = F.in[I_DSKIP][g * 16 + (lane & 15)];
        float hr = 0.f, hi = 0.f;
        for (int t = 0; t < SEQ; ++t) {
            const h16* ur = U + (size_t)(b * SEQ + t) * D + g * 16;
            float u[16]; ld8h(ur, u); ld8h(ur + 8, u + 8);
            float xr = 0.f, xi = 0.f;
#pragma unroll
            for (int c = 0; c < 16; ++c) { xr += bbr[c] * u[c]; xi += bbi[c] * u[c]; }
            const float nhr = abr * hr - abi * hi + xr, nhi = abr * hi + abi * hr + xi; hr = nhr; hi = nhi;
            float mine = 0.f;
#pragma unroll
            for (int c = 0; c < 16; ++c) { const float yc = wave_sum(cr[c] * hr - ci[c] * hi); if (lane == c) mine = yc; }
            if (lane < 16) { const float val = mine + dsk * h2f(ur[lane]); GY[(size_t)(b * SEQ + t) * D + g * 16 + lane] = (h16)(pk2h(gelu_tanh(val), 0.f) & 0xffffu); }
        }
    }
}


__device__ __forceinline__ void ssm_prep(Frame& F) {
    typedef float f32x2v __attribute__((ext_vector_type(2)));
    const float* SA = (const float*)(F.ws + WS_SSMA); const float* SB = (const float*)(F.ws + WS_SSMB);
    LAS f32x2v* PW = (LAS f32x2v*)(F.lds + RING_OFF);
    LAS f32x2v* BB = (LAS f32x2v*)(F.lds + RING_OFF + 16384);
    LAS f32x2v* CC = (LAS f32x2v*)(F.lds + RING_OFF + 32768);
    LAS float* KL = (LAS float*)(F.lds + RING_OFF + 49152);
    const int tid = F.tid;
    LAS int* tsk = (LAS int*)(F.lds + RING_OFF + 65536);
    for (;;) {
        if (tid == 0) *tsk = (int)__hip_atomic_fetch_add(F.ctl + CW_PREP, 1u, RLX_AGENT);
        __syncthreads();
        const int task = *tsk;
        __syncthreads();
        if (task >= 256) break;
        const int g = task >> 2, part = task & 3;
        const float idt = 1.0f / expf(F.in[I_LOGDT][g]);
        if (tid < 64) { float pr = 1.0f, pi = 0.0f; const float ar = SA[(g * 64 + tid) * 2], ai = SA[(g * 64 + tid) * 2 + 1];
            for (int k = 0; k <= 16; ++k) { PW[k * 64 + tid] = (f32x2v){pr, pi}; const float nr = pr * ar - pi * ai, ni = pr * ai + pi * ar; pr = nr; pi = ni; } }
        for (int e = tid; e < 1024; e += NWAVES * 64) { BB[e] = (f32x2v){SB[(g * 1024 + e) * 2] * idt, SB[(g * 1024 + e) * 2 + 1] * idt};
            CC[e] = (f32x2v){F.in[I_CRE][g * 1024 + e], F.in[I_CIM][g * 1024 + e]}; }
        __syncthreads();
        h16* base = (h16*)((unsigned char*)F.out + 100 * MiB) + (size_t)g * 131072;
        if (part == 0) {
            for (int q = tid; q < 64 * 64; q += NWAVES * 64) { const int f = q >> 6, l = q & 63, rt = f >> 4, t = f & 15, r32 = l & 31, hi = l >> 5, p = 16 * rt + (r32 & 15), im = r32 >> 4;
                const f32x2v a = PW[(15 - t) * 64 + p]; hf8 v;
#pragma unroll
                for (int j = 0; j < 8; ++j) { const f32x2v bb = BB[p * 16 + 8 * hi + j]; v[j] = (_Float16)(im ? (a.x * bb.y + a.y * bb.x) : (a.x * bb.x - a.y * bb.y)); }
                *(v4u*)(base + (size_t)q * 8) = __builtin_bit_cast(v4u, v); }
        } else if (part == 1) {
            for (int q = tid; q < 64 * 64; q += NWAVES * 64) { const int f = q >> 6, l = q & 63, rtY = f >> 3, q8 = f & 7, rt = q8 >> 1, sIm = q8 & 1, r32 = l & 31, hi = l >> 5;
                const int t = 2 * rtY + (r32 >> 4), c = r32 & 15; hf8 v;
#pragma unroll
                for (int j = 0; j < 8; ++j) { const int p = 16 * rt + (j & 3) + 8 * (j >> 2) + 4 * hi; const f32x2v a = PW[(t + 1) * 64 + p], cc = CC[c * 64 + p];
                    const float zr = cc.x * a.x - cc.y * a.y, zi = cc.x * a.y + cc.y * a.x; v[j] = (_Float16)(sIm ? -zi : zr); }
                *(v4u*)(base + 32768 + (size_t)q * 8) = __builtin_bit_cast(v4u, v); }
        } else {
            { const int L = tid >> 5, c = (tid >> 1) & 15, c20 = (tid & 1) * 8; float acc8[8];
#pragma unroll
                for (int j = 0; j < 8; ++j) acc8[j] = 0.f;
                for (int p = 0; p < 64; ++p) { const f32x2v a = PW[L * 64 + p], cc = CC[c * 64 + p];
                    const float zr = cc.x * a.x - cc.y * a.y, zi = cc.x * a.y + cc.y * a.x;
#pragma unroll
                    for (int j = 0; j < 8; ++j) { const f32x2v bb = BB[p * 16 + c20 + j]; acc8[j] += zr * bb.x - zi * bb.y; } }
#pragma unroll
                for (int j = 0; j < 8; ++j) KL[L * 256 + c * 16 + c20 + j] = acc8[j]; }
            __syncthreads();
            const int q0 = (part - 2) * 4096;
            for (int q = q0 + tid; q < q0 + 4096; q += NWAVES * 64) { const int f = q >> 6, l = q & 63, rtY = f >> 4, s = f & 15, r32 = l & 31, hi = l >> 5;
                const int t = 2 * rtY + (r32 >> 4), c = r32 & 15, L = t - s; hf8 v;
#pragma unroll
                for (int j = 0; j < 8; ++j) v[j] = (_Float16)((L >= 0) ? KL[(L & 15) * 256 + c * 16 + 8 * hi + j] : 0.f);
                *(v4u*)(base + 65536 + (size_t)q * 8) = __builtin_bit_cast(v4u, v); }
        }
        __syncthreads();
    }
}
__device__ __forceinline__ void ph10_ssm_mfma(Frame& F) {
    const h16* U = (const h16*)(F.ws + WS_B); h16* GY = (h16*)(F.ws + WS_C);
    const float* SA = (const float*)(F.ws + WS_SSMA);
    typedef float f32x2v __attribute__((ext_vector_type(2)));
    LAS f32x2v* SL = (LAS f32x2v*)(F.lds + RING_OFF);
    LAS unsigned char* OPL = F.lds + RING_OFF;
    int tid_ = F.tid; asm volatile("" : "+v"(tid_));
    const int tid = tid_, lane = tid & 63, r32 = lane & 31, hi = lane >> 5, wave = F.wave;
    for (int unit = blockIdx.x; unit < BATCH * 64; unit += F.G) {
        const int b = unit >> 6, g = unit & 63;
        const float dt = expf(F.in[I_LOGDT][g]);
        const h16* MW1 = (const h16*)((const unsigned char*)F.out + 100 * MiB) + (size_t)g * 131072; const h16* MG = MW1 + 32768; const h16* MT = MW1 + 65536;
        const int ch = 32 * wave + r32;
        const h16* urow = U + (size_t)(b * SEQ + 16 * ch) * D + g * 16;
        { v4u w1[8];
#pragma unroll
            for (int i = 0; i < 8; ++i) w1[i] = *(const v4u*)(MW1 + (size_t)(i * 512 + tid) * 8);
#pragma unroll
            for (int i = 0; i < 8; ++i) *(LAS v4u*)(OPL + (size_t)(i * 512 + tid) * 16) = w1[i]; }
        __builtin_amdgcn_sched_barrier(0);
        hf8 ub[16];
#pragma unroll
        for (int t = 0; t < 16; ++t) ub[t] = ldf8(urow + (size_t)t * D + 8 * hi);
        __syncthreads();
        f32x16 acc[4];
#pragma unroll
        for (int rt = 0; rt < 4; ++rt)
#pragma unroll
            for (int r = 0; r < 16; ++r) acc[rt][r] = 0.f;
#pragma unroll
        for (int t = 0; t < 16; ++t)
        {
#pragma unroll
            for (int rt = 0; rt < 4; ++rt) acc[rt] = MFMA32(__builtin_bit_cast(hf8, *(const LAS v4u*)(OPL + (rt * 16 + t) * 1024 + lane * 16)), ub[t], acc[rt]);
            if ((t & 3) == 3) __builtin_amdgcn_sched_barrier(0); }
        __syncthreads();
#pragma unroll
        for (int rt = 0; rt < 4; ++rt)
#pragma unroll
            for (int r = 0; r < 8; ++r) { const int p = 16 * rt + (r & 3) + 8 * (r >> 2) + 4 * hi; SL[p * 257 + ch] = (f32x2v){acc[rt][r], acc[rt][r + 8]}; }
        __syncthreads();
        {
            const int p = tid & 63, sg = tid >> 6;
            float pr = SA[(g * 64 + p) * 2], pi = SA[(g * 64 + p) * 2 + 1];
#pragma unroll
            for (int q = 0; q < 4; ++q) { const float nr = pr * pr - pi * pi, ni = 2.0f * pr * pi; pr = nr; pi = ni; }
            const float aLr = pr, aLi = pi;
            float xr = 0.f, xi = 0.f;
            for (int j0 = 0; j0 < 32; j0 += 8) { f32x2v sv[8];
#pragma unroll
                for (int j = 0; j < 8; ++j) sv[j] = SL[p * 257 + 32 * sg + j0 + j];
#pragma unroll
                for (int j = 0; j < 8; ++j) { const float nr = aLr * xr - aLi * xi + sv[j].x, ni = aLr * xi + aLi * xr + sv[j].y; xr = nr; xi = ni; sv[j] = (f32x2v){xr, xi}; }
#pragma unroll
                for (int j = 0; j < 8; ++j) SL[p * 257 + 32 * sg + j0 + j] = sv[j]; }
#pragma unroll
            for (int q = 0; q < 5; ++q) { const float nr = pr * pr - pi * pi, ni = 2.0f * pr * pi; pr = nr; pi = ni; }
            __syncthreads();
            float cr = 0.f, ci = 0.f;
            for (int s2 = 0; s2 < sg; ++s2) { const int c2 = 32 * s2 + 31; const f32x2v ag = SL[p * 257 + c2];
                const float nr = pr * cr - pi * ci + ag.x, ni = pr * ci + pi * cr + ag.y; cr = nr; ci = ni; }
            __syncthreads();
            float prevr = 0.f, previ = 0.f, wr = 1.0f, wi = 0.0f;
            for (int j0 = 0; j0 < 32; j0 += 8) { f32x2v xv[8];
#pragma unroll
                for (int j = 0; j < 8; ++j) xv[j] = SL[p * 257 + 32 * sg + j0 + j];
#pragma unroll
                for (int j = 0; j < 8; ++j) { const f32x2v in = (f32x2v){prevr + wr * cr - wi * ci, previ + wr * ci + wi * cr};
                    prevr = xv[j].x; previ = xv[j].y; xv[j] = in; const float nr = wr * aLr - wi * aLi, ni = wr * aLi + wi * aLr; wr = nr; wi = ni; }
#pragma unroll
                for (int j = 0; j < 8; ++j) SL[p * 257 + 32 * sg + j0 + j] = xv[j]; }
        }
        __syncthreads();
        v4u ifw[8];
#pragma unroll
        for (int rt = 0; rt < 4; ++rt) { float re[8], im[8];
#pragma unroll
            for (int j = 0; j < 8; ++j) { const int p = 16 * rt + (j & 3) + 8 * (j >> 2) + 4 * hi; const f32x2v v = SL[p * 257 + ch]; re[j] = v.x; im[j] = v.y; }
            v4u w0, w1; w0.x = pk2h(re[0], re[1]); w0.y = pk2h(re[2], re[3]); w0.z = pk2h(re[4], re[5]); w0.w = pk2h(re[6], re[7]);
            w1.x = pk2h(im[0], im[1]); w1.y = pk2h(im[2], im[3]); w1.z = pk2h(im[4], im[5]); w1.w = pk2h(im[6], im[7]);
            ifw[2 * rt] = w0; ifw[2 * rt + 1] = w1; }
        LAS v4u* IFL = (LAS v4u*)(OPL + 49152 + wave * 8192);
        const f32x4 dk0 = *(const f32x4*)(F.in[I_DSKIP] + g * 16 + 4 * hi), dk1 = *(const f32x4*)(F.in[I_DSKIP] + g * 16 + 8 + 4 * hi);
        unsigned char* yrow = (unsigned char*)GY + (size_t)(b * SEQ + 16 * ch) * D + g * 16;
        v4u pg, pt0, pt1;
        pg = *(const v4u*)(MG + (size_t)tid * 8); pt0 = *(const v4u*)(MT + (size_t)tid * 8); pt1 = pt0;
        __syncthreads();
#pragma unroll
        for (int q = 0; q < 8; ++q) IFL[q * 64 + lane] = ifw[q];
        *(LAS v4u*)(OPL + tid * 16) = pg; if (tid < 128) *(LAS v4u*)(OPL + 8192 + tid * 16) = pt0;
        __syncthreads();
#pragma unroll
        for (int rtY = 0; rtY < 8; ++rtY) {
            LAS unsigned char* cur = OPL + (rtY & 1) * 24576;
            if (rtY < 7) { const int nT = (2 * (rtY + 1) + 2) * 64;
                pg = *(const v4u*)(MG + (size_t)((rtY + 1) * 8 * 64 + tid) * 8);
                if (tid < nT) pt0 = *(const v4u*)(MT + (size_t)((rtY + 1) * 16 * 64 + tid) * 8);
                if (tid + 512 < nT) pt1 = *(const v4u*)(MT + (size_t)((rtY + 1) * 16 * 64 + tid + 512) * 8); }
            f32x16 y0, y1;
#pragma unroll
            for (int r = 0; r < 16; ++r) { y0[r] = 0.f; y1[r] = 0.f; }
#pragma unroll
            for (int q = 0; q < 8; ++q) { const hf8 af = __builtin_bit_cast(hf8, *(const LAS v4u*)(cur + q * 1024 + lane * 16)); const hf8 bf = __builtin_bit_cast(hf8, IFL[q * 64 + lane]); if (q & 1) y1 = MFMA32(af, bf, y1); else y0 = MFMA32(af, bf, y0); }
#pragma unroll
            for (int s2 = 0; s2 <= 2 * rtY + 1; ++s2) { const hf8 af = __builtin_bit_cast(hf8, *(const LAS v4u*)(cur + 8192 + s2 * 1024 + lane * 16)); if (s2 & 1) y1 = MFMA32(af, ub[s2], y1); else y0 = MFMA32(af, ub[s2], y0); }
#pragma unroll
            for (int tt = 0; tt < 2; ++tt) { const size_t ro = (size_t)(2 * rtY + tt) * D;
                const v4u uw = __builtin_bit_cast(v4u, ub[2 * rtY + tt]);
                const auto sw0 = __builtin_amdgcn_permlane32_swap(uw.x, uw.z, false, false), sw1 = __builtin_amdgcn_permlane32_swap(uw.y, uw.w, false, false);
                const f32x4 u0 = {hlo(sw0[0]), hhi(sw0[0]), hlo(sw1[0]), hhi(sw1[0])}, u1 = {hlo(sw0[1]), hhi(sw0[1]), hlo(sw1[1]), hhi(sw1[1])};
                float yv[8];
#pragma unroll
                for (int e = 0; e < 8; ++e) yv[e] = (y0[8 * tt + e] + y1[8 * tt + e]) * dt;
                const unsigned w0 = pg8::pk4f8(S8_GY * gelu_tanh(yv[0] + dk0[0] * u0[0]), S8_GY * gelu_tanh(yv[1] + dk0[1] * u0[1]), S8_GY * gelu_tanh(yv[2] + dk0[2] * u0[2]), S8_GY * gelu_tanh(yv[3] + dk0[3] * u0[3]));
                const unsigned w1 = pg8::pk4f8(S8_GY * gelu_tanh(yv[4] + dk1[0] * u1[0]), S8_GY * gelu_tanh(yv[5] + dk1[1] * u1[1]), S8_GY * gelu_tanh(yv[6] + dk1[2] * u1[2]), S8_GY * gelu_tanh(yv[7] + dk1[3] * u1[3]));
                const auto sx = __builtin_amdgcn_permlane32_swap(w0, w1, false, false);
                *(v2u*)(yrow + ro + 8 * hi) = (v2u){sx[0], sx[1]}; }
            if (rtY < 7) { const int nT = (2 * (rtY + 1) + 2) * 64; LAS unsigned char* nxt = OPL + ((rtY + 1) & 1) * 24576;
                *(LAS v4u*)(nxt + tid * 16) = pg;
                if (tid < nT) *(LAS v4u*)(nxt + 8192 + tid * 16) = pt0;
                if (tid + 512 < nT) *(LAS v4u*)(nxt + 8192 + (tid + 512) * 16) = pt1; }
            __syncthreads();
        }
    }
}

__device__ __forceinline__ void ph12_rows_route(Frame& F) {
    const int gw = F.vcu * NWAVES + F.wave, NGW = F.G * NWAVES, lane = F.lane;
    const float* mod1 = (const float*)(F.ws + WS_MOD) + (size_t)BATCH * 6 * D;
    const h16* Y3 = (const h16*)(F.ws + WS_A); h16* H16 = (h16*)(F.ws + WS_VT1);
    int* tok_e = (int*)(F.ws + WS_TOKE); float* tok_g = (float*)(F.ws + WS_TOKG);
    LAS unsigned* lcnt = (LAS unsigned*)(F.lds + 1024);
    if (F.tid < 8) lcnt[F.tid] = 0u;
    __syncthreads();
    LAS f32x4* RWL = (LAS f32x4*)(F.lds + 4096);
    for (int e = F.tid; e < 2048; e += NWAVES * 64) { const int jih = e >> 6, l = e & 63, j = jih >> 3, i = (jih >> 1) & 3, hf = jih & 1;
        RWL[e] = *(const f32x4*)(F.in[I_RW] + (size_t)(4 * l + 256 * j + i) * 8 + 4 * hf); }
    __syncthreads();
    const f32x4 rb0 = *(const f32x4*)(F.in[I_RB]), rb1 = *(const f32x4*)(F.in[I_RB] + 4);
    const h16* UPREV = (const h16*)(F.ws + WS_B);
    const int WPB = F.G, bq = gw / WPB, r0 = gw % WPB; const size_t bo = (size_t)bq * (6 * D);
    RowVec q; rowvec_load<false>(q, mod1 + bo + 1 * D, mod1 + bo, mod1 + bo + 2 * D, F.in[I_LN1G1], F.in[I_LN1B1], mod1 + bo + 4 * D, mod1 + bo + 3 * D, lane);
    for (int t0 = r0; t0 < SEQ; t0 += WPB) {
        { const int m = bq * SEQ + t0;
        RowIn rr1; row_load<false>(rr1, nullptr, UPREV + (size_t)m * D, Y3 + (size_t)m * D, lane);
        f32x4 hv[4];
        row_block<false>(rr1, q, H16 + (size_t)m * D, hv, lane);
        f32x4 a0 = {0.f, 0.f, 0.f, 0.f}, a1 = a0;
#pragma unroll
        for (int j = 0; j < 4; ++j)
#pragma unroll
            for (int i = 0; i < 4; ++i) { a0 += hv[j][i] * RWL[((j * 4 + i) * 2 + 0) * 64 + lane]; a1 += hv[j][i] * RWL[((j * 4 + i) * 2 + 1) * 64 + lane]; }
        float lg[8];
#pragma unroll
        for (int e = 0; e < 4; ++e) { lg[e] = wave_sum(a0[e]) + rb0[e]; lg[4 + e] = wave_sum(a1[e]) + rb1[e]; }
        int e1 = 0; float v1 = lg[0];
#pragma unroll
        for (int e = 1; e < 8; ++e) if (lg[e] > v1) { v1 = lg[e]; e1 = e; }
        int e2 = -1; float v2 = -INFINITY;
#pragma unroll
        for (int e = 0; e < 8; ++e) if (e != e1 && lg[e] > v2) { v2 = lg[e]; e2 = e; }
        const float g1 = 1.0f / (1.0f + expf(v2 - v1)), g2 = 1.0f - g1;
        if (lane == 0) { tok_e[2 * m] = e1; tok_e[2 * m + 1] = e2; tok_g[2 * m] = g1; tok_g[2 * m + 1] = g2;
            __hip_atomic_fetch_add(lcnt + e1, 1u, __ATOMIC_RELAXED, __HIP_MEMORY_SCOPE_WORKGROUP); __hip_atomic_fetch_add(lcnt + e2, 1u, __ATOMIC_RELAXED, __HIP_MEMORY_SCOPE_WORKGROUP); }
        }
    }
    __syncthreads();
    if (F.tid < 8) __hip_atomic_fetch_add(F.ctl + CW_ECNT + F.tid, lcnt[F.tid], RLX_AGENT);
}
__device__ __forceinline__ void moe_prefix(Frame& F, int (&tp)[9]) {
    int acc = 0;
#pragma unroll
    for (int e = 0; e < 8; ++e) { tp[e] = acc; const unsigned c = __hip_atomic_load(F.ctl + CW_ECNT + e, RLX_AGENT); acc += (int)((c + 255u) >> 8); }
    tp[8] = acc;
}
__device__ __forceinline__ unsigned f8of4h(unsigned w0, unsigned w1) { return pg8::pk4f8(hlo(w0) * S8_H, hhi(w0) * S8_H, hlo(w1) * S8_H, hhi(w1) * S8_H); }
__device__ __forceinline__ void ph13_gather(Frame& F) {
    const int gw = F.vcu * NWAVES + F.wave, NGW = F.G * NWAVES, lane = F.lane;
    int tp[9]; moe_prefix(F, tp);
    const int* tok_e = (const int*)(F.ws + WS_TOKE); int* tok_p = (int*)(F.ws + WS_TOKP);
    const h16* H16 = (const h16*)(F.ws + WS_VT1); unsigned char* HG = F.ws + WS_B;
    for (int base = gw * 16; base < M; base += NGW * 16) {
        const bool own = lane < 16; const int m = base + (lane & 15);
        const int ea = own ? tok_e[2 * m] : -1, eb = own ? tok_e[2 * m + 1] : -1;
        const unsigned long long below = (lane == 0) ? 0ull : (~0ull >> (64 - lane));
        int ra = 0, rb = 0, mycnt = 0;
#pragma unroll
        for (int e = 0; e < 8; ++e) {
            const unsigned long long ma = __ballot(ea == e), mb = __ballot(eb == e);
            const int ca = __popcll(ma), cb = __popcll(mb);
            if (lane == e) mycnt = ca + cb;
            if (ea == e) ra = __popcll(ma & below);
            if (eb == e) rb = ca + __popcll(mb & below);
        }
        unsigned basee = 0u;
        if (lane < 8 && mycnt > 0) basee = __hip_atomic_fetch_add(F.ctl + CW_ECUR + lane, (unsigned)mycnt, RLX_AGENT);
        int tpl = 0;
#pragma unroll
        for (int e = 0; e < 8; ++e) if (lane == e) tpl = tp[e];
        const int segbase = tpl * 256 + (int)basee;
        const int pa = __shfl(segbase, ea & 7) + ra, pb = __shfl(segbase, eb & 7) + rb;
        if (own) { tok_p[2 * m] = pa; tok_p[2 * m + 1] = pb; }
#pragma unroll
        for (int t4 = 0; t4 < 16; t4 += 8) {
            v4u v0[8], v1[8]; int p1[8], p2[8];
#pragma unroll
            for (int i = 0; i < 8; ++i) { const h16* src = H16 + (size_t)(base + t4 + i) * D + 16 * lane; v0[i] = *(const v4u*)src; v1[i] = *(const v4u*)(src + 8);
                p1[i] = __shfl(pa, t4 + i); p2[i] = __shfl(pb, t4 + i); }
#pragma unroll
            for (int i = 0; i < 8; ++i) {
                v4u o; o.x = f8of4h(v0[i].x, v0[i].y); o.y = f8of4h(v0[i].z, v0[i].w); o.z = f8of4h(v1[i].x, v1[i].y); o.w = f8of4h(v1[i].z, v1[i].w);
                *(v4u*)(HG + (size_t)p1[i] * D + 16 * lane) = o; *(v4u*)(HG + (size_t)p2[i] * D + 16 * lane) = o; }
        }
    }
}
__device__ __forceinline__ void ph16_final(Frame& F) {
    const int gw = F.vcu * NWAVES + F.wave, NGW = F.G * NWAVES, lane = F.lane;
    const float* mod1 = (const float*)(F.ws + WS_MOD) + (size_t)BATCH * 6 * D;
    const int* tok_p = (const int*)(F.ws + WS_TOKP); const float* tok_g = (const float*)(F.ws + WS_TOKG);
    const h16* YG = (const h16*)(F.ws + WS_B);
    const h16* H16 = (const h16*)(F.ws + WS_VT1);
    struct Row16 { v2u x[4]; v2u a[4], c[4]; float w1, w2; };
    auto load16 = [&](Row16& r, int m) {
        const int p1 = tok_p[2 * m], p2 = tok_p[2 * m + 1]; r.w1 = tok_g[2 * m]; r.w2 = tok_g[2 * m + 1];
#pragma unroll
        for (int j = 0; j < 4; ++j) { const int col = 4 * lane + 256 * j; r.x[j] = *(const v2u*)(H16 + (size_t)m * D + col);
            r.a[j] = *(const v2u*)(YG + (size_t)p1 * D + col); r.c[j] = *(const v2u*)(YG + (size_t)p2 * D + col); } };
    const int WPB = F.G, bq = gw / WPB, r0 = gw % WPB; const size_t bo = (size_t)bq * (6 * D);
    RowVec q; rowvec_load<false>(q, mod1 + bo + 4 * D, mod1 + bo + 3 * D, mod1 + bo + 5 * D, F.in[I_LN2G1], F.in[I_LN2B1], mod1 + bo, mod1 + bo, lane);
    for (int t0 = r0; t0 < SEQ; t0 += 4 * WPB) {
        Row16 rw4[4];
#pragma unroll
        for (int i = 0; i < 4; ++i) { const int t = t0 + i * WPB; if (t < SEQ) load16(rw4[i], bq * SEQ + t); }
#pragma unroll
        for (int i = 0; i < 4; ++i) { const int t = t0 + i * WPB; if (t >= SEQ) continue; const int m = bq * SEQ + t; const Row16& cur = rw4[i];
        f32x4 v[4];
#pragma unroll
        for (int j = 0; j < 4; ++j) {
            const f32x4 ya = {hlo(cur.a[j].x), hhi(cur.a[j].x), hlo(cur.a[j].y), hhi(cur.a[j].y)}, yc = {hlo(cur.c[j].x), hhi(cur.c[j].x), hlo(cur.c[j].y), hhi(cur.c[j].y)};
            const f32x4 x3 = (cvt4(cur.x[j]) - q.psh[j]) * q.rdiv[j];
            v[j] = DN_ALPHA * x3 + q.gate1[j] * (cur.w1 * ya + cur.w2 * yc); }
        ln_rows_v(v, q);
#pragma unroll
        for (int j = 0; j < 4; ++j) *(f32x4*)(F.out + (size_t)m * D + 4 * lane + 256 * j) = v[j];
        }
    }
}

struct Args { const float* in[39]; float* out; unsigned char* ws; int ph_lo, ph_hi; };
__global__ void __launch_bounds__(NWAVES * 64, 2) mk_fwd(Args args) {
    extern __shared__ __attribute__((aligned(16))) unsigned char lds[];
    Frame F;
    F.lds = (LAS unsigned char*)lds;
    F.MISC = (volatile LAS unsigned*)(F.lds + MISC_OFF);
    F.tid = threadIdx.x; F.lane = F.tid & 63; F.wave = __builtin_amdgcn_readfirstlane(F.tid >> 6);
    F.G = gridDim.x; { const int bx = blockIdx.x; F.vcu = (F.G % 8 == 0) ? (bx % 8) * (F.G / 8) + bx / 8 : bx; }
    F.ws = args.ws; F.out = args.out; F.ctl = (gu32*)(args.ws + WS_CTL);
#pragma unroll
    for (int i = 0; i < 39; ++i) F.in[i] = args.in[i];
    for (int u = F.tid; u < (LDS_BYTES - LDSCTL_OFF) / 4; u += NWAVES * 64) ((LAS unsigned*)(F.lds + LDSCTL_OFF))[u] = 0u;
    __syncthreads();
    XcdBarrier bar; bar.bar = (unsigned*)(F.ctl + CW_BAR); bar.x = 0; bar.st = nullptr;
    if (N_LAUNCHES == 1) bar = xcd_barrier_post((unsigned*)(F.ctl + CW_BAR), F.MISC + 8);
    const int lo = args.ph_lo, hi = args.ph_hi;
    unsigned char* ws = args.ws;
    const float* mod0 = (const float*)(ws + WS_MOD); const float* mod1 = mod0 + (size_t)BATCH * 6 * D;
#ifndef PH_MASK
#define PH_MASK 0x1ffff
#endif
#define IN(k) (((PH_MASK >> (k)) & 1) && lo <= (k) && (k) < hi)
#define SEAM(k) do { if (N_LAUNCHES == 1 && IN(k) && IN((k) + 1)) xcd_barrier(bar); } while (0)

    if (IN(0)) { ph0_mods(F); SEAM(0); }
    if (IN(1)) { ph1_prologue(F); SEAM(1); }
    if (IN(2)) {
        pg8::Gemm g{(const h16*)(ws + WS_B), (const h16*)(ws + WS_W_IN), M, 3 * D, D}; pg8::StaticOrder S; S.init(M, 3 * D, F.G, (int)blockIdx.x);
        pg8::EpiQKV E{(h16*)(ws + WS_A), (h16*)(ws + WS_KA), (h16*)(ws + WS_KB1), (h16*)(ws + WS_KB4), (h16*)(ws + WS_KB16), (unsigned*)(F.ctl + CW_KMAX), QSCALE_A, QSCALE_B};
        pg8::gemm_phase<pg8::EpiQKV, pg8::StaticOrder, true, true>(F.lds + RING_OFF, g, S, E);
        SEAM(2);
    }
    if (IN(4)) { ph4_diff_mfma(F); dil_pass<0>(F); dil_pass<1>(F);
        __syncthreads(); ssm_prep(F);
        xcd_barrier(bar); dil_pass<2>(F); SEAM(4); }
    if (IN(5)) {
        pg8::Gemm g{(const h16*)(ws + WS_B), (const h16*)(ws + WS_W_OUT), M, D, D}; pg8::StaticOrder S; S.init(M, D, F.G, (int)blockIdx.x);
        pg8::EpiF16 E{(h16*)(ws + WS_C), D, 4, 0.f, 0.f};
        pg8::gemm_phase<pg8::EpiF16, pg8::StaticOrder, true, true>(F.lds + RING_OFF, g, S, E);
        SEAM(5);
    }
    if (IN(6)) {
        ph_rows<true>(F, F.in[I_X], (const h16*)(ws + WS_B), mod0, mod0, (const h16*)(ws + WS_C), mod0 + 2 * D, F.in[I_LN1G0], F.in[I_LN1B0], mod0 + 4 * D, mod0 + 3 * D, (h16*)(ws + WS_B));
        SEAM(6);
    }
    if (IN(7)) {
        pg8::Gemm g{(const h16*)(ws + WS_B), (const h16*)(ws + WS_W_F1), M, 2 * DFF, D}; pg8::StaticOrder S; S.init(M, 2 * DFF, F.G, (int)blockIdx.x);
        pg8::EpiGated8<0, false> E{ws + WS_A, DFF, 22, nullptr, 1.0f, S8_HID};
        pg8::gemm_phase<pg8::EpiGated8<0, false>, pg8::StaticOrder, true, true>(F.lds + RING_OFF, g, S, E);
        SEAM(7);
    }
    if (IN(8)) {
        pg8::Gemm g{(const h16*)(ws + WS_A), (const h16*)(ws + WS_W_F2), M, D, DFF / 2}; pg8::StaticOrder S; S.init(M, D, F.G, (int)blockIdx.x);
        pg8::EpiF16S E{(h16*)(ws + WS_C), D, 4, 1.0f / (S8_HID * S8_WF2)};
        pg8::gemm_phase<pg8::EpiF16S, pg8::StaticOrder, true, true, true>(F.lds + RING_OFF, g, S, E);
        SEAM(8);
    }
    if (IN(9)) {
        ph_rows<false>(F, nullptr, (const h16*)(ws + WS_B), mod0 + 4 * D, mod0 + 3 * D, (const h16*)(ws + WS_C), mod0 + 5 * D, F.in[I_LN2G0], F.in[I_LN2B0], mod1 + 1 * D, mod1 + 0 * D, (h16*)(ws + WS_B));
        SEAM(9);
    }
    if (IN(10)) { ph10_ssm_mfma(F); SEAM(10); }
    if (IN(11)) {
        pg8::Gemm g{(const h16*)(ws + WS_C), (const h16*)(ws + WS_W_GLU), M, 2 * D, D / 2}; pg8::StaticOrder S; S.init(M, 2 * D, F.G, (int)blockIdx.x);
        pg8::EpiGated<1> E{(h16*)(ws + WS_A), D, 8, F.in[I_BGLU], 1.0f / (S8_GY * S8_WGLU)};
        pg8::gemm_phase<pg8::EpiGated<1>, pg8::StaticOrder, true, true, true>(F.lds + RING_OFF, g, S, E);
        SEAM(11);
    }
    if (IN(12)) { ph12_rows_route(F); SEAM(12); }
    if (IN(13)) { ph13_gather(F); SEAM(13); }
    if (IN(14)) {
        pg8::MoeOrder S; moe_prefix(F, S.tp); S.nN = 11; S.G = F.G; S.c = (int)blockIdx.x;
        pg8::Gemm g{(const h16*)(ws + WS_B), (const h16*)(ws + WS_W_E1), 0, 2 * DFE, D / 2};
        pg8::EpiGated8<0, true> E{ws + WS_A, DFE_PAD, 11, nullptr, 1.0f / (S8_H * S8_WE1), S8_HID};
        pg8::gemm_phase<pg8::EpiGated8<0, true>, pg8::MoeOrder, true, true, true>(F.lds + RING_OFF, g, S, E);
        SEAM(14);
    }
    if (IN(15)) {
        pg8::MoeOrder S; moe_prefix(F, S.tp); S.nN = 4; S.G = F.G; S.c = (int)blockIdx.x;
        pg8::Gemm g{(const h16*)(ws + WS_A), (const h16*)(ws + WS_W_E2), 0, D, DFE_PAD / 2};
        pg8::EpiF16S E{(h16*)(ws + WS_B), D, 4, 1.0f / (S8_HID * S8_WE2)};
        pg8::gemm_phase<pg8::EpiF16S, pg8::MoeOrder, true, true, true>(F.lds + RING_OFF, g, S, E);
        SEAM(15);
    }
    if (IN(16)) { ph16_final(F); }
#undef IN
#undef SEAM
}

extern "C" void kernel_launch(void* const* d_in, const int* in_sizes, int n_in, void* d_out, int out_size, void* d_ws, size_t ws_size, hipStream_t stream) {
    static int grid = 0;
    if (grid == 0) {
        if (n_in != 39 || in_sizes[0] != M * D || out_size != M * D || ws_size < WS_END) { fprintf(stderr, "kernel_launch: unexpected problem shape (n_in %d, in0 %d, out %d, ws %zu)\n", n_in, n_in > 0 ? in_sizes[0] : -1, out_size, ws_size); grid = -1; return; }
        int dev = 0, cus = 0, per_cu = 0;
        if (hipGetDevice(&dev) != hipSuccess || hipDeviceGetAttribute(&cus, hipDeviceAttributeMultiprocessorCount, dev) != hipSuccess) { grid = -1; return; }
        if (hipFuncSetAttribute((const void*)mk_fwd, hipFuncAttributeMaxDynamicSharedMemorySize, LDS_BYTES) != hipSuccess) { fprintf(stderr, "kernel_launch: hipFuncSetAttribute failed\n"); grid = -1; return; }
        if (hipOccupancyMaxActiveBlocksPerMultiprocessor(&per_cu, (const void*)mk_fwd, NWAVES * 64, LDS_BYTES) != hipSuccess || per_cu < 1) { fprintf(stderr, "kernel_launch: occupancy query says %d\n", per_cu); }
        (void)hipGetLastError();
        grid = cus;
    }
    if (grid < 0) return;
    if (hipMemsetAsync((char*)d_ws + WS_CTL, 0, CTL_ZERO_BYTES, stream) != hipSuccess) return;
    Args a{};
    for (int i = 0; i < 39; ++i) a.in[i] = (const float*)d_in[i];
    a.out = (float*)d_out; a.ws = (unsigned char*)d_ws;
    for (int li = 0; li < N_LAUNCHES; ++li) {
        a.ph_lo = (N_LAUNCHES == 1) ? 0 : li; a.ph_hi = (N_LAUNCHES == 1) ? NPH : li + 1;
        hipLaunchKernelGGL(mk_fwd, dim3(grid), dim3(NWAVES * 64), LDS_BYTES, stream, a);
        if (hipPeekAtLastError() != hipSuccess) { fprintf(stderr, "kernel_launch: launch %d failed\n", li); break; }
    }
}
```

```cpp
#include <hip/hip_runtime.h>
#include <cstdio>
#include <cstdint>

#ifndef MK_N_LAUNCHES
#define MK_N_LAUNCHES 1
#endif

namespace pg8 {
#define PG8_LAS __attribute__((address_space(3)))
typedef unsigned short h16_t;
typedef _Float16 f16x8 __attribute__((ext_vector_type(8)));
typedef _Float16 f16x2 __attribute__((ext_vector_type(2)));
typedef float f32x4 __attribute__((ext_vector_type(4)));
typedef float f32x16 __attribute__((ext_vector_type(16)));
typedef unsigned u32x4 __attribute__((ext_vector_type(4)));
constexpr int BM = 256, BK = 64, HALF = 128, HTB = HALF * BK * 2  , STAGE_BYTES = 8 * HTB, NXCD = 8, WGM = 8;

__host__ __device__ __forceinline__ int lds_byte(int r, int c) { const int st = (r >> 4) * 2 + (c >> 5), rr = r & 15, cc = c & 31, ob = rr * 64 + cc * 2; return st * 1024 + (ob ^ (((ob >> 9) & 1) << 5)); }
__host__ __device__ __forceinline__ void stage_rc(int b, int& R, int& C) { const int st = b / 1024, sb = b % 1024, swz = sb ^ (((sb >> 9) & 1) << 5); R = (st >> 1) * 16 + swz / 64; C = (st & 1) * 32 + (swz % 64) / 2; }
__host__ __device__ __forceinline__ int perm32(int rho) { const int n = rho >> 4, i = rho & 15; return 8 * (i >> 2) + 4 * n + (i & 3); }

struct Unit { int pm, pn; };
struct Gemm { const h16_t* A; const h16_t* Bt; int M, N, K; };

struct StaticOrder {
    int nM, nN, nwg, G, c;
    __host__ __device__ void init(int M, int N, int G_, int c_) { nM = M / BM; nN = N / BM; nwg = nM * nN; G = G_; c = c_; }
    __host__ __device__ bool next(int i, Unit& u) const {
        const long L = (long)i * G + c; if (L >= nwg) return false;
        int wgid = (int)L; { const int q = nwg / NXCD, r = nwg % NXCD, xcd = wgid % NXCD, off = wgid / NXCD; wgid = (xcd < r ? xcd * (q + 1) : r * (q + 1) + (xcd - r) * q) + off; }
        const int nig = WGM * nN, gid = wgid / nig, fm = gid * WGM, gsz = (nM - fm) < WGM ? (nM - fm) : WGM;
        u.pm = fm + ((wgid % nig) % gsz); u.pn = (wgid % nig) / gsz; return true;
    }
    __device__ __forceinline__ void a_ready(const Unit&) const {}
    __device__ __forceinline__ void done(const Unit&) const {}
};
struct MoeOrder {
    int tp[9]; int nN, G, c;
    __device__ bool next(int i, Unit& u) const {
        const long L = (long)i * G + c; const int nM = tp[8], nwg = nM * nN; if (L >= nwg) return false;
        int wgid = (int)L; { const int q = nwg / NXCD, r = nwg % NXCD, xcd = wgid % NXCD, off = wgid / NXCD; wgid = (xcd < r ? xcd * (q + 1) : r * (q + 1) + (xcd - r) * q) + off; }
        const int nig = WGM * nN, gid = wgid / nig, fm = gid * WGM, gsz = (nM - fm) < WGM ? (nM - fm) : WGM;
        const int rt = fm + ((wgid % nig) % gsz), cn = (wgid % nig) / gsz; int e = 0;
#pragma unroll
        for (int k = 1; k < 8; ++k) e += (rt >= tp[k]) ? 1 : 0;
        u.pm = rt; u.pn = e * nN + cn; return true;
    }
    __device__ __forceinline__ void a_ready(const Unit&) const {}
    __device__ __forceinline__ void done(const Unit&) const {}
};

__device__ __forceinline__ unsigned pk2h(float lo, float hi) { f16x2 v = {(_Float16)lo, (_Float16)hi}; return __builtin_bit_cast(unsigned, v); }
typedef int i32x4 __attribute__((ext_vector_type(4)));
typedef int i32x8 __attribute__((ext_vector_type(8)));
__device__ __forceinline__ unsigned pk4f8(float a, float b, float c, float d) {
    a = __builtin_amdgcn_fmed3f(a, -448.f, 448.f); b = __builtin_amdgcn_fmed3f(b, -448.f, 448.f); c = __builtin_amdgcn_fmed3f(c, -448.f, 448.f); d = __builtin_amdgcn_fmed3f(d, -448.f, 448.f);
    int w = __builtin_amdgcn_cvt_pk_fp8_f32(a, b, 0, false); w = __builtin_amdgcn_cvt_pk_fp8_f32(c, d, w, true); return (unsigned)w;
}
__device__ __forceinline__ float fast_sigmoid(float v) { return __builtin_amdgcn_rcpf(1.0f + __builtin_amdgcn_exp2f(-1.4426950408889634f * v)); }

struct EpiF16 {
    static constexpr bool PERM = true, AFTER_DRAIN = false;
    h16_t* O; int ldc; int nmod; float sA; float sB;
    __device__ __forceinline__ void operator()(const f32x4 (&acc)[2][2][4][2], const Unit& u, int wr, int wc, int fr, int fq) const {
        const int row0 = u.pm * BM + wr * 64 + fr; const int pn = u.pn % nmod;
        float sc = 1.f; if (sA != 0.f) { if (pn < 2) sc = sA; else if (pn == 6 || pn == 7) sc = sB; }
        const int col0 = pn * BM + wc * 32 + 8 * fq;
#pragma unroll
        for (int ai = 0; ai < 2; ++ai)
#pragma unroll
            for (int m = 0; m < 4; ++m) { h16_t* rowp = O + (size_t)(row0 + ai * HALF + m * 16) * ldc + col0;
#pragma unroll
                for (int bj = 0; bj < 2; ++bj) { const f32x4 v0 = acc[ai][bj][m][0] * sc, v1 = acc[ai][bj][m][1] * sc;
                    u32x4 w; w.x = pk2h(v0[0], v0[1]); w.y = pk2h(v0[2], v0[3]); w.z = pk2h(v1[0], v1[1]); w.w = pk2h(v1[2], v1[3]);
                    *(u32x4*)(rowp + bj * HALF) = w; } }
    }
};

struct EpiQKV {
    static constexpr bool PERM = true, AFTER_DRAIN = false;
    h16_t* O; h16_t* KA; h16_t* KB1; h16_t* KB4; h16_t* KB16; unsigned* kmax; float sA, sB;
    __device__ __forceinline__ static int pi32(int r) { return (r & 0x13) | ((r & 4) << 1) | ((r & 8) >> 1); }
    __device__ __forceinline__ void operator()(const f32x4 (&acc)[2][2][4][2], const Unit& u, int wr, int wc, int fr, int fq) const {
        const int row0 = u.pm * BM + wr * 64 + fr, pn = u.pn;
        const bool isKA = (pn == 2 || pn == 3), isKB = (pn == 8 || pn == 9);
        if (!isKA && !isKB) {
            const float sc = (pn < 2) ? sA : (pn == 6 || pn == 7) ? sB : 1.0f;
            const int col0 = pn * BM + wc * 32 + 8 * fq;
#pragma unroll
            for (int ai = 0; ai < 2; ++ai)
#pragma unroll
                for (int m = 0; m < 4; ++m) { h16_t* rowp = O + (size_t)(row0 + ai * HALF + m * 16) * 3072 + col0;
#pragma unroll
                    for (int bj = 0; bj < 2; ++bj) { const f32x4 v0 = acc[ai][bj][m][0] * sc, v1 = acc[ai][bj][m][1] * sc;
                        u32x4 w; w.x = pk2h(v0[0], v0[1]); w.y = pk2h(v0[2], v0[3]); w.z = pk2h(v1[0], v1[1]); w.w = pk2h(v1[2], v1[3]);
                        *(u32x4*)(rowp + bj * HALF) = w; } }
            return;
        }
        const int b = u.pm >> 4;
        float mx[2] = {0.f, 0.f};
#pragma unroll
        for (int ai = 0; ai < 2; ++ai)
#pragma unroll
            for (int m = 0; m < 4; ++m) { const int t = (row0 + ai * HALF + m * 16) & 4095;
#pragma unroll
                for (int bj = 0; bj < 2; ++bj) { const f32x4 v0 = acc[ai][bj][m][0], v1 = acc[ai][bj][m][1];
                    u32x4 w; w.x = pk2h(v0[0], v0[1]); w.y = pk2h(v0[2], v0[3]); w.z = pk2h(v1[0], v1[1]); w.w = pk2h(v1[2], v1[3]);
                    const int cs = (pn & 1) * 256 + bj * HALF + wc * 32 + 8 * fq, h = cs >> 6, c8 = (cs & 63) >> 3, bh = b * 8 + h;
                    if (isKA) {
                        const int frag = (c8 >> 2) * 2 + ((c8 >> 1) & 1), hi = c8 & 1;
                        *(u32x4*)(KA + ((size_t)((bh * 128 + (t >> 5)) * 4 + frag) * 64 + hi * 32 + pi32(t & 31)) * 8) = w;
                        float q2 = (v0[0] * v0[0] + v0[1] * v0[1]) + (v0[2] * v0[2] + v0[3] * v0[3]) + (v1[0] * v1[0] + v1[1] * v1[1]) + (v1[2] * v1[2] + v1[3] * v1[3]);
                        q2 += __shfl_xor(q2, 16); q2 += __shfl_xor(q2, 32);
                        mx[bj] = fmaxf(mx[bj], q2);
                    } else {
                        const int sl = c8 >> 1, hi = c8 & 1;
                        { const int uu = t >> 5, r = t & 31; *(u32x4*)(KB1 + ((size_t)((bh * 128 + uu) * 4 + sl) * 64 + hi * 32 + pi32(r)) * 8) = w; }
                        { const int i = t >> 2, uu = (t & 3) * 32 + (i >> 5), r = i & 31; *(u32x4*)(KB4 + ((size_t)((bh * 128 + uu) * 4 + sl) * 64 + hi * 32 + pi32(r)) * 8) = w; }
                        { const int i = t >> 4, uu = (t & 15) * 8 + (i >> 5), r = i & 31; *(u32x4*)(KB16 + ((size_t)((bh * 128 + uu) * 4 + sl) * 64 + hi * 32 + pi32(r)) * 8) = w; }
                    } } }
        if (isKA) {
#pragma unroll
            for (int bj = 0; bj < 2; ++bj) { float v = mx[bj];
                v = fmaxf(v, __shfl_xor(v, 1)); v = fmaxf(v, __shfl_xor(v, 2)); v = fmaxf(v, __shfl_xor(v, 4)); v = fmaxf(v, __shfl_xor(v, 8));
                const int cs = (pn & 1) * 256 + bj * HALF + wc * 32;
                if ((threadIdx.x & 63) == 0) __hip_atomic_fetch_max(kmax + (b * 8 + (cs >> 6)) * 2 + ((cs >> 5) & 1), __float_as_uint(v * 1.002f), __ATOMIC_RELAXED, __HIP_MEMORY_SCOPE_AGENT); }
        }
    }
};

template <int MODE> struct EpiGated {
    static constexpr bool PERM = true, AFTER_DRAIN = false;
    h16_t* O; int ldc; int nmod; const float* bias; float sin;
    __device__ __forceinline__ void operator()(const f32x4 (&acc)[2][2][4][2], const Unit& u, int wr, int wc, int fr, int fq) const {
        const int row0 = u.pm * BM + wr * 64 + fr; const int pn = u.pn % nmod;
        const int col0 = pn * HALF + wc * 32 + 8 * fq;
        f32x4 ba[2], bb[2];
#pragma unroll
        for (int n = 0; n < 2; ++n) { if (MODE == 1) { ba[n] = *(const f32x4*)(bias + col0 + 4 * n); bb[n] = *(const f32x4*)(bias + 1024 + col0 + 4 * n); } else { ba[n] = (f32x4){0.f, 0.f, 0.f, 0.f}; bb[n] = ba[n]; } }
#pragma unroll
        for (int ai = 0; ai < 2; ++ai)
#pragma unroll
            for (int m = 0; m < 4; ++m) { h16_t* rowp = O + (size_t)(row0 + ai * HALF + m * 16) * ldc + col0;
                float r[8];
#pragma unroll
                for (int n = 0; n < 2; ++n)
#pragma unroll
                    for (int e = 0; e < 4; ++e) { const float a = acc[ai][0][m][n][e] * sin + ba[n][e], b = acc[ai][1][m][n][e] * sin + bb[n][e];
                        r[4 * n + e] = (MODE == 0) ? (a * fast_sigmoid(a)) * b : a * fast_sigmoid(b); }
                u32x4 w; w.x = pk2h(r[0], r[1]); w.y = pk2h(r[2], r[3]); w.z = pk2h(r[4], r[5]); w.w = pk2h(r[6], r[7]);
                *(u32x4*)rowp = w; }
    }
};

__device__ __forceinline__ unsigned pk4i8(float a, float b, float c, float d) {
    const float MG = 12582912.0f;
    const unsigned ua = __builtin_bit_cast(unsigned, __builtin_amdgcn_fmed3f(a, -127.f, 127.f) + MG), ub = __builtin_bit_cast(unsigned, __builtin_amdgcn_fmed3f(b, -127.f, 127.f) + MG);
    const unsigned uc = __builtin_bit_cast(unsigned, __builtin_amdgcn_fmed3f(c, -127.f, 127.f) + MG), ud = __builtin_bit_cast(unsigned, __builtin_amdgcn_fmed3f(d, -127.f, 127.f) + MG);
    const unsigned lo = __builtin_amdgcn_perm(ub, ua, 0x0c0c0400u), hi = __builtin_amdgcn_perm(ud, uc, 0x0c0c0400u);
    return __builtin_amdgcn_perm(hi, lo, 0x05040100u);
}
struct EpiF16S {
    static constexpr bool PERM = true, AFTER_DRAIN = false;
    h16_t* O; int ldc; int nmod; float s;
    __device__ __forceinline__ void operator()(const f32x4 (&acc)[2][2][4][2], const Unit& u, int wr, int wc, int fr, int fq) const {
        const int row0 = u.pm * BM + wr * 64 + fr; const int pn = u.pn % nmod;
        const int col0 = pn * BM + wc * 32 + 8 * fq;
#pragma unroll
        for (int ai = 0; ai < 2; ++ai)
#pragma unroll
            for (int m = 0; m < 4; ++m) { h16_t* rowp = O + (size_t)(row0 + ai * HALF + m * 16) * ldc + col0;
#pragma unroll
                for (int bj = 0; bj < 2; ++bj) { const f32x4 v0 = acc[ai][bj][m][0] * s, v1 = acc[ai][bj][m][1] * s;
                    u32x4 w; w.x = pk2h(v0[0], v0[1]); w.y = pk2h(v0[2], v0[3]); w.z = pk2h(v1[0], v1[1]); w.w = pk2h(v1[2], v1[3]);
                    *(u32x4*)(rowp + bj * HALF) = w; } }
    }
};
template <int MODE, bool PADLAST> struct EpiGated8 {
    static constexpr bool PERM = true, AFTER_DRAIN = false;
    unsigned char* O; int ldc; int nmod; const float* bias; float sin, so;
    const float* rs = nullptr; const float* wsa = nullptr; const float* wsb = nullptr;
    __device__ __forceinline__ void operator()(const f32x4 (&acc)[2][2][4][2], const Unit& u, int wr, int wc, int fr, int fq) const {
        const int row0 = u.pm * BM + wr * 64 + fr; const int pn = u.pn % nmod;
        const int col0 = pn * HALF + wc * 32 + 8 * fq;
        float sa = sin, sb = sin; if (wsa) { const int e = u.pn / nmod; sa *= wsa[e]; sb *= wsb[e]; }
        f32x4 ba[2], bb[2];
#pragma unroll
        for (int n = 0; n < 2; ++n) { if (MODE == 1) { ba[n] = *(const f32x4*)(bias + col0 + 4 * n); bb[n] = *(const f32x4*)(bias + 1024 + col0 + 4 * n); } else { ba[n] = (f32x4){0.f, 0.f, 0.f, 0.f}; bb[n] = ba[n]; } }
#pragma unroll
        for (int ai = 0; ai < 2; ++ai)
#pragma unroll
            for (int m = 0; m < 4; ++m) { unsigned char* rowp = O + (size_t)(row0 + ai * HALF + m * 16) * ldc + col0;
                float r[8]; float ra = sa, rb = sb; if (rs) { const float rv = rs[row0 + ai * HALF + m * 16]; ra *= rv; rb *= rv; }
#pragma unroll
                for (int n = 0; n < 2; ++n)
#pragma unroll
                    for (int e = 0; e < 4; ++e) { const float a = acc[ai][0][m][n][e] * ra + ba[n][e], b = acc[ai][1][m][n][e] * rb + bb[n][e];
                        r[4 * n + e] = (MODE == 0) ? (a * fast_sigmoid(a)) * (b * so) : (a * so) * fast_sigmoid(b); }
                typedef unsigned u32x2 __attribute__((ext_vector_type(2)));
                u32x2 w; w.x = pk4f8(r[0], r[1], r[2], r[3]); w.y = pk4f8(r[4], r[5], r[6], r[7]);
                *(u32x2*)rowp = w;
                if (PADLAST) { if (pn == nmod - 1) *(u32x2*)(rowp + HALF) = (u32x2){0u, 0u}; } }
    }
};

template <class Epi, class Sched, bool ALIGN_EPI = false, bool SP2 = false, int OPM = 0>
__device__ __forceinline__ void gemm_phase(PG8_LAS unsigned char* lds, const Gemm g, const Sched& S, const Epi& E) {
    constexpr bool F8 = (OPM == 1), I8 = (OPM == 2);
    const int tid = threadIdx.x, wid = __builtin_amdgcn_readfirstlane(tid >> 6), lane = tid & 63, wr = wid >> 2, wc = wid & 3, fr = lane & 15, fq = lane >> 4;
    const int K = g.K, nt = K / BK;
    unsigned voffA[2], voffB[2];
#pragma unroll
    for (int i = 0; i < 2; ++i) { int R, C; stage_rc(tid * 16 + i * 8192, R, C); const int Rb = Epi::PERM ? ((R & ~31) + perm32(R & 31)) : R;
        voffA[i] = (unsigned)(R * K + C) * 2u; voffB[i] = (unsigned)(Rb * K + C) * 2u; }
    const size_t kstep = (size_t)(BK * 2);
    const size_t hstep = (size_t)HALF * K * 2;
    const size_t qstep = (size_t)64 * K * 2;
    const size_t tstep = 2 * hstep;
    const unsigned ldsw = (unsigned)wid * 1024u;
    const int aoff = lds_byte(wr * 64 + fr, fq * 8); int boff = lds_byte(wc * 32 + fr, fq * 8);
    if constexpr (F8) { boff += 4 * HTB; asm volatile("" : "+v"(boff)); }
#define PG8_SA(b, h) (((b) * 2 + (h)) * HTB)
#define PG8_SB(b, h) ((4 + (b) * 2 + (h)) * HTB)
#define PG8_SBR(b, h) ((F8 ? 0 : 4 * HTB) + ((b) * 2 + (h)) * HTB)
#define PG8_STAGE(bufoff, gbase, voff) do { _Pragma("unroll") for (int _i = 0; _i < 2; ++_i) { \
        if constexpr (F8) __builtin_amdgcn_global_load_lds((const unsigned*)((const char*)(gbase) + (size_t)_i * qstep + (voff)[0]), (PG8_LAS unsigned*)(lds + (bufoff) + ldsw + _i * 8192), 16, 0, 0); \
        else __builtin_amdgcn_global_load_lds((const unsigned*)((const char*)(gbase) + (voff)[_i]), (PG8_LAS unsigned*)(lds + (bufoff) + ldsw + _i * 8192), 16, 0, 0); } } while (0)
#define PG8_LD8(off) __builtin_shufflevector(*(const PG8_LAS i32x4*)(lds + (off)), *(const PG8_LAS i32x4*)(lds + (off) + 1024), 0, 1, 2, 3, 4, 5, 6, 7)
#define PG8_LDA(dst, b, h) do { _Pragma("unroll") for (int m = 0; m < 4; ++m) { if constexpr (F8) dst##8[m] = PG8_LD8(PG8_SA(b, h) + aoff + m * 2048); \
        else { _Pragma("unroll") for (int k = 0; k < 2; ++k) dst[m][k] = *(const PG8_LAS f16x8*)(lds + PG8_SA(b, h) + aoff + m * 2048 + k * 1024); } } } while (0)
#define PG8_LDB(dst, b, h) do { _Pragma("unroll") for (int n = 0; n < 2; ++n) { if constexpr (F8) dst##8[n] = PG8_LD8(PG8_SBR(b, h) + boff + n * 2048); \
        else { _Pragma("unroll") for (int k = 0; k < 2; ++k) dst[n][k] = *(const PG8_LAS f16x8*)(lds + PG8_SBR(b, h) + boff + n * 2048 + k * 1024); } } } while (0)
#define PG8_MMA(ai, bj, At, Bt) do { __builtin_amdgcn_s_setprio(1); _Pragma("unroll") for (int m = 0; m < 4; ++m) _Pragma("unroll") for (int n = 0; n < 2; ++n) { \
        if constexpr (F8) { f32x4 c_ = {acc16[ai][bj][n][4 * m], acc16[ai][bj][n][4 * m + 1], acc16[ai][bj][n][4 * m + 2], acc16[ai][bj][n][4 * m + 3]}; \
            c_ = __builtin_amdgcn_mfma_scale_f32_16x16x128_f8f6f4(Bt##8[n], At##8[m], c_, 0, 0, 0, 0, 0, 0); \
            acc16[ai][bj][n][4 * m] = c_[0]; acc16[ai][bj][n][4 * m + 1] = c_[1]; acc16[ai][bj][n][4 * m + 2] = c_[2]; acc16[ai][bj][n][4 * m + 3] = c_[3]; } \
        else if constexpr (I8) { _Pragma("unroll") for (int k = 0; k < 2; ++k) acci[ai][bj][m][n] = __builtin_amdgcn_mfma_i32_16x16x64_i8(__builtin_bit_cast(i32x4, Bt[n][k]), __builtin_bit_cast(i32x4, At[m][k]), acci[ai][bj][m][n], 0, 0, 0); } \
        else { _Pragma("unroll") for (int k = 0; k < 2; ++k) acc[ai][bj][m][n] = __builtin_amdgcn_mfma_f32_16x16x32_f16(Bt[n][k], At[m][k], acc[ai][bj][m][n], 0, 0, 0); } } \
        __builtin_amdgcn_s_setprio(0); } while (0)
#define PG8_WAIT_V(n) asm volatile("s_waitcnt vmcnt(" #n ")" ::: "memory")
#define PG8_WAIT_L(n) asm volatile("s_waitcnt lgkmcnt(" #n ")" ::: "memory")
#define PG8_BAR __builtin_amdgcn_s_barrier()
#define PG8_SCHED __builtin_amdgcn_sched_barrier(0)
    Unit cur, nxt; int ui = 0;
    if (!S.next(0, cur)) return;
    f32x4 acc[2][2][4][2]; f32x16 acc16[2][2][2]; i32x4 acci[2][2][4][2];
#define PG8_ZERO_ACC do { _Pragma("unroll") for (int a = 0; a < 2; ++a) _Pragma("unroll") for (int b = 0; b < 2; ++b) { \
        if constexpr (F8) { _Pragma("unroll") for (int n = 0; n < 2; ++n) _Pragma("unroll") for (int r = 0; r < 16; ++r) acc16[a][b][n][r] = 0.f; } \
        else if constexpr (I8) { _Pragma("unroll") for (int m = 0; m < 4; ++m) _Pragma("unroll") for (int n = 0; n < 2; ++n) acci[a][b][m][n] = (i32x4){0, 0, 0, 0}; } \
        else { _Pragma("unroll") for (int m = 0; m < 4; ++m) _Pragma("unroll") for (int n = 0; n < 2; ++n) acc[a][b][m][n] = (f32x4){0.f, 0.f, 0.f, 0.f}; } } } while (0)
    PG8_ZERO_ACC;
    f16x8 At[4][2], B0[2][2], B1[2][2]; i32x8 At8[4], B08[2], B18[2];
    const char* cA = (const char*)g.A + (size_t)cur.pm * tstep; const char* cB = (const char*)g.Bt + (size_t)cur.pn * tstep;
    S.a_ready(cur);
    if constexpr (SP2) {
        PG8_STAGE(PG8_SB(0, 0), cB, voffB); PG8_STAGE(PG8_SB(0, 1), cB + hstep, voffB); PG8_STAGE(PG8_SA(0, 0), cA, voffA); PG8_STAGE(PG8_SA(0, 1), cA + hstep, voffA);
        if (wr == 1) PG8_BAR;
        PG8_WAIT_V(2); PG8_BAR;
        PG8_STAGE(PG8_SB(1, 0), cB + kstep, voffB); PG8_STAGE(PG8_SA(1, 0), cA + kstep, voffA); PG8_STAGE(PG8_SB(1, 1), cB + hstep + kstep, voffB);
        PG8_WAIT_V(6); PG8_BAR;
    } else {
        PG8_STAGE(PG8_SB(0, 0), cB, voffB); PG8_STAGE(PG8_SA(0, 0), cA, voffA); PG8_STAGE(PG8_SB(0, 1), cB + hstep, voffB); PG8_STAGE(PG8_SA(0, 1), cA + hstep, voffA);
        if (wr == 1) PG8_BAR;
        PG8_WAIT_V(4); PG8_BAR;
        PG8_STAGE(PG8_SB(1, 0), cB + kstep, voffB); PG8_STAGE(PG8_SA(1, 0), cA + kstep, voffA); PG8_STAGE(PG8_SB(1, 1), cB + hstep + kstep, voffB);
        PG8_WAIT_V(6); PG8_BAR;
    }
    for (;;) {
        const bool has_next = S.next(ui + 1, nxt);
        const char* nA = has_next ? (const char*)g.A + (size_t)nxt.pm * tstep : cA; const char* nB = has_next ? (const char*)g.Bt + (size_t)nxt.pn * tstep : cB;
        for (int t = 0; t < nt; t += 2) {
            const bool last = (t == nt - 2);
            const char* a1 = cA + (size_t)(t + 1) * kstep;
            const char* a2 = last ? nA : cA + (size_t)(t + 2) * kstep; const char* b2 = last ? nB : cB + (size_t)(t + 2) * kstep;
            const char* a3 = a2 + kstep; const char* b3 = b2 + kstep;
            if (last && has_next) S.a_ready(nxt);
            if constexpr (SP2) {
            PG8_LDB(B0, 0, 0); PG8_LDB(B1, 0, 1); PG8_SCHED; PG8_LDA(At, 0, 0); PG8_STAGE(PG8_SA(1, 1), a1 + hstep, voffA);
            PG8_WAIT_V(8); PG8_WAIT_L(0); PG8_BAR; PG8_MMA(0, 0, At, B0); PG8_MMA(0, 1, At, B1); PG8_BAR; PG8_SCHED;
            PG8_LDA(At, 0, 1); PG8_STAGE(PG8_SB(0, 0), b2, voffB); PG8_STAGE(PG8_SB(0, 1), b2 + hstep, voffB); PG8_STAGE(PG8_SA(0, 0), a2, voffA);
            PG8_WAIT_V(8); PG8_WAIT_L(0); PG8_BAR; PG8_MMA(1, 0, At, B0); PG8_MMA(1, 1, At, B1); PG8_BAR; PG8_SCHED;
            PG8_LDB(B0, 1, 0); PG8_LDB(B1, 1, 1); PG8_SCHED; PG8_LDA(At, 1, 0); PG8_STAGE(PG8_SA(0, 1), a2 + hstep, voffA);
            PG8_WAIT_V(8); PG8_WAIT_L(0); PG8_BAR; PG8_MMA(0, 0, At, B0); PG8_MMA(0, 1, At, B1); PG8_BAR; PG8_SCHED;
            PG8_LDA(At, 1, 1); PG8_STAGE(PG8_SB(1, 0), b3, voffB); PG8_STAGE(PG8_SB(1, 1), b3 + hstep, voffB); PG8_STAGE(PG8_SA(1, 0), a3, voffA);
            PG8_WAIT_V(8); PG8_WAIT_L(0); PG8_BAR; PG8_MMA(1, 0, At, B0); PG8_MMA(1, 1, At, B1); PG8_BAR; PG8_SCHED;
            } else {
            PG8_LDB(B0, 0, 0); PG8_SCHED; PG8_LDA(At, 0, 0); PG8_STAGE(PG8_SA(1, 1), a1 + hstep, voffA);
            PG8_WAIT_L(8); PG8_BAR; PG8_WAIT_L(0); PG8_MMA(0, 0, At, B0); PG8_BAR; PG8_SCHED;
            PG8_LDB(B1, 0, 1); PG8_STAGE(PG8_SB(0, 0), b2, voffB);
            PG8_BAR; PG8_WAIT_L(0); PG8_MMA(0, 1, At, B1); PG8_BAR;
            PG8_LDA(At, 0, 1); PG8_STAGE(PG8_SA(0, 0), a2, voffA);
            PG8_BAR; PG8_WAIT_L(0); PG8_MMA(1, 0, At, B0); PG8_BAR; PG8_SCHED;
            PG8_STAGE(PG8_SB(0, 1), b2 + hstep, voffB);
            PG8_WAIT_V(6); PG8_BAR; PG8_MMA(1, 1, At, B1); PG8_BAR;
            PG8_LDB(B0, 1, 0); PG8_SCHED; PG8_LDA(At, 1, 0); PG8_STAGE(PG8_SA(0, 1), a2 + hstep, voffA);
            PG8_WAIT_L(8); PG8_BAR; PG8_WAIT_L(0); PG8_MMA(0, 0, At, B0); PG8_BAR; PG8_SCHED;
            PG8_LDB(B1, 1, 1); PG8_STAGE(PG8_SB(1, 0), b3, voffB);
            PG8_BAR; PG8_WAIT_L(0); PG8_MMA(0, 1, At, B1); PG8_BAR;
            PG8_LDA(At, 1, 1); PG8_STAGE(PG8_SA(1, 0), a3, voffA);
            PG8_BAR; PG8_WAIT_L(0); PG8_MMA(1, 0, At, B0); PG8_BAR; PG8_SCHED;
            PG8_STAGE(PG8_SB(1, 1), b3 + hstep, voffB);
            PG8_WAIT_V(6); PG8_BAR; PG8_MMA(1, 1, At, B1); PG8_BAR;
            }
        }
        if constexpr (ALIGN_EPI) { if (wr == 0) PG8_BAR; }
        if constexpr (F8) {
#pragma unroll
            for (int a = 0; a < 2; ++a)
#pragma unroll
                for (int b = 0; b < 2; ++b)
#pragma unroll
                    for (int m = 0; m < 4; ++m)
#pragma unroll
                        for (int n = 0; n < 2; ++n) acc[a][b][m][n] = (f32x4){acc16[a][b][n][4 * m], acc16[a][b][n][4 * m + 1], acc16[a][b][n][4 * m + 2], acc16[a][b][n][4 * m + 3]};
        }
        if constexpr (I8) {
#pragma unroll
            for (int a = 0; a < 2; ++a)
#pragma unroll
                for (int b = 0; b < 2; ++b)
#pragma unroll
                    for (int m = 0; m < 4; ++m)
#pragma unroll
                        for (int n = 0; n < 2; ++n) acc[a][b][m][n] = __builtin_convertvector(acci[a][b][m][n], f32x4);
        }
        if constexpr (!Epi::AFTER_DRAIN) { E(acc, cur, wr, wc, fr, fq); S.done(cur); }
        if (!has_next) break;
        PG8_ZERO_ACC;
        cur = nxt; cA = nA; cB = nB; ++ui;
        if constexpr (ALIGN_EPI) { if (wr == 1) PG8_BAR; }
    }
    PG8_WAIT_V(0);
    if constexpr (!ALIGN_EPI) { if (wr == 0) PG8_BAR; }
    PG8_BAR;
    if constexpr (Epi::AFTER_DRAIN) { E.fused(acc, cur, wr, wc, fr, fq, lds, wid, lane); S.done(cur); }
#undef PG8_SA
#undef PG8_SB
#undef PG8_SBR
#undef PG8_STAGE
#undef PG8_LDA
#undef PG8_LDB
#undef PG8_MMA
#undef PG8_ZERO_ACC
#undef PG8_LD8
#undef PG8_WAIT_V
#undef PG8_WAIT_L
#undef PG8_BAR
#undef PG8_SCHED
}
}

constexpr int NWAVES = 8;
constexpr int BATCH = 8, SEQ = 4096, D = 1024, M = BATCH * SEQ;
constexpr int DFF = 2816, NEXP = 8, DFE = 1408;
constexpr int NPH = 17;
constexpr int N_LAUNCHES = MK_N_LAUNCHES;
static_assert(N_LAUNCHES == 1, "one launch only (PH4 has an inner grid barrier)");
constexpr int DFE_PAD = 1536;
constexpr float S8_H = 8.0f, S8_HID = 8.0f, S8_WE1 = 512.0f, S8_WE2 = 1024.0f, S8_WF1 = 512.0f, S8_WF2 = 1024.0f, S8_WGLU = 1024.0f, S8_GY = 16.0f;
constexpr float LN_EPS = 1e-5f, LOG2E = 1.4426950408889634f, DN_ALPHA = 1.4142135623730951f;
constexpr float QSCALE_A = 0.17677669529663687f * LOG2E;
constexpr float QSCALE_B = 0.125f * LOG2E;

constexpr size_t MiB = 1u << 20;
constexpr size_t WS_CTL = 0, CTL_ZERO_BYTES = 1 * MiB;
constexpr size_t WS_MOD = 1 * MiB;
constexpr size_t WS_SSMA = 1 * MiB + 512 * 1024;
constexpr size_t WS_SSMB = WS_SSMA + 64 * 1024;
constexpr size_t WS_TOKE = 2 * MiB + 512 * 1024;
constexpr size_t WS_TOKG = WS_TOKE + 256 * 1024;
constexpr size_t WS_TOKP = WS_TOKG + 256 * 1024;
constexpr size_t WS_WSC = 2 * MiB + 256 * 1024;
constexpr size_t WS_RS0 = 3 * MiB + 256 * 1024;
constexpr size_t WS_RS2 = WS_RS0 + 128 * 1024;
constexpr size_t WS_RSG = WS_RS2 + 128 * 1024;
constexpr size_t WS_TAMAX = WS_RSG + 320 * 1024;
static_assert(WS_TAMAX + 128 * 1024 <= 4 * MiB, "scale tables fit below the weights");
constexpr float I8_CLIP = 4.25f;
constexpr size_t WS_W_IN = 4 * MiB, WS_W_OUT = 10 * MiB, WS_W_F1 = 12 * MiB, WS_W_F2 = 23 * MiB, WS_W_GLU = 28 * MiB + 512 * 1024;
constexpr size_t WS_W_E1 = 32 * MiB + 512 * 1024, WS_W_E2 = 76 * MiB + 512 * 1024;
constexpr size_t WS_A = 100 * MiB, WS_B = 292 * MiB, WS_C = 356 * MiB, WS_VT1 = 424 * MiB, WS_END = 488 * MiB;
constexpr size_t WS_UG = 228 * MiB;
constexpr size_t WS_SSMM = 196 * MiB;
constexpr size_t WS_KA = 356 * MiB, WS_KB1 = 388 * MiB, WS_KB4 = 420 * MiB, WS_KB16 = 452 * MiB;
constexpr int MOE_MAX_TILES = 264;
static_assert(WS_W_E2 + (size_t)NEXP * D * DFE * 2 <= WS_A, "weights fit");
static_assert((size_t)MOE_MAX_TILES * 256 * DFE * 2 <= WS_B - WS_A, "hidden_g fits region A");
static_assert(WS_B + (size_t)MOE_MAX_TILES * 256 * D * 2 <= WS_VT1, "gathered rows fit");
constexpr int CW_TMO = 0, CW_CODE = 1;
constexpr int CW_ECNT = 64;
constexpr int CW_ECUR = 128;
constexpr int CW_UQ = 1024;
constexpr int CW_TQ = 192;
constexpr int CW_PREP = 512;
constexpr int CW_KMAX = 256;
constexpr int CW_BAR = 4096;

constexpr int RING_OFF = 0, RING_BYTES = 131072;
constexpr int LDSCTL_OFF = RING_BYTES + 1024, MISC_OFF = LDSCTL_OFF + 320;
constexpr int LDS_BYTES = 147456;

#define GAS __attribute__((address_space(1)))
#define LAS __attribute__((address_space(3)))
typedef unsigned short h16;
typedef unsigned v4u __attribute__((ext_vector_type(4)));
typedef unsigned v2u __attribute__((ext_vector_type(2)));
typedef float f32x4 __attribute__((ext_vector_type(4)));
typedef GAS unsigned gu32;
#define RLX_AGENT __ATOMIC_RELAXED, __HIP_MEMORY_SCOPE_AGENT
#define LDS_WAIT() asm volatile("s_waitcnt lgkmcnt(0)" ::: "memory")
#define VM_WAIT() asm volatile("s_waitcnt vmcnt(0)" ::: "memory")
using pg8::pk2h;
__device__ __forceinline__ float h2f(unsigned short v) { return (float)__builtin_bit_cast(_Float16, v); }
__device__ __forceinline__ float hlo(unsigned w) { return h2f((unsigned short)(w & 0xffffu)); }
__device__ __forceinline__ float hhi(unsigned w) { return h2f((unsigned short)(w >> 16)); }
#define DPPF_(x, ctrl, rm) __builtin_bit_cast(float, __builtin_amdgcn_update_dpp(0, __builtin_bit_cast(int, (x)), (ctrl), (rm), 0xf, false))
__device__ __forceinline__ float wave_sum(float v) {
    v += DPPF_(v, 0xb1, 0xf);
    v += DPPF_(v, 0x4e, 0xf);
    v += DPPF_(v, 0x124, 0xf);
    v += DPPF_(v, 0x128, 0xf);
    v += DPPF_(v, 0x142, 0xa);
    v += DPPF_(v, 0x143, 0xc);
    return __builtin_bit_cast(float, __builtin_amdgcn_readlane(__builtin_bit_cast(int, v), 63));
}
__device__ __forceinline__ float wave_maxd(float v) {
    v = fmaxf(v, DPPF_(v, 0xb1, 0xf)); v = fmaxf(v, DPPF_(v, 0x4e, 0xf)); v = fmaxf(v, DPPF_(v, 0x124, 0xf)); v = fmaxf(v, DPPF_(v, 0x128, 0xf));
    v = fmaxf(v, DPPF_(v, 0x142, 0xa)); v = fmaxf(v, DPPF_(v, 0x143, 0xc));
    return __builtin_bit_cast(float, __builtin_amdgcn_readlane(__builtin_bit_cast(int, v), 63));
}
__device__ __forceinline__ float wave_max(float v) {
#pragma unroll
    for (int o = 1; o < 64; o <<= 1) v = fmaxf(v, __shfl_xor(v, o));
    return v;
}
__device__ __forceinline__ float ex2(float v) { return __builtin_amdgcn_exp2f(v); }
__device__ __forceinline__ float gelu_tanh(float v) {
    const float z = 0.7978845608028654f * (v + 0.044715f * v * v * v);
    const float e = ex2(2.0f * LOG2E * z);
    const float th = 1.0f - 2.0f * __builtin_amdgcn_rcpf(1.0f + e);
    return 0.5f * v * (1.0f + th);
}

#define XB_TMO      128
#define XB_XCNT(j)  (256  + 64 * (j))
#define XB_XSUB(j)  (1280 + 64 * (j))
#define XB_XGEN(j)  (2304 + 64 * (j))
#define XB_TOP      3328
#define XB_TOPGEN   3392
#define XCD_BAR_WORDS 3456
#define XB_SPIN_CAP (1u << 18)

__device__ __forceinline__ unsigned xb_ld(unsigned* p)              { return __hip_atomic_load(p, __ATOMIC_RELAXED, __HIP_MEMORY_SCOPE_AGENT); }
__device__ __forceinline__ unsigned xb_add(unsigned* p, unsigned v) { return __hip_atomic_fetch_add(p, v, __ATOMIC_RELAXED, __HIP_MEMORY_SCOPE_AGENT); }
__device__ __forceinline__ unsigned xb_xcc_id() { return (unsigned)__builtin_amdgcn_s_getreg((3 << 11) | 20) & 0xFu; }
#define XB_SPIN(cond, bar) do { unsigned _sp = 0; while (cond) { __builtin_amdgcn_s_sleep(1); \
    if ((++_sp & 255u) == 0u) { if (xb_ld(&(bar)[XB_TMO])) break; if (_sp > XB_SPIN_CAP) { atomicAdd(&(bar)[XB_TMO], 1u); break; } } } } while (0)

struct XcdBarrier {
    unsigned* bar; unsigned x;
    volatile LAS unsigned* st;
};

__device__ __forceinline__ XcdBarrier xcd_barrier_post(unsigned* bar, volatile LAS unsigned* st) {
    XcdBarrier b; b.bar = bar; b.x = xb_xcc_id(); b.st = st;
    if (threadIdx.x == 0) (void)xb_add(&bar[XB_XCNT(b.x)], 1u);
    return b;
}
__device__ __forceinline__ void xcd_barrier_complete(unsigned* bar, unsigned x, unsigned& nloc, unsigned& nx) {
    const unsigned G = gridDim.x * gridDim.y * gridDim.z;
    unsigned sum, cnt, mine, sp = 0u;
    for (;;) {
        sum = 0u; cnt = 0u; mine = 0u;
#pragma unroll
        for (unsigned j = 0; j < 16; ++j) { const unsigned c = xb_ld(&bar[XB_XCNT(j)]); sum += c; cnt += (c > 0u) ? 1u : 0u; mine = (j == x) ? c : mine; }
        if (sum == G) break;
        __builtin_amdgcn_s_sleep(1);
        if ((++sp & 255u) == 0u) { if (xb_ld(&bar[XB_TMO])) break; if (sp > XB_SPIN_CAP) { atomicAdd(&bar[XB_TMO], 1u); break; } }
    }
    nloc = mine > 0u ? mine : 1u; nx = cnt > 0u ? cnt : 1u;
}

__device__ __forceinline__ void xcd_barrier(const XcdBarrier& b) {
    asm volatile("s_waitcnt vmcnt(0)" ::: "memory");
    __syncthreads();
    if (threadIdx.x == 0) {
        unsigned* bar = b.bar;
        __builtin_amdgcn_s_waitcnt(0);
        unsigned nloc = b.st[0], nx = b.st[1];
        if (nloc == 0u) { xcd_barrier_complete(bar, b.x, nloc, nx); b.st[0] = nloc; b.st[1] = nx; }
        const unsigned old = xb_add(&bar[XB_XSUB(b.x)], 1u);
        const unsigned gen = old / nloc;
        if (old + 1u == (gen + 1u) * nloc) {
            __builtin_amdgcn_fence(__ATOMIC_RELEASE, "agent");
            asm volatile("s_waitcnt vmcnt(0)" ::: "memory");
            const unsigned og = xb_add(&bar[XB_TOP], 1u);
            const unsigned tg = og / nx;
            if (og + 1u == (tg + 1u) * nx) xb_add(&bar[XB_TOPGEN], 1u);
            else XB_SPIN(xb_ld(&bar[XB_TOPGEN]) == tg, bar);
            __builtin_amdgcn_fence(__ATOMIC_ACQUIRE, "agent");
            xb_add(&bar[XB_XGEN(b.x)], 1u);
            asm volatile("s_waitcnt vmcnt(0)" ::: "memory");
        } else {
            XB_SPIN(xb_ld(&bar[XB_XGEN(b.x)]) == gen, bar);
            __builtin_amdgcn_fence(__ATOMIC_ACQUIRE, "agent");
            asm volatile("s_waitcnt vmcnt(0)" ::: "memory");
        }
    }
    __syncthreads();
}

struct Frame {
    LAS unsigned char* lds;
    volatile LAS unsigned* MISC;
    gu32* ctl;
    int tid, lane, wave;
    int vcu, G;
    const float* in[39]; float* out; unsigned char* ws;
};
enum { I_X = 0, I_C, I_ADAW0, I_ADAB0, I_WIN, I_LQ1, I_LK1, I_LQ2, I_LK2, I_SUBLN, I_WOUT, I_LN1G0, I_LN1B0, I_FG, I_FU, I_FD, I_LN2G0, I_LN2B0,
       I_ADAW1, I_ADAB1, I_ARE, I_AIM, I_LOGDT, I_BRE, I_BIM, I_CRE, I_CIM, I_DSKIP, I_WGLU, I_BGLU, I_LN1G1, I_LN1B1, I_RW, I_RB, I_EG, I_EU, I_ED, I_LN2G1, I_LN2B1 };

__device__ __forceinline__ void ph0_mods(Frame& F) {
    LAS float* sc = (LAS float*)(F.lds);
    LAS float* part = (LAS float*)(F.lds + 32768);
    float* mod = (float*)(F.ws + WS_MOD);
    if ((int)blockIdx.x < 192) {
        const float* c = F.in[I_C];
        for (int i = F.tid; i < BATCH * D; i += NWAVES * 64) { const float v = c[i]; sc[i] = v / (1.0f + expf(-v)); }
        __syncthreads();
        for (int it = blockIdx.x; it < 192; it += F.G) {
            const int l = it / 96, j0 = (it % 96) * 64;
            const float* W = F.in[l ? I_ADAW1 : I_ADAW0]; const float* bias = F.in[l ? I_ADAB1 : I_ADAB0];
            float acc[8];
#pragma unroll
            for (int b = 0; b < 8; ++b) acc[b] = 0.f;
            const int k0 = F.wave * 128;
            for (int kk = k0; kk < k0 + 128; kk += 16) { float w[16];
#pragma unroll
                for (int i = 0; i < 16; ++i) w[i] = W[(size_t)(kk + i) * (6 * D) + j0 + F.lane];
#pragma unroll
                for (int i = 0; i < 16; ++i)
#pragma unroll
                    for (int b = 0; b < 8; ++b) acc[b] += sc[b * D + kk + i] * w[i]; }
#pragma unroll
            for (int b = 0; b < 8; ++b) part[(F.wave * 8 + b) * 64 + F.lane] = acc[b];
            __syncthreads();
            float s = 0.f;
#pragma unroll
            for (int w2 = 0; w2 < 8; ++w2) s += part[(w2 * 8 + F.wave) * 64 + F.lane];
            mod[(size_t)(l * 8 + F.wave) * (6 * D) + j0 + F.lane] = s + bias[j0 + F.lane];
            __syncthreads();
        }
    }
    const int gid = ((int)blockIdx.x - ((F.G >= 200) ? 192 : 0)) * (NWAVES * 64) + F.tid;
    if (gid >= 0 && gid < 64 * 64) {
        const int g = gid >> 6;
        const float ar = F.in[I_ARE][gid], ai = F.in[I_AIM][gid], dt = expf(F.in[I_LOGDT][g]);
        const float mag = expf(dt * ar); float sn, cs; sincosf(dt * ai, &sn, &cs);
        const float abr = mag * cs, abi = mag * sn, den = ar * ar + ai * ai, nr = abr - 1.0f, ni = abi;
        const float zr = (nr * ar + ni * ai) / den, zi = (ni * ar - nr * ai) / den;
        float* SA = (float*)(F.ws + WS_SSMA); float* SB = (float*)(F.ws + WS_SSMB);
        SA[gid * 2] = abr; SA[gid * 2 + 1] = abi;
#pragma unroll
        for (int c = 0; c < 16; ++c) { const float br = F.in[I_BRE][gid * 16 + c], bi = F.in[I_BIM][gid * 16 + c];
            SB[(gid * 16 + c) * 2] = zr * br - zi * bi; SB[(gid * 16 + c) * 2 + 1] = zr * bi + zi * br; }
    }
    const int tq = (int)blockIdx.x - ((F.G >= 224) ? 200 : 0);
    if (tq >= 0 && tq < 24) {
        const float* W; int ldw, K = D, N, n0 = 0;
        if (tq < 6) { W = F.in[I_WIN]; ldw = 3 * D; N = 512; n0 = 512 * tq; }
        else if (tq == 6) { W = F.in[I_FG]; ldw = DFF; N = DFF; }
        else if (tq == 7) { W = F.in[I_FU]; ldw = DFF; N = DFF; }
        else if (tq < 16) { W = F.in[I_EG] + (size_t)(tq - 8) * D * DFE; ldw = DFE; N = DFE; }
        else { W = F.in[I_EU] + (size_t)(tq - 16) * D * DFE; ldw = DFE; N = DFE; }
        float v[32];
#pragma unroll
        for (int j = 0; j < 4; ++j)
#pragma unroll
            for (int i = 0; i < 8; ++i) v[j * 8 + i] = W[(size_t)((j * 8 + F.wave) * (K / 32)) * ldw + n0 + i * (N / 8) + F.lane];
        float ss = 0.f;
#pragma unroll
        for (int i = 0; i < 32; ++i) ss += v[i] * v[i];
        ss = wave_sum(ss);
        LAS float* red = (LAS float*)(F.lds + 65536);
        if (F.lane == 0) red[F.wave] = ss;
        __syncthreads();
        if (F.tid == 0) { float t = 0.f;
#pragma unroll
            for (int w2 = 0; w2 < 8; ++w2) t += red[w2];
            const float rms = sqrtf(t * (1.0f / 16384.0f)); float* wsc = (float*)(F.ws + WS_WSC);
            wsc[tq] = 127.0f / (I8_CLIP * rms); wsc[32 + tq] = (I8_CLIP * rms) * (1.0f / 127.0f); }
    }
}

struct TItem { const float* src; unsigned char* dst; int ldw, rowb; float f8s; };
__device__ __forceinline__ void titem_make(TItem& t, const float* W, int ldw, int K, int N, unsigned char* WT, int rowmap, int item, int lane, float f8s = 0.f, int rowb = 0) {
    const int nblk = N / 32, kb = item / nblk, nb = item % nblk, k0 = 64 * kb, n0 = 32 * nb;
    const int r0 = rowmap == 0 ? n0 : ((n0 >> 7) * 256 + (n0 & 127) + (rowmap == 2 ? 128 : 0));
    const int esz = (f8s != 0.f) ? 1 : 2;
    t.src = W + (size_t)(k0 + (lane >> 5)) * ldw + n0 + (lane & 31); t.ldw = ldw; t.rowb = rowb ? rowb : K * esz; t.f8s = f8s;
    t.dst = WT + (size_t)(r0 + (lane >> 3)) * t.rowb + (size_t)(k0 + 8 * (lane & 7)) * esz;
}
__device__ __forceinline__ void titem_decode(Frame& F, TItem& t, int it, int lane) {
    constexpr int I_0 = 16 * 96, I_1 = 16 * 32, I_2 = 16 * 88, I_3 = 16 * 88, I_4 = 44 * 32, I_5 = 16 * 32, I_6 = 16 * 32;
    constexpr int I_7 = 16 * 44, I_8 = 16 * 44, I_9 = 22 * 32;
    unsigned char* ws = F.ws; int r = it; const float* wsc = (const float*)(ws + WS_WSC);
    if (r < I_0) { titem_make(t, F.in[I_WIN], 3 * D, D, 3 * D, ws + WS_W_IN, 0, r, lane); return; } r -= I_0;
    if (r < I_1) { titem_make(t, F.in[I_WOUT], D, D, D, ws + WS_W_OUT, 0, r, lane); return; } r -= I_1;
    if (r < I_2) { titem_make(t, F.in[I_FG], DFF, D, DFF, ws + WS_W_F1, 1, r, lane, -wsc[6]); return; } r -= I_2;
    if (r < I_3) { titem_make(t, F.in[I_FU], DFF, D, DFF, ws + WS_W_F1, 2, r, lane, -wsc[7]); return; } r -= I_3;
    if (r < I_4) { titem_make(t, F.in[I_FD], D, DFF, D, ws + WS_W_F2, 0, r, lane, S8_WF2); return; } r -= I_4;
    if (r < I_5) { titem_make(t, F.in[I_WGLU], 2 * D, D, D, ws + WS_W_GLU, 1, r, lane, S8_WGLU); return; } r -= I_5;
    if (r < I_6) { titem_make(t, F.in[I_WGLU] + D, 2 * D, D, D, ws + WS_W_GLU, 2, r, lane, S8_WGLU); return; } r -= I_6;
    const int e = r / (I_7 + I_8 + I_9); r -= e * (I_7 + I_8 + I_9);
    if (r < I_7) { titem_make(t, F.in[I_EG] + (size_t)e * D * DFE, DFE, D, DFE, ws + WS_W_E1 + (size_t)e * 2 * DFE * D, 1, r, lane, S8_WE1); return; } r -= I_7;
    if (r < I_8) { titem_make(t, F.in[I_EU] + (size_t)e * D * DFE, DFE, D, DFE, ws + WS_W_E1 + (size_t)e * 2 * DFE * D, 2, r, lane, S8_WE1); return; } r -= I_8;
    titem_make(t, F.in[I_ED] + (size_t)e * DFE * D, D, DFE, D, ws + WS_W_E2 + (size_t)e * D * DFE_PAD, 0, r, lane, S8_WE2, DFE_PAD);
}
constexpr int NIT_L0 = 16 * 96 + 16 * 32 + 2 * 16 * 88 + 44 * 32;
constexpr int NIT_ALL = NIT_L0 + 2 * 16 * 32 + NEXP * (2 * 16 * 44 + 22 * 32);
__device__ __forceinline__ void transpose_items(Frame& F, int it0, int it1, LAS float* scr) {
    const int gw = F.vcu * NWAVES + F.wave, NGW = F.G * NWAVES, lane = F.lane;
    const int NITEMS = it1;
    if (it0 + gw < NITEMS) {
        TItem cur; titem_decode(F, cur, it0 + gw, lane);
        float cv[32];
#pragma unroll
        for (int i = 0; i < 32; ++i) cv[i] = cur.src[(size_t)(2 * i) * cur.ldw];
        for (int it = it0 + gw; it < NITEMS; it += NGW) {
            TItem nxt = cur; float nv[32];
            const bool hn = it + NGW < NITEMS;
            if (hn) { titem_decode(F, nxt, it + NGW, lane);
#pragma unroll
                for (int i = 0; i < 32; ++i) nv[i] = nxt.src[(size_t)(2 * i) * nxt.ldw]; }
#pragma unroll
            for (int i = 0; i < 32; ++i) scr[(2 * i + (lane >> 5)) * 33 + (lane & 31)] = cv[i];
            LDS_WAIT(); asm volatile("" ::: "memory");
            const int c = lane & 7;
            if (cur.f8s == 0.f) {
#pragma unroll
                for (int j = 0; j < 4; ++j) { const int n = (lane >> 3) + 8 * j; const LAS float* sp = scr + (8 * c) * 33 + n;
                    v4u o; o.x = pk2h(sp[0 * 33], sp[1 * 33]); o.y = pk2h(sp[2 * 33], sp[3 * 33]); o.z = pk2h(sp[4 * 33], sp[5 * 33]); o.w = pk2h(sp[6 * 33], sp[7 * 33]);
                    *(GAS v4u*)(cur.dst + (size_t)(8 * j) * cur.rowb) = o; }
            } else if (cur.f8s > 0.f) { const float sw = cur.f8s;
#pragma unroll
                for (int j = 0; j < 4; ++j) { const int n = (lane >> 3) + 8 * j; const LAS float* sp = scr + (8 * c) * 33 + n;
                    v2u o; o.x = pg8::pk4f8(sp[0 * 33] * sw, sp[1 * 33] * sw, sp[2 * 33] * sw, sp[3 * 33] * sw); o.y = pg8::pk4f8(sp[4 * 33] * sw, sp[5 * 33] * sw, sp[6 * 33] * sw, sp[7 * 33] * sw);
                    *(GAS v2u*)(cur.dst + (size_t)(8 * j) * cur.rowb) = o; }
            } else { const float sw = -cur.f8s;
#pragma unroll
                for (int j = 0; j < 4; ++j) { const int n = (lane >> 3) + 8 * j; const LAS float* sp = scr + (8 * c) * 33 + n;
                    v2u o; o.x = pg8::pk4i8(sp[0 * 33] * sw, sp[1 * 33] * sw, sp[2 * 33] * sw, sp[3 * 33] * sw); o.y = pg8::pk4i8(sp[4 * 33] * sw, sp[5 * 33] * sw, sp[6 * 33] * sw, sp[7 * 33] * sw);
                    *(GAS v2u*)(cur.dst + (size_t)(8 * j) * cur.rowb) = o; }
            }
            LDS_WAIT(); asm volatile("" ::: "memory");
            if (hn) {
#pragma unroll
                for (int i = 0; i < 32; ++i) cv[i] = nv[i];
                cur = nxt; }
        }
    }
}
__device__ __forceinline__ void ph1_prologue(Frame& F) {
    const int gw = F.vcu * NWAVES + F.wave, NGW = F.G * NWAVES, lane = F.lane;
    unsigned char* ws = F.ws;
    transpose_items(F, 0, NIT_ALL, (LAS float*)(F.lds + RING_OFF + F.wave * 16384));
    for (int i = (int)blockIdx.x * (NWAVES * 64) + F.tid; i < NEXP * D * 8; i += F.G * NWAVES * 64)
        *(v4u*)(ws + WS_W_E2 + (size_t)(i >> 3) * DFE_PAD + DFE + 16 * (i & 7)) = (v4u){0u, 0u, 0u, 0u};
    const float* mod0 = (const float*)(ws + WS_MOD);
    h16* H0 = (h16*)(ws + WS_B);
    {
        const int WPB = F.G, bq = gw / WPB, r0 = gw % WPB; const float* mb = mod0 + (size_t)bq * (6 * D);
        f32x4 sc1[4], shv[4];
#pragma unroll
        for (int j = 0; j < 4; ++j) { const int col = 4 * lane + 256 * j; shv[j] = *(const f32x4*)(mb + col); sc1[j] = 1.0f + *(const f32x4*)(mb + D + col); }
        for (int t0 = r0; t0 < SEQ; t0 += 8 * WPB) {
            f32x4 xr[8][4];
#pragma unroll
            for (int i = 0; i < 8; ++i) { const int t = t0 + i * WPB; if (t < SEQ) {
#pragma unroll
                for (int j = 0; j < 4; ++j) xr[i][j] = *(const f32x4*)(F.in[I_X] + ((size_t)bq * SEQ + t) * D + 4 * lane + 256 * j); } }
#pragma unroll
            for (int i = 0; i < 8; ++i) { const int t = t0 + i * WPB; if (t < SEQ) {
#pragma unroll
                for (int j = 0; j < 4; ++j) { const int col = 4 * lane + 256 * j;
                    const f32x4 h = xr[i][j] * sc1[j] + shv[j]; v2u o; o.x = pk2h(h[0], h[1]); o.y = pk2h(h[2], h[3]);
                    *(v2u*)(H0 + ((size_t)bq * SEQ + t) * D + col) = o; } } }
        }
    }
}

__device__ __forceinline__ f32x4 ld4h(const h16* p) { const v2u w = *(const v2u*)p; return (f32x4){hlo(w.x), hhi(w.x), hlo(w.y), hhi(w.y)}; }
__device__ __forceinline__ void ld8h(const h16* p, float* f) { const v4u w = *(const v4u*)p; f[0] = hlo(w.x); f[1] = hhi(w.x); f[2] = hlo(w.y); f[3] = hhi(w.y); f[4] = hlo(w.z); f[5] = hhi(w.z); f[6] = hlo(w.w); f[7] = hhi(w.w); }
__device__ __forceinline__ float lane_reduce64(float (&v)[64], int lane) {
#pragma unroll
    for (int s = 0; s < 6; ++s) { const int half = 32 >> s; const bool up = (lane & half) != 0;
#pragma unroll
        for (int i = 0; i < half; ++i) { const float lo = v[i], hi = v[i + half]; const float send = up ? lo : hi, keep = up ? hi : lo; v[i] = keep + __shfl_xor(send, half); } }
    return v[0];
}
__device__ __forceinline__ float lam_value(Frame& F) {
    float s1 = 0.f, s2 = 0.f;
#pragma unroll 4
    for (int i = 0; i < 32; ++i) { s1 += F.in[I_LQ1][i] * F.in[I_LK1][i]; s2 += F.in[I_LQ2][i] * F.in[I_LK2][i]; }
    return expf(s1) - expf(s2) + 0.2f;
}
template <bool DIFF, bool DIL> __device__ __forceinline__ void ph4_attn_naive(Frame& F) {
    const h16* QKV = (const h16*)(F.ws + WS_A); h16* O = (h16*)(F.ws + WS_B);
    const int gw = F.vcu * NWAVES + F.wave, NGW = F.G * NWAVES, lane = F.lane;
    const float lam = lam_value(F);
    const float sub_w = F.in[I_SUBLN][lane] * 0.8f;
    if (DIFF) for (int it = gw; it < BATCH * 8 * SEQ; it += NGW) {
        const int bh = it >> 12, r = it & 4095, i = (bh & 1) ? 4095 - r : r, b = bh >> 3, h = bh & 7;
        const size_t rowq = (size_t)(b * SEQ + i) * 3072;
        const float slope2 = exp2f(-0.5f * (float)(h + 1)) * LOG2E;
        float res[2];
#pragma unroll
        for (int mp = 0; mp < 2; ++mp) {
            float q[32];
#pragma unroll
            for (int d8 = 0; d8 < 4; ++d8) ld8h(QKV + rowq + h * 64 + mp * 32 + d8 * 8, q + d8 * 8);
            float acc[64];
#pragma unroll
            for (int d = 0; d < 64; ++d) acc[d] = 0.f;
            float mrun = -INFINITY, l = 0.f;
            for (int j = lane; j <= i; j += 64) {
                const size_t rowk = (size_t)(b * SEQ + j) * 3072;
                float s = 0.f;
#pragma unroll
                for (int d8 = 0; d8 < 4; ++d8) { float kf[8]; ld8h(QKV + rowk + 512 + h * 64 + mp * 32 + d8 * 8, kf);
#pragma unroll
                    for (int e = 0; e < 8; ++e) s += q[d8 * 8 + e] * kf[e]; }
                s -= slope2 * (float)(i - j);
                const float mn = fmaxf(mrun, s), alpha = ex2(mrun - mn), p = ex2(s - mn);
                l = l * alpha + p; mrun = mn;
#pragma unroll
                for (int d8 = 0; d8 < 8; ++d8) { float vf[8]; ld8h(QKV + rowk + 1024 + h * 64 + d8 * 8, vf);
#pragma unroll
                    for (int e = 0; e < 8; ++e) acc[d8 * 8 + e] = acc[d8 * 8 + e] * alpha + p * vf[e]; }
            }
            const float Mx = wave_max(mrun), scl = (mrun == -INFINITY) ? 0.f : ex2(mrun - Mx), L = wave_sum(l * scl);
#pragma unroll
            for (int d = 0; d < 64; ++d) acc[d] *= scl;
            const float mine = lane_reduce64(acc, lane);
            res[mp] = mine / L;
        }
        const float o = res[0] - lam * res[1];
        const float ss = wave_sum(o * o);
        const float y = o * (1.0f / sqrtf(ss * (1.0f / 64.0f) + LN_EPS)) * sub_w;
        O[(size_t)(b * SEQ + i) * D + h * 64 + lane] = (h16)(pk2h(y, 0.f) & 0xffffu);
    }
    if (DIL) for (int it = gw; it < BATCH * 8 * SEQ; it += NGW) {
        const int bh = it >> 12, i = it & 4095, b = bh >> 3, h = bh & 7;
        const size_t rowq = (size_t)(b * SEQ + i) * 3072;
        const float slope2 = exp2f(-0.5f * (float)(h + 9)) * LOG2E;
        float q[64];
#pragma unroll
        for (int d8 = 0; d8 < 8; ++d8) ld8h(QKV + rowq + 1536 + h * 64 + d8 * 8, q + d8 * 8);
        float og[3], lse[3];
#pragma unroll
        for (int g = 0; g < 3; ++g) {
            const int dil = (g == 0) ? 1 : (g == 1) ? 4 : 16;
            float acc[64];
#pragma unroll
            for (int d = 0; d < 64; ++d) acc[d] = 0.f;
            float mrun = -INFINITY, l = 0.f;
            for (int jj = lane; jj <= 128; jj += 64) {
                const int t = i - jj * dil;
                if (t >= 0) {
                    const size_t rowk = (size_t)(b * SEQ + t) * 3072;
                    float s = 0.f;
#pragma unroll
                    for (int d8 = 0; d8 < 8; ++d8) { float kf[8]; ld8h(QKV + rowk + 2048 + h * 64 + d8 * 8, kf);
#pragma unroll
                        for (int e = 0; e < 8; ++e) s += q[d8 * 8 + e] * kf[e]; }
                    s -= slope2 * (float)(jj * dil);
                    const float mn = fmaxf(mrun, s), alpha = ex2(mrun - mn), p = ex2(s - mn);
                    l = l * alpha + p; mrun = mn;
#pragma unroll
                    for (int d8 = 0; d8 < 8; ++d8) { float vf[8]; ld8h(QKV + rowk + 2560 + h * 64 + d8 * 8, vf);
#pragma unroll
                        for (int e = 0; e < 8; ++e) acc[d8 * 8 + e] = acc[d8 * 8 + e] * alpha + p * vf[e]; }
                }
            }
            const float Mx = wave_max(mrun), scl = (mrun == -INFINITY) ? 0.f : ex2(mrun - Mx), L = wave_sum(l * scl);
#pragma unroll
            for (int d = 0; d < 64; ++d) acc[d] *= scl;
            const float mine = lane_reduce64(acc, lane);
            og[g] = mine / L; lse[g] = Mx + log2f(L);
        }
        const float mx = fmaxf(lse[0], fmaxf(lse[1], lse[2]));
        const float w0 = ex2(lse[0] - mx), w1 = ex2(lse[1] - mx), w2 = ex2(lse[2] - mx);
        const float y = (w0 * og[0] + w1 * og[1] + w2 * og[2]) / (w0 + w1 + w2);
        O[(size_t)(b * SEQ + i) * D + 512 + h * 64 + lane] = (h16)(pk2h(y, 0.f) & 0xffffu);
    }
}


typedef _Float16 hf8 __attribute__((ext_vector_type(8)));
typedef float f32x16 __attribute__((ext_vector_type(16)));
__device__ __forceinline__ hf8 ldf8(const h16* p) { return __builtin_bit_cast(hf8, *(const v4u*)p); }
#define MFMA32(a, b, c) __builtin_amdgcn_mfma_f32_32x32x16_f16((a), (b), (c), 0, 0, 0)
typedef short v4i16_t __attribute__((ext_vector_type(4)));
typedef _Float16 hf4 __attribute__((ext_vector_type(4)));
__device__ __forceinline__ void v_stage(LAS unsigned char* vl, const v4u (&vn)[4], int lane) {
#pragma unroll
    for (int i = 0; i < 4; ++i) *(LAS v4u*)(vl + ((lane & 7) >> 2) * 2048 + ((lane >> 3) + 8 * i) * 64 + (lane & 3) * 16) = vn[i];
}
__device__ __forceinline__ hf8 v_frag(const LAS unsigned char* trb, int dt, int s) {
    const v4i16_t lo = __builtin_amdgcn_ds_read_tr16_b64_v4i16((LAS v4i16_t*)(trb + dt * 2048 + (16 * s) * 64));
    const v4i16_t hi = __builtin_amdgcn_ds_read_tr16_b64_v4i16((LAS v4i16_t*)(trb + dt * 2048 + (16 * s + 4) * 64));
    return __builtin_shufflevector(__builtin_bit_cast(hf4, lo), __builtin_bit_cast(hf4, hi), 0, 1, 2, 3, 4, 5, 6, 7);
}
__device__ __forceinline__ float rowmax16(const f32x16& s) {
    float m;
    asm("s_nop 15\n\ts_nop 7\n\t"
                 "v_max3_f32 %0, %1, %2, %3\n\tv_max3_f32 %0, %0, %4, %5\n\tv_max3_f32 %0, %0, %6, %7\n\tv_max3_f32 %0, %0, %8, %9\n\t"
                 "v_max3_f32 %0, %0, %10, %11\n\tv_max3_f32 %0, %0, %12, %13\n\tv_max3_f32 %0, %0, %14, %15\n\tv_max_f32 %0, %0, %16"
                 : "=&v"(m)
                 : "v"(s[0]), "v"(s[1]), "v"(s[2]), "v"(s[3]), "v"(s[4]), "v"(s[5]), "v"(s[6]), "v"(s[7]), "v"(s[8]), "v"(s[9]), "v"(s[10]), "v"(s[11]), "v"(s[12]), "v"(s[13]), "v"(s[14]), "v"(s[15]));
    return m;
}
constexpr float LAZY_THR = 8.0f;
__device__ __forceinline__ float half_max(float v) { auto rr = __builtin_amdgcn_permlane32_swap(__float_as_uint(v), __float_as_uint(v), false, false); return fmaxf(__uint_as_float(rr[0]), __uint_as_float(rr[1])); }
__device__ __forceinline__ float half_sum(float v) { auto rr = __builtin_amdgcn_permlane32_swap(__float_as_uint(v), __float_as_uint(v), false, false); return __uint_as_float(rr[0]) + __uint_as_float(rr[1]); }
constexpr float SKIP_BITS = 30.0f;
__device__ __forceinline__ void ph4_diff_mfma(Frame& F) {
    const h16* QKV = (const h16*)(F.ws + WS_A); const h16* KA = (const h16*)(F.ws + WS_KA); h16* O = (h16*)(F.ws + WS_B);
    int lane_ = F.lane; asm volatile("" : "+v"(lane_));
    const int gw = F.vcu * NWAVES + F.wave, NGW = F.G * NWAVES, lane = lane_, r32 = lane & 31, hi = lane >> 5;
    const float lam = lam_value(F);
    LAS unsigned char* vl = F.lds + RING_OFF + F.wave * 4096;
    const LAS unsigned char* trb = vl + (8 * hi + ((lane & 15) >> 2)) * 64 + (16 * ((lane >> 4) & 1) + 4 * (lane & 3)) * 2;
    for (int k = 0; k < 4; ++k) {
        if (gw >= 2048) break;
        const int ty = gw & 1, qp = (gw >> 1) & 127, b = gw >> 8;
        const int h = (ty == 0) ? ((k == 0) ? 7 : (k == 1) ? 0 : (k == 2) ? 4 : 3) : ((k == 0) ? 6 : (k == 1) ? 1 : (k == 2) ? 5 : 2);
        const int bh = b * 8 + h, qt = (k & 1) ? 127 - qp : qp, i0 = qt * 32;
        const float slope2 = exp2f(-0.5f * (float)(h + 1)) * LOG2E;
        const h16* qrow = QKV + (size_t)(b * SEQ + i0 + r32) * 3072 + h * 64 + 8 * hi;
        hf8 qf[2][2];
#pragma unroll
        for (int mp = 0; mp < 2; ++mp)
#pragma unroll
            for (int sl = 0; sl < 2; ++sl) qf[mp][sl] = ldf8(qrow + mp * 32 + sl * 16);
        float need;
        { float sq[2];
#pragma unroll
            for (int mp = 0; mp < 2; ++mp) { float a = 0.f;
#pragma unroll
                for (int sl = 0; sl < 2; ++sl)
#pragma unroll
                    for (int e = 0; e < 8; ++e) { const float v = (float)qf[mp][sl][e]; a += v * v; }
                a = half_sum(a);
                const float km = __uint_as_float(__hip_atomic_load(F.ctl + CW_KMAX + (b * 8 + h) * 2 + mp, RLX_AGENT));
                sq[mp] = sqrtf(a * km) * 1.001f + 0.01f; }
            need = fmaxf(sq[0], sq[1]) + SKIP_BITS - log2f(1.0f - exp2f(-slope2)); }
        float coff[16];
#pragma unroll
        for (int r = 0; r < 16; ++r) coff[r] = slope2 * (float)(16 * (r >> 3) + 8 * hi + (r & 7));
        f32x16 o[2][2];
#pragma unroll
        for (int mp = 0; mp < 2; ++mp)
#pragma unroll
            for (int dt = 0; dt < 2; ++dt)
#pragma unroll
                for (int r = 0; r < 16; ++r) o[mp][dt][r] = 0.f;
        float mrun[2] = {0.f, 0.f}, lrun[2] = {0.f, 0.f};
        const h16* kbase = KA + ((size_t)(bh * 128) * 4 * 64 + lane) * 8;
        const h16* vbase = QKV + (size_t)(b * SEQ + (lane >> 3)) * 3072 + 1024 + h * 64 + 8 * (lane & 7);
        hf8 kn[2][2]; v4u vn[4];
        { const h16* kb2 = kbase + (size_t)(qt * 4) * 512; const h16* vb2 = vbase + (size_t)(32 * qt) * 3072;
#pragma unroll
            for (int mp = 0; mp < 2; ++mp)
#pragma unroll
                for (int sl = 0; sl < 2; ++sl) kn[mp][sl] = ldf8(kb2 + (mp * 2 + sl) * 512);
#pragma unroll
            for (int i = 0; i < 4; ++i) vn[i] = *(const v4u*)(vb2 + (size_t)(8 * i) * 3072); }
        for (int kt = qt; kt >= 0; --kt) {
            hf8 kf[2][2];
#pragma unroll
            for (int a = 0; a < 2; ++a)
#pragma unroll
                for (int c = 0; c < 2; ++c) kf[a][c] = kn[a][c];
            asm volatile("" ::: "memory");
            v_stage(vl, vn, lane);
            asm volatile("" ::: "memory");
            if (kt > 0) {
                const h16* kb2 = kbase + (size_t)((kt - 1) * 4) * 512; const h16* vb2 = vbase + (size_t)(32 * (kt - 1)) * 3072;
#pragma unroll
                for (int mp = 0; mp < 2; ++mp)
#pragma unroll
                    for (int sl = 0; sl < 2; ++sl) kn[mp][sl] = ldf8(kb2 + (mp * 2 + sl) * 512);
#pragma unroll
                for (int i = 0; i < 4; ++i) vn[i] = *(const v4u*)(vb2 + (size_t)(8 * i) * 3072);
            }
            hf8 vf[2][2];
#pragma unroll
            for (int dt = 0; dt < 2; ++dt)
#pragma unroll
                for (int s2 = 0; s2 < 2; ++s2) vf[dt][s2] = v_frag(trb, dt, s2);
            asm volatile("" ::: "memory");
            const float tb = slope2 * (float)(32 * kt - i0);
            const bool diag = (kt == qt);
            f32x16 sc[2];
#pragma unroll
            for (int mp = 0; mp < 2; ++mp) { const float tbm = tb - mrun[mp];
#pragma unroll
                for (int r = 0; r < 16; ++r) sc[mp][r] = coff[r] + tbm;
                if (diag) {
#pragma unroll
                    for (int r = 0; r < 16; ++r) if (16 * (r >> 3) + 8 * hi + (r & 7) > r32) sc[mp][r] = -INFINITY;
                } }
            sc[0] = MFMA32(kf[0][0], qf[0][0], sc[0]); sc[1] = MFMA32(kf[1][0], qf[1][0], sc[1]);
            sc[0] = MFMA32(kf[0][1], qf[0][1], sc[0]); sc[1] = MFMA32(kf[1][1], qf[1][1], sc[1]);
            hf8 pb[2][2];
#pragma unroll
            for (int mp = 0; mp < 2; ++mp) {
                const float mx = half_max(rowmax16(sc[mp]));
                if (diag || __any(mx > LAZY_THR)) {
                    const float dl = diag ? mx : fmaxf(mx, 0.f), alpha = ex2(-dl); mrun[mp] += dl; lrun[mp] *= alpha;
#pragma unroll
                    for (int r = 0; r < 16; ++r) sc[mp][r] -= dl;
#pragma unroll
                    for (int dt = 0; dt < 2; ++dt)
#pragma unroll
                        for (int r = 0; r < 16; ++r) o[mp][dt][r] *= alpha; }
                float ls = 0.f;
#pragma unroll
                for (int r = 0; r < 16; ++r) { sc[mp][r] = ex2(sc[mp][r]); ls += sc[mp][r]; }
                lrun[mp] += ls;
                v4u p0, p1;
                p0.x = pk2h(sc[mp][0], sc[mp][1]); p0.y = pk2h(sc[mp][2], sc[mp][3]); p0.z = pk2h(sc[mp][4], sc[mp][5]); p0.w = pk2h(sc[mp][6], sc[mp][7]);
                p1.x = pk2h(sc[mp][8], sc[mp][9]); p1.y = pk2h(sc[mp][10], sc[mp][11]); p1.z = pk2h(sc[mp][12], sc[mp][13]); p1.w = pk2h(sc[mp][14], sc[mp][15]);
                pb[mp][0] = __builtin_bit_cast(hf8, p0); pb[mp][1] = __builtin_bit_cast(hf8, p1);
            }
#pragma unroll
            for (int s2 = 0; s2 < 2; ++s2)
#pragma unroll
                for (int mp = 0; mp < 2; ++mp)
#pragma unroll
                    for (int dt = 0; dt < 2; ++dt) o[mp][dt] = MFMA32(vf[dt][s2], pb[mp][s2], o[mp][dt]);
            if (__all(slope2 * (float)(i0 + 1 - 32 * kt) >= need - fminf(mrun[0], mrun[1]))) break;
        }
        const float l0 = half_sum(lrun[0]), l1 = half_sum(lrun[1]);
        const float i0l = 1.0f / l0, i1l = lam / l1;
        float ss = 0.f;
#pragma unroll
        for (int dt = 0; dt < 2; ++dt)
#pragma unroll
            for (int r = 0; r < 16; ++r) { const float v = o[0][dt][r] * i0l - o[1][dt][r] * i1l; o[0][dt][r] = v; ss += v * v; }
        ss = half_sum(ss);
        const float rstd = 0.8f / sqrtf(ss * (1.0f / 64.0f) + LN_EPS);
        h16* orow = O + (size_t)(b * SEQ + i0 + r32) * D + h * 64;
#pragma unroll
        for (int dt = 0; dt < 2; ++dt)
#pragma unroll
            for (int gp = 0; gp < 2; ++gp) { v2u w[2];
#pragma unroll
                for (int e = 0; e < 2; ++e) { const int g = 2 * gp + e, d = 32 * dt + 8 * g + 4 * hi; const f32x4 sw = *(const f32x4*)(F.in[I_SUBLN] + d);
                    w[e].x = pk2h(o[0][dt][4 * g] * rstd * sw[0], o[0][dt][4 * g + 1] * rstd * sw[1]); w[e].y = pk2h(o[0][dt][4 * g + 2] * rstd * sw[2], o[0][dt][4 * g + 3] * rstd * sw[3]); }
                const auto sx = __builtin_amdgcn_permlane32_swap(w[0].x, w[1].x, false, false), sy = __builtin_amdgcn_permlane32_swap(w[0].y, w[1].y, false, false);
                *(v4u*)(orow + 32 * dt + 16 * gp + 8 * hi) = (v4u){sx[0], sy[0], sx[1], sy[1]}; }
    }
}

template <int MODE> __device__ __forceinline__ void dil_pass(Frame& F) {
    constexpr int STR = (MODE == 0) ? 1 : (MODE == 1) ? 4 : 16, NT = (MODE == 0) ? 5 : 4, LO = (MODE == 0) ? 0 : 33, NU = BATCH * 8 * 128;
    const h16* QKV = (const h16*)(F.ws + WS_A); h16* O = (h16*)(F.ws + WS_B);
    const h16* KB = (MODE == 0) ? (const h16*)(F.ws + WS_KB1) : (MODE == 1) ? (const h16*)(F.ws + WS_KB4) : (const h16*)(F.ws + WS_KB16);
    h16* PO1 = (h16*)F.out; h16* PO2 = PO1 + (size_t)BATCH * 8 * SEQ * 64; float* PM1 = (float*)(PO2 + (size_t)BATCH * 8 * SEQ * 64); float* PM2 = PM1 + (size_t)BATCH * 8 * SEQ * 2;
    int lane_ = F.lane; asm volatile("" : "+v"(lane_));
    const int gw = F.vcu * NWAVES + F.wave, NGW = F.G * NWAVES, lane = lane_, r32 = lane & 31, hi = lane >> 5;
    LAS unsigned char* vl = F.lds + RING_OFF + F.wave * 4096;
    const LAS unsigned char* trb = vl + (8 * hi + ((lane & 15) >> 2)) * 64 + (16 * ((lane >> 4) & 1) + 4 * (lane & 3)) * 2;
#define DU_BH(i) ((i) >> 7)
#define DU_RR(i) ((MODE == 0) ? 0 : (MODE == 1) ? (((i) & 127) >> 5) : (((i) & 127) >> 3))
#define DU_QB(i) ((MODE == 0) ? ((i) & 127) : (MODE == 1) ? ((i) & 31) : ((i) & 7))
#define DU_KB0(i) ((MODE == 0) ? DU_QB(i) : DU_QB(i) - 1)
#define DU_NT(i) ((DU_KB0(i) + 1 < NT) ? DU_KB0(i) + 1 : NT)
#define DU_LOADQ(i, q) do { const int bh_ = DU_BH(i), tq_ = STR * (32 * DU_QB(i) + r32) + DU_RR(i); \
        const h16* qr_ = QKV + (size_t)((bh_ >> 3) * SEQ + tq_) * 3072 + 1536 + (bh_ & 7) * 64 + 8 * hi; \
        _Pragma("unroll") for (int sl_ = 0; sl_ < 4; ++sl_) q[sl_] = ldf8(qr_ + sl_ * 16); } while (0)
#define DU_LOADKV(i, kb) do { const int bh_ = DU_BH(i), rr_ = DU_RR(i), ub_ = (MODE == 0) ? 0 : (MODE == 1) ? rr_ * 32 : rr_ * 8; \
        const h16* kp_ = KB + ((size_t)((bh_ * 128 + ub_ + (kb)) * 4) * 64 + lane) * 8; \
        const h16* vp_ = QKV + (size_t)((bh_ >> 3) * SEQ + STR * (32 * (kb) + (lane >> 3)) + rr_) * 3072 + 2560 + (bh_ & 7) * 64 + 8 * (lane & 7); \
        _Pragma("unroll") for (int sl_ = 0; sl_ < 4; ++sl_) kn[sl_] = ldf8(kp_ + sl_ * 512); \
        _Pragma("unroll") for (int i_ = 0; i_ < 4; ++i_) vn[i_] = *(const v4u*)(vp_ + (size_t)(STR * 8 * i_) * 3072); } while (0)
    int idx = gw; if (idx >= NU) return;
    hf8 kn[4]; v4u vn[4];
    if (DU_NT(idx) > 0) DU_LOADKV(idx, DU_KB0(idx));
    for (;;) {
        const int nidx = idx + NGW; const bool hn = nidx < NU;
        const int bh = DU_BH(idx), b = bh >> 3, h = bh & 7, rr = DU_RR(idx), qb = DU_QB(idx), kb0 = DU_KB0(idx), ntile = DU_NT(idx);
        const float sS = exp2f(-0.5f * (float)(h + 9)) * LOG2E * (float)STR;
        const int tq = STR * (32 * qb + r32) + rr;
        hf8 qf[4];
        DU_LOADQ(idx, qf);
        const size_t prw = (size_t)bh * SEQ + tq;
        float pm1 = 0.f, pl1 = 0.f, pm2 = 0.f, pl2 = 0.f;
        float cb[16];
#pragma unroll
        for (int r = 0; r < 16; ++r) { const int ko = 16 * (r >> 3) + 8 * hi + (r & 7), dd = r32 - ko;
            const float lg = (MODE == 0) ? (((dd & 15) == 0) ? 1.5849625007211562f : ((dd & 3) == 0) ? 1.0f : 0.0f) : (MODE == 1) ? (((dd & 3) == 0) ? 1.0f : 0.0f) : 0.0f;
            cb[r] = sS * (float)ko + lg; }
        f32x16 o[2];
#pragma unroll
        for (int dt = 0; dt < 2; ++dt)
#pragma unroll
            for (int r = 0; r < 16; ++r) o[dt][r] = 0.f;
        float mrun = 0.f, lrun = 0.f; bool started = false;
        for (int j = 0; j < ntile; ++j) {
            const int kb = kb0 - j;
            hf8 kf[4];
#pragma unroll
            for (int sl = 0; sl < 4; ++sl) kf[sl] = kn[sl];
            asm volatile("" ::: "memory");
            v_stage(vl, vn, lane);
            asm volatile("" ::: "memory");
            if (j + 1 < ntile) DU_LOADKV(idx, kb - 1);
            else if (hn && DU_NT(nidx) > 0) DU_LOADKV(nidx, DU_KB0(nidx));
            hf8 vf[2][2];
#pragma unroll
            for (int dt = 0; dt < 2; ++dt)
#pragma unroll
                for (int s2 = 0; s2 < 2; ++s2) vf[dt][s2] = v_frag(trb, dt, s2);
            asm volatile("" ::: "memory");
            const float tb = sS * (float)(32 * (kb - qb)) - mrun;
            f32x16 s;
#pragma unroll
            for (int r = 0; r < 16; ++r) s[r] = cb[r] + tb;
            if (j == 0 || j == NT - 1) {
                const int dl0 = 32 * (qb - kb) + r32;
#pragma unroll
                for (int r = 0; r < 16; ++r) { const int dl = dl0 - (16 * (r >> 3) + 8 * hi + (r & 7)); if (dl < LO || dl > 128) s[r] = -INFINITY; }
            }
#pragma unroll
            for (int sl = 0; sl < 4; ++sl) s = MFMA32(kf[sl], qf[sl], s);
            const float mx = half_max(rowmax16(s));
            const bool fresh = !started && mx > -INFINITY;
            if (__any(fresh || mx > LAZY_THR)) {
                const float dl = fresh ? mx : fmaxf(mx, 0.f), alpha = ex2(-dl); mrun += dl; lrun *= alpha; started = started || fresh;
#pragma unroll
                for (int r = 0; r < 16; ++r) s[r] -= dl;
#pragma unroll
                for (int dt = 0; dt < 2; ++dt)
#pragma unroll
                    for (int r = 0; r < 16; ++r) o[dt][r] *= alpha; }
            float ls = 0.f;
#pragma unroll
            for (int r = 0; r < 16; ++r) { s[r] = ex2(s[r]); ls += s[r]; }
            lrun += ls;
            v4u p0, p1;
            p0.x = pk2h(s[0], s[1]); p0.y = pk2h(s[2], s[3]); p0.z = pk2h(s[4], s[5]); p0.w = pk2h(s[6], s[7]);
            p1.x = pk2h(s[8], s[9]); p1.y = pk2h(s[10], s[11]); p1.z = pk2h(s[12], s[13]); p1.w = pk2h(s[14], s[15]);
            const hf8 pb0 = __builtin_bit_cast(hf8, p0), pb1 = __builtin_bit_cast(hf8, p1);
#pragma unroll
            for (int dt = 0; dt < 2; ++dt) { o[dt] = MFMA32(vf[dt][0], pb0, o[dt]); o[dt] = MFMA32(vf[dt][1], pb1, o[dt]); }
        }
        if (ntile == 0 && hn && DU_NT(nidx) > 0) DU_LOADKV(nidx, DU_KB0(nidx));
        const float l = half_sum(lrun), mt = (l > 0.f) ? mrun - sS * (float)r32 : -1.0e30f;
        if (MODE != 2) {
            const float il = (l > 0.f) ? 1.0f / l : 0.f;
            h16* po = ((MODE == 0) ? PO1 : PO2) + prw * 64; float* pm = ((MODE == 0) ? PM1 : PM2) + prw * 2;
#pragma unroll
            for (int dt = 0; dt < 2; ++dt)
#pragma unroll
                for (int gp = 0; gp < 2; ++gp) { v2u w[2];
#pragma unroll
                    for (int e = 0; e < 2; ++e) { const int g = 2 * gp + e; w[e].x = pk2h(o[dt][4 * g] * il, o[dt][4 * g + 1] * il); w[e].y = pk2h(o[dt][4 * g + 2] * il, o[dt][4 * g + 3] * il); }
                    const auto sx = __builtin_amdgcn_permlane32_swap(w[0].x, w[1].x, false, false), sy = __builtin_amdgcn_permlane32_swap(w[0].y, w[1].y, false, false);
                    *(v4u*)(po + 32 * dt + 16 * gp + 8 * hi) = (v4u){sx[0], sy[0], sx[1], sy[1]}; }
            if (hi == 0) { pm[0] = mt; pm[1] = l; }
        } else {
            pm1 = PM1[prw * 2]; pl1 = PM1[prw * 2 + 1]; pm2 = PM2[prw * 2]; pl2 = PM2[prw * 2 + 1];
            const float Mx = fmaxf(pm1, fmaxf(pm2, mt));
            const float w1 = pl1 * ex2(pm1 - Mx), w2 = pl2 * ex2(pm2 - Mx), w3 = ex2(mt - Mx), inv = 1.0f / (w1 + w2 + w3 * l);
            const h16* p1 = PO1 + prw * 64; const h16* p2 = PO2 + prw * 64;
            h16* orow = O + (size_t)(b * SEQ + tq) * D + 512 + h * 64;
#pragma unroll
            for (int dt = 0; dt < 2; ++dt)
#pragma unroll
                for (int gp = 0; gp < 2; ++gp) { v2u w[2];
#pragma unroll
                    for (int e2 = 0; e2 < 2; ++e2) { const int g = 2 * gp + e2, d = 32 * dt + 8 * g + 4 * hi; const f32x4 a = ld4h(p1 + d), c = ld4h(p2 + d);
                        float y[4];
#pragma unroll
                        for (int e = 0; e < 4; ++e) y[e] = (w1 * a[e] + w2 * c[e] + w3 * o[dt][4 * g + e]) * inv;
                        w[e2].x = pk2h(y[0], y[1]); w[e2].y = pk2h(y[2], y[3]); }
                    const auto sx = __builtin_amdgcn_permlane32_swap(w[0].x, w[1].x, false, false), sy = __builtin_amdgcn_permlane32_swap(w[0].y, w[1].y, false, false);
                    *(v4u*)(orow + 32 * dt + 16 * gp + 8 * hi) = (v4u){sx[0], sy[0], sx[1], sy[1]}; }
        }
        if (!hn) break;
        idx = nidx;
    }
#undef DU_BH
#undef DU_RR
#undef DU_QB
#undef DU_KB0
#undef DU_NT
#undef DU_LOADQ
#undef DU_LOADKV
}

struct RowLn { f32x4 n[4]; };
__device__ __forceinline__ void ln_rows(f32x4 (&v)[4], const float* lg, const float* lb, int lane) {
    float s = 0.f;
#pragma unroll
    for (int j = 0; j < 4; ++j) s += (v[j][0] + v[j][1]) + (v[j][2] + v[j][3]);
    const float mean = wave_sum(s) * (1.0f / D); float s2 = 0.f;
#pragma unroll
    for (int j = 0; j < 4; ++j) { v[j] = v[j] - mean; s2 += (v[j][0] * v[j][0] + v[j][1] * v[j][1]) + (v[j][2] * v[j][2] + v[j][3] * v[j][3]); }
    const float rstd = 1.0f / sqrtf(wave_sum(s2) * (1.0f / D) + LN_EPS);
#pragma unroll
    for (int j = 0; j < 4; ++j) { const int col = 4 * lane + 256 * j; v[j] = v[j] * rstd * *(const f32x4*)(lg + col) + *(const f32x4*)(lb + col); }
}
struct RowIn { f32x4 x[4]; v2u hx[4]; v2u y[4]; };
template <bool XF32> __device__ __forceinline__ void row_load(RowIn& r, const float* xin, const h16* hin, const h16* y, int lane) {
#pragma unroll
    for (int j = 0; j < 4; ++j) { const int col = 4 * lane + 256 * j; if (XF32) r.x[j] = *(const f32x4*)(xin + col); else r.hx[j] = *(const v2u*)(hin + col); r.y[j] = *(const v2u*)(y + col); }
}
__device__ __forceinline__ f32x4 cvt4(v2u w) { return (f32x4){hlo(w.x), hhi(w.x), hlo(w.y), hhi(w.y)}; }
struct RowVec { f32x4 rdiv[4], psh[4], gate1[4], lg[4], lb[4], sc1[4], sh[4]; };
template <bool XF32> __device__ __forceinline__ void rowvec_load(RowVec& q, const float* psc, const float* psh, const float* gate, const float* lg, const float* lb, const float* sc, const float* sh, int lane) {
#pragma unroll
    for (int j = 0; j < 4; ++j) { const int col = 4 * lane + 256 * j;
        if (!XF32) { const f32x4 d = 1.0f + *(const f32x4*)(psc + col); q.rdiv[j] = (f32x4){__builtin_amdgcn_rcpf(d[0]), __builtin_amdgcn_rcpf(d[1]), __builtin_amdgcn_rcpf(d[2]), __builtin_amdgcn_rcpf(d[3])}; q.psh[j] = *(const f32x4*)(psh + col); }
        q.gate1[j] = 1.0f + *(const f32x4*)(gate + col); q.lg[j] = *(const f32x4*)(lg + col); q.lb[j] = *(const f32x4*)(lb + col);
        q.sc1[j] = 1.0f + *(const f32x4*)(sc + col); q.sh[j] = *(const f32x4*)(sh + col); }
}
__device__ __forceinline__ void ln_rows_v(f32x4 (&v)[4], const RowVec& q) {
    float s = 0.f;
#pragma unroll
    for (int j = 0; j < 4; ++j) s += (v[j][0] + v[j][1]) + (v[j][2] + v[j][3]);
    const float mean = wave_sum(s) * (1.0f / D); float s2 = 0.f;
#pragma unroll
    for (int j = 0; j < 4; ++j) { v[j] = v[j] - mean; s2 += (v[j][0] * v[j][0] + v[j][1] * v[j][1]) + (v[j][2] * v[j][2] + v[j][3] * v[j][3]); }
    const float rstd = 1.0f / sqrtf(wave_sum(s2) * (1.0f / D) + LN_EPS);
#pragma unroll
    for (int j = 0; j < 4; ++j) v[j] = v[j] * rstd * q.lg[j] + q.lb[j];
}
template <bool XF32> __device__ __forceinline__ void row_block(const RowIn& in, const RowVec& q, h16* ho, f32x4 (&hv)[4], int lane, unsigned char* ho8 = nullptr, float* rs8 = nullptr) {
    f32x4 v[4];
#pragma unroll
    for (int j = 0; j < 4; ++j) { f32x4 xv; if (XF32) xv = in.x[j]; else xv = (cvt4(in.hx[j]) - q.psh[j]) * q.rdiv[j];
        v[j] = DN_ALPHA * xv + q.gate1[j] * cvt4(in.y[j]); }
    ln_rows_v(v, q);
#pragma unroll
    for (int j = 0; j < 4; ++j) { const int col = 4 * lane + 256 * j;
        hv[j] = v[j] * q.sc1[j] + q.sh[j];
        v2u o; o.x = pk2h(hv[j][0], hv[j][1]); o.y = pk2h(hv[j][2], hv[j][3]); *(v2u*)(ho + col) = o; }
    if (ho8) { float am = 0.f;
#pragma unroll
        for (int j = 0; j < 4; ++j) am = fmaxf(am, fmaxf(fmaxf(fabsf(hv[j][0]), fabsf(hv[j][1])), fmaxf(fabsf(hv[j][2]), fabsf(hv[j][3]))));
        am = fmaxf(wave_maxd(am), 1e-20f); const float qs = 127.0f / am;
#pragma unroll
        for (int j = 0; j < 4; ++j) *(unsigned*)(ho8 + 4 * lane + 256 * j) = pg8::pk4i8(hv[j][0] * qs, hv[j][1] * qs, hv[j][2] * qs, hv[j][3] * qs);
        if (lane == 0) *rs8 = am * (1.0f / 127.0f); }
}
template <bool XF32> __device__ __forceinline__ void ph_rows(Frame& F, const float* xin, const h16* HIN, const float* psc, const float* psh, const h16* Y, const float* modl_gate  ,
                                        const float* lg, const float* lb, const float* mod_sc, const float* mod_sh, h16* HO, unsigned char* HO8 = nullptr, float* RS8 = nullptr) {
    const int gw = F.vcu * NWAVES + F.wave, WPB = F.G;
    const int b = gw / WPB, r0 = gw % WPB; const size_t bo = (size_t)b * (6 * D);
    RowVec q; rowvec_load<XF32>(q, psc + bo, psh + bo, modl_gate + bo, lg, lb, mod_sc + bo, mod_sh + bo, F.lane);
    for (int t0 = r0; t0 < SEQ; t0 += 4 * WPB) {
        RowIn r[4];
#pragma unroll
        for (int i = 0; i < 4; ++i) { const int t = t0 + i * WPB; if (t < SEQ) { const size_t m = (size_t)b * SEQ + t; row_load<XF32>(r[i], xin + m * D, HIN + m * D, Y + m * D, F.lane); } }
#pragma unroll
        for (int i = 0; i < 4; ++i) { const int t = t0 + i * WPB; if (t < SEQ) { const size_t m = (size_t)b * SEQ + t; f32x4 hv[4];
            row_block<XF32>(r[i], q, HO + m * D, hv, F.lane, HO8 ? HO8 + m * D : nullptr, RS8 + m); } }
    }
}

__device__ __forceinline__ void ph10_ssm_naive(Frame& F) {
    const h16* U = (const h16*)(F.ws + WS_B); h16* GY = (h16*)(F.ws + WS_C);
    const float* SA = (const float*)(F.ws + WS_SSMA); const float* SB = (const float*)(F.ws + WS_SSMB);
    const int gw = F.vcu * NWAVES + F.wave, NGW = F.G * NWAVES, lane = F.lane;
    for (int it = gw; it < BATCH * 64; it += NGW) {
        const int b = it >> 6, g = it & 63, gp = g * 64 + lane;
        const float abr = SA[gp * 2], abi = SA[gp * 2 + 1];
        float bbr[16], bbi[16], cr[16], ci[16];
#pragma unroll
        for (int c = 0; c < 16; ++c) { bbr[c] = SB[(gp * 16 + c) * 2]; bbi[c] = SB[(gp * 16 + c) * 2 + 1]; cr[c] = F.in[I_CRE][(g * 16 + c) * 64 + lane]; ci[c] = F.in[I_CIM][(g * 16 + c) * 64 + lane]; }
        const float dsk = F.in[I_DSKIP][g * 16 + (lane & 15)];
        float hr = 0.f, hi = 0.f;
        for (int t = 0; t < SEQ; ++t) {
            const h16* ur = U + (size_t)(b * SEQ + t) * D + g * 16;
            float u[16]; ld8h(ur, u); ld8h(ur + 8, u + 8);
            float xr = 0.f, xi = 0.f;
#pragma unroll
            for (int c = 0; c < 16; ++c) { xr += bbr[c] * u[c]; xi += bbi[c] * u[c]; }
            const float nhr = abr * hr - abi * hi + xr, nhi = abr * hi + abi * hr + xi; hr = nhr; hi = nhi;
            float mine = 0.f;
#pragma unroll
            for (int c = 0; c < 16; ++c) { const float yc = wave_sum(cr[c] * hr - ci[c] * hi); if (lane == c) mine = yc; }
            if (lane < 16) { const float val = mine + dsk * h2f(ur[lane]); GY[(size_t)(b * SEQ + t) * D + g * 16 + lane] = (h16)(pk2h(gelu_tanh(val), 0.f) & 0xffffu); }
        }
    }
}


__device__ __forceinline__ void ssm_prep(Frame& F) {
    typedef float f32x2v __attribute__((ext_vector_type(2)));
    const float* SA = (const float*)(F.ws + WS_SSMA); const float* SB = (const float*)(F.ws + WS_SSMB);
    LAS f32x2v* PW = (LAS f32x2v*)(F.lds + RING_OFF);
    LAS f32x2v* BB = (LAS f32x2v*)(F.lds + RING_OFF + 16384);
    LAS f32x2v* CC = (LAS f32x2v*)(F.lds + RING_OFF + 32768);
    LAS float* KL = (LAS float*)(F.lds + RING_OFF + 49152);
    const int tid = F.tid;
    LAS int* tsk = (LAS int*)(F.lds + RING_OFF + 65536);
    for (;;) {
        if (tid == 0) *tsk = (int)__hip_atomic_fetch_add(F.ctl + CW_PREP, 1u, RLX_AGENT);
        __syncthreads();
        const int task = *tsk;
        __syncthreads();
        if (task >= 256) break;
        const int g = task >> 2, part = task & 3;
        const float idt = 1.0f / expf(F.in[I_LOGDT][g]);
        if (tid < 64) { float pr = 1.0f, pi = 0.0f; const float ar = SA[(g * 64 + tid) * 2], ai = SA[(g * 64 + tid) * 2 + 1];
            for (int k = 0; k <= 16; ++k) { PW[k * 64 + tid] = (f32x2v){pr, pi}; const float nr = pr * ar - pi * ai, ni = pr * ai + pi * ar; pr = nr; pi = ni; } }
        for (int e = tid; e < 1024; e += NWAVES * 64) { BB[e] = (f32x2v){SB[(g * 1024 + e) * 2] * idt, SB[(g * 1024 + e) * 2 + 1] * idt};
            CC[e] = (f32x2v){F.in[I_CRE][g * 1024 + e], F.in[I_CIM][g * 1024 + e]}; }
        __syncthreads();
        h16* base = (h16*)((unsigned char*)F.out + 100 * MiB) + (size_t)g * 131072;
        if (part == 0) {
            for (int q = tid; q < 64 * 64; q += NWAVES * 64) { const int f = q >> 6, l = q & 63, rt = f >> 4, t = f & 15, r32 = l & 31, hi = l >> 5, p = 16 * rt + (r32 & 15), im = r32 >> 4;
                const f32x2v a = PW[(15 - t) * 64 + p]; hf8 v;
#pragma unroll
                for (int j = 0; j < 8; ++j) { const f32x2v bb = BB[p * 16 + 8 * hi + j]; v[j] = (_Float16)(im ? (a.x * bb.y + a.y * bb.x) : (a.x * bb.x - a.y * bb.y)); }
                *(v4u*)(base + (size_t)q * 8) = __builtin_bit_cast(v4u, v); }
        } else if (part == 1) {
            for (int q = tid; q < 64 * 64; q += NWAVES * 64) { const int f = q >> 6, l = q & 63, rtY = f >> 3, q8 = f & 7, rt = q8 >> 1, sIm = q8 & 1, r32 = l & 31, hi = l >> 5;
                const int t = 2 * rtY + (r32 >> 4), c = r32 & 15; hf8 v;
#pragma unroll
                for (int j = 0; j < 8; ++j) { const int p = 16 * rt + (j & 3) + 8 * (j >> 2) + 4 * hi; const f32x2v a = PW[(t + 1) * 64 + p], cc = CC[c * 64 + p];
                    const float zr = cc.x * a.x - cc.y * a.y, zi = cc.x * a.y + cc.y * a.x; v[j] = (_Float16)(sIm ? -zi : zr); }
                *(v4u*)(base + 32768 + (size_t)q * 8) = __builtin_bit_cast(v4u, v); }
        } else {
            { const int L = tid >> 5, c = (tid >> 1) & 15, c20 = (tid & 1) * 8; float acc8[8];
#pragma unroll
                for (int j = 0; j < 8; ++j) acc8[j] = 0.f;
                for (int p = 0; p < 64; ++p) { const f32x2v a = PW[L * 64 + p], cc = CC[c * 64 + p];
                    const float zr = cc.x * a.x - cc.y * a.y, zi = cc.x * a.y + cc.y * a.x;
#pragma unroll
                    for (int j = 0; j < 8; ++j) { const f32x2v bb = BB[p * 16 + c20 + j]; acc8[j] += zr * bb.x - zi * bb.y; } }
#pragma unroll
                for (int j = 0; j < 8; ++j) KL[L * 256 + c * 16 + c20 + j] = acc8[j]; }
            __syncthreads();
            const int q0 = (part - 2) * 4096;
            for (int q = q0 + tid; q < q0 + 4096; q += NWAVES * 64) { const int f = q >> 6, l = q & 63, rtY = f >> 4, s = f & 15, r32 = l & 31, hi = l >> 5;
                const int t = 2 * rtY + (r32 >> 4), c = r32 & 15, L = t - s; hf8 v;
#pragma unroll
                for (int j = 0; j < 8; ++j) v[j] = (_Float16)((L >= 0) ? KL[(L & 15) * 256 + c * 16 + 8 * hi + j] : 0.f);
                *(v4u*)(base + 65536 + (size_t)q * 8) = __builtin_bit_cast(v4u, v); }
        }
        __syncthreads();
    }
}
__device__ __forceinline__ void ph10_ssm_mfma(Frame& F) {
    const h16* U = (const h16*)(F.ws + WS_B); h16* GY = (h16*)(F.ws + WS_C);
    const float* SA = (const float*)(F.ws + WS_SSMA);
    typedef float f32x2v __attribute__((ext_vector_type(2)));
    LAS f32x2v* SL = (LAS f32x2v*)(F.lds + RING_OFF);
    LAS unsigned char* OPL = F.lds + RING_OFF;
    int tid_ = F.tid; asm volatile("" : "+v"(tid_));
    const int tid = tid_, lane = tid & 63, r32 = lane & 31, hi = lane >> 5, wave = F.wave;
    for (int unit = blockIdx.x; unit < BATCH * 64; unit += F.G) {
        const int b = unit >> 6, g = unit & 63;
        const float dt = expf(F.in[I_LOGDT][g]);
        const h16* MW1 = (const h16*)((const unsigned char*)F.out + 100 * MiB) + (size_t)g * 131072; const h16* MG = MW1 + 32768; const h16* MT = MW1 + 65536;
        const int ch = 32 * wave + r32;
        const h16* urow = U + (size_t)(b * SEQ + 16 * ch) * D + g * 16;
        { v4u w1[8];
#pragma unroll
            for (int i = 0; i < 8; ++i) w1[i] = *(const v4u*)(MW1 + (size_t)(i * 512 + tid) * 8);
#pragma unroll
            for (int i = 0; i < 8; ++i) *(LAS v4u*)(OPL + (size_t)(i * 512 + tid) * 16) = w1[i]; }
        __builtin_amdgcn_sched_barrier(0);
        hf8 ub[16];
#pragma unroll
        for (int t = 0; t < 16; ++t) ub[t] = ldf8(urow + (size_t)t * D + 8 * hi);
        __syncthreads();
        f32x16 acc[4];
#pragma unroll
        for (int rt = 0; rt < 4; ++rt)
#pragma unroll
            for (int r = 0; r < 16; ++r) acc[rt][r] = 0.f;
#pragma unroll
        for (int t = 0; t < 16; ++t)
        {
#pragma unroll
            for (int rt = 0; rt < 4; ++rt) acc[rt] = MFMA32(__builtin_bit_cast(hf8, *(const LAS v4u*)(OPL + (rt * 16 + t) * 1024 + lane * 16)), ub[t], acc[rt]);
            if ((t & 3) == 3) __builtin_amdgcn_sched_barrier(0); }
        __syncthreads();
#pragma unroll
        for (int rt = 0; rt < 4; ++rt)
#pragma unroll
            for (int r = 0; r < 8; ++r) { const int p = 16 * rt + (r & 3) + 8 * (r >> 2) + 4 * hi; SL[p * 257 + ch] = (f32x2v){acc[rt][r], acc[rt][r + 8]}; }
        __syncthreads();
        {
            const int p = tid & 63, sg = tid >> 6;
            float pr = SA[(g * 64 + p) * 2], pi = SA[(g * 64 + p) * 2 + 1];
#pragma unroll
            for (int q = 0; q < 4; ++q) { const float nr = pr * pr - pi * pi, ni = 2.0f * pr * pi; pr = nr; pi = ni; }
            const float aLr = pr, aLi = pi;
            float xr = 0.f, xi = 0.f;
            for (int j0 = 0; j0 < 32; j0 += 8) { f32x2v sv[8];
#pragma unroll
                for (int j = 0; j < 8; ++j) sv[j] = SL[p * 257 + 32 * sg + j0 + j];
#pragma unroll
                for (int j = 0; j < 8; ++j) { const float nr = aLr * xr - aLi * xi + sv[j].x, ni = aLr * xi + aLi * xr + sv[j].y; xr = nr; xi = ni; sv[j] = (f32x2v){xr, xi}; }
#pragma unroll
                for (int j = 0; j < 8; ++j) SL[p * 257 + 32 * sg + j0 + j] = sv[j]; }
#pragma unroll
            for (int q = 0; q < 5; ++q) { const float nr = pr * pr - pi * pi, ni = 2.0f * pr * pi; pr = nr; pi = ni; }
            __syncthreads();
            float cr = 0.f, ci = 0.f;
            for (int s2 = 0; s2 < sg; ++s2) { const int c2 = 32 * s2 + 31; const f32x2v ag = SL[p * 257 + c2];
                const float nr = pr * cr - pi * ci + ag.x, ni = pr * ci + pi * cr + ag.y; cr = nr; ci = ni; }
            __syncthreads();
            float prevr = 0.f, previ = 0.f, wr = 1.0f, wi = 0.0f;
            for (int j0 = 0; j0 < 32; j0 += 8) { f32x2v xv[8];
#pragma unroll
                for (int j = 0; j < 8; ++j) xv[j] = SL[p * 257 + 32 * sg + j0 + j];
#pragma unroll
                for (int j = 0; j < 8; ++j) { const f32x2v in = (f32x2v){prevr + wr * cr - wi * ci, previ + wr * ci + wi * cr};
                    prevr = xv[j].x; previ = xv[j].y; xv[j] = in; const float nr = wr * aLr - wi * aLi, ni = wr * aLi + wi * aLr; wr = nr; wi = ni; }
#pragma unroll
                for (int j = 0; j < 8; ++j) SL[p * 257 + 32 * sg + j0 + j] = xv[j]; }
        }
        __syncthreads();
        v4u ifw[8];
#pragma unroll
        for (int rt = 0; rt < 4; ++rt) { float re[8], im[8];
#pragma unroll
            for (int j = 0; j < 8; ++j) { const int p = 16 * rt + (j & 3) + 8 * (j >> 2) + 4 * hi; const f32x2v v = SL[p * 257 + ch]; re[j] = v.x; im[j] = v.y; }
            v4u w0, w1; w0.x = pk2h(re[0], re[1]); w0.y = pk2h(re[2], re[3]); w0.z = pk2h(re[4], re[5]); w0.w = pk2h(re[6], re[7]);
            w1.x = pk2h(im[0], im[1]); w1.y = pk2h(im[2], im[3]); w1.z = pk2h(im[4], im[5]); w1.w = pk2h(im[6], im[7]);
            ifw[2 * rt] = w0; ifw[2 * rt + 1] = w1; }
        LAS v4u* IFL = (LAS v4u*)(OPL + 49152 + wave * 8192);
        const f32x4 dk0 = *(const f32x4*)(F.in[I_DSKIP] + g * 16 + 4 * hi), dk1 = *(const f32x4*)(F.in[I_DSKIP] + g * 16 + 8 + 4 * hi);
        unsigned char* yrow = (unsigned char*)GY + (size_t)(b * SEQ + 16 * ch) * D + g * 16;
        v4u pg, pt0, pt1;
        pg = *(const v4u*)(MG + (size_t)tid * 8); pt0 = *(const v4u*)(MT + (size_t)tid * 8); pt1 = pt0;
        __syncthreads();
#pragma unroll
        for (int q = 0; q < 8; ++q) IFL[q * 64 + lane] = ifw[q];
        *(LAS v4u*)(OPL + tid * 16) = pg; if (tid < 128) *(LAS v4u*)(OPL + 8192 + tid * 16) = pt0;
        __syncthreads();
#pragma unroll
        for (int rtY = 0; rtY < 8; ++rtY) {
            LAS unsigned char* cur = OPL + (rtY & 1) * 24576;
            if (rtY < 7) { const int nT = (2 * (rtY + 1) + 2) * 64;
                pg = *(const v4u*)(MG + (size_t)((rtY + 1) * 8 * 64 + tid) * 8);
                if (tid < nT) pt0 = *(const v4u*)(MT + (size_t)((rtY + 1) * 16 * 64 + tid) * 8);
                if (tid + 512 < nT) pt1 = *(const v4u*)(MT + (size_t)((rtY + 1) * 16 * 64 + tid + 512) * 8); }
            f32x16 y0, y1;
#pragma unroll
            for (int r = 0; r < 16; ++r) { y0[r] = 0.f; y1[r] = 0.f; }
#pragma unroll
            for (int q = 0; q < 8; ++q) { const hf8 af = __builtin_bit_cast(hf8, *(const LAS v4u*)(cur + q * 1024 + lane * 16)); const hf8 bf = __builtin_bit_cast(hf8, IFL[q * 64 + lane]); if (q & 1) y1 = MFMA32(af, bf, y1); else y0 = MFMA32(af, bf, y0); }
#pragma unroll
            for (int s2 = 0; s2 <= 2 * rtY + 1; ++s2) { const hf8 af = __builtin_bit_cast(hf8, *(const LAS v4u*)(cur + 8192 + s2 * 1024 + lane * 16)); if (s2 & 1) y1 = MFMA32(af, ub[s2], y1); else y0 = MFMA32(af, ub[s2], y0); }
#pragma unroll
            for (int tt = 0; tt < 2; ++tt) { const size_t ro = (size_t)(2 * rtY + tt) * D;
                const v4u uw = __builtin_bit_cast(v4u, ub[2 * rtY + tt]);
                const auto sw0 = __builtin_amdgcn_permlane32_swap(uw.x, uw.z, false, false), sw1 = __builtin_amdgcn_permlane32_swap(uw.y, uw.w, false, false);
                const f32x4 u0 = {hlo(sw0[0]), hhi(sw0[0]), hlo(sw1[0]), hhi(sw1[0])}, u1 = {hlo(sw0[1]), hhi(sw0[1]), hlo(sw1[1]), hhi(sw1[1])};
                float yv[8];
#pragma unroll
                for (int e = 0; e < 8; ++e) yv[e] = (y0[8 * tt + e] + y1[8 * tt + e]) * dt;
                const unsigned w0 = pg8::pk4f8(S8_GY * gelu_tanh(yv[0] + dk0[0] * u0[0]), S8_GY * gelu_tanh(yv[1] + dk0[1] * u0[1]), S8_GY * gelu_tanh(yv[2] + dk0[2] * u0[2]), S8_GY * gelu_tanh(yv[3] + dk0[3] * u0[3]));
                const unsigned w1 = pg8::pk4f8(S8_GY * gelu_tanh(yv[4] + dk1[0] * u1[0]), S8_GY * gelu_tanh(yv[5] + dk1[1] * u1[1]), S8_GY * gelu_tanh(yv[6] + dk1[2] * u1[2]), S8_GY * gelu_tanh(yv[7] + dk1[3] * u1[3]));
                const auto sx = __builtin_amdgcn_permlane32_swap(w0, w1, false, false);
                *(v2u*)(yrow + ro + 8 * hi) = (v2u){sx[0], sx[1]}; }
            if (rtY < 7) { const int nT = (2 * (rtY + 1) + 2) * 64; LAS unsigned char* nxt = OPL + ((rtY + 1) & 1) * 24576;
                *(LAS v4u*)(nxt + tid * 16) = pg;
                if (tid < nT) *(LAS v4u*)(nxt + 8192 + tid * 16) = pt0;
                if (tid + 512 < nT) *(LAS v4u*)(nxt + 8192 + (tid + 512) * 16) = pt1; }
            __syncthreads();
        }
    }
}

__device__ __forceinline__ void ph12_rows_route(Frame& F) {
    const int gw = F.vcu * NWAVES + F.wave, NGW = F.G * NWAVES, lane = F.lane;
    const float* mod1 = (const float*)(F.ws + WS_MOD) + (size_t)BATCH * 6 * D;
    const h16* Y3 = (const h16*)(F.ws + WS_A); h16* H16 = (h16*)(F.ws + WS_VT1);
    int* tok_e = (int*)(F.ws + WS_TOKE); float* tok_g = (float*)(F.ws + WS_TOKG);
    LAS unsigned* lcnt = (LAS unsigned*)(F.lds + 1024);
    if (F.tid < 8) lcnt[F.tid] = 0u;
    __syncthreads();
    LAS f32x4* RWL = (LAS f32x4*)(F.lds + 4096);
    for (int e = F.tid; e < 2048; e += NWAVES * 64) { const int jih = e >> 6, l = e & 63, j = jih >> 3, i = (jih >> 1) & 3, hf = jih & 1;
        RWL[e] = *(const f32x4*)(F.in[I_RW] + (size_t)(4 * l + 256 * j + i) * 8 + 4 * hf); }
    __syncthreads();
    const f32x4 rb0 = *(const f32x4*)(F.in[I_RB]), rb1 = *(const f32x4*)(F.in[I_RB] + 4);
    const h16* UPREV = (const h16*)(F.ws + WS_B);
    const int WPB = F.G, bq = gw / WPB, r0 = gw % WPB; const size_t bo = (size_t)bq * (6 * D);
    RowVec q; rowvec_load<false>(q, mod1 + bo + 1 * D, mod1 + bo, mod1 + bo + 2 * D, F.in[I_LN1G1], F.in[I_LN1B1], mod1 + bo + 4 * D, mod1 + bo + 3 * D, lane);
    for (int t0 = r0; t0 < SEQ; t0 += WPB) {
        { const int m = bq * SEQ + t0;
        RowIn rr1; row_load<false>(rr1, nullptr, UPREV + (size_t)m * D, Y3 + (size_t)m * D, lane);
        f32x4 hv[4];
        row_block<false>(rr1, q, H16 + (size_t)m * D, hv, lane);
        f32x4 a0 = {0.f, 0.f, 0.f, 0.f}, a1 = a0;
#pragma unroll
        for (int j = 0; j < 4; ++j)
#pragma unroll
            for (int i = 0; i < 4; ++i) { a0 += hv[j][i] * RWL[((j * 4 + i) * 2 + 0) * 64 + lane]; a1 += hv[j][i] * RWL[((j * 4 + i) * 2 + 1) * 64 + lane]; }
        float lg[8];
#pragma unroll
        for (int e = 0; e < 4; ++e) { lg[e] = wave_sum(a0[e]) + rb0[e]; lg[4 + e] = wave_sum(a1[e]) + rb1[e]; }
        int e1 = 0; float v1 = lg[0];
#pragma unroll
        for (int e = 1; e < 8; ++e) if (lg[e] > v1) { v1 = lg[e]; e1 = e; }
        int e2 = -1; float v2 = -INFINITY;
#pragma unroll
        for (int e = 0; e < 8; ++e) if (e != e1 && lg[e] > v2) { v2 = lg[e]; e2 = e; }
        const float g1 = 1.0f / (1.0f + expf(v2 - v1)), g2 = 1.0f - g1;
        if (lane == 0) { tok_e[2 * m] = e1; tok_e[2 * m + 1] = e2; tok_g[2 * m] = g1; tok_g[2 * m + 1] = g2;
            __hip_atomic_fetch_add(lcnt + e1, 1u, __ATOMIC_RELAXED, __HIP_MEMORY_SCOPE_WORKGROUP); __hip_atomic_fetch_add(lcnt + e2, 1u, __ATOMIC_RELAXED, __HIP_MEMORY_SCOPE_WORKGROUP); }
        }
    }
    __syncthreads();
    if (F.tid < 8) __hip_atomic_fetch_add(F.ctl + CW_ECNT + F.tid, lcnt[F.tid], RLX_AGENT);
}
__device__ __forceinline__ void moe_prefix(Frame& F, int (&tp)[9]) {
    int acc = 0;
#pragma unroll
    for (int e = 0; e < 8; ++e) { tp[e] = acc; const unsigned c = __hip_atomic_load(F.ctl + CW_ECNT + e, RLX_AGENT); acc += (int)((c + 255u) >> 8); }
    tp[8] = acc;
}
__device__ __forceinline__ unsigned f8of4h(unsigned w0, unsigned w1) { return pg8::pk4f8(hlo(w0) * S8_H, hhi(w0) * S8_H, hlo(w1) * S8_H, hhi(w1) * S8_H); }
__device__ __forceinline__ void ph13_gather(Frame& F) {
    const int gw = F.vcu * NWAVES + F.wave, NGW = F.G * NWAVES, lane = F.lane;
    int tp[9]; moe_prefix(F, tp);
    const int* tok_e = (const int*)(F.ws + WS_TOKE); int* tok_p = (int*)(F.ws + WS_TOKP);
    const h16* H16 = (const h16*)(F.ws + WS_VT1); unsigned char* HG = F.ws + WS_B;
    for (int base = gw * 16; base < M; base += NGW * 16) {
        const bool own = lane < 16; const int m = base + (lane & 15);
        const int ea = own ? tok_e[2 * m] : -1, eb = own ? tok_e[2 * m + 1] : -1;
        const unsigned long long below = (lane == 0) ? 0ull : (~0ull >> (64 - lane));
        int ra = 0, rb = 0, mycnt = 0;
#pragma unroll
        for (int e = 0; e < 8; ++e) {
            const unsigned long long ma = __ballot(ea == e), mb = __ballot(eb == e);
            const int ca = __popcll(ma), cb = __popcll(mb);
            if (lane == e) mycnt = ca + cb;
            if (ea == e) ra = __popcll(ma & below);
            if (eb == e) rb = ca + __popcll(mb & below);
        }
        unsigned basee = 0u;
        if (lane < 8 && mycnt > 0) basee = __hip_atomic_fetch_add(F.ctl + CW_ECUR + lane, (unsigned)mycnt, RLX_AGENT);
        int tpl = 0;
#pragma unroll
        for (int e = 0; e < 8; ++e) if (lane == e) tpl = tp[e];
        const int segbase = tpl * 256 + (int)basee;
        const int pa = __shfl(segbase, ea & 7) + ra, pb = __shfl(segbase, eb & 7) + rb;
        if (own) { tok_p[2 * m] = pa; tok_p[2 * m + 1] = pb; }
#pragma unroll
        for (int t4 = 0; t4 < 16; t4 += 8) {
            v4u v0[8], v1[8]; int p1[8], p2[8];
#pragma unroll
            for (int i = 0; i < 8; ++i) { const h16* src = H16 + (size_t)(base + t4 + i) * D + 16 * lane; v0[i] = *(const v4u*)src; v1[i] = *(const v4u*)(src + 8);
                p1[i] = __shfl(pa, t4 + i); p2[i] = __shfl(pb, t4 + i); }
#pragma unroll
            for (int i = 0; i < 8; ++i) {
                v4u o; o.x = f8of4h(v0[i].x, v0[i].y); o.y = f8of4h(v0[i].z, v0[i].w); o.z = f8of4h(v1[i].x, v1[i].y); o.w = f8of4h(v1[i].z, v1[i].w);
                *(v4u*)(HG + (size_t)p1[i] * D + 16 * lane) = o; *(v4u*)(HG + (size_t)p2[i] * D + 16 * lane) = o; }
        }
    }
}
__device__ __forceinline__ void ph16_final(Frame& F) {
    const int gw = F.vcu * NWAVES + F.wave, NGW = F.G * NWAVES, lane = F.lane;
    const float* mod1 = (const float*)(F.ws + WS_MOD) + (size_t)BATCH * 6 * D;
    const int* tok_p = (const int*)(F.ws + WS_TOKP); const float* tok_g = (const float*)(F.ws + WS_TOKG);
    const h16* YG = (const h16*)(F.ws + WS_B);
    const h16* H16 = (const h16*)(F.ws + WS_VT1);
    struct Row16 { v2u x[4]; v2u a[4], c[4]; float w1, w2; };
    auto load16 = [&](Row16& r, int m) {
        const int p1 = tok_p[2 * m], p2 = tok_p[2 * m + 1]; r.w1 = tok_g[2 * m]; r.w2 = tok_g[2 * m + 1];
#pragma unroll
        for (int j = 0; j < 4; ++j) { const int col = 4 * lane + 256 * j; r.x[j] = *(const v2u*)(H16 + (size_t)m * D + col);
            r.a[j] = *(const v2u*)(YG + (size_t)p1 * D + col); r.c[j] = *(const v2u*)(YG + (size_t)p2 * D + col); } };
    const int WPB = F.G, bq = gw / WPB, r0 = gw % WPB; const size_t bo = (size_t)bq * (6 * D);
    RowVec q; rowvec_load<false>(q, mod1 + bo + 4 * D, mod1 + bo + 3 * D, mod1 + bo + 5 * D, F.in[I_LN2G1], F.in[I_LN2B1], mod1 + bo, mod1 + bo, lane);
    for (int t0 = r0; t0 < SEQ; t0 += 4 * WPB) {
        Row16 rw4[4];
#pragma unroll
        for (int i = 0; i < 4; ++i) { const int t = t0 + i * WPB; if (t < SEQ) load16(rw4[i], bq * SEQ + t); }
#pragma unroll
        for (int i = 0; i < 4; ++i) { const int t = t0 + i * WPB; if (t >= SEQ) continue; const int m = bq * SEQ + t; const Row16& cur = rw4[i];
        f32x4 v[4];
#pragma unroll
        for (int j = 0; j < 4; ++j) {
            const f32x4 ya = {hlo(cur.a[j].x), hhi(cur.a[j].x), hlo(cur.a[j].y), hhi(cur.a[j].y)}, yc = {hlo(cur.c[j].x), hhi(cur.c[j].x), hlo(cur.c[j].y), hhi(cur.c[j].y)};
            const f32x4 x3 = (cvt4(cur.x[j]) - q.psh[j]) * q.rdiv[j];
            v[j] = DN_ALPHA * x3 + q.gate1[j] * (cur.w1 * ya + cur.w2 * yc); }
        ln_rows_v(v, q);
#pragma unroll
        for (int j = 0; j < 4; ++j) *(f32x4*)(F.out + (size_t)m * D + 4 * lane + 256 * j) = v[j];
        }
    }
}

struct Args { const float* in[39]; float* out; unsigned char* ws; int ph_lo, ph_hi; };
__global__ void __launch_bounds__(NWAVES * 64, 2) mk_fwd(Args args) {
    extern __shared__ __attribute__((aligned(16))) unsigned char lds[];
    Frame F;
    F.lds = (LAS unsigned char*)lds;
    F.MISC = (volatile LAS unsigned*)(F.lds + MISC_OFF);
    F.tid = threadIdx.x; F.lane = F.tid & 63; F.wave = __builtin_amdgcn_readfirstlane(F.tid >> 6);
    F.G = gridDim.x; { const int bx = blockIdx.x; F.vcu = (F.G % 8 == 0) ? (bx % 8) * (F.G / 8) + bx / 8 : bx; }
    F.ws = args.ws; F.out = args.out; F.ctl = (gu32*)(args.ws + WS_CTL);
#pragma unroll
    for (int i = 0; i < 39; ++i) F.in[i] = args.in[i];
    for (int u = F.tid; u < (LDS_BYTES - LDSCTL_OFF) / 4; u += NWAVES * 64) ((LAS unsigned*)(F.lds + LDSCTL_OFF))[u] = 0u;
    __syncthreads();
    XcdBarrier bar; bar.bar = (unsigned*)(F.ctl + CW_BAR); bar.x = 0; bar.st = nullptr;
    if (N_LAUNCHES == 1) bar = xcd_barrier_post((unsigned*)(F.ctl + CW_BAR), F.MISC + 8);
    const int lo = args.ph_lo, hi = args.ph_hi;
    unsigned char* ws = args.ws;
    const float* mod0 = (const float*)(ws + WS_MOD); const float* mod1 = mod0 + (size_t)BATCH * 6 * D;
#ifndef PH_MASK
#define PH_MASK 0x1ffff
#endif
#define IN(k) (((PH_MASK >> (k)) & 1) && lo <= (k) && (k) < hi)
#define SEAM(k) do { if (N_LAUNCHES == 1 && IN(k) && IN((k) + 1)) xcd_barrier(bar); } while (0)

    if (IN(0)) { ph0_mods(F); SEAM(0); }
    if (IN(1)) { ph1_prologue(F); SEAM(1); }
    if (IN(2)) {
        pg8::Gemm g{(const h16*)(ws + WS_B), (const h16*)(ws + WS_W_IN), M, 3 * D, D}; pg8::StaticOrder S; S.init(M, 3 * D, F.G, (int)blockIdx.x);
        pg8::EpiQKV E{(h16*)(ws + WS_A), (h16*)(ws + WS_KA), (h16*)(ws + WS_KB1), (h16*)(ws + WS_KB4), (h16*)(ws + WS_KB16), (unsigned*)(F.ctl + CW_KMAX), QSCALE_A, QSCALE_B};
        pg8::gemm_phase<pg8::EpiQKV, pg8::StaticOrder, true, true>(F.lds + RING_OFF, g, S, E);
        SEAM(2);
    }
    if (IN(4)) { ph4_diff_mfma(F); dil_pass<0>(F); dil_pass<1>(F);
        __syncthreads(); ssm_prep(F);
        xcd_barrier(bar); dil_pass<2>(F); SEAM(4); }
    if (IN(5)) {
        pg8::Gemm g{(const h16*)(ws + WS_B), (const h16*)(ws + WS_W_OUT), M, D, D}; pg8::StaticOrder S; S.init(M, D, F.G, (int)blockIdx.x);
        pg8::EpiF16 E{(h16*)(ws + WS_C), D, 4, 0.f, 0.f};
        pg8::gemm_phase<pg8::EpiF16, pg8::StaticOrder, true, true>(F.lds + RING_OFF, g, S, E);
        SEAM(5);
    }
    if (IN(6)) {
        ph_rows<true>(F, F.in[I_X], (const h16*)(ws + WS_B), mod0, mod0, (const h16*)(ws + WS_C), mod0 + 2 * D, F.in[I_LN1G0], F.in[I_LN1B0], mod0 + 4 * D, mod0 + 3 * D, (h16*)(ws + WS_B), ws + WS_VT1, (float*)(ws + WS_RS2));
        SEAM(6);
    }
    if (IN(7)) {
        pg8::Gemm g{(const h16*)(ws + WS_VT1), (const h16*)(ws + WS_W_F1), M, 2 * DFF, D / 2}; pg8::StaticOrder S; S.init(M, 2 * DFF, F.G, (int)blockIdx.x);
        const float* wsc = (const float*)(ws + WS_WSC) + 32;
        pg8::EpiGated8<0, false> E{ws + WS_A, DFF, 22, nullptr, 1.0f, S8_HID, (const float*)(ws + WS_RS2), wsc + 6, wsc + 7};
        pg8::gemm_phase<pg8::EpiGated8<0, false>, pg8::StaticOrder, true, true, 2>(F.lds + RING_OFF, g, S, E);
        SEAM(7);
    }
    if (IN(8)) {
        pg8::Gemm g{(const h16*)(ws + WS_A), (const h16*)(ws + WS_W_F2), M, D, DFF / 2}; pg8::StaticOrder S; S.init(M, D, F.G, (int)blockIdx.x);
        pg8::EpiF16S E{(h16*)(ws + WS_C), D, 4, 1.0f / (S8_HID * S8_WF2)};
        pg8::gemm_phase<pg8::EpiF16S, pg8::StaticOrder, true, true, true>(F.lds + RING_OFF, g, S, E);
        SEAM(8);
    }
    if (IN(9)) {
        ph_rows<false>(F, nullptr, (const h16*)(ws + WS_B), mod0 + 4 * D, mod0 + 3 * D, (const h16*)(ws + WS_C), mod0 + 5 * D, F.in[I_LN2G0], F.in[I_LN2B0], mod1 + 1 * D, mod1 + 0 * D, (h16*)(ws + WS_B));
        SEAM(9);
    }
    if (IN(10)) { ph10_ssm_mfma(F); SEAM(10); }
    if (IN(11)) {
        pg8::Gemm g{(const h16*)(ws + WS_C), (const h16*)(ws + WS_W_GLU), M, 2 * D, D / 2}; pg8::StaticOrder S; S.init(M, 2 * D, F.G, (int)blockIdx.x);
        pg8::EpiGated<1> E{(h16*)(ws + WS_A), D, 8, F.in[I_BGLU], 1.0f / (S8_GY * S8_WGLU)};
        pg8::gemm_phase<pg8::EpiGated<1>, pg8::StaticOrder, true, true, true>(F.lds + RING_OFF, g, S, E);
        SEAM(11);
    }
    if (IN(12)) { ph12_rows_route(F); SEAM(12); }
    if (IN(13)) { ph13_gather(F); SEAM(13); }
    if (IN(14)) {
        pg8::MoeOrder S; moe_prefix(F, S.tp); S.nN = 11; S.G = F.G; S.c = (int)blockIdx.x;
        pg8::Gemm g{(const h16*)(ws + WS_B), (const h16*)(ws + WS_W_E1), 0, 2 * DFE, D / 2};
        pg8::EpiGated8<0, true> E{ws + WS_A, DFE_PAD, 11, nullptr, 1.0f / (S8_H * S8_WE1), S8_HID};
        pg8::gemm_phase<pg8::EpiGated8<0, true>, pg8::MoeOrder, true, true, true>(F.lds + RING_OFF, g, S, E);
        SEAM(14);
    }
    if (IN(15)) {
        pg8::MoeOrder S; moe_prefix(F, S.tp); S.nN = 4; S.G = F.G; S.c = (int)blockIdx.x;
        pg8::Gemm g{(const h16*)(ws + WS_A), (const h16*)(ws + WS_W_E2), 0, D, DFE_PAD / 2};
        pg8::EpiF16S E{(h16*)(ws + WS_B), D, 4, 1.0f / (S8_HID * S8_WE2)};
        pg8::gemm_phase<pg8::EpiF16S, pg8::MoeOrder, true, true, true>(F.lds + RING_OFF, g, S, E);
        SEAM(15);
    }
    if (IN(16)) { ph16_final(F); }
#undef IN
#undef SEAM
}

extern "C" void kernel_launch(void* const* d_in, const int* in_sizes, int n_in, void* d_out, int out_size, void* d_ws, size_t ws_size, hipStream_t stream) {
    static int grid = 0;
    if (grid == 0) {
        if (n_in != 39 || in_sizes[0] != M * D || out_size != M * D || ws_size < WS_END) { fprintf(stderr, "kernel_launch: unexpected problem shape (n_in %d, in0 %d, out %d, ws %zu)\n", n_in, n_in > 0 ? in_sizes[0] : -1, out_size, ws_size); grid = -1; return; }
        int dev = 0, cus = 0, per_cu = 0;
        if (hipGetDevice(&dev) != hipSuccess || hipDeviceGetAttribute(&cus, hipDeviceAttributeMultiprocessorCount, dev) != hipSuccess) { grid = -1; return; }
        if (hipFuncSetAttribute((const void*)mk_fwd, hipFuncAttributeMaxDynamicSharedMemorySize, LDS_BYTES) != hipSuccess) { fprintf(stderr, "kernel_launch: hipFuncSetAttribute failed\n"); grid = -1; return; }
        if (hipOccupancyMaxActiveBlocksPerMultiprocessor(&per_cu, (const void*)mk_fwd, NWAVES * 64, LDS_BYTES) != hipSuccess || per_cu < 1) { fprintf(stderr, "kernel_launch: occupancy query says %d\n", per_cu); }
        (void)hipGetLastError();
        grid = cus;
    }
    if (grid < 0) return;
    if (hipMemsetAsync((char*)d_ws + WS_CTL, 0, CTL_ZERO_BYTES, stream) != hipSuccess) return;
    Args a{};
    for (int i = 0; i < 39; ++i) a.in[i] = (const float*)d_in[i];
    a.out = (float*)d_out; a.ws = (unsigned char*)d_ws;
    for (int li = 0; li < N_LAUNCHES; ++li) {
        a.ph_lo = (N_LAUNCHES == 1) ? 0 : li; a.ph_hi = (N_LAUNCHES == 1) ? NPH : li + 1;
        hipLaunchKernelGGL(mk_fwd, dim3(grid), dim3(NWAVES * 64), LDS_BYTES, stream, a);
        if (hipPeekAtLastError() != hipSuccess) { fprintf(stderr, "kernel_launch: launch %d failed\n", li); break; }
    }
}
```

```cpp
#include <hip/hip_runtime.h>
#include <cstdio>
#include <cstdint>

#ifndef NR_6
#define NR_6 6
#endif
#ifndef NR_12
#define NR_12 2
#endif
#ifndef WGM_2
#define WGM_2 4
#endif
#ifndef WGM_5
#define WGM_5 4
#endif
#ifndef WGM_7
#define WGM_7 2
#endif
#ifndef WGM_8
#define WGM_8 8
#endif
#ifndef WGM_11
#define WGM_11 8
#endif
#ifndef WGM_14
#define WGM_14 2
#endif
#ifndef WGM_15
#define WGM_15 8
#endif
#ifndef MK_N_LAUNCHES
#define MK_N_LAUNCHES 1
#endif

namespace pg8 {
#define PG8_LAS __attribute__((address_space(3)))
typedef unsigned short h16_t;
typedef _Float16 f16x8 __attribute__((ext_vector_type(8)));
typedef _Float16 f16x2 __attribute__((ext_vector_type(2)));
typedef float f32x4 __attribute__((ext_vector_type(4)));
typedef float f32x16 __attribute__((ext_vector_type(16)));
typedef unsigned u32x4 __attribute__((ext_vector_type(4)));
constexpr int BM = 256, BK = 64, HALF = 128, HTB = HALF * BK * 2  , STAGE_BYTES = 8 * HTB, NXCD = 8, WGM = 8;

__host__ __device__ __forceinline__ int lds_byte(int r, int c) { const int st = (r >> 4) * 2 + (c >> 5), rr = r & 15, cc = c & 31, ob = rr * 64 + cc * 2; return st * 1024 + (ob ^ (((ob >> 9) & 1) << 5)); }
__host__ __device__ __forceinline__ void stage_rc(int b, int& R, int& C) { const int st = b / 1024, sb = b % 1024, swz = sb ^ (((sb >> 9) & 1) << 5); R = (st >> 1) * 16 + swz / 64; C = (st & 1) * 32 + (swz % 64) / 2; }
__host__ __device__ __forceinline__ int perm32(int rho) { const int n = rho >> 4, i = rho & 15; return 8 * (i >> 2) + 4 * n + (i & 3); }

struct Unit { int pm, pn, aoff; };
struct Gemm { const h16_t* A; const h16_t* Bt; int M, N, K; const int* arows = nullptr; unsigned amax = 0x7fffffffu; };

struct StaticOrder {
    int nM, nN, nwg, G, c, wgm;
    __host__ __device__ void init(int M, int N, int G_, int c_, int wgm_ = WGM) { nM = M / BM; nN = N / BM; nwg = nM * nN; G = G_; c = c_; wgm = wgm_; }
    __host__ __device__ bool next(int i, Unit& u) const {
        const long L = (long)i * G + c; if (L >= nwg) return false;
        int wgid = (int)L; { const int q = nwg / NXCD, r = nwg % NXCD, xcd = wgid % NXCD, off = wgid / NXCD; wgid = (xcd < r ? xcd * (q + 1) : r * (q + 1) + (xcd - r) * q) + off; }
        const int nig = wgm * nN, gid = wgid / nig, fm = gid * wgm, gsz = (nM - fm) < wgm ? (nM - fm) : wgm;
        u.pm = fm + ((wgid % nig) % gsz); u.pn = (wgid % nig) / gsz; u.aoff = 0; return true;
    }
    __device__ __forceinline__ void a_ready(const Unit&) const {}
    __device__ __forceinline__ void done(const Unit&) const {}
};
struct MoeOrder {
    int tp[9]; int nN, G, c, wgm = WGM, cap = 0;
    __device__ bool next(int i, Unit& u) const {
        const long L = (long)i * G + c; const int nM = tp[8], nwg = nM * nN; if (L >= nwg) return false;
        int wgid = (int)L; { const int q = nwg / NXCD, r = nwg % NXCD, xcd = wgid % NXCD, off = wgid / NXCD; wgid = (xcd < r ? xcd * (q + 1) : r * (q + 1) + (xcd - r) * q) + off; }
        const int nig = wgm * nN, gid = wgid / nig, fm = gid * wgm, gsz = (nM - fm) < wgm ? (nM - fm) : wgm;
        const int rt = fm + ((wgid % nig) % gsz), cn = (wgid % nig) / gsz; int e = 0;
#pragma unroll
        for (int k = 1; k < 8; ++k) e += (rt >= tp[k]) ? 1 : 0;
        int tpe = 0;
#pragma unroll
        for (int k = 1; k < 8; ++k) if (rt >= tp[k]) tpe = tp[k];
        u.pm = rt; u.pn = e * nN + cn; u.aoff = e * cap - tpe * 256; return true;
    }
    __device__ __forceinline__ void a_ready(const Unit&) const {}
    __device__ __forceinline__ void done(const Unit&) const {}
};

__device__ __forceinline__ unsigned pk2h(float lo, float hi) { f16x2 v = {(_Float16)lo, (_Float16)hi}; return __builtin_bit_cast(unsigned, v); }
typedef int i32x4 __attribute__((ext_vector_type(4)));
typedef int i32x8 __attribute__((ext_vector_type(8)));
__device__ __forceinline__ unsigned pk4f8(float a, float b, float c, float d) {
    a = __builtin_amdgcn_fmed3f(a, -448.f, 448.f); b = __builtin_amdgcn_fmed3f(b, -448.f, 448.f); c = __builtin_amdgcn_fmed3f(c, -448.f, 448.f); d = __builtin_amdgcn_fmed3f(d, -448.f, 448.f);
    int w = __builtin_amdgcn_cvt_pk_fp8_f32(a, b, 0, false); w = __builtin_amdgcn_cvt_pk_fp8_f32(c, d, w, true); return (unsigned)w;
}
__device__ __forceinline__ float fast_sigmoid(float v) { return __builtin_amdgcn_rcpf(1.0f + __builtin_amdgcn_exp2f(-1.4426950408889634f * v)); }

struct EpiF16 {
    static constexpr bool PERM = true, AFTER_DRAIN = false, HAS_RS = false;
    h16_t* O; int ldc; int nmod; float sA; float sB;
    __device__ __forceinline__ void operator()(const f32x4 (&acc)[2][2][4][2], const Unit& u, int wr, int wc, int fr, int fq) const {
        const int row0 = u.pm * BM + wr * 64 + fr; const int pn = u.pn % nmod;
        float sc = 1.f; if (sA != 0.f) { if (pn < 2) sc = sA; else if (pn == 6 || pn == 7) sc = sB; }
        const int col0 = pn * BM + wc * 32 + 8 * fq;
#pragma unroll
        for (int ai = 0; ai < 2; ++ai)
#pragma unroll
            for (int m = 0; m < 4; ++m) { h16_t* rowp = O + (size_t)(row0 + ai * HALF + m * 16) * ldc + col0;
#pragma unroll
                for (int bj = 0; bj < 2; ++bj) { const f32x4 v0 = acc[ai][bj][m][0] * sc, v1 = acc[ai][bj][m][1] * sc;
                    u32x4 w; w.x = pk2h(v0[0], v0[1]); w.y = pk2h(v0[2], v0[3]); w.z = pk2h(v1[0], v1[1]); w.w = pk2h(v1[2], v1[3]);
                    *(u32x4*)(rowp + bj * HALF) = w; } }
    }
};

struct EpiQKV {
    static constexpr bool PERM = true, AFTER_DRAIN = false, HAS_RS = true;
    h16_t* O; h16_t* KA; h16_t* KB1; h16_t* KB4; h16_t* KB16; unsigned* kmax; float sA, sB;
    const float* rs; const float* wsd;
    __device__ __forceinline__ static int pi32(int r) { return (r & 0x13) | ((r & 4) << 1) | ((r & 8) >> 1); }
    __device__ __forceinline__ void load_rs(const Unit& u, int wr, int fr, float (&rsv)[10]) const {
        const int row0 = u.pm * BM + wr * 64 + fr;
#pragma unroll
        for (int i = 0; i < 8; ++i) rsv[i] = rs[row0 + (i >> 2) * HALF + (i & 3) * 16];
        rsv[8] = wsd[u.pn >> 1]; rsv[9] = 0.f;
    }
    __device__ __forceinline__ void operator()(const f32x4 (&acc)[2][2][4][2], const Unit& u, int wr, int wc, int fr, int fq, const float (&rsv)[10]) const {
        const int row0 = u.pm * BM + wr * 64 + fr, pn = u.pn;
        const bool isKA = (pn == 2 || pn == 3), isKB = (pn == 8 || pn == 9);
        const float wsf = rsv[8];
        if (!isKA && !isKB) {
            const float sc0 = ((pn < 2) ? sA : (pn == 6 || pn == 7) ? sB : 1.0f) * wsf;
            const int col0 = pn * BM + wc * 32 + 8 * fq;
#pragma unroll
            for (int ai = 0; ai < 2; ++ai)
#pragma unroll
                for (int m = 0; m < 4; ++m) { h16_t* rowp = O + (size_t)(row0 + ai * HALF + m * 16) * 3072 + col0; const float sc = sc0 * rsv[ai * 4 + m];
#pragma unroll
                    for (int bj = 0; bj < 2; ++bj) { const f32x4 v0 = acc[ai][bj][m][0] * sc, v1 = acc[ai][bj][m][1] * sc;
                        u32x4 w; w.x = pk2h(v0[0], v0[1]); w.y = pk2h(v0[2], v0[3]); w.z = pk2h(v1[0], v1[1]); w.w = pk2h(v1[2], v1[3]);
                        *(u32x4*)(rowp + bj * HALF) = w; } }
            return;
        }
        const int b = u.pm >> 4;
        float mx[2] = {0.f, 0.f};
#pragma unroll
        for (int ai = 0; ai < 2; ++ai)
#pragma unroll
            for (int m = 0; m < 4; ++m) { const int t = (row0 + ai * HALF + m * 16) & 4095; const float sc = wsf * rsv[ai * 4 + m];
#pragma unroll
                for (int bj = 0; bj < 2; ++bj) { const f32x4 v0 = acc[ai][bj][m][0] * sc, v1 = acc[ai][bj][m][1] * sc;
                    u32x4 w; w.x = pk2h(v0[0], v0[1]); w.y = pk2h(v0[2], v0[3]); w.z = pk2h(v1[0], v1[1]); w.w = pk2h(v1[2], v1[3]);
                    const int cs = (pn & 1) * 256 + bj * HALF + wc * 32 + 8 * fq, h = cs >> 6, c8 = (cs & 63) >> 3, bh = b * 8 + h;
                    if (isKA) {
                        const int frag = (c8 >> 2) * 2 + ((c8 >> 1) & 1), hi = c8 & 1;
                        *(u32x4*)(KA + ((size_t)((bh * 128 + (t >> 5)) * 4 + frag) * 64 + hi * 32 + pi32(t & 31)) * 8) = w;
                        float q2 = (v0[0] * v0[0] + v0[1] * v0[1]) + (v0[2] * v0[2] + v0[3] * v0[3]) + (v1[0] * v1[0] + v1[1] * v1[1]) + (v1[2] * v1[2] + v1[3] * v1[3]);
                        { const auto s16 = __builtin_amdgcn_permlane16_swap(__float_as_uint(q2), __float_as_uint(q2), false, false); q2 = __uint_as_float(s16[0]) + __uint_as_float(s16[1]);
                          const auto s32 = __builtin_amdgcn_permlane32_swap(__float_as_uint(q2), __float_as_uint(q2), false, false); q2 = __uint_as_float(s32[0]) + __uint_as_float(s32[1]); }
                        mx[bj] = fmaxf(mx[bj], q2);
                    } else {
                        const int sl = c8 >> 1, hi = c8 & 1;
                        { const int uu = t >> 5, r = t & 31; *(u32x4*)(KB1 + ((size_t)((bh * 128 + uu) * 4 + sl) * 64 + hi * 32 + pi32(r)) * 8) = w; }
                        { const int i = t >> 2, uu = (t & 3) * 32 + (i >> 5), r = i & 31; *(u32x4*)(KB4 + ((size_t)((bh * 128 + uu) * 4 + sl) * 64 + hi * 32 + pi32(r)) * 8) = w; }
                        { const int i = t >> 4, uu = (t & 15) * 8 + (i >> 5), r = i & 31; *(u32x4*)(KB16 + ((size_t)((bh * 128 + uu) * 4 + sl) * 64 + hi * 32 + pi32(r)) * 8) = w; }
                    } } }
        if (isKA) {
#pragma unroll
            for (int bj = 0; bj < 2; ++bj) { float v = mx[bj];
#define PG8_DPPF(x, ctrl) __builtin_bit_cast(float, __builtin_amdgcn_update_dpp(0, __builtin_bit_cast(int, (x)), (ctrl), 0xf, 0xf, false))
                v = fmaxf(v, PG8_DPPF(v, 0xb1)); v = fmaxf(v, PG8_DPPF(v, 0x4e)); v = fmaxf(v, PG8_DPPF(v, 0x124)); v = fmaxf(v, PG8_DPPF(v, 0x128));
#undef PG8_DPPF
                const int cs = (pn & 1) * 256 + bj * HALF + wc * 32;
                if ((threadIdx.x & 63) == 0) __hip_atomic_fetch_max(kmax + (b * 8 + (cs >> 6)) * 2 + ((cs >> 5) & 1), __float_as_uint(v * 1.002f), __ATOMIC_RELAXED, __HIP_MEMORY_SCOPE_AGENT); }
        }
    }
};

template <int MODE> struct EpiGated {
    static constexpr bool PERM = true, AFTER_DRAIN = false, HAS_RS = false;
    h16_t* O; int ldc; int nmod; const float* bias; float sin;
    __device__ __forceinline__ void operator()(const f32x4 (&acc)[2][2][4][2], const Unit& u, int wr, int wc, int fr, int fq) const {
        const int row0 = u.pm * BM + wr * 64 + fr; const int pn = u.pn % nmod;
        const int col0 = pn * HALF + wc * 32 + 8 * fq;
        f32x4 ba[2], bb[2];
#pragma unroll
        for (int n = 0; n < 2; ++n) { if (MODE == 1) { ba[n] = *(const f32x4*)(bias + col0 + 4 * n); bb[n] = *(const f32x4*)(bias + 1024 + col0 + 4 * n); } else { ba[n] = (f32x4){0.f, 0.f, 0.f, 0.f}; bb[n] = ba[n]; } }
#pragma unroll
        for (int ai = 0; ai < 2; ++ai)
#pragma unroll
            for (int m = 0; m < 4; ++m) { h16_t* rowp = O + (size_t)(row0 + ai * HALF + m * 16) * ldc + col0;
                float r[8];
#pragma unroll
                for (int n = 0; n < 2; ++n)
#pragma unroll
                    for (int e = 0; e < 4; ++e) { const float a = acc[ai][0][m][n][e] * sin + ba[n][e], b = acc[ai][1][m][n][e] * sin + bb[n][e];
                        r[4 * n + e] = (MODE == 0) ? (a * fast_sigmoid(a)) * b : a * fast_sigmoid(b); }
                u32x4 w; w.x = pk2h(r[0], r[1]); w.y = pk2h(r[2], r[3]); w.z = pk2h(r[4], r[5]); w.w = pk2h(r[6], r[7]);
                *(u32x4*)rowp = w; }
    }
};

__device__ __forceinline__ unsigned pk4i8(float a, float b, float c, float d) {
    const float MG = 12582912.0f;
    const unsigned ua = __builtin_bit_cast(unsigned, __builtin_amdgcn_fmed3f(a, -127.f, 127.f) + MG), ub = __builtin_bit_cast(unsigned, __builtin_amdgcn_fmed3f(b, -127.f, 127.f) + MG);
    const unsigned uc = __builtin_bit_cast(unsigned, __builtin_amdgcn_fmed3f(c, -127.f, 127.f) + MG), ud = __builtin_bit_cast(unsigned, __builtin_amdgcn_fmed3f(d, -127.f, 127.f) + MG);
    const unsigned lo = __builtin_amdgcn_perm(ub, ua, 0x0c0c0400u), hi = __builtin_amdgcn_perm(ud, uc, 0x0c0c0400u);
    return __builtin_amdgcn_perm(hi, lo, 0x05040100u);
}
struct EpiF16S {
    static constexpr bool PERM = true, AFTER_DRAIN = false, HAS_RS = false;
    h16_t* O; int ldc; int nmod; float s;
    __device__ __forceinline__ void operator()(const f32x4 (&acc)[2][2][4][2], const Unit& u, int wr, int wc, int fr, int fq) const {
        const int row0 = u.pm * BM + wr * 64 + fr; const int pn = u.pn % nmod;
        const int col0 = pn * BM + wc * 32 + 8 * fq;
#pragma unroll
        for (int ai = 0; ai < 2; ++ai)
#pragma unroll
            for (int m = 0; m < 4; ++m) { h16_t* rowp = O + (size_t)(row0 + ai * HALF + m * 16) * ldc + col0;
#pragma unroll
                for (int bj = 0; bj < 2; ++bj) { const f32x4 v0 = acc[ai][bj][m][0] * s, v1 = acc[ai][bj][m][1] * s;
                    u32x4 w; w.x = pk2h(v0[0], v0[1]); w.y = pk2h(v0[2], v0[3]); w.z = pk2h(v1[0], v1[1]); w.w = pk2h(v1[2], v1[3]);
                    *(u32x4*)(rowp + bj * HALF) = w; } }
    }
};
struct EpiF8S {
    static constexpr bool PERM = true, AFTER_DRAIN = false, HAS_RS = false;
    unsigned char* O; int ldc; int nmod; float s;
    __device__ __forceinline__ void operator()(const f32x4 (&acc)[2][2][4][2], const Unit& u, int wr, int wc, int fr, int fq) const {
        const int row0 = u.pm * BM + wr * 64 + fr; const int pn = u.pn % nmod;
        const int col0 = pn * BM + wc * 32 + 8 * fq;
        typedef unsigned u32x2 __attribute__((ext_vector_type(2)));
#pragma unroll
        for (int ai = 0; ai < 2; ++ai)
#pragma unroll
            for (int m = 0; m < 4; ++m) { unsigned char* rowp = O + (size_t)(row0 + ai * HALF + m * 16) * ldc + col0;
#pragma unroll
                for (int bj = 0; bj < 2; ++bj) { const f32x4 v0 = acc[ai][bj][m][0] * s, v1 = acc[ai][bj][m][1] * s;
                    u32x2 w; w.x = pk4f8(v0[0], v0[1], v0[2], v0[3]); w.y = pk4f8(v1[0], v1[1], v1[2], v1[3]);
                    *(u32x2*)(rowp + bj * HALF) = w; } }
    }
};
template <int MODE, bool PADLAST> struct EpiGated8 {
    static constexpr bool PERM = true, AFTER_DRAIN = false, HAS_RS = true;
    unsigned char* O; int ldc; int nmod; const float* bias; float sin, so;
    const float* rs = nullptr; const float* wsa = nullptr; const float* wsb = nullptr;
    __device__ __forceinline__ void load_rs(const Unit& u, int wr, int fr, float (&rsv)[10]) const {
        const int row0 = u.pm * BM + u.aoff + wr * 64 + fr;
#pragma unroll
        for (int i = 0; i < 8; ++i) rsv[i] = rs ? rs[row0 + (i >> 2) * HALF + (i & 3) * 16] : 1.0f;
        const int e = u.pn / nmod; rsv[8] = wsa ? wsa[e] : 1.0f; rsv[9] = wsa ? wsb[e] : 1.0f;
    }
    __device__ __forceinline__ void operator()(const f32x4 (&acc)[2][2][4][2], const Unit& u, int wr, int wc, int fr, int fq, const float (&rsv)[10]) const {
        const int row0 = u.pm * BM + wr * 64 + fr; const int pn = u.pn % nmod;
        const int col0 = pn * HALF + wc * 32 + 8 * fq;
        const float sa = sin * rsv[8], sb = sin * rsv[9];
        f32x4 ba[2], bb[2];
#pragma unroll
        for (int n = 0; n < 2; ++n) { if (MODE == 1) { ba[n] = *(const f32x4*)(bias + col0 + 4 * n); bb[n] = *(const f32x4*)(bias + 1024 + col0 + 4 * n); } else { ba[n] = (f32x4){0.f, 0.f, 0.f, 0.f}; bb[n] = ba[n]; } }
#pragma unroll
        for (int ai = 0; ai < 2; ++ai)
#pragma unroll
            for (int m = 0; m < 4; ++m) { unsigned char* rowp = O + (size_t)(row0 + ai * HALF + m * 16) * ldc + col0;
                float r[8]; const float ra = sa * rsv[ai * 4 + m], rb = sb * rsv[ai * 4 + m];
#pragma unroll
                for (int n = 0; n < 2; ++n)
#pragma unroll
                    for (int e = 0; e < 4; ++e) { const float a = acc[ai][0][m][n][e] * ra + ba[n][e], b = acc[ai][1][m][n][e] * rb + bb[n][e];
                        r[4 * n + e] = (MODE == 0) ? (a * fast_sigmoid(a)) * (b * so) : (a * so) * fast_sigmoid(b); }
                typedef unsigned u32x2 __attribute__((ext_vector_type(2)));
                u32x2 w; w.x = pk4f8(r[0], r[1], r[2], r[3]); w.y = pk4f8(r[4], r[5], r[6], r[7]);
                *(u32x2*)rowp = w;
                if (PADLAST) { if (pn == nmod - 1) *(u32x2*)(rowp + HALF) = (u32x2){0u, 0u}; } }
    }
};

template <class Epi, class Sched, bool ALIGN_EPI = false, bool SP2 = false, int OPM = 0, bool GATHER = false>
__device__ __forceinline__ void gemm_phase(PG8_LAS unsigned char* lds, const Gemm g, const Sched& S, const Epi& E, unsigned long long* tepi = nullptr) {
    constexpr bool F8 = (OPM == 1), I8 = (OPM == 2);
    const int tid = threadIdx.x, wid = __builtin_amdgcn_readfirstlane(tid >> 6), lane = tid & 63, wr = wid >> 2, wc = wid & 3, fr = lane & 15, fq = lane >> 4;
    const int K = g.K, nt = K / BK;
    unsigned voffA[2], voffB[2];
#pragma unroll
    for (int i = 0; i < 2; ++i) { int R, C; stage_rc(tid * 16 + i * 8192, R, C); const int Rb = Epi::PERM ? ((R & ~31) + perm32(R & 31)) : R;
        voffA[i] = (unsigned)(R * K + C) * 2u; voffB[i] = (unsigned)(Rb * K + C) * 2u; }
    const size_t kstep = (size_t)(BK * 2);
    const size_t hstep = (size_t)HALF * K * 2;
    const size_t qstep = (size_t)64 * K * 2;
    const size_t tstep = 2 * hstep;
    const unsigned ldsw = (unsigned)wid * 1024u;
    const int aoff = lds_byte(wr * 64 + fr, fq * 8); int boff = lds_byte(wc * 32 + fr, fq * 8);
    if constexpr (F8) { boff += 4 * HTB; asm volatile("" : "+v"(boff)); }
#define PG8_SA(b, h) (((b) * 2 + (h)) * HTB)
#define PG8_SB(b, h) ((4 + (b) * 2 + (h)) * HTB)
#define PG8_SBR(b, h) ((F8 ? 0 : 4 * HTB) + ((b) * 2 + (h)) * HTB)
#define PG8_STAGE(bufoff, gbase, voff) do { _Pragma("unroll") for (int _i = 0; _i < 2; ++_i) { \
        if constexpr (F8) __builtin_amdgcn_global_load_lds((const unsigned*)((const char*)(gbase) + (size_t)_i * qstep + (voff)[0]), (PG8_LAS unsigned*)(lds + (bufoff) + ldsw + _i * 8192), 16, 0, 0); \
        else __builtin_amdgcn_global_load_lds((const unsigned*)((const char*)(gbase) + (voff)[_i]), (PG8_LAS unsigned*)(lds + (bufoff) + ldsw + _i * 8192), 16, 0, 0); } } while (0)
#define PG8_STAGE_A(bufoff, kptr, h, G) do { if constexpr (GATHER) { _Pragma("unroll") for (int _i = 0; _i < 2; ++_i) \
        __builtin_amdgcn_global_load_lds((const unsigned*)((const char*)(kptr) + (G)[h][_i]), (PG8_LAS unsigned*)(lds + (bufoff) + ldsw + _i * 8192), 16, 0, 0); } \
        else PG8_STAGE(bufoff, (kptr) + (h) * hstep, voffA); } while (0)
#define PG8_LD8(off) __builtin_shufflevector(*(const PG8_LAS i32x4*)(lds + (off)), *(const PG8_LAS i32x4*)(lds + (off) + 1024), 0, 1, 2, 3, 4, 5, 6, 7)
#define PG8_LDA(dst, b, h) do { _Pragma("unroll") for (int m = 0; m < 4; ++m) { if constexpr (F8) dst##8[m] = PG8_LD8(PG8_SA(b, h) + aoff + m * 2048); \
        else { _Pragma("unroll") for (int k = 0; k < 2; ++k) dst[m][k] = *(const PG8_LAS f16x8*)(lds + PG8_SA(b, h) + aoff + m * 2048 + k * 1024); } } } while (0)
#define PG8_LDB(dst, b, h) do { _Pragma("unroll") for (int n = 0; n < 2; ++n) { if constexpr (F8) dst##8[n] = PG8_LD8(PG8_SBR(b, h) + boff + n * 2048); \
        else { _Pragma("unroll") for (int k = 0; k < 2; ++k) dst[n][k] = *(const PG8_LAS f16x8*)(lds + PG8_SBR(b, h) + boff + n * 2048 + k * 1024); } } } while (0)
#define PG8_MMA(ai, bj, At, Bt) do { __builtin_amdgcn_s_setprio(1); _Pragma("unroll") for (int m = 0; m < 4; ++m) _Pragma("unroll") for (int n = 0; n < 2; ++n) { \
        if constexpr (F8) { f32x4 c_ = {acc16[ai][bj][n][4 * m], acc16[ai][bj][n][4 * m + 1], acc16[ai][bj][n][4 * m + 2], acc16[ai][bj][n][4 * m + 3]}; \
            c_ = __builtin_amdgcn_mfma_scale_f32_16x16x128_f8f6f4(Bt##8[n], At##8[m], c_, 0, 0, 0, 0, 0, 0); \
            acc16[ai][bj][n][4 * m] = c_[0]; acc16[ai][bj][n][4 * m + 1] = c_[1]; acc16[ai][bj][n][4 * m + 2] = c_[2]; acc16[ai][bj][n][4 * m + 3] = c_[3]; } \
        else if constexpr (I8) { _Pragma("unroll") for (int k = 0; k < 2; ++k) acci[ai][bj][m][n] = __builtin_amdgcn_mfma_i32_16x16x64_i8(__builtin_bit_cast(i32x4, Bt[n][k]), __builtin_bit_cast(i32x4, At[m][k]), acci[ai][bj][m][n], 0, 0, 0); } \
        else { _Pragma("unroll") for (int k = 0; k < 2; ++k) acc[ai][bj][m][n] = __builtin_amdgcn_mfma_f32_16x16x32_f16(Bt[n][k], At[m][k], acc[ai][bj][m][n], 0, 0, 0); } } \
        __builtin_amdgcn_s_setprio(0); } while (0)
#define PG8_WAIT_V(n) asm volatile("s_waitcnt vmcnt(" #n ")" ::: "memory")
#define PG8_WAIT_L(n) asm volatile("s_waitcnt lgkmcnt(" #n ")" ::: "memory")
#define PG8_BAR __builtin_amdgcn_s_barrier()
#define PG8_SCHED __builtin_amdgcn_sched_barrier(0)
    Unit cur, nxt; int ui = 0;
    if (!S.next(0, cur)) return;
    f32x4 acc[2][2][4][2]; f32x16 acc16[2][2][2]; i32x4 acci[2][2][4][2];
#define PG8_ZERO_ACC do { _Pragma("unroll") for (int a = 0; a < 2; ++a) _Pragma("unroll") for (int b = 0; b < 2; ++b) { \
        if constexpr (F8) { _Pragma("unroll") for (int n = 0; n < 2; ++n) _Pragma("unroll") for (int r = 0; r < 16; ++r) acc16[a][b][n][r] = 0.f; } \
        else if constexpr (I8) { _Pragma("unroll") for (int m = 0; m < 4; ++m) _Pragma("unroll") for (int n = 0; n < 2; ++n) acci[a][b][m][n] = (i32x4){0, 0, 0, 0}; } \
        else { _Pragma("unroll") for (int m = 0; m < 4; ++m) _Pragma("unroll") for (int n = 0; n < 2; ++n) acc[a][b][m][n] = (f32x4){0.f, 0.f, 0.f, 0.f}; } } } while (0)
    PG8_ZERO_ACC;
    f16x8 At[4][2], B0[2][2], B1[2][2]; i32x8 At8[4], B08[2], B18[2];
    const char* cA = (const char*)g.A + (GATHER ? (size_t)0 : (size_t)cur.pm * tstep); const char* cB = (const char*)g.Bt + (size_t)cur.pn * tstep;
    S.a_ready(cur);
    unsigned gcur[2][2], gnxt[2][2], gld[2][2], g2[2][2];
    int gR, gC; stage_rc(tid * 16, gR, gC);
#define PG8_GLOAD(dst, u) do { _Pragma("unroll") for (int h_ = 0; h_ < 2; ++h_) _Pragma("unroll") for (int i_ = 0; i_ < 2; ++i_) \
        { const unsigned t_ = (unsigned)g.arows[(u).pm * BM + (u).aoff + h_ * HALF + i_ * 64 + gR]; dst[h_][i_] = (t_ < g.amax ? t_ : g.amax) * (unsigned)(K * 2) + (unsigned)(gC * 2); } } while (0)
    if constexpr (GATHER) { Unit u1, u2; PG8_GLOAD(gcur, cur);
        if (S.next(1, u1)) PG8_GLOAD(gnxt, u1); else { _Pragma("unroll") for (int h_ = 0; h_ < 2; ++h_) _Pragma("unroll") for (int i_ = 0; i_ < 2; ++i_) gnxt[h_][i_] = gcur[h_][i_]; }
        asm volatile("" : "+v"(gnxt[0][0]), "+v"(gnxt[0][1]), "+v"(gnxt[1][0]), "+v"(gnxt[1][1]));
        if (S.next(2, u2)) PG8_GLOAD(gld, u2); else { _Pragma("unroll") for (int h_ = 0; h_ < 2; ++h_) _Pragma("unroll") for (int i_ = 0; i_ < 2; ++i_) gld[h_][i_] = gcur[h_][i_]; } }
    float rsv[10]; if constexpr (Epi::HAS_RS) E.load_rs(cur, wr, fr, rsv);
    if constexpr (SP2) {
        PG8_STAGE(PG8_SB(0, 0), cB, voffB); PG8_STAGE(PG8_SB(0, 1), cB + hstep, voffB); PG8_STAGE_A(PG8_SA(0, 0), cA, 0, gcur); PG8_STAGE_A(PG8_SA(0, 1), cA, 1, gcur);
        if (wr == 1) PG8_BAR;
        PG8_WAIT_V(2); PG8_BAR;
        PG8_STAGE(PG8_SB(1, 0), cB + kstep, voffB); PG8_STAGE_A(PG8_SA(1, 0), cA + kstep, 0, gcur); PG8_STAGE(PG8_SB(1, 1), cB + hstep + kstep, voffB);
        PG8_WAIT_V(6); PG8_BAR;
    } else {
        PG8_STAGE(PG8_SB(0, 0), cB, voffB); PG8_STAGE_A(PG8_SA(0, 0), cA, 0, gcur); PG8_STAGE(PG8_SB(0, 1), cB + hstep, voffB); PG8_STAGE_A(PG8_SA(0, 1), cA, 1, gcur);
        if (wr == 1) PG8_BAR;
        PG8_WAIT_V(4); PG8_BAR;
        PG8_STAGE(PG8_SB(1, 0), cB + kstep, voffB); PG8_STAGE_A(PG8_SA(1, 0), cA + kstep, 0, gcur); PG8_STAGE(PG8_SB(1, 1), cB + hstep + kstep, voffB);
        PG8_WAIT_V(6); PG8_BAR;
    }
    for (;;) {
        const bool has_next = S.next(ui + 1, nxt);
        const char* nA = (has_next && !GATHER) ? (const char*)g.A + (size_t)nxt.pm * tstep : cA; const char* nB = has_next ? (const char*)g.Bt + (size_t)nxt.pn * tstep : cB;
        for (int t = 0; t < nt; t += 2) {
            const bool last = (t == nt - 2);
            const char* a1 = cA + (size_t)(t + 1) * kstep;
            const char* a2 = last ? nA : cA + (size_t)(t + 2) * kstep; const char* b2 = last ? nB : cB + (size_t)(t + 2) * kstep;
            const char* a3 = a2 + kstep; const char* b3 = b2 + kstep;
            if (last && has_next) S.a_ready(nxt);
            if constexpr (GATHER) { _Pragma("unroll") for (int h_ = 0; h_ < 2; ++h_) _Pragma("unroll") for (int i_ = 0; i_ < 2; ++i_) g2[h_][i_] = last ? gnxt[h_][i_] : gcur[h_][i_]; }
            if constexpr (SP2) {
            PG8_LDB(B0, 0, 0); PG8_LDB(B1, 0, 1); PG8_SCHED; PG8_LDA(At, 0, 0); PG8_STAGE_A(PG8_SA(1, 1), a1, 1, gcur);
            PG8_WAIT_V(8); PG8_WAIT_L(0); PG8_BAR; PG8_MMA(0, 0, At, B0); PG8_MMA(0, 1, At, B1); PG8_BAR; PG8_SCHED;
            PG8_LDA(At, 0, 1); PG8_STAGE(PG8_SB(0, 0), b2, voffB); PG8_STAGE(PG8_SB(0, 1), b2 + hstep, voffB); PG8_STAGE_A(PG8_SA(0, 0), a2, 0, g2);
            PG8_WAIT_V(8); PG8_WAIT_L(0); PG8_BAR; PG8_MMA(1, 0, At, B0); PG8_MMA(1, 1, At, B1); PG8_BAR; PG8_SCHED;
            PG8_LDB(B0, 1, 0); PG8_LDB(B1, 1, 1); PG8_SCHED; PG8_LDA(At, 1, 0); PG8_STAGE_A(PG8_SA(0, 1), a2, 1, g2);
            PG8_WAIT_V(8); PG8_WAIT_L(0); PG8_BAR; PG8_MMA(0, 0, At, B0); PG8_MMA(0, 1, At, B1); PG8_BAR; PG8_SCHED;
            PG8_LDA(At, 1, 1); PG8_STAGE(PG8_SB(1, 0), b3, voffB); PG8_STAGE(PG8_SB(1, 1), b3 + hstep, voffB); PG8_STAGE_A(PG8_SA(1, 0), a3, 0, g2);
            PG8_WAIT_V(8); PG8_WAIT_L(0); PG8_BAR; PG8_MMA(1, 0, At, B0); PG8_MMA(1, 1, At, B1); PG8_BAR; PG8_SCHED;
            } else {
            PG8_LDB(B0, 0, 0); PG8_SCHED; PG8_LDA(At, 0, 0); PG8_STAGE_A(PG8_SA(1, 1), a1, 1, gcur);
            PG8_WAIT_L(8); PG8_BAR; PG8_WAIT_L(0); PG8_MMA(0, 0, At, B0); PG8_BAR; PG8_SCHED;
            PG8_LDB(B1, 0, 1); PG8_STAGE(PG8_SB(0, 0), b2, voffB);
            PG8_BAR; PG8_WAIT_L(0); PG8_MMA(0, 1, At, B1); PG8_BAR;
            PG8_LDA(At, 0, 1); PG8_STAGE_A(PG8_SA(0, 0), a2, 0, g2);
            PG8_BAR; PG8_WAIT_L(0); PG8_MMA(1, 0, At, B0); PG8_BAR; PG8_SCHED;
            PG8_STAGE(PG8_SB(0, 1), b2 + hstep, voffB);
            PG8_WAIT_V(6); PG8_BAR; PG8_MMA(1, 1, At, B1); PG8_BAR;
            PG8_LDB(B0, 1, 0); PG8_SCHED; PG8_LDA(At, 1, 0); PG8_STAGE_A(PG8_SA(0, 1), a2, 1, g2);
            PG8_WAIT_L(8); PG8_BAR; PG8_WAIT_L(0); PG8_MMA(0, 0, At, B0); PG8_BAR; PG8_SCHED;
            PG8_LDB(B1, 1, 1); PG8_STAGE(PG8_SB(1, 0), b3, voffB);
            PG8_BAR; PG8_WAIT_L(0); PG8_MMA(0, 1, At, B1); PG8_BAR;
            PG8_LDA(At, 1, 1); PG8_STAGE_A(PG8_SA(1, 0), a3, 0, g2);
            PG8_BAR; PG8_WAIT_L(0); PG8_MMA(1, 0, At, B0); PG8_BAR; PG8_SCHED;
            PG8_STAGE(PG8_SB(1, 1), b3 + hstep, voffB);
            PG8_WAIT_V(6); PG8_BAR; PG8_MMA(1, 1, At, B1); PG8_BAR;
            }
        }
        if constexpr (GATHER) asm volatile("" : "+v"(gld[0][0]), "+v"(gld[0][1]), "+v"(gld[1][0]), "+v"(gld[1][1]));
        if constexpr (ALIGN_EPI) { if (wr == 0) PG8_BAR; }
        if constexpr (F8) {
#pragma unroll
            for (int a = 0; a < 2; ++a)
#pragma unroll
                for (int b = 0; b < 2; ++b)
#pragma unroll
                    for (int m = 0; m < 4; ++m)
#pragma unroll
                        for (int n = 0; n < 2; ++n) acc[a][b][m][n] = (f32x4){acc16[a][b][n][4 * m], acc16[a][b][n][4 * m + 1], acc16[a][b][n][4 * m + 2], acc16[a][b][n][4 * m + 3]};
        }
        if constexpr (I8) {
#pragma unroll
            for (int a = 0; a < 2; ++a)
#pragma unroll
                for (int b = 0; b < 2; ++b)
#pragma unroll
                    for (int m = 0; m < 4; ++m)
#pragma unroll
                        for (int n = 0; n < 2; ++n) acc[a][b][m][n] = __builtin_convertvector(acci[a][b][m][n], f32x4);
        }
#ifdef PROBE_EPI_SEL
        const unsigned long long te0_ = __builtin_amdgcn_s_memtime();
#endif
        if constexpr (!Epi::AFTER_DRAIN) { if constexpr (Epi::HAS_RS) E(acc, cur, wr, wc, fr, fq, rsv); else E(acc, cur, wr, wc, fr, fq); S.done(cur); }
#ifdef PROBE_EPI_SEL
        if (tepi && (PROBE_EPI_SEL(cur.pn))) { asm volatile("s_waitcnt vmcnt(0)" ::: "memory"); *tepi += __builtin_amdgcn_s_memtime() - te0_; }
#endif (one unit per workgroup only) run below, once the LDS region is free
        if (!has_next) break;
        PG8_ZERO_ACC;
        cur = nxt; cA = nA; cB = nB; ++ui;
        if constexpr (GATHER) { Unit u3;
#pragma unroll
            for (int h_ = 0; h_ < 2; ++h_)
#pragma unroll
                for (int i_ = 0; i_ < 2; ++i_) { gcur[h_][i_] = gnxt[h_][i_]; gnxt[h_][i_] = gld[h_][i_]; }
            if (S.next(ui + 2, u3)) PG8_GLOAD(gld, u3); }
        if constexpr (Epi::HAS_RS) E.load_rs(cur, wr, fr, rsv);
        if constexpr (ALIGN_EPI) { if (wr == 1) PG8_BAR; }
    }
    PG8_WAIT_V(0);
    if constexpr (!ALIGN_EPI) { if (wr == 0) PG8_BAR; }
    PG8_BAR;
    if constexpr (Epi::AFTER_DRAIN) { E.fused(acc, cur, wr, wc, fr, fq, lds, wid, lane); S.done(cur); }
#undef PG8_SA
#undef PG8_SB
#undef PG8_SBR
#undef PG8_STAGE
#undef PG8_STAGE_A
#undef PG8_LDA
#undef PG8_LDB
#undef PG8_MMA
#undef PG8_GLOAD
#undef PG8_ZERO_ACC
#undef PG8_LD8
#undef PG8_WAIT_V
#undef PG8_WAIT_L
#undef PG8_BAR
#undef PG8_SCHED
}
}

constexpr int NWAVES = 8;
constexpr int BATCH = 8, SEQ = 4096, D = 1024, M = BATCH * SEQ;
constexpr int DFF = 2816, NEXP = 8, DFE = 1408;
constexpr int NPH = 17;
constexpr int N_LAUNCHES = MK_N_LAUNCHES;
static_assert(N_LAUNCHES == 1, "one launch only (PH4 has an inner grid barrier)");
constexpr int DFE_PAD = 1536;
constexpr float S8_H = 8.0f, S8_HID = 8.0f, S8_WE1 = 512.0f, S8_WE2 = 1024.0f, S8_WF1 = 512.0f, S8_WF2 = 1024.0f, S8_WGLU = 1024.0f, S8_GY = 16.0f, S8_Y3 = 128.0f, S8_YG = 32.0f, S8_Y2 = 64.0f;
constexpr float LN_EPS = 1e-5f, LOG2E = 1.4426950408889634f, DN_ALPHA = 1.4142135623730951f;
constexpr float QSCALE_A = 0.17677669529663687f * LOG2E;
constexpr float QSCALE_B = 0.125f * LOG2E;

constexpr size_t MiB = 1u << 20;
constexpr size_t WS_CTL = 0, CTL_ZERO_BYTES = 1 * MiB;
constexpr size_t WS_MOD = 1 * MiB;
constexpr size_t WS_SSMA = 1 * MiB + 512 * 1024;
constexpr size_t WS_SSMB = WS_SSMA + 64 * 1024;
constexpr size_t WS_TOKE = 2 * MiB + 512 * 1024;
constexpr size_t WS_TOKG = WS_TOKE + 256 * 1024;
constexpr size_t WS_TOKP = WS_TOKG + 256 * 1024;
constexpr size_t WS_WSC = 2 * MiB + 256 * 1024;
constexpr size_t WS_RS0 = 3 * MiB + 256 * 1024;
constexpr size_t WS_RS2 = WS_RS0 + 128 * 1024;
constexpr size_t WS_RSG = WS_RS2 + 128 * 1024;
constexpr size_t WS_TAMAX = WS_RSG + 320 * 1024;
static_assert(WS_TAMAX + 128 * 1024 <= 4 * MiB, "scale tables fit below the weights");
constexpr float I8_CLIP = 4.25f;
constexpr size_t WS_W_IN = 4 * MiB, WS_W_OUT = 10 * MiB, WS_W_F1 = 12 * MiB, WS_W_F2 = 23 * MiB, WS_W_GLU = 28 * MiB + 512 * 1024;
constexpr size_t WS_W_E1 = 32 * MiB + 512 * 1024, WS_W_E2 = 76 * MiB + 512 * 1024;
constexpr size_t WS_A = 100 * MiB, WS_B = 292 * MiB, WS_C = 356 * MiB, WS_VT1 = 424 * MiB, WS_END = 488 * MiB;
constexpr int LCAP = M;
constexpr size_t WS_RSGL = 356 * MiB + 44 * MiB;
constexpr size_t WS_ROWL = 356 * MiB + 40 * MiB;
constexpr size_t WS_UG = 228 * MiB;
constexpr size_t WS_SSMM = 196 * MiB;
constexpr size_t WS_KA = 356 * MiB, WS_KB1 = 388 * MiB, WS_KB4 = 420 * MiB, WS_KB16 = 452 * MiB;
constexpr int MOE_MAX_TILES = 264;
static_assert(WS_W_E2 + (size_t)NEXP * D * DFE * 2 <= WS_A, "weights fit");
static_assert((size_t)MOE_MAX_TILES * 256 * DFE * 2 <= WS_B - WS_A, "hidden_g fits region A");
static_assert(WS_B + (size_t)MOE_MAX_TILES * 256 * D * 2 <= WS_VT1, "gathered rows fit");
constexpr int CW_TMO = 0, CW_CODE = 1;
constexpr int CW_ECNT = 64;
constexpr int CW_ECUR = 128;
constexpr int CW_UQ = 1024;
constexpr int CW_TQ = 192;
constexpr int CW_PREP = 512;
constexpr int CW_KMAX = 256;
constexpr int CW_BAR = 4096;

constexpr int RING_OFF = 0, RING_BYTES = 131072;
constexpr int LDSCTL_OFF = RING_BYTES + 1024, MISC_OFF = LDSCTL_OFF + 320;
constexpr int LDS_BYTES = 147456;

#define GAS __attribute__((address_space(1)))
#define LAS __attribute__((address_space(3)))
typedef unsigned short h16;
typedef unsigned v4u __attribute__((ext_vector_type(4)));
typedef unsigned v2u __attribute__((ext_vector_type(2)));
typedef float f32x4 __attribute__((ext_vector_type(4)));
typedef GAS unsigned gu32;
#define RLX_AGENT __ATOMIC_RELAXED, __HIP_MEMORY_SCOPE_AGENT
#define LDS_WAIT() asm volatile("s_waitcnt lgkmcnt(0)" ::: "memory")
#define VM_WAIT() asm volatile("s_waitcnt vmcnt(0)" ::: "memory")
using pg8::pk2h;
__device__ __forceinline__ float h2f(unsigned short v) { return (float)__builtin_bit_cast(_Float16, v); }
__device__ __forceinline__ float hlo(unsigned w) { return h2f((unsigned short)(w & 0xffffu)); }
__device__ __forceinline__ float hhi(unsigned w) { return h2f((unsigned short)(w >> 16)); }
#define DPPF_(x, ctrl, rm) __builtin_bit_cast(float, __builtin_amdgcn_update_dpp(0, __builtin_bit_cast(int, (x)), (ctrl), (rm), 0xf, false))
__device__ __forceinline__ float wave_sum(float v) {
    v += DPPF_(v, 0xb1, 0xf);
    v += DPPF_(v, 0x4e, 0xf);
    v += DPPF_(v, 0x124, 0xf);
    v += DPPF_(v, 0x128, 0xf);
    v += DPPF_(v, 0x142, 0xa);
    v += DPPF_(v, 0x143, 0xc);
    return __builtin_bit_cast(float, __builtin_amdgcn_readlane(__builtin_bit_cast(int, v), 63));
}
__device__ __forceinline__ float wave_maxd(float v) {
    v = fmaxf(v, DPPF_(v, 0xb1, 0xf)); v = fmaxf(v, DPPF_(v, 0x4e, 0xf)); v = fmaxf(v, DPPF_(v, 0x124, 0xf)); v = fmaxf(v, DPPF_(v, 0x128, 0xf));
    v = fmaxf(v, DPPF_(v, 0x142, 0xa)); v = fmaxf(v, DPPF_(v, 0x143, 0xc));
    return __builtin_bit_cast(float, __builtin_amdgcn_readlane(__builtin_bit_cast(int, v), 63));
}
__device__ __forceinline__ void wave_sum2(float a, float b, float& sa, float& sb) {
    const auto s = __builtin_amdgcn_permlane32_swap(__float_as_uint(a), __float_as_uint(b), false, false);
    float v = __uint_as_float(s[0]) + __uint_as_float(s[1]);
    v += DPPF_(v, 0xb1, 0xf); v += DPPF_(v, 0x4e, 0xf); v += DPPF_(v, 0x124, 0xf); v += DPPF_(v, 0x128, 0xf);
    v += DPPF_(v, 0x142, 0xa);
    sa = __builtin_bit_cast(float, __builtin_amdgcn_readlane(__builtin_bit_cast(int, v), 31)); sb = __builtin_bit_cast(float, __builtin_amdgcn_readlane(__builtin_bit_cast(int, v), 63));
}
__device__ __forceinline__ void wave_sum8(const float (&p)[8], float (&t)[8]) {
    float q[4], r[2];
#pragma unroll
    for (int i = 0; i < 4; ++i) { const auto s = __builtin_amdgcn_permlane32_swap(__float_as_uint(p[i]), __float_as_uint(p[i + 4]), false, false); q[i] = __uint_as_float(s[0]) + __uint_as_float(s[1]); }
#pragma unroll
    for (int i = 0; i < 2; ++i) { const auto s = __builtin_amdgcn_permlane16_swap(__float_as_uint(q[i]), __float_as_uint(q[i + 2]), false, false); r[i] = __uint_as_float(s[0]) + __uint_as_float(s[1]); }
#pragma unroll
    for (int i = 0; i < 2; ++i) { float v = r[i]; v += DPPF_(v, 0xb1, 0xf); v += DPPF_(v, 0x4e, 0xf); v += DPPF_(v, 0x124, 0xf); v += DPPF_(v, 0x128, 0xf); r[i] = v; }
#pragma unroll
    for (int i = 0; i < 2; ++i)
#pragma unroll
        for (int k = 0; k < 4; ++k) t[i + 2 * k] = __builtin_bit_cast(float, __builtin_amdgcn_readlane(__builtin_bit_cast(int, r[i]), 16 * k));
}
__device__ __forceinline__ float wave_max(float v) {
#pragma unroll
    for (int o = 1; o < 64; o <<= 1) v = fmaxf(v, __shfl_xor(v, o));
    return v;
}
__device__ __forceinline__ float ex2(float v) { return __builtin_amdgcn_exp2f(v); }
__device__ __forceinline__ float gelu_tanh(float v) {
    constexpr float KG = 2.0f * LOG2E * 0.7978845608028654f;
    const float e = ex2(v * (KG + (KG * 0.044715f) * (v * v)));
    return v - v * __builtin_amdgcn_rcpf(1.0f + e);
}

#define XB_TMO      128
#define XB_XCNT(j)  (256  + 64 * (j))
#define XB_XSUB(j)  (1280 + 64 * (j))
#define XB_XGEN(j)  (2304 + 64 * (j))
#define XB_TOP      3328
#define XB_TOPGEN   3392
#define XCD_BAR_WORDS 3456
#define XB_SPIN_CAP (1u << 18)

__device__ __forceinline__ unsigned xb_ld(unsigned* p)              { return __hip_atomic_load(p, __ATOMIC_RELAXED, __HIP_MEMORY_SCOPE_AGENT); }
__device__ __forceinline__ unsigned xb_add(unsigned* p, unsigned v) { return __hip_atomic_fetch_add(p, v, __ATOMIC_RELAXED, __HIP_MEMORY_SCOPE_AGENT); }
__device__ __forceinline__ unsigned xb_xcc_id() { return (unsigned)__builtin_amdgcn_s_getreg((3 << 11) | 20) & 0xFu; }
#define XB_SPIN(cond, bar) do { unsigned _sp = 0; while (cond) { __builtin_amdgcn_s_sleep(1); \
    if ((++_sp & 255u) == 0u) { if (xb_ld(&(bar)[XB_TMO])) break; if (_sp > XB_SPIN_CAP) { atomicAdd(&(bar)[XB_TMO], 1u); break; } } } } while (0)

struct XcdBarrier {
    unsigned* bar; unsigned x;
    volatile LAS unsigned* st;
};

__device__ __forceinline__ XcdBarrier xcd_barrier_post(unsigned* bar, volatile LAS unsigned* st) {
    XcdBarrier b; b.bar = bar; b.x = xb_xcc_id(); b.st = st;
    if (threadIdx.x == 0) (void)xb_add(&bar[XB_XCNT(b.x)], 1u);
    return b;
}
__device__ __forceinline__ void xcd_barrier_complete(unsigned* bar, unsigned x, unsigned& nloc, unsigned& nx) {
    const unsigned G = gridDim.x * gridDim.y * gridDim.z;
    unsigned sum, cnt, mine, sp = 0u;
    for (;;) {
        sum = 0u; cnt = 0u; mine = 0u;
#pragma unroll
        for (unsigned j = 0; j < 16; ++j) { const unsigned c = xb_ld(&bar[XB_XCNT(j)]); sum += c; cnt += (c > 0u) ? 1u : 0u; mine = (j == x) ? c : mine; }
        if (sum == G) break;
        __builtin_amdgcn_s_sleep(1);
        if ((++sp & 255u) == 0u) { if (xb_ld(&bar[XB_TMO])) break; if (sp > XB_SPIN_CAP) { atomicAdd(&bar[XB_TMO], 1u); break; } }
    }
    nloc = mine > 0u ? mine : 1u; nx = cnt > 0u ? cnt : 1u;
}

__device__ __forceinline__ void xcd_barrier(const XcdBarrier& b) {
    asm volatile("s_waitcnt vmcnt(0)" ::: "memory");
    __syncthreads();
    if (threadIdx.x == 0) {
        unsigned* bar = b.bar;
        __builtin_amdgcn_s_waitcnt(0);
        unsigned nloc = b.st[0], nx = b.st[1];
        if (nloc == 0u) { xcd_barrier_complete(bar, b.x, nloc, nx); b.st[0] = nloc; b.st[1] = nx; }
        const unsigned old = xb_add(&bar[XB_XSUB(b.x)], 1u);
        const unsigned gen = old / nloc;
        if (old + 1u == (gen + 1u) * nloc) {
            __builtin_amdgcn_fence(__ATOMIC_RELEASE, "agent");
            asm volatile("s_waitcnt vmcnt(0)" ::: "memory");
            const unsigned og = xb_add(&bar[XB_TOP], 1u);
            const unsigned tg = og / nx;
            if (og + 1u == (tg + 1u) * nx) xb_add(&bar[XB_TOPGEN], 1u);
            else XB_SPIN(xb_ld(&bar[XB_TOPGEN]) == tg, bar);
            __builtin_amdgcn_fence(__ATOMIC_ACQUIRE, "agent");
            xb_add(&bar[XB_XGEN(b.x)], 1u);
            asm volatile("s_waitcnt vmcnt(0)" ::: "memory");
        } else {
            XB_SPIN(xb_ld(&bar[XB_XGEN(b.x)]) == gen, bar);
            __builtin_amdgcn_fence(__ATOMIC_ACQUIRE, "agent");
            asm volatile("s_waitcnt vmcnt(0)" ::: "memory");
        }
    }
    __syncthreads();
}

struct Frame {
    LAS unsigned char* lds;
    volatile LAS unsigned* MISC;
    gu32* ctl;
    int tid, lane, wave;
    int vcu, G;
    const float* in[39]; float* out; unsigned char* ws;
#ifdef PROBE_PH
    unsigned long long pt0_ = 0, pt1_ = 0;
#endif
};
#ifdef PROBE_PH
#define PB(k) do { if ((k) == PROBE_PH) F.pt0_ = __builtin_amdgcn_s_memtime(); } while (0)
#define PE(k) do { if ((k) == PROBE_PH) F.pt1_ = __builtin_amdgcn_s_memtime(); } while (0)
#else
#define PB(k) do { } while (0)
#define PE(k) do { } while (0)
#endif
enum { I_X = 0, I_C, I_ADAW0, I_ADAB0, I_WIN, I_LQ1, I_LK1, I_LQ2, I_LK2, I_SUBLN, I_WOUT, I_LN1G0, I_LN1B0, I_FG, I_FU, I_FD, I_LN2G0, I_LN2B0,
       I_ADAW1, I_ADAB1, I_ARE, I_AIM, I_LOGDT, I_BRE, I_BIM, I_CRE, I_CIM, I_DSKIP, I_WGLU, I_BGLU, I_LN1G1, I_LN1B1, I_RW, I_RB, I_EG, I_EU, I_ED, I_LN2G1, I_LN2B1 };

__device__ __forceinline__ void ph0_mods(Frame& F) {
    LAS float* sc = (LAS float*)(F.lds);
    LAS float* part = (LAS float*)(F.lds + 32768);
    float* mod = (float*)(F.ws + WS_MOD);
    if ((int)blockIdx.x < 192) {
        const float* c = F.in[I_C];
        for (int i = F.tid; i < BATCH * D; i += NWAVES * 64) { const float v = c[i]; sc[i] = v / (1.0f + expf(-v)); }
        __syncthreads();
        for (int it = blockIdx.x; it < 192; it += F.G) {
            const int l = it / 96, j0 = (it % 96) * 64;
            const float* W = F.in[l ? I_ADAW1 : I_ADAW0]; const float* bias = F.in[l ? I_ADAB1 : I_ADAB0];
            float acc[8];
#pragma unroll
            for (int b = 0; b < 8; ++b) acc[b] = 0.f;
            const int k0 = F.wave * 128;
            for (int kk = k0; kk < k0 + 128; kk += 16) { float w[16];
#pragma unroll
                for (int i = 0; i < 16; ++i) w[i] = __builtin_nontemporal_load(W + (size_t)(kk + i) * (6 * D) + j0 + F.lane);
#pragma unroll
                for (int i = 0; i < 16; ++i)
#pragma unroll
                    for (int b = 0; b < 8; ++b) acc[b] += sc[b * D + kk + i] * w[i]; }
#pragma unroll
            for (int b = 0; b < 8; ++b) part[(F.wave * 8 + b) * 64 + F.lane] = acc[b];
            __syncthreads();
            float s = 0.f;
#pragma unroll
            for (int w2 = 0; w2 < 8; ++w2) s += part[(w2 * 8 + F.wave) * 64 + F.lane];
            mod[(size_t)(l * 8 + F.wave) * (6 * D) + j0 + F.lane] = s + bias[j0 + F.lane];
            __syncthreads();
        }
    }
    const int gid = ((int)blockIdx.x - ((F.G >= 200) ? 192 : 0)) * (NWAVES * 64) + F.tid;
    if (gid >= 0 && gid < 64 * 64) {
        const int g = gid >> 6;
        const float ar = F.in[I_ARE][gid], ai = F.in[I_AIM][gid], dt = expf(F.in[I_LOGDT][g]);
        const float mag = expf(dt * ar); float sn, cs; sincosf(dt * ai, &sn, &cs);
        const float abr = mag * cs, abi = mag * sn, den = ar * ar + ai * ai, nr = abr - 1.0f, ni = abi;
        const float zr = (nr * ar + ni * ai) / den, zi = (ni * ar - nr * ai) / den;
        float* SA = (float*)(F.ws + WS_SSMA); float* SB = (float*)(F.ws + WS_SSMB);
        SA[gid * 2] = abr; SA[gid * 2 + 1] = abi;
#pragma unroll
        for (int c = 0; c < 16; ++c) { const float br = F.in[I_BRE][gid * 16 + c], bi = F.in[I_BIM][gid * 16 + c];
            SB[(gid * 16 + c) * 2] = zr * br - zi * bi; SB[(gid * 16 + c) * 2 + 1] = zr * bi + zi * br; }
    }
    const int tq = (int)blockIdx.x - ((F.G >= 225) ? 200 : 0);
    if (tq >= 0 && tq < 25) {
        const float* W; int ldw, K = D, N, n0 = 0;
        if (tq < 6) { W = F.in[I_WIN]; ldw = 3 * D; N = 512; n0 = 512 * tq; }
        else if (tq == 24) { W = F.in[I_WOUT]; ldw = D; N = D;
            if (F.wave == 0) { const float mw = wave_maxd(fabsf(F.in[I_SUBLN][F.lane])), clip = 4.0f * mw; if (F.lane == 0) { float* wsc = (float*)(F.ws + WS_WSC); wsc[30] = 127.0f / clip; wsc[62] = clip * (1.0f / 127.0f); } } }
        else if (tq == 6) { W = F.in[I_FG]; ldw = DFF; N = DFF; }
        else if (tq == 7) { W = F.in[I_FU]; ldw = DFF; N = DFF; }
        else if (tq < 16) { W = F.in[I_EG] + (size_t)(tq - 8) * D * DFE; ldw = DFE; N = DFE; }
        else { W = F.in[I_EU] + (size_t)(tq - 16) * D * DFE; ldw = DFE; N = DFE; }
        float v[32];
#pragma unroll
        for (int j = 0; j < 4; ++j)
#pragma unroll
            for (int i = 0; i < 8; ++i) v[j * 8 + i] = W[(size_t)((j * 8 + F.wave) * (K / 32)) * ldw + n0 + i * (N / 8) + F.lane];
        float ss = 0.f;
#pragma unroll
        for (int i = 0; i < 32; ++i) ss += v[i] * v[i];
        ss = wave_sum(ss);
        LAS float* red = (LAS float*)(F.lds + 65536);
        if (F.lane == 0) red[F.wave] = ss;
        __syncthreads();
        if (F.tid == 0) { float t = 0.f;
#pragma unroll
            for (int w2 = 0; w2 < 8; ++w2) t += red[w2];
            const float rms = sqrtf(t * (1.0f / 16384.0f)); float* wsc = (float*)(F.ws + WS_WSC);
            wsc[tq] = 127.0f / (I8_CLIP * rms); wsc[32 + tq] = (I8_CLIP * rms) * (1.0f / 127.0f); }
    }
}

struct TItem { const float* src; unsigned char* dst; int ldw, rowb; float f8s; };
__device__ __forceinline__ void titem_make(TItem& t, const float* W, int ldw, int K, int N, unsigned char* WT, int rowmap, int item, int lane, float f8s, int rowb = 0) {
    const int nblk = N / 32, kb = item / nblk, nb = item % nblk, k0 = 128 * kb, n0 = 32 * nb;
    const int r0 = rowmap == 0 ? n0 : ((n0 >> 7) * 256 + (n0 & 127) + (rowmap == 2 ? 128 : 0));
    t.src = W + (size_t)(k0 + 64 * (lane >> 5)) * ldw + n0 + (lane & 31); t.ldw = ldw; t.rowb = rowb ? rowb : K; t.f8s = f8s;
    t.dst = WT + (size_t)(r0 + (lane >> 3)) * t.rowb + (size_t)(k0 + 16 * (lane & 7));
}
__device__ __forceinline__ void titem_decode(Frame& F, TItem& t, int it, int lane) {
    constexpr int I_0 = 8 * 96, I_1 = 8 * 32, I_2 = 8 * 88, I_3 = 8 * 88, I_4 = 22 * 32, I_5 = 8 * 32, I_6 = 8 * 32;
    constexpr int I_7 = 8 * 44, I_8 = 8 * 44, I_9 = 11 * 32;
    unsigned char* ws = F.ws; int r = it; const float* wsc = (const float*)(ws + WS_WSC);
    if (r < I_0) { titem_make(t, F.in[I_WIN], 3 * D, D, 3 * D, ws + WS_W_IN, 0, r, lane, -wsc[(r % 96) >> 4]); return; } r -= I_0;
    if (r < I_1) { titem_make(t, F.in[I_WOUT], D, D, D, ws + WS_W_OUT, 0, r, lane, -wsc[24]); return; } r -= I_1;
    if (r < I_2) { titem_make(t, F.in[I_FG], DFF, D, DFF, ws + WS_W_F1, 1, r, lane, -wsc[6]); return; } r -= I_2;
    if (r < I_3) { titem_make(t, F.in[I_FU], DFF, D, DFF, ws + WS_W_F1, 2, r, lane, -wsc[7]); return; } r -= I_3;
    if (r < I_4) { titem_make(t, F.in[I_FD], D, DFF, D, ws + WS_W_F2, 0, r, lane, S8_WF2); return; } r -= I_4;
    if (r < I_5) { titem_make(t, F.in[I_WGLU], 2 * D, D, D, ws + WS_W_GLU, 1, r, lane, S8_WGLU); return; } r -= I_5;
    if (r < I_6) { titem_make(t, F.in[I_WGLU] + D, 2 * D, D, D, ws + WS_W_GLU, 2, r, lane, S8_WGLU); return; } r -= I_6;
    const int e = r / (I_7 + I_8 + I_9); r -= e * (I_7 + I_8 + I_9);
    if (r < I_7) { titem_make(t, F.in[I_EG] + (size_t)e * D * DFE, DFE, D, DFE, ws + WS_W_E1 + (size_t)e * 2 * DFE * D, 1, r, lane, -wsc[8 + e]); return; } r -= I_7;
    if (r < I_8) { titem_make(t, F.in[I_EU] + (size_t)e * D * DFE, DFE, D, DFE, ws + WS_W_E1 + (size_t)e * 2 * DFE * D, 2, r, lane, -wsc[16 + e]); return; } r -= I_8;
    titem_make(t, F.in[I_ED] + (size_t)e * DFE * D, D, DFE, D, ws + WS_W_E2 + (size_t)e * D * DFE_PAD, 0, r, lane, S8_WE2, DFE_PAD);
}
constexpr int NIT_ALL = 8 * 96 + 8 * 32 + 2 * 8 * 88 + 22 * 32 + 2 * 8 * 32 + NEXP * (2 * 8 * 44 + 11 * 32);
__device__ __forceinline__ void titem_write(const TItem& cur, const float (&cv)[64], LAS unsigned char* scr, int lane) {
    v4u o[4];
    if (cur.f8s > 0.f) { const float sw = cur.f8s;
#pragma unroll
        for (int j = 0; j < 16; ++j) o[j >> 2][j & 3] = pg8::pk4f8(cv[4 * j] * sw, cv[4 * j + 1] * sw, cv[4 * j + 2] * sw, cv[4 * j + 3] * sw);
    } else { const float sw = -cur.f8s;
#pragma unroll
        for (int j = 0; j < 16; ++j) o[j >> 2][j & 3] = pg8::pk4i8(cv[4 * j] * sw, cv[4 * j + 1] * sw, cv[4 * j + 2] * sw, cv[4 * j + 3] * sw);
    }
    LAS unsigned char* wp = scr + (lane & 31) * 144 + 64 * (lane >> 5);
#pragma unroll
    for (int j = 0; j < 4; ++j) *(LAS v4u*)(wp + 16 * j) = o[j];
    LDS_WAIT(); asm volatile("" ::: "memory");
    const LAS unsigned char* rp = scr + (lane >> 3) * 144 + 16 * (lane & 7);
#pragma unroll
    for (int j = 0; j < 4; ++j) { const v4u w = *(const LAS v4u*)(rp + 8 * j * 144); *(GAS v4u*)(cur.dst + (size_t)(8 * j) * cur.rowb) = w; }
    LDS_WAIT(); asm volatile("" ::: "memory");
}
__device__ __forceinline__ void transpose_items(Frame& F, int it0, int it1, LAS unsigned char* scr) {
    const int gw = F.vcu * NWAVES + F.wave, NGW = F.G * NWAVES, lane = F.lane;
    const int NITEMS = it1;
    TItem ti[2]; float v[2][64];
#define TLOAD(slot, itx) do { if ((itx) < NITEMS) { titem_decode(F, ti[slot], (itx), lane); _Pragma("unroll") for (int i = 0; i < 64; ++i) v[slot][i] = __builtin_nontemporal_load(ti[slot].src + (size_t)i * ti[slot].ldw); } } while (0)
    TLOAD(0, it0 + gw);
    for (int it = it0 + gw; it < NITEMS; it += 2 * NGW) {
        TLOAD(1, it + NGW); titem_write(ti[0], v[0], scr, lane);
        if (it + NGW >= NITEMS) break;
        TLOAD(0, it + 2 * NGW); titem_write(ti[1], v[1], scr, lane);
    }
#undef TLOAD
}
__device__ __forceinline__ void ph1_prologue(Frame& F) {
    const int gw = F.vcu * NWAVES + F.wave, NGW = F.G * NWAVES, lane = F.lane;
    unsigned char* ws = F.ws;
    PB(100); transpose_items(F, 0, NIT_ALL, F.lds + RING_OFF + F.wave * 16384); __syncthreads(); PE(100);
    for (int i = (int)blockIdx.x * (NWAVES * 64) + F.tid; i < NEXP * D * 8; i += F.G * NWAVES * 64)
        *(v4u*)(ws + WS_W_E2 + (size_t)(i >> 3) * DFE_PAD + DFE + 16 * (i & 7)) = (v4u){0u, 0u, 0u, 0u};
    const float* mod0 = (const float*)(ws + WS_MOD);
    unsigned char* H0 = ws + WS_B; float* RS0 = (float*)(ws + WS_RS0);
    {
        const int WPB = F.G, bq = gw / WPB, r0 = gw % WPB; const float* mb = mod0 + (size_t)bq * (6 * D);
        f32x4 sc1[4], shv[4];
#pragma unroll
        for (int j = 0; j < 4; ++j) { const int col = 4 * lane + 256 * j; shv[j] = *(const f32x4*)(mb + col); sc1[j] = 1.0f + *(const f32x4*)(mb + D + col); }
        for (int t0 = r0; t0 < SEQ; t0 += 8 * WPB) {
            f32x4 xr[8][4];
#pragma unroll
            for (int i = 0; i < 8; ++i) { const int t = t0 + i * WPB; if (t < SEQ) {
#pragma unroll
                for (int j = 0; j < 4; ++j) xr[i][j] = __builtin_nontemporal_load((const f32x4*)(F.in[I_X] + ((size_t)bq * SEQ + t) * D + 4 * lane + 256 * j)); } }
#pragma unroll
            for (int i = 0; i < 8; ++i) { const int t = t0 + i * WPB; if (t < SEQ) { const size_t m = (size_t)bq * SEQ + t;
                f32x4 h[4]; float am = 0.f;
#pragma unroll
                for (int j = 0; j < 4; ++j) { h[j] = xr[i][j] * sc1[j] + shv[j]; am = fmaxf(am, fmaxf(fmaxf(fabsf(h[j][0]), fabsf(h[j][1])), fmaxf(fabsf(h[j][2]), fabsf(h[j][3])))); }
                am = fmaxf(wave_maxd(am), 1e-20f); const float qs = 126.999f * __builtin_amdgcn_rcpf(am), MG = 12582912.0f;
#pragma unroll
                for (int j = 0; j < 4; ++j) { unsigned bq4[4];
#pragma unroll
                    for (int e = 0; e < 4; ++e) bq4[e] = __builtin_bit_cast(unsigned, h[j][e] * qs + MG);
                    *(unsigned*)(H0 + m * D + 4 * lane + 256 * j) = __builtin_amdgcn_perm(__builtin_amdgcn_perm(bq4[3], bq4[2], 0x0c0c0400u), __builtin_amdgcn_perm(bq4[1], bq4[0], 0x0c0c0400u), 0x05040100u); }
                if (lane == 0) RS0[m] = am * (1.0f / 127.0f); } }
        }
    }
}

__device__ __forceinline__ f32x4 ld4h(const h16* p) { const v2u w = *(const v2u*)p; return (f32x4){hlo(w.x), hhi(w.x), hlo(w.y), hhi(w.y)}; }
__device__ __forceinline__ void ld8h(const h16* p, float* f) { const v4u w = *(const v4u*)p; f[0] = hlo(w.x); f[1] = hhi(w.x); f[2] = hlo(w.y); f[3] = hhi(w.y); f[4] = hlo(w.z); f[5] = hhi(w.z); f[6] = hlo(w.w); f[7] = hhi(w.w); }
__device__ __forceinline__ float lane_reduce64(float (&v)[64], int lane) {
#pragma unroll
    for (int s = 0; s < 6; ++s) { const int half = 32 >> s; const bool up = (lane & half) != 0;
#pragma unroll
        for (int i = 0; i < half; ++i) { const float lo = v[i], hi = v[i + half]; const float send = up ? lo : hi, keep = up ? hi : lo; v[i] = keep + __shfl_xor(send, half); } }
    return v[0];
}
__device__ __forceinline__ float lam_value(Frame& F) {
    float s1 = 0.f, s2 = 0.f;
#pragma unroll 4
    for (int i = 0; i < 32; ++i) { s1 += F.in[I_LQ1][i] * F.in[I_LK1][i]; s2 += F.in[I_LQ2][i] * F.in[I_LK2][i]; }
    return expf(s1) - expf(s2) + 0.2f;
}
template <bool DIFF, bool DIL> __device__ __forceinline__ void ph4_attn_naive(Frame& F) {
    const h16* QKV = (const h16*)(F.ws + WS_A); h16* O = (h16*)(F.ws + WS_B);
    const int gw = F.vcu * NWAVES + F.wave, NGW = F.G * NWAVES, lane = F.lane;
    const float lam = lam_value(F);
    const float sub_w = F.in[I_SUBLN][lane] * 0.8f;
    if (DIFF) for (int it = gw; it < BATCH * 8 * SEQ; it += NGW) {
        const int bh = it >> 12, r = it & 4095, i = (bh & 1) ? 4095 - r : r, b = bh >> 3, h = bh & 7;
        const size_t rowq = (size_t)(b * SEQ + i) * 3072;
        const float slope2 = exp2f(-0.5f * (float)(h + 1)) * LOG2E;
        float res[2];
#pragma unroll
        for (int mp = 0; mp < 2; ++mp) {
            float q[32];
#pragma unroll
            for (int d8 = 0; d8 < 4; ++d8) ld8h(QKV + rowq + h * 64 + mp * 32 + d8 * 8, q + d8 * 8);
            float acc[64];
#pragma unroll
            for (int d = 0; d < 64; ++d) acc[d] = 0.f;
            float mrun = -INFINITY, l = 0.f;
            for (int j = lane; j <= i; j += 64) {
                const size_t rowk = (size_t)(b * SEQ + j) * 3072;
                float s = 0.f;
#pragma unroll
                for (int d8 = 0; d8 < 4; ++d8) { float kf[8]; ld8h(QKV + rowk + 512 + h * 64 + mp * 32 + d8 * 8, kf);
#pragma unroll
                    for (int e = 0; e < 8; ++e) s += q[d8 * 8 + e] * kf[e]; }
                s -= slope2 * (float)(i - j);
                const float mn = fmaxf(mrun, s), alpha = ex2(mrun - mn), p = ex2(s - mn);
                l = l * alpha + p; mrun = mn;
#pragma unroll
                for (int d8 = 0; d8 < 8; ++d8) { float vf[8]; ld8h(QKV + rowk + 1024 + h * 64 + d8 * 8, vf);
#pragma unroll
                    for (int e = 0; e < 8; ++e) acc[d8 * 8 + e] = acc[d8 * 8 + e] * alpha + p * vf[e]; }
            }
            const float Mx = wave_max(mrun), scl = (mrun == -INFINITY) ? 0.f : ex2(mrun - Mx), L = wave_sum(l * scl);
#pragma unroll
            for (int d = 0; d < 64; ++d) acc[d] *= scl;
            const float mine = lane_reduce64(acc, lane);
            res[mp] = mine / L;
        }
        const float o = res[0] - lam * res[1];
        const float ss = wave_sum(o * o);
        const float y = o * (1.0f / sqrtf(ss * (1.0f / 64.0f) + LN_EPS)) * sub_w;
        O[(size_t)(b * SEQ + i) * D + h * 64 + lane] = (h16)(pk2h(y, 0.f) & 0xffffu);
    }
    if (DIL) for (int it = gw; it < BATCH * 8 * SEQ; it += NGW) {
        const int bh = it >> 12, i = it & 4095, b = bh >> 3, h = bh & 7;
        const size_t rowq = (size_t)(b * SEQ + i) * 3072;
        const float slope2 = exp2f(-0.5f * (float)(h + 9)) * LOG2E;
        float q[64];
#pragma unroll
        for (int d8 = 0; d8 < 8; ++d8) ld8h(QKV + rowq + 1536 + h * 64 + d8 * 8, q + d8 * 8);
        float og[3], lse[3];
#pragma unroll
        for (int g = 0; g < 3; ++g) {
            const int dil = (g == 0) ? 1 : (g == 1) ? 4 : 16;
            float acc[64];
#pragma unroll
            for (int d = 0; d < 64; ++d) acc[d] = 0.f;
            float mrun = -INFINITY, l = 0.f;
            for (int jj = lane; jj <= 128; jj += 64) {
                const int t = i - jj * dil;
                if (t >= 0) {
                    const size_t rowk = (size_t)(b * SEQ + t) * 3072;
                    float s = 0.f;
#pragma unroll
                    for (int d8 = 0; d8 < 8; ++d8) { float kf[8]; ld8h(QKV + rowk + 2048 + h * 64 + d8 * 8, kf);
#pragma unroll
                        for (int e = 0; e < 8; ++e) s += q[d8 * 8 + e] * kf[e]; }
                    s -= slope2 * (float)(jj * dil);
                    const float mn = fmaxf(mrun, s), alpha = ex2(mrun - mn), p = ex2(s - mn);
                    l = l * alpha + p; mrun = mn;
#pragma unroll
                    for (int d8 = 0; d8 < 8; ++d8) { float vf[8]; ld8h(QKV + rowk + 2560 + h * 64 + d8 * 8, vf);
#pragma unroll
                        for (int e = 0; e < 8; ++e) acc[d8 * 8 + e] = acc[d8 * 8 + e] * alpha + p * vf[e]; }
                }
            }
            const float Mx = wave_max(mrun), scl = (mrun == -INFINITY) ? 0.f : ex2(mrun - Mx), L = wave_sum(l * scl);
#pragma unroll
            for (int d = 0; d < 64; ++d) acc[d] *= scl;
            const float mine = lane_reduce64(acc, lane);
            og[g] = mine / L; lse[g] = Mx + log2f(L);
        }
        const float mx = fmaxf(lse[0], fmaxf(lse[1], lse[2]));
        const float w0 = ex2(lse[0] - mx), w1 = ex2(lse[1] - mx), w2 = ex2(lse[2] - mx);
        const float y = (w0 * og[0] + w1 * og[1] + w2 * og[2]) / (w0 + w1 + w2);
        O[(size_t)(b * SEQ + i) * D + 512 + h * 64 + lane] = (h16)(pk2h(y, 0.f) & 0xffffu);
    }
}


typedef _Float16 hf8 __attribute__((ext_vector_type(8)));
typedef float f32x16 __attribute__((ext_vector_type(16)));
__device__ __forceinline__ hf8 ldf8(const h16* p) { return __builtin_bit_cast(hf8, *(const v4u*)p); }
#define MFMA32(a, b, c) __builtin_amdgcn_mfma_f32_32x32x16_f16((a), (b), (c), 0, 0, 0)
typedef short v4i16_t __attribute__((ext_vector_type(4)));
typedef _Float16 hf4 __attribute__((ext_vector_type(4)));
__device__ __forceinline__ void v_stage(LAS unsigned char* vl, const v4u (&vn)[4], int lane) {
#pragma unroll
    for (int i = 0; i < 4; ++i) *(LAS v4u*)(vl + ((lane & 7) >> 2) * 2048 + ((lane >> 3) + 8 * i) * 64 + (lane & 3) * 16) = vn[i];
}
__device__ __forceinline__ hf8 v_frag(const LAS unsigned char* trb, int dt, int s) {
    const v4i16_t lo = __builtin_amdgcn_ds_read_tr16_b64_v4i16((LAS v4i16_t*)(trb + dt * 2048 + (16 * s) * 64));
    const v4i16_t hi = __builtin_amdgcn_ds_read_tr16_b64_v4i16((LAS v4i16_t*)(trb + dt * 2048 + (16 * s + 4) * 64));
    return __builtin_shufflevector(__builtin_bit_cast(hf4, lo), __builtin_bit_cast(hf4, hi), 0, 1, 2, 3, 4, 5, 6, 7);
}
__device__ __forceinline__ float rowmax16(const f32x16& s) {
    float m;
    asm("s_nop 15\n\ts_nop 7\n\t"
                 "v_max3_f32 %0, %1, %2, %3\n\tv_max3_f32 %0, %0, %4, %5\n\tv_max3_f32 %0, %0, %6, %7\n\tv_max3_f32 %0, %0, %8, %9\n\t"
                 "v_max3_f32 %0, %0, %10, %11\n\tv_max3_f32 %0, %0, %12, %13\n\tv_max3_f32 %0, %0, %14, %15\n\tv_max_f32 %0, %0, %16"
                 : "=&v"(m)
                 : "v"(s[0]), "v"(s[1]), "v"(s[2]), "v"(s[3]), "v"(s[4]), "v"(s[5]), "v"(s[6]), "v"(s[7]), "v"(s[8]), "v"(s[9]), "v"(s[10]), "v"(s[11]), "v"(s[12]), "v"(s[13]), "v"(s[14]), "v"(s[15]));
    return m;
}
constexpr float LAZY_THR = 8.0f;
__device__ __forceinline__ float half_max(float v) { auto rr = __builtin_amdgcn_permlane32_swap(__float_as_uint(v), __float_as_uint(v), false, false); return fmaxf(__uint_as_float(rr[0]), __uint_as_float(rr[1])); }
__device__ __forceinline__ float half_sum(float v) { auto rr = __builtin_amdgcn_permlane32_swap(__float_as_uint(v), __float_as_uint(v), false, false); return __uint_as_float(rr[0]) + __uint_as_float(rr[1]); }
constexpr float SKIP_BITS = 24.0f;
__device__ __forceinline__ void ph4_diff_mfma(Frame& F) {
    const h16* QKV = (const h16*)(F.ws + WS_A); const h16* KA = (const h16*)(F.ws + WS_KA); h16* O = (h16*)(F.ws + WS_B);
    const float qO = ((const float*)(F.ws + WS_WSC))[30];
    int lane_ = F.lane; asm volatile("" : "+v"(lane_));
    const int gw = F.vcu * NWAVES + F.wave, NGW = F.G * NWAVES, lane = lane_, r32 = lane & 31, hi = lane >> 5;
    const float lam = lam_value(F);
    LAS unsigned char* vl = F.lds + RING_OFF + F.wave * 4096;
    const LAS unsigned char* trb = vl + (8 * hi + ((lane & 15) >> 2)) * 64 + (16 * ((lane >> 4) & 1) + 4 * (lane & 3)) * 2;
    for (int k = 0; k < 4; ++k) {
        if (gw >= 2048) break;
        const int ty = gw & 1, qp = (gw >> 1) & 127, b = gw >> 8;
        const int h = (ty == 0) ? ((k == 0) ? 7 : (k == 1) ? 0 : (k == 2) ? 4 : 3) : ((k == 0) ? 6 : (k == 1) ? 1 : (k == 2) ? 5 : 2);
        const int bh = b * 8 + h, qt = (k & 1) ? 127 - qp : qp, i0 = qt * 32;
        const float slope2 = exp2f(-0.5f * (float)(h + 1)) * LOG2E;
        const h16* qrow = QKV + (size_t)(b * SEQ + i0 + r32) * 3072 + h * 64 + 8 * hi;
        hf8 qf[2][2];
#pragma unroll
        for (int mp = 0; mp < 2; ++mp)
#pragma unroll
            for (int sl = 0; sl < 2; ++sl) qf[mp][sl] = ldf8(qrow + mp * 32 + sl * 16);
        float need;
        { float sq[2];
#pragma unroll
            for (int mp = 0; mp < 2; ++mp) { float a = 0.f;
#pragma unroll
                for (int sl = 0; sl < 2; ++sl)
#pragma unroll
                    for (int e = 0; e < 8; ++e) { const float v = (float)qf[mp][sl][e]; a += v * v; }
                a = half_sum(a);
                const float km = __uint_as_float(__hip_atomic_load(F.ctl + CW_KMAX + (b * 8 + h) * 2 + mp, RLX_AGENT));
                sq[mp] = sqrtf(a * km) * 1.001f + 0.01f; }
            need = fmaxf(sq[0], sq[1]) + SKIP_BITS - log2f(1.0f - exp2f(-slope2)); }
        float coff[16];
#pragma unroll
        for (int r = 0; r < 16; ++r) coff[r] = slope2 * (float)(16 * (r >> 3) + 8 * hi + (r & 7));
        f32x16 o[2][2];
#pragma unroll
        for (int mp = 0; mp < 2; ++mp)
#pragma unroll
            for (int dt = 0; dt < 2; ++dt)
#pragma unroll
                for (int r = 0; r < 16; ++r) o[mp][dt][r] = 0.f;
        float mrun[2] = {0.f, 0.f}, lrun[2] = {0.f, 0.f};
        const h16* kbase = KA + ((size_t)(bh * 128) * 4 * 64 + lane) * 8;
        const h16* vbase = QKV + (size_t)(b * SEQ + (lane >> 3)) * 3072 + 1024 + h * 64 + 8 * (lane & 7);
        hf8 kn[2][2]; v4u vn[4];
        { const h16* kb2 = kbase + (size_t)(qt * 4) * 512; const h16* vb2 = vbase + (size_t)(32 * qt) * 3072;
#pragma unroll
            for (int mp = 0; mp < 2; ++mp)
#pragma unroll
                for (int sl = 0; sl < 2; ++sl) kn[mp][sl] = ldf8(kb2 + (mp * 2 + sl) * 512);
#pragma unroll
            for (int i = 0; i < 4; ++i) vn[i] = *(const v4u*)(vb2 + (size_t)(8 * i) * 3072); }
        for (int kt = qt; kt >= 0; --kt) {
            hf8 kf[2][2];
#pragma unroll
            for (int a = 0; a < 2; ++a)
#pragma unroll
                for (int c = 0; c < 2; ++c) kf[a][c] = kn[a][c];
            asm volatile("" ::: "memory");
            v_stage(vl, vn, lane);
            asm volatile("" ::: "memory");
            if (kt > 0) {
                const h16* kb2 = kbase + (size_t)((kt - 1) * 4) * 512; const h16* vb2 = vbase + (size_t)(32 * (kt - 1)) * 3072;
#pragma unroll
                for (int mp = 0; mp < 2; ++mp)
#pragma unroll
                    for (int sl = 0; sl < 2; ++sl) kn[mp][sl] = ldf8(kb2 + (mp * 2 + sl) * 512);
#pragma unroll
                for (int i = 0; i < 4; ++i) vn[i] = *(const v4u*)(vb2 + (size_t)(8 * i) * 3072);
            }
            hf8 vf[2][2];
#pragma unroll
            for (int dt = 0; dt < 2; ++dt)
#pragma unroll
                for (int s2 = 0; s2 < 2; ++s2) vf[dt][s2] = v_frag(trb, dt, s2);
            asm volatile("" ::: "memory");
            const float tb = slope2 * (float)(32 * kt - i0);
            const bool diag = (kt == qt);
            f32x16 sc[2];
#pragma unroll
            for (int mp = 0; mp < 2; ++mp) { const float tbm = tb - mrun[mp];
#pragma unroll
                for (int r = 0; r < 16; ++r) sc[mp][r] = coff[r] + tbm;
                if (diag) {
#pragma unroll
                    for (int r = 0; r < 16; ++r) if (16 * (r >> 3) + 8 * hi + (r & 7) > r32) sc[mp][r] = -INFINITY;
                } }
            sc[0] = MFMA32(kf[0][0], qf[0][0], sc[0]); sc[1] = MFMA32(kf[1][0], qf[1][0], sc[1]);
            sc[0] = MFMA32(kf[0][1], qf[0][1], sc[0]); sc[1] = MFMA32(kf[1][1], qf[1][1], sc[1]);
            hf8 pb[2][2];
#pragma unroll
            for (int mp = 0; mp < 2; ++mp) {
                const float mx = half_max(rowmax16(sc[mp]));
                if (diag || __any(mx > LAZY_THR)) {
                    const float dl = diag ? mx : fmaxf(mx, 0.f), alpha = ex2(-dl); mrun[mp] += dl; lrun[mp] *= alpha;
#pragma unroll
                    for (int r = 0; r < 16; ++r) sc[mp][r] -= dl;
#pragma unroll
                    for (int dt = 0; dt < 2; ++dt)
#pragma unroll
                        for (int r = 0; r < 16; ++r) o[mp][dt][r] *= alpha; }
                float ls = 0.f;
#pragma unroll
                for (int r = 0; r < 16; ++r) { sc[mp][r] = ex2(sc[mp][r]); ls += sc[mp][r]; }
                lrun[mp] += ls;
                v4u p0, p1;
                p0.x = pk2h(sc[mp][0], sc[mp][1]); p0.y = pk2h(sc[mp][2], sc[mp][3]); p0.z = pk2h(sc[mp][4], sc[mp][5]); p0.w = pk2h(sc[mp][6], sc[mp][7]);
                p1.x = pk2h(sc[mp][8], sc[mp][9]); p1.y = pk2h(sc[mp][10], sc[mp][11]); p1.z = pk2h(sc[mp][12], sc[mp][13]); p1.w = pk2h(sc[mp][14], sc[mp][15]);
                pb[mp][0] = __builtin_bit_cast(hf8, p0); pb[mp][1] = __builtin_bit_cast(hf8, p1);
            }
#pragma unroll
            for (int s2 = 0; s2 < 2; ++s2)
#pragma unroll
                for (int mp = 0; mp < 2; ++mp)
#pragma unroll
                    for (int dt = 0; dt < 2; ++dt) o[mp][dt] = MFMA32(vf[dt][s2], pb[mp][s2], o[mp][dt]);
            if (__all(slope2 * (float)(i0 + 1 - 32 * kt) >= need - fminf(mrun[0], mrun[1]))) break;
        }
        const float l0 = half_sum(lrun[0]), l1 = half_sum(lrun[1]);
        const float i0l = __builtin_amdgcn_rcpf(l0), i1l = lam * __builtin_amdgcn_rcpf(l1);
        float ss = 0.f;
#pragma unroll
        for (int dt = 0; dt < 2; ++dt)
#pragma unroll
            for (int r = 0; r < 16; ++r) { const float v = o[0][dt][r] * i0l - o[1][dt][r] * i1l; o[0][dt][r] = v; ss += v * v; }
        ss = half_sum(ss);
        const float rstd = 0.8f * __builtin_amdgcn_rsqf(ss * (1.0f / 64.0f) + LN_EPS);
        unsigned char* orow = (unsigned char*)O + (size_t)(b * SEQ + i0 + r32) * D + h * 64;
        const float rq = rstd * qO;
#pragma unroll
        for (int dt = 0; dt < 2; ++dt)
#pragma unroll
            for (int gp = 0; gp < 2; ++gp) { unsigned w[2];
#pragma unroll
                for (int e = 0; e < 2; ++e) { const int g = 2 * gp + e, d = 32 * dt + 8 * g + 4 * hi; const f32x4 sw = *(const f32x4*)(F.in[I_SUBLN] + d);
                    w[e] = pg8::pk4i8(o[0][dt][4 * g] * rq * sw[0], o[0][dt][4 * g + 1] * rq * sw[1], o[0][dt][4 * g + 2] * rq * sw[2], o[0][dt][4 * g + 3] * rq * sw[3]); }
                const auto sx = __builtin_amdgcn_permlane32_swap(w[0], w[1], false, false);
                *(v2u*)(orow + 32 * dt + 16 * gp + 8 * hi) = (v2u){sx[0], sx[1]}; }
    }
}

template <int MODE> __device__ __forceinline__ void dil_pass(Frame& F) {
    constexpr int STR = (MODE == 0) ? 1 : (MODE == 1) ? 4 : 16, NT = (MODE == 0) ? 5 : 4, LO = (MODE == 0) ? 0 : 33, NU = BATCH * 8 * 128;
    const h16* QKV = (const h16*)(F.ws + WS_A); h16* O = (h16*)(F.ws + WS_B);
    const float qO = ((const float*)(F.ws + WS_WSC))[30];
    const h16* KB = (MODE == 0) ? (const h16*)(F.ws + WS_KB1) : (MODE == 1) ? (const h16*)(F.ws + WS_KB4) : (const h16*)(F.ws + WS_KB16);
    h16* PO1 = (h16*)F.out; h16* PO2 = PO1 + (size_t)BATCH * 8 * SEQ * 64; float* PM1 = (float*)(PO2 + (size_t)BATCH * 8 * SEQ * 64); float* PM2 = PM1 + (size_t)BATCH * 8 * SEQ * 2;
    int lane_ = F.lane; asm volatile("" : "+v"(lane_));
    const int gw = F.vcu * NWAVES + F.wave, NGW = F.G * NWAVES, lane = lane_, r32 = lane & 31, hi = lane >> 5;
    LAS unsigned char* vl = F.lds + RING_OFF + F.wave * 4096;
    const LAS unsigned char* trb = vl + (8 * hi + ((lane & 15) >> 2)) * 64 + (16 * ((lane >> 4) & 1) + 4 * (lane & 3)) * 2;
#define DU_BH(i) ((i) >> 7)
#define DU_RR(i) ((MODE == 0) ? 0 : (MODE == 1) ? (((i) & 127) >> 5) : (((i) & 127) >> 3))
#define DU_QB(i) ((MODE == 0) ? ((i) & 127) : (MODE == 1) ? ((i) & 31) : ((i) & 7))
#define DU_KB0(i) ((MODE == 0) ? DU_QB(i) : DU_QB(i) - 1)
#define DU_NT(i) ((DU_KB0(i) + 1 < NT) ? DU_KB0(i) + 1 : NT)
#define DU_LOADQ(i, q) do { const int bh_ = DU_BH(i), tq_ = STR * (32 * DU_QB(i) + r32) + DU_RR(i); \
        const h16* qr_ = QKV + (size_t)((bh_ >> 3) * SEQ + tq_) * 3072 + 1536 + (bh_ & 7) * 64 + 8 * hi; \
        _Pragma("unroll") for (int sl_ = 0; sl_ < 4; ++sl_) q[sl_] = ldf8(qr_ + sl_ * 16); } while (0)
#define DU_LOADKV(i, kb) do { const int bh_ = DU_BH(i), rr_ = DU_RR(i), ub_ = (MODE == 0) ? 0 : (MODE == 1) ? rr_ * 32 : rr_ * 8; \
        const h16* kp_ = KB + ((size_t)((bh_ * 128 + ub_ + (kb)) * 4) * 64 + lane) * 8; \
        const h16* vp_ = QKV + (size_t)((bh_ >> 3) * SEQ + STR * (32 * (kb) + (lane >> 3)) + rr_) * 3072 + 2560 + (bh_ & 7) * 64 + 8 * (lane & 7); \
        _Pragma("unroll") for (int sl_ = 0; sl_ < 4; ++sl_) kn[sl_] = ldf8(kp_ + sl_ * 512); \
        _Pragma("unroll") for (int i_ = 0; i_ < 4; ++i_) vn[i_] = *(const v4u*)(vp_ + (size_t)(STR * 8 * i_) * 3072); } while (0)
    int idx = gw; if (idx >= NU) return;
    hf8 kn[4]; v4u vn[4];
    if (DU_NT(idx) > 0) DU_LOADKV(idx, DU_KB0(idx));
    for (;;) {
        const int nidx = idx + NGW; const bool hn = nidx < NU;
        const int bh = DU_BH(idx), b = bh >> 3, h = bh & 7, rr = DU_RR(idx), qb = DU_QB(idx), kb0 = DU_KB0(idx), ntile = DU_NT(idx);
        const float sS = exp2f(-0.5f * (float)(h + 9)) * LOG2E * (float)STR;
        const int tq = STR * (32 * qb + r32) + rr;
        hf8 qf[4];
        DU_LOADQ(idx, qf);
        const size_t prw = (size_t)bh * SEQ + tq;
        float pm1 = 0.f, pl1 = 0.f, pm2 = 0.f, pl2 = 0.f;
        v2u pa8[8], pc8[8];
        if (MODE == 2) { pm1 = PM1[prw * 2]; pl1 = PM1[prw * 2 + 1]; pm2 = PM2[prw * 2]; pl2 = PM2[prw * 2 + 1];
#pragma unroll
            for (int k8 = 0; k8 < 8; ++k8) { const int d = 32 * (k8 >> 2) + 8 * (k8 & 3) + 4 * hi; pa8[k8] = *(const v2u*)(PO1 + prw * 64 + d); pc8[k8] = *(const v2u*)(PO2 + prw * 64 + d); } }
        float cb[16];
#pragma unroll
        for (int r = 0; r < 16; ++r) { const int ko = 16 * (r >> 3) + 8 * hi + (r & 7), dd = r32 - ko;
            const float lg = (MODE == 0) ? (((dd & 15) == 0) ? 1.5849625007211562f : ((dd & 3) == 0) ? 1.0f : 0.0f) : (MODE == 1) ? (((dd & 3) == 0) ? 1.0f : 0.0f) : 0.0f;
            cb[r] = sS * (float)ko + lg; }
        f32x16 o[2];
#pragma unroll
        for (int dt = 0; dt < 2; ++dt)
#pragma unroll
            for (int r = 0; r < 16; ++r) o[dt][r] = 0.f;
        float mrun = 0.f, lrun = 0.f; bool started = false;
        for (int j = 0; j < ntile; ++j) {
            const int kb = kb0 - j;
            hf8 kf[4];
#pragma unroll
            for (int sl = 0; sl < 4; ++sl) kf[sl] = kn[sl];
            asm volatile("" ::: "memory");
            v_stage(vl, vn, lane);
            asm volatile("" ::: "memory");
            if (j + 1 < ntile) DU_LOADKV(idx, kb - 1);
            else if (hn && DU_NT(nidx) > 0) DU_LOADKV(nidx, DU_KB0(nidx));
            hf8 vf[2][2];
#pragma unroll
            for (int dt = 0; dt < 2; ++dt)
#pragma unroll
                for (int s2 = 0; s2 < 2; ++s2) vf[dt][s2] = v_frag(trb, dt, s2);
            asm volatile("" ::: "memory");
            const float tb = sS * (float)(32 * (kb - qb)) - mrun;
            f32x16 s;
#pragma unroll
            for (int r = 0; r < 16; ++r) s[r] = cb[r] + tb;
            if (j == 0 || j == NT - 1) {
                const int dl0 = 32 * (qb - kb) + r32;
#pragma unroll
                for (int r = 0; r < 16; ++r) { const int dl = dl0 - (16 * (r >> 3) + 8 * hi + (r & 7)); if (dl < LO || dl > 128) s[r] = -INFINITY; }
            }
#pragma unroll
            for (int sl = 0; sl < 4; ++sl) s = MFMA32(kf[sl], qf[sl], s);
            const float mx = half_max(rowmax16(s));
            const bool fresh = !started && mx > -INFINITY;
            if (__any(fresh || mx > LAZY_THR)) {
                const float dl = fresh ? mx : fmaxf(mx, 0.f), alpha = ex2(-dl); mrun += dl; lrun *= alpha; started = started || fresh;
#pragma unroll
                for (int r = 0; r < 16; ++r) s[r] -= dl;
#pragma unroll
                for (int dt = 0; dt < 2; ++dt)
#pragma unroll
                    for (int r = 0; r < 16; ++r) o[dt][r] *= alpha; }
            float ls = 0.f;
#pragma unroll
            for (int r = 0; r < 16; ++r) { s[r] = ex2(s[r]); ls += s[r]; }
            lrun += ls;
            v4u p0, p1;
            p0.x = pk2h(s[0], s[1]); p0.y = pk2h(s[2], s[3]); p0.z = pk2h(s[4], s[5]); p0.w = pk2h(s[6], s[7]);
            p1.x = pk2h(s[8], s[9]); p1.y = pk2h(s[10], s[11]); p1.z = pk2h(s[12], s[13]); p1.w = pk2h(s[14], s[15]);
            const hf8 pb0 = __builtin_bit_cast(hf8, p0), pb1 = __builtin_bit_cast(hf8, p1);
#pragma unroll
            for (int dt = 0; dt < 2; ++dt) { o[dt] = MFMA32(vf[dt][0], pb0, o[dt]); o[dt] = MFMA32(vf[dt][1], pb1, o[dt]); }
        }
        if (ntile == 0 && hn && DU_NT(nidx) > 0) DU_LOADKV(nidx, DU_KB0(nidx));
        const float l = half_sum(lrun), mt = (l > 0.f) ? mrun - sS * (float)r32 : -1.0e30f;
        if (MODE != 2) {
            const float il = (l > 0.f) ? __builtin_amdgcn_rcpf(l) : 0.f;
            h16* po = ((MODE == 0) ? PO1 : PO2) + prw * 64; float* pm = ((MODE == 0) ? PM1 : PM2) + prw * 2;
#pragma unroll
            for (int dt = 0; dt < 2; ++dt)
#pragma unroll
                for (int gp = 0; gp < 2; ++gp) { v2u w[2];
#pragma unroll
                    for (int e = 0; e < 2; ++e) { const int g = 2 * gp + e; w[e].x = pk2h(o[dt][4 * g] * il, o[dt][4 * g + 1] * il); w[e].y = pk2h(o[dt][4 * g + 2] * il, o[dt][4 * g + 3] * il); }
                    const auto sx = __builtin_amdgcn_permlane32_swap(w[0].x, w[1].x, false, false), sy = __builtin_amdgcn_permlane32_swap(w[0].y, w[1].y, false, false);
                    *(v4u*)(po + 32 * dt + 16 * gp + 8 * hi) = (v4u){sx[0], sy[0], sx[1], sy[1]}; }
            if (hi == 0) { pm[0] = mt; pm[1] = l; }
        } else {
            const float Mx = fmaxf(pm1, fmaxf(pm2, mt));
            const float w1 = pl1 * ex2(pm1 - Mx), w2 = pl2 * ex2(pm2 - Mx), w3 = ex2(mt - Mx), inv = __builtin_amdgcn_rcpf(w1 + w2 + w3 * l);
            unsigned char* orow = (unsigned char*)O + (size_t)(b * SEQ + tq) * D + 512 + h * 64;
            const float invq = inv * qO;
#pragma unroll
            for (int dt = 0; dt < 2; ++dt)
#pragma unroll
                for (int gp = 0; gp < 2; ++gp) { unsigned w[2];
#pragma unroll
                    for (int e2 = 0; e2 < 2; ++e2) { const int g = 2 * gp + e2; const v2u wa_ = pa8[4 * dt + g], wc_ = pc8[4 * dt + g]; const f32x4 a = {hlo(wa_.x), hhi(wa_.x), hlo(wa_.y), hhi(wa_.y)}, c = {hlo(wc_.x), hhi(wc_.x), hlo(wc_.y), hhi(wc_.y)};
                        float y[4];
#pragma unroll
                        for (int e = 0; e < 4; ++e) y[e] = (w1 * a[e] + w2 * c[e] + w3 * o[dt][4 * g + e]) * invq;
                        w[e2] = pg8::pk4i8(y[0], y[1], y[2], y[3]); }
                    const auto sx = __builtin_amdgcn_permlane32_swap(w[0], w[1], false, false);
                    *(v2u*)(orow + 32 * dt + 16 * gp + 8 * hi) = (v2u){sx[0], sx[1]}; }
        }
        if (!hn) break;
        idx = nidx;
    }
#undef DU_BH
#undef DU_RR
#undef DU_QB
#undef DU_KB0
#undef DU_NT
#undef DU_LOADQ
#undef DU_LOADKV
}

struct RowLn { f32x4 n[4]; };
__device__ __forceinline__ void ln_rows(f32x4 (&v)[4], const float* lg, const float* lb, int lane) {
    float s = 0.f;
#pragma unroll
    for (int j = 0; j < 4; ++j) s += (v[j][0] + v[j][1]) + (v[j][2] + v[j][3]);
    const float mean = wave_sum(s) * (1.0f / D); float s2 = 0.f;
#pragma unroll
    for (int j = 0; j < 4; ++j) { v[j] = v[j] - mean; s2 += (v[j][0] * v[j][0] + v[j][1] * v[j][1]) + (v[j][2] * v[j][2] + v[j][3] * v[j][3]); }
    const float rstd = 1.0f / sqrtf(wave_sum(s2) * (1.0f / D) + LN_EPS);
#pragma unroll
    for (int j = 0; j < 4; ++j) { const int col = 4 * lane + 256 * j; v[j] = v[j] * rstd * *(const f32x4*)(lg + col) + *(const f32x4*)(lb + col); }
}
struct RowIn { f32x4 x[4]; v2u hx[4]; v2u y[4]; };
template <bool XF32, bool Y8 = false> __device__ __forceinline__ void row_load(RowIn& r, const float* xin, const h16* hin, const h16* y, int lane) {
#pragma unroll
    for (int j = 0; j < 4; ++j) { const int col = 4 * lane + 256 * j; if (XF32) r.x[j] = __builtin_nontemporal_load((const f32x4*)(xin + col)); else r.hx[j] = __builtin_nontemporal_load((const v2u*)(hin + col));
        if (Y8) r.y[j].x = __builtin_nontemporal_load((const unsigned*)((const unsigned char*)y + col)); else r.y[j] = __builtin_nontemporal_load((const v2u*)(y + col)); }
}
__device__ __forceinline__ f32x4 cvt4(v2u w) { return (f32x4){hlo(w.x), hhi(w.x), hlo(w.y), hhi(w.y)}; }
typedef float f32x2r __attribute__((ext_vector_type(2)));
__device__ __forceinline__ f32x4 cvt4f8(unsigned w) { const f32x2r lo = __builtin_amdgcn_cvt_pk_f32_fp8((int)w, false), hi = __builtin_amdgcn_cvt_pk_f32_fp8((int)w, true); return (f32x4){lo[0], lo[1], hi[0], hi[1]}; }
struct RowVec { f32x4 rdiv[4], psh[4], gate1[4], lg[4], lb[4], sc1[4], sh[4]; };
template <bool XF32> __device__ __forceinline__ void rowvec_load(RowVec& q, const float* psc, const float* psh, const float* gate, const float* lg, const float* lb, const float* sc, const float* sh, int lane) {
#pragma unroll
    for (int j = 0; j < 4; ++j) { const int col = 4 * lane + 256 * j;
        if (!XF32) { const f32x4 d = 1.0f + *(const f32x4*)(psc + col); q.rdiv[j] = (f32x4){__builtin_amdgcn_rcpf(d[0]), __builtin_amdgcn_rcpf(d[1]), __builtin_amdgcn_rcpf(d[2]), __builtin_amdgcn_rcpf(d[3])}; q.psh[j] = *(const f32x4*)(psh + col); }
        q.gate1[j] = 1.0f + *(const f32x4*)(gate + col); q.lg[j] = *(const f32x4*)(lg + col); q.lb[j] = *(const f32x4*)(lb + col);
        q.sc1[j] = 1.0f + *(const f32x4*)(sc + col); q.sh[j] = *(const f32x4*)(sh + col); }
}
__device__ __forceinline__ void ln_rows_v(f32x4 (&v)[4], const RowVec& q) {
    float s = 0.f, s2 = 0.f;
#pragma unroll
    for (int j = 0; j < 4; ++j) { s += (v[j][0] + v[j][1]) + (v[j][2] + v[j][3]); s2 += (v[j][0] * v[j][0] + v[j][1] * v[j][1]) + (v[j][2] * v[j][2] + v[j][3] * v[j][3]); }
    float ts, ts2; wave_sum2(s, s2, ts, ts2);
    const float mean = ts * (1.0f / D), var = fmaxf(ts2 * (1.0f / D) - mean * mean, 0.f);
    const float rstd = __builtin_amdgcn_rsqf(var + LN_EPS);
#pragma unroll
    for (int j = 0; j < 4; ++j) v[j] = (v[j] - mean) * rstd * q.lg[j] + q.lb[j];
}
template <bool XF32, bool Y8 = false> __device__ __forceinline__ void row_block(const RowIn& in, const RowVec& q, h16* ho, f32x4 (&hv)[4], int lane, unsigned char* ho8 = nullptr, float* rs8 = nullptr, float y8inv = 1.0f / S8_Y3) {
    f32x4 v[4];
#pragma unroll
    for (int j = 0; j < 4; ++j) { f32x4 xv; if (XF32) xv = in.x[j]; else xv = (cvt4(in.hx[j]) - q.psh[j]) * q.rdiv[j];
        const f32x4 yv = Y8 ? cvt4f8(in.y[j].x) * y8inv : cvt4(in.y[j]);
        v[j] = DN_ALPHA * xv + q.gate1[j] * yv; }
    ln_rows_v(v, q);
#pragma unroll
    for (int j = 0; j < 4; ++j) { const int col = 4 * lane + 256 * j;
        hv[j] = v[j] * q.sc1[j] + q.sh[j];
        v2u o; o.x = pk2h(hv[j][0], hv[j][1]); o.y = pk2h(hv[j][2], hv[j][3]); *(v2u*)(ho + col) = o; }
    if (ho8) { float am = 0.f;
#pragma unroll
        for (int j = 0; j < 4; ++j) am = fmaxf(am, fmaxf(fmaxf(fabsf(hv[j][0]), fabsf(hv[j][1])), fmaxf(fabsf(hv[j][2]), fabsf(hv[j][3]))));
        am = fmaxf(wave_maxd(am), 1e-20f); const float qs = 126.999f * __builtin_amdgcn_rcpf(am), MG = 12582912.0f;
#pragma unroll
        for (int j = 0; j < 4; ++j) { unsigned b[4];
#pragma unroll
            for (int e = 0; e < 4; ++e) b[e] = __builtin_bit_cast(unsigned, hv[j][e] * qs + MG);
            *(unsigned*)(ho8 + 4 * lane + 256 * j) = __builtin_amdgcn_perm(__builtin_amdgcn_perm(b[3], b[2], 0x0c0c0400u), __builtin_amdgcn_perm(b[1], b[0], 0x0c0c0400u), 0x05040100u); }
        if (lane == 0) *rs8 = am * (1.0f / 127.0f); }
}
template <bool XF32, bool Y8 = false, int NR = 4> __device__ __forceinline__ void ph_rows(Frame& F, const float* xin, const h16* HIN, const float* psc, const float* psh, const h16* Y, const float* modl_gate  ,
                                        const float* lg, const float* lb, const float* mod_sc, const float* mod_sh, h16* HO, unsigned char* HO8 = nullptr, float* RS8 = nullptr, float y8inv = 1.0f) {
    const int gw = F.vcu * NWAVES + F.wave, WPB = F.G;
    const int b = gw / WPB, r0 = gw % WPB; const size_t bo = (size_t)b * (6 * D);
    RowVec q; rowvec_load<XF32>(q, psc + bo, psh + bo, modl_gate + bo, lg, lb, mod_sc + bo, mod_sh + bo, F.lane);
    for (int t0 = r0; t0 < SEQ; t0 += NR * WPB) {
        RowIn r[NR];
#pragma unroll
        for (int i = 0; i < NR; ++i) { const int t = t0 + i * WPB; if (t < SEQ) { const size_t m = (size_t)b * SEQ + t; row_load<XF32, Y8>(r[i], xin + m * D, HIN + m * D, Y8 ? (const h16*)((const unsigned char*)Y + m * D) : Y + m * D, F.lane); } }
#pragma unroll
        for (int i = 0; i < NR; ++i) { const int t = t0 + i * WPB; if (t < SEQ) { const size_t m = (size_t)b * SEQ + t; f32x4 hv[4];
            row_block<XF32, Y8>(r[i], q, HO + m * D, hv, F.lane, HO8 ? HO8 + m * D : nullptr, RS8 + m, y8inv); } }
    }
}

__device__ __forceinline__ void ph10_ssm_naive(Frame& F) {
    const h16* U = (const h16*)(F.ws + WS_B); h16* GY = (h16*)(F.ws + WS_C);
    const float* SA = (const float*)(F.ws + WS_SSMA); const float* SB = (const float*)(F.ws + WS_SSMB);
    const int gw = F.vcu * NWAVES + F.wave, NGW = F.G * NWAVES, lane = F.lane;
    for (int it = gw; it < BATCH * 64; it += NGW) {
        const int b = it >> 6, g = it & 63, gp = g * 64 + lane;
        const float abr = SA[gp * 2], abi = SA[gp * 2 + 1];
        float bbr[16], bbi[16], cr[16], ci[16];
#pragma unroll
        for (int c = 0; c < 16; ++c) { bbr[c] = SB[(gp * 16 + c) * 2]; bbi[c] = SB[(gp * 16 + c) * 2 + 1]; cr[c] = F.in[I_CRE][(g * 16 + c) * 64 + lane]; ci[c] = F.in[I_CIM][(g * 16 + c) * 64 + lane]; }
        const float dsk = F.in[I_DSKIP][g * 16 + (lane & 15)];
        float hr = 0.f, hi = 0.f;
        for (int t = 0; t < SEQ; ++t) {
            const h16* ur = U + (size_t)(b * SEQ + t) * D + g * 16;
            float u[16]; ld8h(ur, u); ld8h(ur + 8, u + 8);
            float xr = 0.f, xi = 0.f;
#pragma unroll
            for (int c = 0; c < 16; ++c) { xr += bbr[c] * u[c]; xi += bbi[c] * u[c]; }
            const float nhr = abr * hr - abi * hi + xr, nhi = abr * hi + abi * hr + xi; hr = nhr; hi = nhi;
            float mine = 0.f;
#pragma unroll
            for (int c = 0; c < 16; ++c) { const float yc = wave_sum(cr[c] * hr - ci[c] * hi); if (lane == c) mine = yc; }
            if (lane < 16) { const float val = mine + dsk * h2f(ur[lane]); GY[(size_t)(b * SEQ + t) * D + g * 16 + lane] = (h16)(pk2h(gelu_tanh(val), 0.f) & 0xffffu); }
        }
    }
}


__device__ __forceinline__ void ssm_prep(Frame& F) {
    typedef float f32x2v __attribute__((ext_vector_type(2)));
    const float* SA = (const float*)(F.ws + WS_SSMA); const float* SB = (const float*)(F.ws + WS_SSMB);
    LAS f32x2v* PW = (LAS f32x2v*)(F.lds + RING_OFF);
    LAS f32x2v* BB = (LAS f32x2v*)(F.lds + RING_OFF + 16384);
    LAS f32x2v* CC = (LAS f32x2v*)(F.lds + RING_OFF + 32768);
    LAS float* KL = (LAS float*)(F.lds + RING_OFF + 49152);
    const int tid = F.tid;
    LAS int* tsk = (LAS int*)(F.lds + RING_OFF + 65536);
    for (;;) {
        if (tid == 0) *tsk = (int)__hip_atomic_fetch_add(F.ctl + CW_PREP, 1u, RLX_AGENT);
        __syncthreads();
        const int task = *tsk;
        __syncthreads();
        if (task >= 256) break;
        const int g = task >> 2, part = task & 3;
        const float idt = 1.0f / expf(F.in[I_LOGDT][g]);
        if (tid < 64) { float pr = 1.0f, pi = 0.0f; const float ar = SA[(g * 64 + tid) * 2], ai = SA[(g * 64 + tid) * 2 + 1];
            for (int k = 0; k <= 16; ++k) { PW[k * 64 + tid] = (f32x2v){pr, pi}; const float nr = pr * ar - pi * ai, ni = pr * ai + pi * ar; pr = nr; pi = ni; } }
        for (int e = tid; e < 1024; e += NWAVES * 64) { BB[e] = (f32x2v){SB[(g * 1024 + e) * 2] * idt, SB[(g * 1024 + e) * 2 + 1] * idt};
            CC[e] = (f32x2v){F.in[I_CRE][g * 1024 + e], F.in[I_CIM][g * 1024 + e]}; }
        __syncthreads();
        h16* base = (h16*)((unsigned char*)F.out + 100 * MiB) + (size_t)g * 131072;
        if (part == 0) {
            for (int q = tid; q < 64 * 64; q += NWAVES * 64) { const int f = q >> 6, l = q & 63, rt = f >> 4, t = f & 15, r32 = l & 31, hi = l >> 5, p = 16 * rt + (r32 & 15), im = r32 >> 4;
                const f32x2v a = PW[(15 - t) * 64 + p]; hf8 v;
#pragma unroll
                for (int j = 0; j < 8; ++j) { const f32x2v bb = BB[p * 16 + 8 * hi + j]; v[j] = (_Float16)(im ? (a.x * bb.y + a.y * bb.x) : (a.x * bb.x - a.y * bb.y)); }
                *(v4u*)(base + (size_t)q * 8) = __builtin_bit_cast(v4u, v); }
        } else if (part == 1) {
            for (int q = tid; q < 64 * 64; q += NWAVES * 64) { const int f = q >> 6, l = q & 63, rtY = f >> 3, q8 = f & 7, rt = q8 >> 1, sIm = q8 & 1, r32 = l & 31, hi = l >> 5;
                const int t = 2 * rtY + (r32 >> 4), c = r32 & 15; hf8 v;
#pragma unroll
                for (int j = 0; j < 8; ++j) { const int p = 16 * rt + (j & 3) + 8 * (j >> 2) + 4 * hi; const f32x2v a = PW[(t + 1) * 64 + p], cc = CC[c * 64 + p];
                    const float zr = cc.x * a.x - cc.y * a.y, zi = cc.x * a.y + cc.y * a.x; v[j] = (_Float16)(sIm ? -zi : zr); }
                *(v4u*)(base + 32768 + (size_t)q * 8) = __builtin_bit_cast(v4u, v); }
        } else {
            { const int L = tid >> 5, c = (tid >> 1) & 15, c20 = (tid & 1) * 8; float acc8[8];
#pragma unroll
                for (int j = 0; j < 8; ++j) acc8[j] = 0.f;
                for (int p = 0; p < 64; ++p) { const f32x2v a = PW[L * 64 + p], cc = CC[c * 64 + p];
                    const float zr = cc.x * a.x - cc.y * a.y, zi = cc.x * a.y + cc.y * a.x;
#pragma unroll
                    for (int j = 0; j < 8; ++j) { const f32x2v bb = BB[p * 16 + c20 + j]; acc8[j] += zr * bb.x - zi * bb.y; } }
#pragma unroll
                for (int j = 0; j < 8; ++j) KL[L * 256 + c * 16 + c20 + j] = acc8[j]; }
            __syncthreads();
            const int q0 = (part - 2) * 4096;
            for (int q = q0 + tid; q < q0 + 4096; q += NWAVES * 64) { const int f = q >> 6, l = q & 63, rtY = f >> 4, s = f & 15, r32 = l & 31, hi = l >> 5;
                const int t = 2 * rtY + (r32 >> 4), c = r32 & 15, L = t - s; hf8 v;
#pragma unroll
                for (int j = 0; j < 8; ++j) v[j] = (_Float16)((L >= 0) ? KL[(L & 15) * 256 + c * 16 + 8 * hi + j] : 0.f);
                *(v4u*)(base + 65536 + (size_t)q * 8) = __builtin_bit_cast(v4u, v); }
        }
        __syncthreads();
    }
}
__device__ __forceinline__ void ph10_ssm_mfma(Frame& F) {
    const h16* U = (const h16*)(F.ws + WS_B); h16* GY = (h16*)(F.ws + WS_C);
    const float* SA = (const float*)(F.ws + WS_SSMA);
    typedef float f32x2v __attribute__((ext_vector_type(2)));
    LAS f32x2v* SL = (LAS f32x2v*)(F.lds + RING_OFF);
    LAS unsigned char* OPL = F.lds + RING_OFF;
    int tid_ = F.tid; asm volatile("" : "+v"(tid_));
    const int tid = tid_, lane = tid & 63, r32 = lane & 31, hi = lane >> 5, wave = F.wave;
    for (int unit = F.vcu; unit < BATCH * 64; unit += F.G) {
        const int b = unit >> 6, g = unit & 63;
        const float dt = expf(F.in[I_LOGDT][g]);
        const h16* MW1 = (const h16*)((const unsigned char*)F.out + 100 * MiB) + (size_t)g * 131072; const h16* MG = MW1 + 32768; const h16* MT = MW1 + 65536;
        const int ch = 32 * wave + r32;
        const h16* urow = U + (size_t)(b * SEQ + 16 * ch) * D + g * 16;
        { v4u w1[8];
#pragma unroll
            for (int i = 0; i < 8; ++i) w1[i] = *(const v4u*)(MW1 + (size_t)(i * 512 + tid) * 8);
#pragma unroll
            for (int i = 0; i < 8; ++i) *(LAS v4u*)(OPL + (size_t)(i * 512 + tid) * 16) = w1[i]; }
        __builtin_amdgcn_sched_barrier(0);
        hf8 ub[16];
#pragma unroll
        for (int t = 0; t < 16; ++t) ub[t] = ldf8(urow + (size_t)t * D + 8 * hi);
        __syncthreads();
        f32x16 acc[4];
#pragma unroll
        for (int rt = 0; rt < 4; ++rt)
#pragma unroll
            for (int r = 0; r < 16; ++r) acc[rt][r] = 0.f;
#pragma unroll
        for (int t = 0; t < 16; ++t)
        {
#pragma unroll
            for (int rt = 0; rt < 4; ++rt) acc[rt] = MFMA32(__builtin_bit_cast(hf8, *(const LAS v4u*)(OPL + (rt * 16 + t) * 1024 + lane * 16)), ub[t], acc[rt]);
            if ((t & 3) == 3) __builtin_amdgcn_sched_barrier(0); }
        __syncthreads();
#pragma unroll
        for (int rt = 0; rt < 4; ++rt)
#pragma unroll
            for (int r = 0; r < 8; ++r) { const int p = 16 * rt + (r & 3) + 8 * (r >> 2) + 4 * hi; SL[p * 257 + ch] = (f32x2v){acc[rt][r], acc[rt][r + 8]}; }
        __syncthreads();
        {
            const int p = tid & 63, sg = tid >> 6;
            float pr = SA[(g * 64 + p) * 2], pi = SA[(g * 64 + p) * 2 + 1];
#pragma unroll
            for (int q = 0; q < 4; ++q) { const float nr = pr * pr - pi * pi, ni = 2.0f * pr * pi; pr = nr; pi = ni; }
            const float aLr = pr, aLi = pi;
            float xr = 0.f, xi = 0.f;
            for (int j0 = 0; j0 < 32; j0 += 8) { f32x2v sv[8];
#pragma unroll
                for (int j = 0; j < 8; ++j) sv[j] = SL[p * 257 + 32 * sg + j0 + j];
#pragma unroll
                for (int j = 0; j < 8; ++j) { const float nr = aLr * xr - aLi * xi + sv[j].x, ni = aLr * xi + aLi * xr + sv[j].y; xr = nr; xi = ni; sv[j] = (f32x2v){xr, xi}; }
#pragma unroll
                for (int j = 0; j < 8; ++j) SL[p * 257 + 32 * sg + j0 + j] = sv[j]; }
#pragma unroll
            for (int q = 0; q < 5; ++q) { const float nr = pr * pr - pi * pi, ni = 2.0f * pr * pi; pr = nr; pi = ni; }
            __syncthreads();
            float cr = 0.f, ci = 0.f;
            for (int s2 = 0; s2 < sg; ++s2) { const int c2 = 32 * s2 + 31; const f32x2v ag = SL[p * 257 + c2];
                const float nr = pr * cr - pi * ci + ag.x, ni = pr * ci + pi * cr + ag.y; cr = nr; ci = ni; }
            __syncthreads();
            float prevr = 0.f, previ = 0.f, wr = 1.0f, wi = 0.0f;
            for (int j0 = 0; j0 < 32; j0 += 8) { f32x2v xv[8];
#pragma unroll
                for (int j = 0; j < 8; ++j) xv[j] = SL[p * 257 + 32 * sg + j0 + j];
#pragma unroll
                for (int j = 0; j < 8; ++j) { const f32x2v in = (f32x2v){prevr + wr * cr - wi * ci, previ + wr * ci + wi * cr};
                    prevr = xv[j].x; previ = xv[j].y; xv[j] = in; const float nr = wr * aLr - wi * aLi, ni = wr * aLi + wi * aLr; wr = nr; wi = ni; }
#pragma unroll
                for (int j = 0; j < 8; ++j) SL[p * 257 + 32 * sg + j0 + j] = xv[j]; }
        }
        __syncthreads();
        v4u ifw[8];
#pragma unroll
        for (int rt = 0; rt < 4; ++rt) { float re[8], im[8];
#pragma unroll
            for (int j = 0; j < 8; ++j) { const int p = 16 * rt + (j & 3) + 8 * (j >> 2) + 4 * hi; const f32x2v v = SL[p * 257 + ch]; re[j] = v.x; im[j] = v.y; }
            v4u w0, w1; w0.x = pk2h(re[0], re[1]); w0.y = pk2h(re[2], re[3]); w0.z = pk2h(re[4], re[5]); w0.w = pk2h(re[6], re[7]);
            w1.x = pk2h(im[0], im[1]); w1.y = pk2h(im[2], im[3]); w1.z = pk2h(im[4], im[5]); w1.w = pk2h(im[6], im[7]);
            ifw[2 * rt] = w0; ifw[2 * rt + 1] = w1; }
        LAS v4u* IFL = (LAS v4u*)(OPL + 49152 + wave * 8192);
        const f32x4 dk0 = *(const f32x4*)(F.in[I_DSKIP] + g * 16 + 4 * hi), dk1 = *(const f32x4*)(F.in[I_DSKIP] + g * 16 + 8 + 4 * hi);
        unsigned char* yrow = (unsigned char*)GY + (size_t)(b * SEQ + 16 * ch) * D + g * 16;
        v4u pg, pt0, pt1;
        pg = *(const v4u*)(MG + (size_t)tid * 8); pt0 = *(const v4u*)(MT + (size_t)tid * 8); pt1 = pt0;
        __syncthreads();
#pragma unroll
        for (int q = 0; q < 8; ++q) IFL[q * 64 + lane] = ifw[q];
        *(LAS v4u*)(OPL + tid * 16) = pg; if (tid < 128) *(LAS v4u*)(OPL + 8192 + tid * 16) = pt0;
        __syncthreads();
#pragma unroll
        for (int rtY = 0; rtY < 8; ++rtY) {
            LAS unsigned char* cur = OPL + (rtY & 1) * 24576;
            if (rtY < 7) { const int nT = (2 * (rtY + 1) + 2) * 64;
                pg = *(const v4u*)(MG + (size_t)((rtY + 1) * 8 * 64 + tid) * 8);
                if (tid < nT) pt0 = *(const v4u*)(MT + (size_t)((rtY + 1) * 16 * 64 + tid) * 8);
                if (tid + 512 < nT) pt1 = *(const v4u*)(MT + (size_t)((rtY + 1) * 16 * 64 + tid + 512) * 8); }
            f32x16 y0, y1;
#pragma unroll
            for (int r = 0; r < 16; ++r) { y0[r] = 0.f; y1[r] = 0.f; }
#pragma unroll
            for (int q = 0; q < 8; ++q) { const hf8 af = __builtin_bit_cast(hf8, *(const LAS v4u*)(cur + q * 1024 + lane * 16)); const hf8 bf = __builtin_bit_cast(hf8, IFL[q * 64 + lane]); if (q & 1) y1 = MFMA32(af, bf, y1); else y0 = MFMA32(af, bf, y0); }
#pragma unroll
            for (int s2 = 0; s2 <= 2 * rtY + 1; ++s2) { const hf8 af = __builtin_bit_cast(hf8, *(const LAS v4u*)(cur + 8192 + s2 * 1024 + lane * 16)); if (s2 & 1) y1 = MFMA32(af, ub[s2], y1); else y0 = MFMA32(af, ub[s2], y0); }
#pragma unroll
            for (int tt = 0; tt < 2; ++tt) { const size_t ro = (size_t)(2 * rtY + tt) * D;
                const v4u uw = __builtin_bit_cast(v4u, ub[2 * rtY + tt]);
                const auto sw0 = __builtin_amdgcn_permlane32_swap(uw.x, uw.z, false, false), sw1 = __builtin_amdgcn_permlane32_swap(uw.y, uw.w, false, false);
                const f32x4 u0 = {hlo(sw0[0]), hhi(sw0[0]), hlo(sw1[0]), hhi(sw1[0])}, u1 = {hlo(sw0[1]), hhi(sw0[1]), hlo(sw1[1]), hhi(sw1[1])};
                float yv[8];
#pragma unroll
                for (int e = 0; e < 8; ++e) yv[e] = (y0[8 * tt + e] + y1[8 * tt + e]) * dt;
                const unsigned w0 = pg8::pk4f8(S8_GY * gelu_tanh(yv[0] + dk0[0] * u0[0]), S8_GY * gelu_tanh(yv[1] + dk0[1] * u0[1]), S8_GY * gelu_tanh(yv[2] + dk0[2] * u0[2]), S8_GY * gelu_tanh(yv[3] + dk0[3] * u0[3]));
                const unsigned w1 = pg8::pk4f8(S8_GY * gelu_tanh(yv[4] + dk1[0] * u1[0]), S8_GY * gelu_tanh(yv[5] + dk1[1] * u1[1]), S8_GY * gelu_tanh(yv[6] + dk1[2] * u1[2]), S8_GY * gelu_tanh(yv[7] + dk1[3] * u1[3]));
                const auto sx = __builtin_amdgcn_permlane32_swap(w0, w1, false, false);
                *(v2u*)(yrow + ro + 8 * hi) = (v2u){sx[0], sx[1]}; }
            if (rtY < 7) { const int nT = (2 * (rtY + 1) + 2) * 64; LAS unsigned char* nxt = OPL + ((rtY + 1) & 1) * 24576;
                *(LAS v4u*)(nxt + tid * 16) = pg;
                if (tid < nT) *(LAS v4u*)(nxt + 8192 + tid * 16) = pt0;
                if (tid + 512 < nT) *(LAS v4u*)(nxt + 8192 + (tid + 512) * 16) = pt1; }
            __syncthreads();
        }
    }
}

__device__ __forceinline__ void ph12_rows_route(Frame& F) {
    const int gw = F.vcu * NWAVES + F.wave, NGW = F.G * NWAVES, lane = F.lane;
    const float* mod1 = (const float*)(F.ws + WS_MOD) + (size_t)BATCH * 6 * D;
    const h16* Y3 = (const h16*)(F.ws + WS_A); h16* H16 = (h16*)(F.ws + WS_VT1);
    int* tok_e = (int*)(F.ws + WS_TOKE); float* tok_g = (float*)(F.ws + WS_TOKG);
    LAS int* lrow = (LAS int*)(F.lds + 2048);
    LAS f32x4* RWL = (LAS f32x4*)(F.lds + 4096);
    for (int e = F.tid; e < 2048; e += NWAVES * 64) { const int jih = e >> 6, l = e & 63, j = jih >> 3, i = (jih >> 1) & 3, hf = jih & 1;
        RWL[e] = *(const f32x4*)(F.in[I_RW] + (size_t)(4 * l + 256 * j + i) * 8 + 4 * hf); }
    __syncthreads();
    const f32x4 rb0 = *(const f32x4*)(F.in[I_RB]), rb1 = *(const f32x4*)(F.in[I_RB] + 4);
    const h16* UPREV = (const h16*)(F.ws + WS_B);
    const int WPB = F.G, bq = gw / WPB, r0 = gw % WPB; const size_t bo = (size_t)bq * (6 * D);
    RowVec q; rowvec_load<false>(q, mod1 + bo + 1 * D, mod1 + bo, mod1 + bo + 2 * D, F.in[I_LN1G1], F.in[I_LN1B1], mod1 + bo + 4 * D, mod1 + bo + 3 * D, lane);
    for (int t00 = r0; t00 < SEQ; t00 += NR_12 * WPB) {
        RowIn rr4[NR_12];
#pragma unroll
        for (int i4 = 0; i4 < NR_12; ++i4) { const int t = t00 + i4 * WPB; if (t < SEQ) { const int m = bq * SEQ + t;
            row_load<false, true>(rr4[i4], nullptr, UPREV + (size_t)m * D, (const h16*)((const unsigned char*)Y3 + (size_t)m * D), lane); } }
#pragma unroll
        for (int i4 = 0; i4 < NR_12; ++i4) { const int t0 = t00 + i4 * WPB; if (t0 >= SEQ) continue; const int m = bq * SEQ + t0;
        const RowIn& rr1 = rr4[i4];
        f32x4 hv[4];
        row_block<false, true>(rr1, q, H16 + (size_t)m * D, hv, lane, F.ws + WS_C + (size_t)m * D, (float*)(F.ws + WS_TAMAX) + m);
        f32x4 a0 = {0.f, 0.f, 0.f, 0.f}, a1 = a0;
#pragma unroll
        for (int j = 0; j < 4; ++j)
#pragma unroll
            for (int i = 0; i < 4; ++i) { a0 += hv[j][i] * RWL[((j * 4 + i) * 2 + 0) * 64 + lane]; a1 += hv[j][i] * RWL[((j * 4 + i) * 2 + 1) * 64 + lane]; }
        float lg[8];
        { const float pp[8] = {a0[0], a0[1], a0[2], a0[3], a1[0], a1[1], a1[2], a1[3]}; wave_sum8(pp, lg); }
#pragma unroll
        for (int e = 0; e < 4; ++e) { lg[e] += rb0[e]; lg[4 + e] += rb1[e]; }
        int e1 = 0; float v1 = lg[0];
#pragma unroll
        for (int e = 1; e < 8; ++e) if (lg[e] > v1) { v1 = lg[e]; e1 = e; }
        int e2 = -1; float v2 = -INFINITY;
#pragma unroll
        for (int e = 0; e < 8; ++e) if (e != e1 && lg[e] > v2) { v2 = lg[e]; e2 = e; }
        const float g1 = __builtin_amdgcn_rcpf(1.0f + __builtin_amdgcn_exp2f((v2 - v1) * LOG2E)), g2 = 1.0f - g1;
        if (lane == 0) { tok_e[2 * m] = e1; tok_e[2 * m + 1] = e2; tok_g[2 * m] = g1; tok_g[2 * m + 1] = g2;
            const int ri = F.wave * 16 + ((t00 - r0) / WPB) + i4; lrow[ri] = m; lrow[128 + ri] = e1; lrow[256 + ri] = e2; }
        }
    }
    __syncthreads();
    {
        const int wave = F.wave; const bool own = lane < 16; const int ri = wave * 16 + (lane & 15);
        const int m = own ? lrow[ri] : 0, ea = own ? lrow[128 + ri] : -1, eb = own ? lrow[256 + ri] : -1;
        const float rsm = own ? ((const float*)(F.ws + WS_TAMAX))[m] : 0.f;
        const unsigned long long below = (lane == 0) ? 0ull : (~0ull >> (64 - lane));
        int ra = 0, rb = 0, mycnt = 0;
#pragma unroll
        for (int e = 0; e < 8; ++e) {
            const unsigned long long ma = __ballot(ea == e), mb = __ballot(eb == e);
            const int ca = __popcll(ma), cb = __popcll(mb);
            if (lane == e) mycnt = ca + cb;
            if (ea == e) ra = __popcll(ma & below);
            if (eb == e) rb = ca + __popcll(mb & below);
        }
        LAS unsigned* cntl = (LAS unsigned*)(F.lds + 1024);
        if (lane < 8) cntl[wave * 8 + lane] = (unsigned)mycnt;
        __syncthreads();
        if (wave == 0 && lane < 8) { unsigned tot = 0u;
#pragma unroll
            for (int w2 = 0; w2 < 8; ++w2) tot += cntl[w2 * 8 + lane];
            cntl[64 + lane] = tot ? __hip_atomic_fetch_add(F.ctl + CW_ECNT + lane, tot, RLX_AGENT) : 0u; }
        __syncthreads();
        int bs = 0;
        if (lane < 8) { bs = (int)cntl[64 + lane]; for (int w2 = 0; w2 < wave; ++w2) bs += (int)cntl[w2 * 8 + lane]; }
        const int ia = __shfl(bs, ea & 7) + ra, ib = __shfl(bs, eb & 7) + rb;
        if (own) { int* tok_p = (int*)(F.ws + WS_TOKP); int* rowlist = (int*)(F.ws + WS_ROWL); float* rsg = (float*)(F.ws + WS_RSGL);
            tok_p[2 * m] = ia; tok_p[2 * m + 1] = ib; rowlist[ea * LCAP + ia] = m; rowlist[eb * LCAP + ib] = m; rsg[ea * LCAP + ia] = rsm; rsg[eb * LCAP + ib] = rsm; }
    }
}
__device__ __forceinline__ void moe_prefix(Frame& F, int (&tp)[9]) {
    int acc = 0;
#pragma unroll
    for (int e = 0; e < 8; ++e) { tp[e] = acc; const unsigned c = __hip_atomic_load(F.ctl + CW_ECNT + e, RLX_AGENT); acc += (int)((c + 255u) >> 8); }
    tp[8] = acc;
}
__device__ __forceinline__ unsigned i8of4h(unsigned w0, unsigned w1, float qs) { return pg8::pk4i8(hlo(w0) * qs, hhi(w0) * qs, hlo(w1) * qs, hhi(w1) * qs); }
__device__ __forceinline__ void ph13_gather(Frame& F) {
    const int lane = F.lane, wave = F.wave;
    int tp[9]; moe_prefix(F, tp);
    const int* tok_e = (const int*)(F.ws + WS_TOKE); int* tok_p = (int*)(F.ws + WS_TOKP);
    int* rowlist = (int*)(F.ws + WS_ROWL); float* rsg = (float*)(F.ws + WS_RSG); const float* rsq = (const float*)(F.ws + WS_TAMAX);
    LAS unsigned* cntl = (LAS unsigned*)(F.lds + 2048);
    for (int bb = F.vcu * 128; bb < M; bb += F.G * 128) {
        const int base = bb + wave * 16;
        const bool own = lane < 16; const int m = base + (lane & 15);
        const int ea = own ? tok_e[2 * m] : -1, eb = own ? tok_e[2 * m + 1] : -1;
        const float rsm = own ? rsq[m] : 0.f;
        const unsigned long long below = (lane == 0) ? 0ull : (~0ull >> (64 - lane));
        int ra = 0, rb = 0, mycnt = 0;
#pragma unroll
        for (int e = 0; e < 8; ++e) {
            const unsigned long long ma = __ballot(ea == e), mb = __ballot(eb == e);
            const int ca = __popcll(ma), cb = __popcll(mb);
            if (lane == e) mycnt = ca + cb;
            if (ea == e) ra = __popcll(ma & below);
            if (eb == e) rb = ca + __popcll(mb & below);
        }
        if (lane < 8) cntl[wave * 8 + lane] = (unsigned)mycnt;
        __syncthreads();
        if (wave == 0 && lane < 8) { unsigned tot = 0u;
#pragma unroll
            for (int w2 = 0; w2 < 8; ++w2) tot += cntl[w2 * 8 + lane];
            cntl[64 + lane] = tot ? __hip_atomic_fetch_add(F.ctl + CW_ECUR + lane, tot, RLX_AGENT) : 0u; }
        __syncthreads();
        int segbase = 0;
        if (lane < 8) { unsigned bs = cntl[64 + lane];
            for (int w2 = 0; w2 < wave; ++w2) bs += cntl[w2 * 8 + lane];
            int tpl = 0;
#pragma unroll
            for (int e = 0; e < 8; ++e) if (lane == e) tpl = tp[e];
            segbase = tpl * 256 + (int)bs; }
        const int pa = __shfl(segbase, ea & 7) + ra, pb = __shfl(segbase, eb & 7) + rb;
        if (own) { tok_p[2 * m] = pa; tok_p[2 * m + 1] = pb; rowlist[pa] = m; rowlist[pb] = m; rsg[pa] = rsm; rsg[pb] = rsm; }
        __syncthreads();
    }
    if (F.vcu == 0) {
#pragma unroll
        for (int e = 0; e < 8; ++e) { const int c = (int)__hip_atomic_load(F.ctl + CW_ECNT + e, RLX_AGENT), p0 = tp[e] * 256 + c, p1 = tp[e + 1] * 256;
            for (int p_ = p0 + F.tid; p_ < p1; p_ += NWAVES * 64) rowlist[p_] = 0; }
    }
}
__device__ __forceinline__ void ph16_final(Frame& F) {
    const int gw = F.vcu * NWAVES + F.wave, NGW = F.G * NWAVES, lane = F.lane;
    const float* mod1 = (const float*)(F.ws + WS_MOD) + (size_t)BATCH * 6 * D;
    const int* tok_p = (const int*)(F.ws + WS_TOKP); const float* tok_g = (const float*)(F.ws + WS_TOKG); const int* tok_e = (const int*)(F.ws + WS_TOKE);
    int tp[9]; moe_prefix(F, tp);
    const unsigned char* YG = F.ws + WS_B;
    const h16* H16 = (const h16*)(F.ws + WS_VT1);
    struct Row16 { v2u x[4]; unsigned a[4], c[4]; float w1, w2; };
    auto load16 = [&](Row16& r, int m) {
        const int e1 = tok_e[2 * m], e2 = tok_e[2 * m + 1]; int t1 = 0, t2 = 0;
#pragma unroll
        for (int k = 1; k < 8; ++k) { if (e1 >= k) t1 = tp[k]; if (e2 >= k) t2 = tp[k]; }
        const int p1 = t1 * 256 + tok_p[2 * m], p2 = t2 * 256 + tok_p[2 * m + 1]; r.w1 = tok_g[2 * m]; r.w2 = tok_g[2 * m + 1];
#pragma unroll
        for (int j = 0; j < 4; ++j) { const int col = 4 * lane + 256 * j; r.x[j] = __builtin_nontemporal_load((const v2u*)(H16 + (size_t)m * D + col));
            r.a[j] = __builtin_nontemporal_load((const unsigned*)(YG + (size_t)p1 * D + col)); r.c[j] = __builtin_nontemporal_load((const unsigned*)(YG + (size_t)p2 * D + col)); } };
    const int WPB = F.G, bq = gw / WPB, r0 = gw % WPB; const size_t bo = (size_t)bq * (6 * D);
    RowVec q; rowvec_load<false>(q, mod1 + bo + 4 * D, mod1 + bo + 3 * D, mod1 + bo + 5 * D, F.in[I_LN2G1], F.in[I_LN2B1], mod1 + bo, mod1 + bo, lane);
    for (int t0 = r0; t0 < SEQ; t0 += 4 * WPB) {
        Row16 rw4[4];
#pragma unroll
        for (int i = 0; i < 4; ++i) { const int t = t0 + i * WPB; if (t < SEQ) load16(rw4[i], bq * SEQ + t); }
#pragma unroll
        for (int i = 0; i < 4; ++i) { const int t = t0 + i * WPB; if (t >= SEQ) continue; const int m = bq * SEQ + t; const Row16& cur = rw4[i];
        f32x4 v[4];
#pragma unroll
        for (int j = 0; j < 4; ++j) {
            const f32x4 ya = cvt4f8(cur.a[j]), yc = cvt4f8(cur.c[j]);
            const f32x4 x3 = (cvt4(cur.x[j]) - q.psh[j]) * q.rdiv[j];
            v[j] = DN_ALPHA * x3 + q.gate1[j] * ((cur.w1 * (1.0f / S8_YG)) * ya + (cur.w2 * (1.0f / S8_YG)) * yc); }
        ln_rows_v(v, q);
#pragma unroll
        for (int j = 0; j < 4; ++j) __builtin_nontemporal_store(v[j], (f32x4*)(F.out + (size_t)m * D + 4 * lane + 256 * j));
        }
    }
}

struct Args { const float* in[39]; float* out; unsigned char* ws; int ph_lo, ph_hi; };
__global__ void __launch_bounds__(NWAVES * 64, 2) mk_fwd(Args args) {
    extern __shared__ __attribute__((aligned(16))) unsigned char lds[];
    Frame F;
    F.lds = (LAS unsigned char*)lds;
    F.MISC = (volatile LAS unsigned*)(F.lds + MISC_OFF);
    F.tid = threadIdx.x; F.lane = F.tid & 63; F.wave = __builtin_amdgcn_readfirstlane(F.tid >> 6);
    F.G = gridDim.x; { const int bx = blockIdx.x; F.vcu = (F.G % 8 == 0) ? (bx % 8) * (F.G / 8) + bx / 8 : bx; }
    F.ws = args.ws; F.out = args.out; F.ctl = (gu32*)(args.ws + WS_CTL);
#pragma unroll
    for (int i = 0; i < 39; ++i) F.in[i] = args.in[i];
    for (int u = F.tid; u < (LDS_BYTES - LDSCTL_OFF) / 4; u += NWAVES * 64) ((LAS unsigned*)(F.lds + LDSCTL_OFF))[u] = 0u;
    __syncthreads();
    XcdBarrier bar; bar.bar = (unsigned*)(F.ctl + CW_BAR); bar.x = 0; bar.st = nullptr;
    if (N_LAUNCHES == 1) bar = xcd_barrier_post((unsigned*)(F.ctl + CW_BAR), F.MISC + 8);
    const int lo = args.ph_lo, hi = args.ph_hi;
    unsigned char* ws = args.ws;
    const float* mod0 = (const float*)(ws + WS_MOD); const float* mod1 = mod0 + (size_t)BATCH * 6 * D;
#ifndef PH_MASK
#define PH_MASK 0x1ffff
#endif
#define IN(k) (((PH_MASK >> (k)) & 1) && lo <= (k) && (k) < hi)
#define SEAM(k) do { if (N_LAUNCHES == 1 && IN(k) && IN((k) + 1)) xcd_barrier(bar); } while (0)

    if (IN(0)) { PB(0); ph0_mods(F); SEAM(0); PE(0); }
    if (IN(1)) { PB(1); ph1_prologue(F); SEAM(1); PE(1); }
    if (IN(2)) { PB(2);
        pg8::Gemm g{(const h16*)(ws + WS_B), (const h16*)(ws + WS_W_IN), M, 3 * D, D / 2}; pg8::StaticOrder S; S.init(M, 3 * D, F.G, (int)blockIdx.x, WGM_2);
        pg8::EpiQKV E{(h16*)(ws + WS_A), (h16*)(ws + WS_KA), (h16*)(ws + WS_KB1), (h16*)(ws + WS_KB4), (h16*)(ws + WS_KB16), (unsigned*)(F.ctl + CW_KMAX), QSCALE_A, QSCALE_B,
                      (const float*)(ws + WS_RS0), (const float*)(ws + WS_WSC) + 32};
#ifdef PROBE_EPI_SEL
        pg8::gemm_phase<pg8::EpiQKV, pg8::StaticOrder, true, true, 2>(F.lds + RING_OFF, g, S, E, &F.pt1_);
#else
        pg8::gemm_phase<pg8::EpiQKV, pg8::StaticOrder, true, true, 2>(F.lds + RING_OFF, g, S, E);
#endif
        SEAM(2); PE(2);
    }
    if (IN(4)) { PB(4); ph4_diff_mfma(F); dil_pass<0>(F); dil_pass<1>(F);
        __syncthreads(); ssm_prep(F);
        xcd_barrier(bar); dil_pass<2>(F); SEAM(4); PE(4); }
    if (IN(5)) { PB(5);
        pg8::Gemm g{(const h16*)(ws + WS_B), (const h16*)(ws + WS_W_OUT), M, D, D / 2}; pg8::StaticOrder S; S.init(M, D, F.G, (int)blockIdx.x, WGM_5);
        const float* wsc = (const float*)(ws + WS_WSC) + 32;
        pg8::EpiF16S E{(h16*)(ws + WS_C), D, 4, wsc[24] * wsc[30]};
        pg8::gemm_phase<pg8::EpiF16S, pg8::StaticOrder, true, true, 2>(F.lds + RING_OFF, g, S, E);
        SEAM(5); PE(5);
    }
    if (IN(6)) { PB(6);
        ph_rows<true, false, NR_6>(F, F.in[I_X], (const h16*)(ws + WS_B), mod0, mod0, (const h16*)(ws + WS_C), mod0 + 2 * D, F.in[I_LN1G0], F.in[I_LN1B0], mod0 + 4 * D, mod0 + 3 * D, (h16*)(ws + WS_B), ws + WS_VT1, (float*)(ws + WS_RS2));
        SEAM(6); PE(6);
    }
    if (IN(7)) { PB(7);
        pg8::Gemm g{(const h16*)(ws + WS_VT1), (const h16*)(ws + WS_W_F1), M, 2 * DFF, D / 2}; pg8::StaticOrder S; S.init(M, 2 * DFF, F.G, (int)blockIdx.x, WGM_7);
        const float* wsc = (const float*)(ws + WS_WSC) + 32;
        pg8::EpiGated8<0, false> E{ws + WS_A, DFF, 22, nullptr, 1.0f, S8_HID, (const float*)(ws + WS_RS2), wsc + 6, wsc + 7};
        pg8::gemm_phase<pg8::EpiGated8<0, false>, pg8::StaticOrder, true, true, 2>(F.lds + RING_OFF, g, S, E);
        SEAM(7); PE(7);
    }
    if (IN(8)) { PB(8);
        pg8::Gemm g{(const h16*)(ws + WS_A), (const h16*)(ws + WS_W_F2), M, D, DFF / 2}; pg8::StaticOrder S; S.init(M, D, F.G, (int)blockIdx.x, WGM_8);
        pg8::EpiF8S E{ws + WS_C, D, 4, S8_Y2 / (S8_HID * S8_WF2)};
        pg8::gemm_phase<pg8::EpiF8S, pg8::StaticOrder, true, true, 1>(F.lds + RING_OFF, g, S, E);
        SEAM(8); PE(8);
    }
    if (IN(9)) { PB(9);
        ph_rows<false, true>(F, nullptr, (const h16*)(ws + WS_B), mod0 + 4 * D, mod0 + 3 * D, (const h16*)(ws + WS_C), mod0 + 5 * D, F.in[I_LN2G0], F.in[I_LN2B0], mod1 + 1 * D, mod1 + 0 * D, (h16*)(ws + WS_B), nullptr, nullptr, 1.0f / S8_Y2);
        SEAM(9); PE(9);
    }
    if (IN(10)) { PB(10); ph10_ssm_mfma(F); SEAM(10); PE(10); }
    if (IN(11)) { PB(11);
        pg8::Gemm g{(const h16*)(ws + WS_C), (const h16*)(ws + WS_W_GLU), M, 2 * D, D / 2}; pg8::StaticOrder S; S.init(M, 2 * D, F.G, (int)blockIdx.x, WGM_11);
        pg8::EpiGated8<1, false> E{ws + WS_A, D, 8, F.in[I_BGLU], 1.0f / (S8_GY * S8_WGLU), S8_Y3};
        pg8::gemm_phase<pg8::EpiGated8<1, false>, pg8::StaticOrder, true, true, 1>(F.lds + RING_OFF, g, S, E);
        SEAM(11); PE(11);
    }
    if (IN(12)) { PB(12); ph12_rows_route(F); SEAM(12); PE(12); }
    if (IN(14)) { PB(14);
        pg8::MoeOrder S; moe_prefix(F, S.tp); S.nN = 11; S.G = F.G; S.c = (int)blockIdx.x; S.wgm = WGM_14; S.cap = LCAP;
        pg8::Gemm g{(const h16*)(ws + WS_C), (const h16*)(ws + WS_W_E1), 0, 2 * DFE, D / 2, (const int*)(ws + WS_ROWL), (unsigned)(M - 1)};
        const float* wsc = (const float*)(ws + WS_WSC) + 32;
        pg8::EpiGated8<0, true> E{ws + WS_A, DFE_PAD, 11, nullptr, 1.0f, S8_HID, (const float*)(ws + WS_RSGL), wsc + 8, wsc + 16};
        pg8::gemm_phase<pg8::EpiGated8<0, true>, pg8::MoeOrder, true, true, 2, true>(F.lds + RING_OFF, g, S, E);
        SEAM(14); PE(14);
    }
    if (IN(15)) { PB(15);
        pg8::MoeOrder S; moe_prefix(F, S.tp); S.nN = 4; S.G = F.G; S.c = (int)blockIdx.x; S.wgm = WGM_15;
        pg8::Gemm g{(const h16*)(ws + WS_A), (const h16*)(ws + WS_W_E2), 0, D, DFE_PAD / 2};
        pg8::EpiF8S E{ws + WS_B, D, 4, S8_YG / (S8_HID * S8_WE2)};
        pg8::gemm_phase<pg8::EpiF8S, pg8::MoeOrder, true, true, 1>(F.lds + RING_OFF, g, S, E);
        SEAM(15); PE(15);
    }
    if (IN(16)) { PB(16); ph16_final(F); PE(16); }
#ifdef PROBE_PH
    { const unsigned long long tgt = 9ull * (F.pt1_ - F.pt0_), ts = __builtin_amdgcn_s_memtime(); while (__builtin_amdgcn_s_memtime() - ts < tgt) __builtin_amdgcn_s_sleep(8); }
#endif
#undef IN
#undef SEAM
}

extern "C" void kernel_launch(void* const* d_in, const int* in_sizes, int n_in, void* d_out, int out_size, void* d_ws, size_t ws_size, hipStream_t stream) {
    static int grid = 0;
    if (grid == 0) {
        if (n_in != 39 || in_sizes[0] != M * D || out_size != M * D || ws_size < WS_END) { fprintf(stderr, "kernel_launch: unexpected problem shape (n_in %d, in0 %d, out %d, ws %zu)\n", n_in, n_in > 0 ? in_sizes[0] : -1, out_size, ws_size); grid = -1; return; }
        int dev = 0, cus = 0, per_cu = 0;
        if (hipGetDevice(&dev) != hipSuccess || hipDeviceGetAttribute(&cus, hipDeviceAttributeMultiprocessorCount, dev) != hipSuccess) { grid = -1; return; }
        if (hipFuncSetAttribute((const void*)mk_fwd, hipFuncAttributeMaxDynamicSharedMemorySize, LDS_BYTES) != hipSuccess) { fprintf(stderr, "kernel_launch: hipFuncSetAttribute failed\n"); grid = -1; return; }
        if (hipOccupancyMaxActiveBlocksPerMultiprocessor(&per_cu, (const void*)mk_fwd, NWAVES * 64, LDS_BYTES) != hipSuccess || per_cu < 1) { fprintf(stderr, "kernel_launch: occupancy query says %d\n", per_cu); }
        (void)hipGetLastError();
        grid = cus;
    }
    if (grid < 0) return;
    if (hipMemsetAsync((char*)d_ws + WS_CTL, 0, CTL_ZERO_BYTES, stream) != hipSuccess) return;
    Args a{};
    for (int i = 0; i < 39; ++i) a.in[i] = (const float*)d_in[i];
    a.out = (float*)d_out; a.ws = (unsigned char*)d_ws;
    for (int li = 0; li < N_LAUNCHES; ++li) {
        a.ph_lo = (N_LAUNCHES == 1) ? 0 : li; a.ph_hi = (N_LAUNCHES == 1) ? NPH : li + 1;
        hipLaunchKernelGGL(mk_fwd, dim3(grid), dim3(NWAVES * 64), LDS_BYTES, stream, a);
        if (hipPeekAtLastError() != hipSuccess) { fprintf(stderr, "kernel_launch: launch %d failed\n", li); break; }
    }
}
```
